# Optimizing an MI355X kernel written in HIP

```python
import jax
import jax.numpy as jnp
from jax import lax
import numpy as np


D_MODEL = 1024
BATCH = 4
SEQ = 8192
DEPTH = 1

N_META = 16
ATT_HEADS = 8
ATT_KV_HEADS = 2
HEAD_DIM = 64
ATT_GROUP = ATT_HEADS // ATT_KV_HEADS
WINDOW = 128
BLOCK = 128
ROPE_THETA = 500000.0
ROT_DIM = HEAD_DIM // 4
ATT_Q = ATT_HEADS * HEAD_DIM
ATT_KV = ATT_KV_HEADS * HEAD_DIM
MASK_VALUE = -1e30
RWKV_HEADS = 8
RWKV_HEAD = 64
RWKV_WIDTH = RWKV_HEADS * RWKV_HEAD
DECAY_LORA = 64
AAA_LORA = 64
GATE_LORA = 128
GN_EPS = 64e-5
RWKV_IN = 3 * RWKV_WIDTH + DECAY_LORA + AAA_LORA + GATE_LORA
IN_COLS = ATT_Q + 2 * ATT_KV + RWKV_IN + 2 * D_MODEL
D_FF = 2816
NORM_EPS = 1e-6

kernel_name = 'hybrid_swa_sink_rwkv7_macaron_meta'


def rms_norm(x, gain):
    xf = x.astype(jnp.float32)
    y = xf * lax.rsqrt(jnp.mean(xf * xf, axis=-1, keepdims=True) + NORM_EPS)
    return (y * gain.astype(jnp.float32)).astype(x.dtype)


def swiglu(x, w_gate_up, w_down):
    gate, up = jnp.split(x @ w_gate_up, 2, axis=-1)
    return (jax.nn.silu(gate) * up) @ w_down


def partial_rope(x, pos):
    half = ROT_DIM // 2
    inv_freq = 1.0 / (ROPE_THETA ** (jnp.arange(half, dtype=jnp.float32) * (2.0 / ROT_DIM)))
    ang = pos.astype(jnp.float32)[:, None] * inv_freq[None, :]
    cos = jnp.cos(ang)[None, :, None, :]
    sin = jnp.sin(ang)[None, :, None, :]
    xr = x[..., :ROT_DIM].astype(jnp.float32)
    x1, x2 = xr[..., :half], xr[..., half:]
    rot = jnp.concatenate([x1 * cos - x2 * sin, x2 * cos + x1 * sin], axis=-1).astype(x.dtype)
    return jnp.concatenate([rot, x[..., ROT_DIM:]], axis=-1)


def sliding_window_gqa_sinks(q, k, v, sinks):
    B, T = q.shape[0], q.shape[1]
    pad = (-T) % BLOCK
    Tp = T + pad
    nb = Tp // BLOCK
    padw = ((0, 0), (pad, 0), (0, 0), (0, 0))
    qb = jnp.pad(q, padw).reshape(B, nb, BLOCK, ATT_KV_HEADS, ATT_GROUP, HEAD_DIM)
    kb = jnp.pad(k, padw).reshape(B, nb, BLOCK, ATT_KV_HEADS, HEAD_DIM)
    vb = jnp.pad(v, padw).reshape(B, nb, BLOCK, ATT_KV_HEADS, HEAD_DIM)
    kw = jnp.concatenate([jnp.concatenate([jnp.zeros_like(kb[:, :1]), kb[:, :-1]], axis=1), kb], axis=2)
    vw = jnp.concatenate([jnp.concatenate([jnp.zeros_like(vb[:, :1]), vb[:, :-1]], axis=1), vb], axis=2)
    s = jnp.einsum('bnqhgd,bnkhd->bnhgqk', qb, kw, preferred_element_type=jnp.float32)
    s = s * (HEAD_DIM ** -0.5)
    blk = jnp.arange(nb)[:, None, None]
    q_idx = blk * BLOCK + jnp.arange(BLOCK)[None, :, None]
    k_idx = (blk - 1) * BLOCK + jnp.arange(2 * BLOCK)[None, None, :]
    rel = q_idx - k_idx
    mask = (rel >= 0) & (rel < WINDOW) & (k_idx >= pad)
    s = jnp.where(mask[None, :, None, None], s, MASK_VALUE)
    sink = jnp.broadcast_to(
        sinks.astype(jnp.float32).reshape(ATT_KV_HEADS, ATT_GROUP)[None, None, :, :, None, None],
        s.shape[:-1] + (1,))
    p = jax.nn.softmax(jnp.concatenate([s, sink], axis=-1), axis=-1)[..., :-1]
    o = jnp.einsum('bnhgqk,bnkhd->bnqhgd', p.astype(v.dtype), vw)
    return o.reshape(B, Tp, ATT_Q)[:, pad:]


def token_shift(z, mu):
    z_prev = jnp.pad(z, ((0, 0), (1, 0), (0, 0)))[:, :-1]
    return z + (z_prev - z) * mu


def wkv7_scan(r, w, k, v, a, b):
    B, T, H, N = r.shape

    def step(S, inp):
        r_t, w_t, k_t, v_t, a_t, b_t = inp
        sa = jnp.einsum('bhvk,bhk->bhv', S, a_t)
        S = S * w_t[:, :, None, :] + sa[..., None] * b_t[:, :, None, :] + v_t[..., None] * k_t[:, :, None, :]
        return S, jnp.einsum('bhvk,bhk->bhv', S, r_t)

    xs = (jnp.moveaxis(r, 1, 0), jnp.moveaxis(w, 1, 0), jnp.moveaxis(k, 1, 0),
          jnp.moveaxis(v, 1, 0), jnp.moveaxis(a, 1, 0), jnp.moveaxis(b, 1, 0))
    S0 = jnp.zeros((B, H, N, N), jnp.float32)
    _, ys = lax.scan(step, S0, xs)
    return jnp.moveaxis(ys, 0, 1)


def rwkv7_time_mix(z, mu, w0, w2, a0, a2, g2, k_k, k_a, r_k, ln_w, ln_b):
    B, T = z.shape[0], z.shape[1]
    f32 = jnp.float32
    z = token_shift(z, mu).astype(f32)
    o1 = RWKV_WIDTH
    o4 = 3 * RWKV_WIDTH + DECAY_LORA
    r, k, v, xw, xa, xg = jnp.split(z, [o1, 2 * o1, 3 * o1, o4, o4 + AAA_LORA], axis=-1)
    w = -jax.nn.softplus(-(w0.astype(f32) + jnp.tanh(xw) @ w2.astype(f32))) - 0.5
    a = jax.nn.sigmoid(a0.astype(f32) + xa @ a2.astype(f32))
    g = jax.nn.sigmoid(xg) @ g2.astype(f32)
    hs = (B, T, RWKV_HEADS, RWKV_HEAD)
    kk = (k * k_k.astype(f32)).reshape(hs)
    kk = kk / jnp.maximum(jnp.sqrt(jnp.sum(kk * kk, axis=-1, keepdims=True)), 1e-12)
    k = k * (1.0 + (a - 1.0) * k_a.astype(f32))
    decay = jnp.exp(-jnp.exp(w))
    r_h, k_h, v_h, a_h = r.reshape(hs), k.reshape(hs), v.reshape(hs), a.reshape(hs)
    y = wkv7_scan(r_h, decay.reshape(hs), k_h, v_h, -kk, kk * a_h)
    mean = jnp.mean(y, axis=-1, keepdims=True)
    var = jnp.mean(jnp.square(y - mean), axis=-1, keepdims=True)
    y = ((y - mean) * lax.rsqrt(var + GN_EPS)).reshape(B, T, RWKV_WIDTH)
    y = y * ln_w.astype(f32) + ln_b.astype(f32)
    bonus = jnp.sum(r_h * k_h * r_k.astype(f32), axis=-1, keepdims=True) * v_h
    return ((y + bonus.reshape(B, T, RWKV_WIDTH)) * g).astype(mu.dtype)


def setup_inputs(seed: int = 0) -> dict:
    key = jax.random.key(seed)
    ks = jax.random.split(key, 32)
    f32 = jnp.float32

    def nrm(k, shape, scale):
        return jax.random.normal(k, shape, f32) * scale

    def gain(k, n):
        return 1.0 + 0.1 * jax.random.normal(k, (DEPTH, n), f32)

    return {
        'x': nrm(ks[0], (BATCH, SEQ, D_MODEL), 1.0),
        'meta_tokens': nrm(ks[1], (N_META, D_MODEL), 1.0),
        'ffn1_norm_pre': gain(ks[2], D_MODEL),
        'ffn1_w_gate_up': nrm(ks[3], (DEPTH, D_MODEL, 2 * D_FF), D_MODEL ** -0.5),
        'ffn1_w_down': nrm(ks[4], (DEPTH, D_FF, D_MODEL), D_FF ** -0.5),
        'ffn1_norm_post': gain(ks[5], D_MODEL),
        'mix_norm_pre': gain(ks[6], D_MODEL),
        'w_in': nrm(ks[7], (DEPTH, D_MODEL, IN_COLS), D_MODEL ** -0.5),
        'att_sinks': nrm(ks[8], (DEPTH, ATT_HEADS), 0.5),
        'rwkv_mu': jax.random.uniform(ks[9], (DEPTH, RWKV_IN), f32, 0.0, 1.0),
        'rwkv_w0': jax.random.uniform(ks[10], (DEPTH, RWKV_WIDTH), f32, -4.0, 1.0),
        'rwkv_w2': nrm(ks[11], (DEPTH, DECAY_LORA, RWKV_WIDTH), DECAY_LORA ** -0.5),
        'rwkv_a0': nrm(ks[12], (DEPTH, RWKV_WIDTH), 0.1),
        'rwkv_a2': nrm(ks[13], (DEPTH, AAA_LORA, RWKV_WIDTH), AAA_LORA ** -0.5),
        'rwkv_g2': nrm(ks[14], (DEPTH, GATE_LORA, RWKV_WIDTH), GATE_LORA ** -0.5),
        'rwkv_k_k': 0.85 + nrm(ks[15], (DEPTH, RWKV_WIDTH), 0.05),
        'rwkv_k_a': 1.0 + nrm(ks[16], (DEPTH, RWKV_WIDTH), 0.05),
        'rwkv_r_k': nrm(ks[17], (DEPTH, RWKV_HEADS, RWKV_HEAD), 0.1),
        'rwkv_ln_w': gain(ks[18], RWKV_WIDTH),
        'rwkv_ln_b': nrm(ks[19], (DEPTH, RWKV_WIDTH), 0.02),
        'w_att_branch': nrm(ks[20], (DEPTH, ATT_Q, D_MODEL), ATT_Q ** -0.5),
        'w_rwkv_branch': nrm(ks[21], (DEPTH, RWKV_WIDTH, D_MODEL), RWKV_WIDTH ** -0.5),
        'w_mix_out': nrm(ks[22], (DEPTH, D_MODEL, D_MODEL), D_MODEL ** -0.5),
        'mix_norm_post': gain(ks[23], D_MODEL),
        'ffn2_norm_pre': gain(ks[24], D_MODEL),
        'ffn2_w_gate_up': nrm(ks[25], (DEPTH, D_MODEL, 2 * D_FF), D_MODEL ** -0.5),
        'ffn2_w_down': nrm(ks[26], (DEPTH, D_FF, D_MODEL), D_FF ** -0.5),
        'ffn2_norm_post': gain(ks[27], D_MODEL),
    }


def reference(x, meta_tokens, ffn1_norm_pre, ffn1_w_gate_up, ffn1_w_down, ffn1_norm_post,
              mix_norm_pre, w_in, att_sinks, rwkv_mu, rwkv_w0, rwkv_w2, rwkv_a0, rwkv_a2,
              rwkv_g2, rwkv_k_k, rwkv_k_a, rwkv_r_k, rwkv_ln_w, rwkv_ln_b, w_att_branch,
              w_rwkv_branch, w_mix_out, mix_norm_post, ffn2_norm_pre, ffn2_w_gate_up,
              ffn2_w_down, ffn2_norm_post):
    B = x.shape[0]
    meta = jnp.broadcast_to(meta_tokens.astype(x.dtype)[None], (B, N_META, D_MODEL))
    h = jnp.concatenate([meta, x], axis=1)
    T = h.shape[1]
    pos = jnp.arange(T, dtype=jnp.int32)
    c_q = ATT_Q
    c_k = c_q + ATT_KV
    c_v = c_k + ATT_KV
    c_r = c_v + RWKV_IN
    c_ga = c_r + D_MODEL
    for l in range(DEPTH):
        f = swiglu(rms_norm(h, ffn1_norm_pre[l]), ffn1_w_gate_up[l], ffn1_w_down[l])
        h = h + 0.5 * rms_norm(f, ffn1_norm_post[l])
        u = rms_norm(h, mix_norm_pre[l])
        z = u @ w_in[l]
        q, k, v, zr, ga, gr = jnp.split(z, [c_q, c_k, c_v, c_r, c_ga], axis=-1)
        q = partial_rope(q.reshape(B, T, ATT_HEADS, HEAD_DIM), pos)
        k = partial_rope(k.reshape(B, T, ATT_KV_HEADS, HEAD_DIM), pos)
        v = v.reshape(B, T, ATT_KV_HEADS, HEAD_DIM)
        y_att = sliding_window_gqa_sinks(q, k, v, att_sinks[l]) @ w_att_branch[l]
        y_rwkv = rwkv7_time_mix(zr, rwkv_mu[l], rwkv_w0[l], rwkv_w2[l], rwkv_a0[l], rwkv_a2[l],
                                rwkv_g2[l], rwkv_k_k[l], rwkv_k_a[l], rwkv_r_k[l],
                                rwkv_ln_w[l], rwkv_ln_b[l]) @ w_rwkv_branch[l]
        merged = jax.nn.sigmoid(ga) * y_att + jax.nn.sigmoid(gr) * y_rwkv
        h = h + rms_norm(merged @ w_mix_out[l], mix_norm_post[l])
        f = swiglu(rms_norm(h, ffn2_norm_pre[l]), ffn2_w_gate_up[l], ffn2_w_down[l])
        h = h + 0.5 * rms_norm(f, ffn2_norm_post[l])
    return h[:, N_META:]
```

```cpp
#include <hip/hip_runtime.h>
#include <cstdio>
#include <cstdint>

namespace pg8 {
#define PG8_LAS __attribute__((address_space(3)))
typedef unsigned short bf16_t;
typedef short bf16x8 __attribute__((ext_vector_type(8)));
typedef float f32x4 __attribute__((ext_vector_type(4)));
typedef unsigned u32x4 __attribute__((ext_vector_type(4)));
constexpr int BM = 256, BK = 64, HALF = 128, HTB = HALF * BK * 2  , STAGE_BYTES = 8 * HTB, NXCD = 8, WGM = 8;

__host__ __device__ __forceinline__ int lds_byte(int r, int c) { const int st = (r >> 4) * 2 + (c >> 5), rr = r & 15, cc = c & 31, ob = rr * 64 + cc * 2; return st * 1024 + (ob ^ (((ob >> 9) & 1) << 5)); }
__host__ __device__ __forceinline__ void stage_rc(int b, int& R, int& C) { const int st = b / 1024, sb = b % 1024, swz = sb ^ (((sb >> 9) & 1) << 5); R = (st >> 1) * 16 + swz / 64; C = (st & 1) * 32 + (swz % 64) / 2; }
__host__ __device__ __forceinline__ int perm32(int rho) { const int n = rho >> 4, i = rho & 15; return 8 * (i >> 2) + 4 * n + (i & 3); }

struct Unit { int pm, pn; };
struct Gemm { const bf16_t* A; const bf16_t* Bt; int M, N, K, lda, ldb; };

struct StaticOrder {
    int nM, nN, nwg, G, c;
    __host__ __device__ void init(int M, int N, int G_, int c_) { nM = M / BM; nN = N / BM; nwg = nM * nN; G = G_; c = c_; }
    __host__ __device__ bool next(int i, Unit& u) const {
        const long L = (long)i * G + c; if (L >= nwg) return false;
        int wgid = (int)L; { const int q = nwg / NXCD, r = nwg % NXCD, xcd = wgid % NXCD, off = wgid / NXCD; wgid = (xcd < r ? xcd * (q + 1) : r * (q + 1) + (xcd - r) * q) + off; }
        const int nig = WGM * nN, gid = wgid / nig, fm = gid * WGM, gsz = (nM - fm) < WGM ? (nM - fm) : WGM;
        u.pm = fm + ((wgid % nig) % gsz); u.pn = (wgid % nig) / gsz; return true;
    }
    __device__ __forceinline__ void a_ready(const Unit&) const {}
    __device__ __forceinline__ void done(const Unit&) const {}
};

typedef float f32x2_cv __attribute__((ext_vector_type(2))); typedef __bf16 bf16x2_cv __attribute__((ext_vector_type(2)));
__device__ __forceinline__ unsigned cvt_pk_bf16(float lo, float hi) { const f32x2_cv v = {lo, hi}; const bf16x2_cv b = __builtin_convertvector(v, bf16x2_cv); return __builtin_bit_cast(unsigned, b); }
typedef float f32x2 __attribute__((ext_vector_type(2)));
#define EPI_IDS int t_ = threadIdx.x; asm volatile("" : "+v"(t_)); const int wr = t_ >> 8, wc = (t_ >> 6) & 3, fr = t_ & 15, fq = (t_ >> 4) & 3; (void)wr_; (void)wc_; (void)fr_; (void)fq_
__device__ __forceinline__ u32x4 pack8(const f32x4 a, const f32x4 b) { u32x4 w; w.x = cvt_pk_bf16(a[0], a[1]); w.y = cvt_pk_bf16(a[2], a[3]); w.z = cvt_pk_bf16(b[0], b[1]); w.w = cvt_pk_bf16(b[2], b[3]); return w; }
__device__ __forceinline__ float bf_lo(unsigned w) { return __builtin_bit_cast(float, w << 16); }
__device__ __forceinline__ float bf_hi(unsigned w) { return __builtin_bit_cast(float, w & 0xffff0000u); }
__device__ __forceinline__ float sigmoidf_(float x) { return __builtin_amdgcn_rcpf(1.0f + __expf(-x)); }
__device__ __forceinline__ float siluf_(float x) { return x * sigmoidf_(x); }

struct EpiSwiGLU {
    static constexpr bool PERM = true, AFTER_DRAIN = false;
    bf16_t* H;
    __device__ __forceinline__ void operator()(const f32x4 (&acc)[2][2][4][2], const Unit& u, int wr_, int wc_, int fr_, int fq_) const {
        EPI_IDS;
        const int row0 = u.pm * BM + wr * 64 + fr, col = u.pn * HALF + wc * 32 + 8 * fq;
#pragma unroll
        for (int ai = 0; ai < 2; ++ai)
#pragma unroll
            for (int m = 0; m < 4; ++m) {
                const f32x4 g0 = acc[ai][0][m][0], g1 = acc[ai][0][m][1], u0 = acc[ai][1][m][0], u1 = acc[ai][1][m][1];
                f32x4 h0, h1;
#pragma unroll
                for (int j = 0; j < 4; ++j) { h0[j] = siluf_(g0[j]) * u0[j]; h1[j] = siluf_(g1[j]) * u1[j]; }
                *(u32x4*)(H + (size_t)(row0 + ai * HALF + m * 16) * 2816 + col) = pack8(h0, h1);
            }
    }
};
struct EpiFSS {
    static constexpr bool PERM = true, AFTER_DRAIN = false;
    bf16_t* Fo; float* SS;
    __device__ __forceinline__ void operator()(const f32x4 (&acc)[2][2][4][2], const Unit& u, int wr_, int wc_, int fr_, int fq_) const {
        EPI_IDS;
        const int row0 = u.pm * BM + wr * 64 + fr, col = u.pn * BM + wc * 32 + 8 * fq;
#pragma unroll
        for (int ai = 0; ai < 2; ++ai)
#pragma unroll
            for (int m = 0; m < 4; ++m) {
                const int row = row0 + ai * HALF + m * 16; float ss = 0.f;
#pragma unroll
                for (int bj = 0; bj < 2; ++bj) { const f32x4 v0 = acc[ai][bj][m][0], v1 = acc[ai][bj][m][1];
                    ss += (v0[0] * v0[0] + v0[1] * v0[1]) + (v0[2] * v0[2] + v0[3] * v0[3]) + (v1[0] * v1[0] + v1[1] * v1[1]) + (v1[2] * v1[2] + v1[3] * v1[3]);
                    *(u32x4*)(Fo + (size_t)row * 1024 + col + bj * HALF) = pack8(v0, v1); }
                ss += __shfl_xor(ss, 16); ss += __shfl_xor(ss, 32);
                if (fq == 0) SS[((size_t)u.pn * 33024 + row) * 4 + wc] = ss;
            }
    }
};
struct EpiWin {
    static constexpr bool PERM = true, AFTER_DRAIN = false;
    bf16_t* Q; bf16_t* KV; bf16_t* ZR; const float* rope; int MR;
    __device__ __forceinline__ void operator()(const f32x4 (&acc)[2][2][4][2], const Unit& u, int wr_, int wc_, int fr_, int fq_) const {
        EPI_IDS;
        const int row0 = u.pm * BM + wr * 64 + fr, pn = u.pn;
        bf16_t* base; int ld, colt;
        if (pn < 2) { base = Q; ld = 512; colt = pn * 256; } else if (pn == 2) { base = KV; ld = 256; colt = 0; } else { base = ZR; ld = 1792; colt = (pn - 3) * 256; }
        const bool rope_lane = (pn <= 2) && ((wc & 1) == 0) && (fq < 2);
#pragma unroll
        for (int ai = 0; ai < 2; ++ai)
#pragma unroll
            for (int m = 0; m < 4; ++m) {
                const int row = row0 + ai * HALF + m * 16;
                f32x4 cs = (f32x4){1.f, 1.f, 1.f, 1.f}, sn = (f32x4){0.f, 0.f, 0.f, 0.f};
                if (rope_lane) { const int pos = row < MR ? (row & 8191) + 16 : (row < MR + 16 ? row - MR : 0);
                    cs = *(const f32x4*)(rope + pos * 16 + 4 * fq); sn = *(const f32x4*)(rope + pos * 16 + 8 + 4 * fq); }
#pragma unroll
                for (int bj = 0; bj < 2; ++bj) { f32x4 v0 = acc[ai][bj][m][0], v1 = acc[ai][bj][m][1];
                    if (rope_lane && (pn < 2 || bj == 0)) { const f32x4 x1 = v0, x2 = v1; v0 = x1 * cs - x2 * sn; v1 = x2 * cs + x1 * sn; }
                    *(u32x4*)(base + (size_t)row * ld + colt + bj * HALF + wc * 32 + 8 * fq) = pack8(v0, v1); }
                asm volatile("" ::: "memory");
            }
    }
};
struct EpiLora {
    static constexpr bool PERM = true, AFTER_DRAIN = false;
    float* LW; bf16_t* Aa; bf16_t* Gg; const float* w0; const float* a0;
    __device__ __forceinline__ void operator()(const f32x4 (&acc)[2][2][4][2], const Unit& u, int wr_, int wc_, int fr_, int fq_) const {
        EPI_IDS;
        const int row0 = u.pm * BM + wr * 64 + fr, pn = u.pn, kind = pn >> 1, colt = (pn & 1) * 256 + wc * 32 + 8 * fq;
#pragma unroll
        for (int bj = 0; bj < 2; ++bj) {
            const int col = colt + bj * HALF;
            f32x4 b0 = (f32x4){0.f, 0.f, 0.f, 0.f}, b1 = b0;
            if (kind == 0) { b0 = *(const f32x4*)(w0 + col); b1 = *(const f32x4*)(w0 + col + 4); }
            else if (kind == 1) { b0 = *(const f32x4*)(a0 + col); b1 = *(const f32x4*)(a0 + col + 4); }
#pragma unroll
            for (int ai = 0; ai < 2; ++ai)
#pragma unroll
                for (int m = 0; m < 4; ++m) {
                    const int row = row0 + ai * HALF + m * 16;
                    f32x4 v0 = acc[ai][bj][m][0] + b0, v1 = acc[ai][bj][m][1] + b1;
                    if (kind == 0) {
#pragma unroll
                        for (int j = 0; j < 4; ++j) { v0[j] = -0.6065306597126334f * sigmoidf_(v0[j]); v1[j] = -0.6065306597126334f * sigmoidf_(v1[j]); }
                        *(f32x4*)(LW + (size_t)row * 512 + col) = v0; *(f32x4*)(LW + (size_t)row * 512 + col + 4) = v1;
                    } else if (kind == 1) {
#pragma unroll
                        for (int j = 0; j < 4; ++j) { v0[j] = sigmoidf_(v0[j]); v1[j] = sigmoidf_(v1[j]); }
                        *(u32x4*)(Aa + (size_t)row * 512 + col) = pack8(v0, v1);
                    } else {
                        *(u32x4*)(Gg + (size_t)row * 512 + col) = pack8(v0, v1);
                    }
                    asm volatile("" ::: "memory");
                }
        }
    }
};
struct EpiGates {
    static constexpr bool PERM = true, AFTER_DRAIN = false;
    bf16_t* Go;
    __device__ __forceinline__ void operator()(const f32x4 (&acc)[2][2][4][2], const Unit& u, int wr_, int wc_, int fr_, int fq_) const {
        EPI_IDS;
        const int row0 = u.pm * BM + wr * 64 + fr, col = u.pn * BM + wc * 32 + 8 * fq;
#pragma unroll
        for (int ai = 0; ai < 2; ++ai)
#pragma unroll
            for (int m = 0; m < 4; ++m)
#pragma unroll
                for (int bj = 0; bj < 2; ++bj) { f32x4 v0 = acc[ai][bj][m][0], v1 = acc[ai][bj][m][1];
#pragma unroll
                    for (int j = 0; j < 4; ++j) { v0[j] = sigmoidf_(v0[j]); v1[j] = sigmoidf_(v1[j]); }
                    *(u32x4*)(Go + (size_t)(row0 + ai * HALF + m * 16) * 2048 + col + bj * HALF) = pack8(v0, v1); }
    }
};
template <bool SECOND> struct EpiBranch {
    static constexpr bool PERM = true, AFTER_DRAIN = false;
    bf16_t* Mg; const bf16_t* Gt;
    __device__ __forceinline__ void operator()(const f32x4 (&acc)[2][2][4][2], const Unit& u, int wr_, int wc_, int fr_, int fq_) const {
        EPI_IDS;
        const int row0 = u.pm * BM + wr * 64 + fr, col = u.pn * BM + wc * 32 + 8 * fq;
#pragma unroll
        for (int ai = 0; ai < 2; ++ai)
#pragma unroll
            for (int m = 0; m < 4; ++m)
#pragma unroll
                for (int bj = 0; bj < 2; ++bj) {
                    const size_t row = (size_t)(row0 + ai * HALF + m * 16);
                    const u32x4 gw = *(const u32x4*)(Gt + row * 2048 + col + bj * HALF);
                    f32x4 v0 = acc[ai][bj][m][0], v1 = acc[ai][bj][m][1];
                    v0[0] *= bf_lo(gw.x); v0[1] *= bf_hi(gw.x); v0[2] *= bf_lo(gw.y); v0[3] *= bf_hi(gw.y);
                    v1[0] *= bf_lo(gw.z); v1[1] *= bf_hi(gw.z); v1[2] *= bf_lo(gw.w); v1[3] *= bf_hi(gw.w);
                    u32x4* dst = (u32x4*)(Mg + row * 1024 + col + bj * HALF);
                    if (SECOND) { const u32x4 pw = *dst;
                        v0[0] += bf_lo(pw.x); v0[1] += bf_hi(pw.x); v0[2] += bf_lo(pw.y); v0[3] += bf_hi(pw.y);
                        v1[0] += bf_lo(pw.z); v1[1] += bf_hi(pw.z); v1[2] += bf_lo(pw.w); v1[3] += bf_hi(pw.w); }
                    *dst = pack8(v0, v1);
                    asm volatile("" ::: "memory");
                }
    }
};
struct EpiMerge {
    static constexpr bool PERM = true, AFTER_DRAIN = false;
    bf16_t* Mg; const bf16_t* Gt; unsigned* cnt;
    __device__ __forceinline__ void operator()(const f32x4 (&acc)[2][2][4][2], const Unit& u, int wr_, int wc_, int fr_, int fq_) const {
        EPI_IDS;
        const int row0 = u.pm * BM + wr * 64 + fr, col = u.pn * HALF + wc * 32 + 8 * fq;
#pragma unroll
        for (int ai = 0; ai < 2; ++ai)
#pragma unroll
            for (int m = 0; m < 4; ++m) {
                const size_t row = (size_t)(row0 + ai * HALF + m * 16);
#ifdef MK_GATE_SC
                u32x4 ga, gr;
                { const unsigned long long* pa = (const unsigned long long*)(Gt + row * 2048 + col); const unsigned long long* pr = (const unsigned long long*)(Gt + row * 2048 + 1024 + col);
                  const unsigned long long a0_ = __hip_atomic_load(pa, __ATOMIC_RELAXED, __HIP_MEMORY_SCOPE_SYSTEM), a1_ = __hip_atomic_load(pa + 1, __ATOMIC_RELAXED, __HIP_MEMORY_SCOPE_SYSTEM);
                  const unsigned long long r0_ = __hip_atomic_load(pr, __ATOMIC_RELAXED, __HIP_MEMORY_SCOPE_SYSTEM), r1_ = __hip_atomic_load(pr + 1, __ATOMIC_RELAXED, __HIP_MEMORY_SCOPE_SYSTEM);
                  ga.x = (unsigned)a0_; ga.y = (unsigned)(a0_ >> 32); ga.z = (unsigned)a1_; ga.w = (unsigned)(a1_ >> 32); gr.x = (unsigned)r0_; gr.y = (unsigned)(r0_ >> 32); gr.z = (unsigned)r1_; gr.w = (unsigned)(r1_ >> 32); }
#else
                const u32x4 ga = *(const u32x4*)(Gt + row * 2048 + col), gr = *(const u32x4*)(Gt + row * 2048 + 1024 + col);
#endif
#ifdef MK_GATE_CHECK
                { const float gmx = fmaxf(fmaxf(fmaxf(bf_lo(ga.x), bf_hi(ga.x)), fmaxf(bf_lo(ga.y), bf_hi(ga.y))), fmaxf(fmaxf(bf_lo(gr.z), bf_hi(gr.z)), fmaxf(bf_lo(gr.w), bf_hi(gr.w))));
                  const float gmn = fminf(fminf(fminf(bf_lo(ga.x), bf_hi(ga.x)), fminf(bf_lo(ga.y), bf_hi(ga.y))), fminf(fminf(bf_lo(gr.z), bf_hi(gr.z)), fminf(bf_lo(gr.w), bf_hi(gr.w))));
                  if (gmx > 1.001f || gmn < 0.f) atomicAdd(cnt, 1u); }
#endif
                const f32x4 a0 = acc[ai][0][m][0], a1 = acc[ai][0][m][1], r0 = acc[ai][1][m][0], r1 = acc[ai][1][m][1];
                f32x4 v0, v1;
                v0[0] = a0[0] * bf_lo(ga.x) + r0[0] * bf_lo(gr.x); v0[1] = a0[1] * bf_hi(ga.x) + r0[1] * bf_hi(gr.x); v0[2] = a0[2] * bf_lo(ga.y) + r0[2] * bf_lo(gr.y); v0[3] = a0[3] * bf_hi(ga.y) + r0[3] * bf_hi(gr.y);
                v1[0] = a1[0] * bf_lo(ga.z) + r1[0] * bf_lo(gr.z); v1[1] = a1[1] * bf_hi(ga.z) + r1[1] * bf_hi(gr.z); v1[2] = a1[2] * bf_lo(ga.w) + r1[2] * bf_lo(gr.w); v1[3] = a1[3] * bf_hi(ga.w) + r1[3] * bf_hi(gr.w);
                *(u32x4*)(Mg + row * 1024 + col) = pack8(v0, v1);
                asm volatile("" ::: "memory");
            }
    }
};
template <class Epi, class Sched, bool ALIGN_EPI = false, bool SP2 = false>
__device__ __forceinline__ void gemm_phase(PG8_LAS unsigned char* lds, const Gemm g, const Sched& S, const Epi& E) {
    int tid_ = threadIdx.x; asm volatile("" : "+v"(tid_));
    const int tid = tid_, wid = __builtin_amdgcn_readfirstlane(tid >> 6), lane = tid & 63, wr = wid >> 2, wc = wid & 3, fr = lane & 15, fq = lane >> 4;
    const int K = g.K, nt = K / BK;
    unsigned voffA[2], voffB[2];
#pragma unroll
    for (int i = 0; i < 2; ++i) { int R, C; stage_rc(tid * 16 + i * 8192, R, C); const int Rb = Epi::PERM ? ((R & ~31) + perm32(R & 31)) : R;
        voffA[i] = (unsigned)(R * g.lda + C) * 2u; voffB[i] = (unsigned)(Rb * g.ldb + C) * 2u; }
    const size_t kstep = (size_t)(BK * 2);
    const size_t hstepA = (size_t)HALF * g.lda * 2, hstepB = (size_t)HALF * g.ldb * 2;
    const size_t tstepA = 2 * hstepA, tstepB = 2 * hstepB;
    const unsigned ldsw = (unsigned)wid * 1024u;
    const int aoff = lds_byte(wr * 64 + fr, fq * 8), boff = lds_byte(wc * 32 + fr, fq * 8);
#define PG8_SA(b, h) (((b) * 2 + (h)) * HTB)
#define PG8_SB(b, h) ((4 + (b) * 2 + (h)) * HTB)
#define PG8_STAGE(bufoff, gbase, voff) do { _Pragma("unroll") for (int _i = 0; _i < 2; ++_i) \
        __builtin_amdgcn_global_load_lds((const unsigned*)((const char*)(gbase) + (voff)[_i]), (PG8_LAS unsigned*)(lds + (bufoff) + ldsw + _i * 8192), 16, 0, 0); } while (0)
#define PG8_LDA(dst, b, h) do { _Pragma("unroll") for (int m = 0; m < 4; ++m) _Pragma("unroll") for (int k = 0; k < 2; ++k) dst[m][k] = *(const PG8_LAS bf16x8*)(lds + PG8_SA(b, h) + aoff + m * 2048 + k * 1024); } while (0)
#define PG8_LDB(dst, b, h) do { _Pragma("unroll") for (int n = 0; n < 2; ++n) _Pragma("unroll") for (int k = 0; k < 2; ++k) dst[n][k] = *(const PG8_LAS bf16x8*)(lds + PG8_SB(b, h) + boff + n * 2048 + k * 1024); } while (0)
#define PG8_MMA(ai, bj, At, Bt) do { __builtin_amdgcn_s_setprio(1); _Pragma("unroll") for (int m = 0; m < 4; ++m) _Pragma("unroll") for (int n = 0; n < 2; ++n) _Pragma("unroll") for (int k = 0; k < 2; ++k) \
        acc[ai][bj][m][n] = __builtin_amdgcn_mfma_f32_16x16x32_bf16(Bt[n][k], At[m][k], acc[ai][bj][m][n], 0, 0, 0); __builtin_amdgcn_s_setprio(0); } while (0)
#define PG8_WAIT_V(n) asm volatile("s_waitcnt vmcnt(" #n ")" ::: "memory")
#define PG8_WAIT_L(n) asm volatile("s_waitcnt lgkmcnt(" #n ")" ::: "memory")
#define PG8_BAR __builtin_amdgcn_s_barrier()
#define PG8_SCHED __builtin_amdgcn_sched_barrier(0)
    Unit cur, nxt; int ui = 0;
    if (!S.next(0, cur)) return;
    f32x4 acc[2][2][4][2];
#pragma unroll
    for (int a = 0; a < 2; ++a)
#pragma unroll
        for (int b = 0; b < 2; ++b)
#pragma unroll
            for (int m = 0; m < 4; ++m)
#pragma unroll
                for (int n = 0; n < 2; ++n) acc[a][b][m][n] = (f32x4){0.f, 0.f, 0.f, 0.f};
    bf16x8 At[4][2], B0[2][2], B1[2][2];
    const char* cA = (const char*)g.A + (size_t)cur.pm * tstepA; const char* cB = (const char*)g.Bt + (size_t)cur.pn * tstepB;
    S.a_ready(cur);
    if constexpr (SP2) {
        PG8_STAGE(PG8_SB(0, 0), cB, voffB); PG8_STAGE(PG8_SB(0, 1), cB + hstepB, voffB); PG8_STAGE(PG8_SA(0, 0), cA, voffA); PG8_STAGE(PG8_SA(0, 1), cA + hstepA, voffA);
        if (wr == 1) PG8_BAR;
        PG8_WAIT_V(2); PG8_BAR;
        PG8_STAGE(PG8_SB(1, 0), cB + kstep, voffB); PG8_STAGE(PG8_SA(1, 0), cA + kstep, voffA); PG8_STAGE(PG8_SB(1, 1), cB + hstepB + kstep, voffB);
        PG8_WAIT_V(6); PG8_BAR;
    } else {
        PG8_STAGE(PG8_SB(0, 0), cB, voffB); PG8_STAGE(PG8_SA(0, 0), cA, voffA); PG8_STAGE(PG8_SB(0, 1), cB + hstepB, voffB); PG8_STAGE(PG8_SA(0, 1), cA + hstepA, voffA);
        if (wr == 1) PG8_BAR;
        PG8_WAIT_V(4); PG8_BAR;
        PG8_STAGE(PG8_SB(1, 0), cB + kstep, voffB); PG8_STAGE(PG8_SA(1, 0), cA + kstep, voffA); PG8_STAGE(PG8_SB(1, 1), cB + hstepB + kstep, voffB);
        PG8_WAIT_V(6); PG8_BAR;
    }
    for (;;) {
        const bool has_next = S.next(ui + 1, nxt);
        const char* nA = has_next ? (const char*)g.A + (size_t)nxt.pm * tstepA : cA; const char* nB = has_next ? (const char*)g.Bt + (size_t)nxt.pn * tstepB : cB;
        for (int t = 0; t < nt; t += 2) {
            const bool last = (t == nt - 2);
            const char* a1 = cA + (size_t)(t + 1) * kstep;
            const char* a2 = last ? nA : cA + (size_t)(t + 2) * kstep; const char* b2 = last ? nB : cB + (size_t)(t + 2) * kstep;
            const char* a3 = a2 + kstep; const char* b3 = b2 + kstep;
            if (last && has_next) S.a_ready(nxt);
            if constexpr (SP2) {
            PG8_LDB(B0, 0, 0); PG8_LDB(B1, 0, 1); PG8_SCHED; PG8_LDA(At, 0, 0); PG8_STAGE(PG8_SA(1, 1), a1 + hstepA, voffA);
            PG8_WAIT_V(8); PG8_WAIT_L(0); PG8_BAR; PG8_MMA(0, 0, At, B0); PG8_MMA(0, 1, At, B1); PG8_BAR; PG8_SCHED;
            PG8_LDA(At, 0, 1); PG8_STAGE(PG8_SB(0, 0), b2, voffB); PG8_STAGE(PG8_SB(0, 1), b2 + hstepB, voffB); PG8_STAGE(PG8_SA(0, 0), a2, voffA);
            PG8_WAIT_V(8); PG8_WAIT_L(0); PG8_BAR; PG8_MMA(1, 0, At, B0); PG8_MMA(1, 1, At, B1); PG8_BAR; PG8_SCHED;
            PG8_LDB(B0, 1, 0); PG8_LDB(B1, 1, 1); PG8_SCHED; PG8_LDA(At, 1, 0); PG8_STAGE(PG8_SA(0, 1), a2 + hstepA, voffA);
            PG8_WAIT_V(8); PG8_WAIT_L(0); PG8_BAR; PG8_MMA(0, 0, At, B0); PG8_MMA(0, 1, At, B1); PG8_BAR; PG8_SCHED;
            PG8_LDA(At, 1, 1); PG8_STAGE(PG8_SB(1, 0), b3, voffB); PG8_STAGE(PG8_SB(1, 1), b3 + hstepB, voffB); PG8_STAGE(PG8_SA(1, 0), a3, voffA);
            PG8_WAIT_V(8); PG8_WAIT_L(0); PG8_BAR; PG8_MMA(1, 0, At, B0); PG8_MMA(1, 1, At, B1); PG8_BAR; PG8_SCHED;
            } else {
            PG8_LDB(B0, 0, 0); PG8_SCHED; PG8_LDA(At, 0, 0); PG8_STAGE(PG8_SA(1, 1), a1 + hstepA, voffA);
            PG8_WAIT_L(8); PG8_BAR; PG8_WAIT_L(0); PG8_MMA(0, 0, At, B0); PG8_BAR; PG8_SCHED;
            PG8_LDB(B1, 0, 1); PG8_STAGE(PG8_SB(0, 0), b2, voffB);
            PG8_BAR; PG8_WAIT_L(0); PG8_MMA(0, 1, At, B1); PG8_BAR;
            PG8_LDA(At, 0, 1); PG8_STAGE(PG8_SA(0, 0), a2, voffA);
            PG8_BAR; PG8_WAIT_L(0); PG8_MMA(1, 0, At, B0); PG8_BAR; PG8_SCHED;
            PG8_STAGE(PG8_SB(0, 1), b2 + hstepB, voffB);
            PG8_WAIT_V(6); PG8_BAR; PG8_MMA(1, 1, At, B1); PG8_BAR;
            PG8_LDB(B0, 1, 0); PG8_SCHED; PG8_LDA(At, 1, 0); PG8_STAGE(PG8_SA(0, 1), a2 + hstepA, voffA);
            PG8_WAIT_L(8); PG8_BAR; PG8_WAIT_L(0); PG8_MMA(0, 0, At, B0); PG8_BAR; PG8_SCHED;
            PG8_LDB(B1, 1, 1); PG8_STAGE(PG8_SB(1, 0), b3, voffB);
            PG8_BAR; PG8_WAIT_L(0); PG8_MMA(0, 1, At, B1); PG8_BAR;
            PG8_LDA(At, 1, 1); PG8_STAGE(PG8_SA(1, 0), a3, voffA);
            PG8_BAR; PG8_WAIT_L(0); PG8_MMA(1, 0, At, B0); PG8_BAR; PG8_SCHED;
            PG8_STAGE(PG8_SB(1, 1), b3 + hstepB, voffB);
            PG8_WAIT_V(6); PG8_BAR; PG8_MMA(1, 1, At, B1); PG8_BAR;
            }
        }
        if constexpr (ALIGN_EPI) { if (wr == 0) PG8_BAR; }
        if constexpr (!Epi::AFTER_DRAIN) { E(acc, cur, wr, wc, fr, fq); S.done(cur); }
        if (!has_next) break;
#pragma unroll
        for (int a = 0; a < 2; ++a)
#pragma unroll
            for (int b = 0; b < 2; ++b)
#pragma unroll
                for (int m = 0; m < 4; ++m)
#pragma unroll
                    for (int n = 0; n < 2; ++n) acc[a][b][m][n] = (f32x4){0.f, 0.f, 0.f, 0.f};
        cur = nxt; cA = nA; cB = nB; ++ui;
        if constexpr (ALIGN_EPI) { if (wr == 1) PG8_BAR; }
    }
    PG8_WAIT_V(0);
    if constexpr (!ALIGN_EPI) { if (wr == 0) PG8_BAR; }
    PG8_BAR;
    if constexpr (Epi::AFTER_DRAIN) { E.fused(acc, cur, wr, wc, fr, fq, lds, wid, lane); S.done(cur); }
#undef PG8_SA
#undef PG8_SB
#undef PG8_STAGE
#undef PG8_LDA
#undef PG8_LDB
#undef PG8_MMA
#undef PG8_WAIT_V
#undef PG8_WAIT_L
#undef PG8_BAR
#undef PG8_SCHED
}
}

constexpr int NWAVES = 8;
constexpr int DM = 1024, NB = 4, SEQL = 8192, NMETA = 16, DFF = 2816;
constexpr int MR = NB * SEQL;
constexpr int MP = MR + 256;
constexpr int NHID2 = 2 * DFF;
constexpr int NIN = 4608, NIN_A = 2560;
#ifndef MK_GN_EPS
#define MK_GN_EPS 64e-5f
#endif
constexpr float NORM_EPS = 1e-6f, GN_EPS = MK_GN_EPS;

constexpr size_t MiB = 1u << 20;
constexpr size_t WS_CTL = 0, CTL_ZERO_BYTES = 64 * 1024;
constexpr size_t WS_WGU1 = 128 * 1024;
constexpr size_t WS_WD1  = WS_WGU1 + (size_t)NHID2 * DM * 2;
constexpr size_t WS_WIN  = WS_WD1 + (size_t)DM * DFF * 2;
constexpr size_t WS_WBR = WS_WIN + (size_t)NIN * DM * 2;
constexpr size_t WS_WMIX = WS_WBR + (size_t)2048 * DM * 2;
constexpr size_t WS_WGU2 = WS_WMIX + (size_t)DM * DM * 2;
constexpr size_t WS_WD2  = WS_WGU2 + (size_t)NHID2 * DM * 2;
constexpr size_t WS_WL   = WS_WD2 + (size_t)DM * DFF * 2;
constexpr size_t WS_ROPE = WS_WL + (size_t)1536 * 256 * 2;
constexpr size_t WS_SS   = WS_ROPE + (size_t)8208 * 16 * 4;
constexpr size_t WS_HMETA = WS_SS + (size_t)MP * 16 * 4;
constexpr size_t WS_SMALL_END = WS_HMETA + 16 * 1024 * 4;
constexpr size_t WS_XN = 52 * MiB;
constexpr size_t WS_F  = WS_XN + (size_t)MP * DM * 2;
constexpr size_t WS_BIG = WS_F + (size_t)MP * DM * 2;
constexpr size_t WS_HID = WS_BIG;
constexpr size_t WS_Q  = WS_BIG;
constexpr size_t WS_KV = WS_Q + (size_t)MP * 512 * 2;
constexpr size_t WS_ZR = WS_KV + (size_t)MP * 256 * 2;
constexpr size_t WS_LW = WS_ZR + (size_t)MP * 1792 * 2;
constexpr size_t WS_AA = WS_LW + (size_t)MP * 512 * 4;
constexpr size_t WS_GG = WS_AA + (size_t)MP * 512 * 2;
constexpr size_t WS_LA = WS_GG + (size_t)MP * 512 * 2;
constexpr size_t WS_MIX_END = WS_LA + (size_t)MP * 256 * 2;
constexpr size_t WS_GATES = WS_BIG;
constexpr size_t WS_MERGED = WS_GATES + (size_t)MR * 2048 * 2;
constexpr size_t WS_END = 512 * MiB;
static_assert(WS_SMALL_END <= WS_XN && WS_HID + (size_t)MP * DFF * 2 <= WS_END && WS_MIX_END <= WS_END && WS_MERGED + (size_t)MR * DM * 2 <= WS_END, "d_ws map");
constexpr int CW_BAR = 1024;

constexpr int RING_OFF = 0, RING_BYTES = 131072;
constexpr int LDSCTL_OFF = RING_BYTES, MISC_OFF = LDSCTL_OFF + 320;
constexpr int LDS_BYTES = 147456;

#define GAS __attribute__((address_space(1)))
#define LAS __attribute__((address_space(3)))
typedef unsigned short bf16;
typedef unsigned v4u __attribute__((ext_vector_type(4)));
typedef unsigned v2u __attribute__((ext_vector_type(2)));
typedef float f32x4 __attribute__((ext_vector_type(4)));
typedef float f32x2v __attribute__((ext_vector_type(2)));
typedef float f32x16 __attribute__((ext_vector_type(16)));
typedef short bf16x8 __attribute__((ext_vector_type(8)));
typedef GAS unsigned gu32;
#define RLX_AGENT __ATOMIC_RELAXED, __HIP_MEMORY_SCOPE_AGENT
#define LDS_WAIT() asm volatile("s_waitcnt lgkmcnt(0)" ::: "memory")
#define VM_WAIT() asm volatile("s_waitcnt vmcnt(0)" ::: "memory")
__device__ __forceinline__ unsigned f2bf(float f) { unsigned u = __builtin_bit_cast(unsigned, f); return (u + 0x7fffu + ((u >> 16) & 1u)) >> 16; }
__device__ __forceinline__ unsigned pk2(float lo, float hi) { return f2bf(lo) | (f2bf(hi) << 16); }
__device__ __forceinline__ float bflo(unsigned w) { return __builtin_bit_cast(float, w << 16); }
__device__ __forceinline__ float bfhi(unsigned w) { return __builtin_bit_cast(float, w & 0xffff0000u); }
__device__ __forceinline__ float bf1(bf16 h) { return __builtin_bit_cast(float, (unsigned)h << 16); }
__device__ __forceinline__ float sigm(float x) { return 1.0f / (1.0f + __expf(-x)); }

#define XB_TMO      128
#define XB_XCNT(j)  (256  + 64 * (j))
#define XB_XSUB(j)  (1280 + 64 * (j))
#define XB_XGEN(j)  (2304 + 64 * (j))
#define XB_TOP      3328
#define XB_TOPGEN   3392
#define XCD_BAR_WORDS 3456
#define XB_SPIN_CAP (1u << 24)

__device__ __forceinline__ unsigned xb_ld(unsigned* p)              { return __hip_atomic_load(p, __ATOMIC_RELAXED, __HIP_MEMORY_SCOPE_AGENT); }
__device__ __forceinline__ unsigned xb_add(unsigned* p, unsigned v) { return __hip_atomic_fetch_add(p, v, __ATOMIC_RELAXED, __HIP_MEMORY_SCOPE_AGENT); }
__device__ __forceinline__ unsigned xb_xcc_id() { return (unsigned)__builtin_amdgcn_s_getreg((3 << 11) | 20) & 0xFu; }
#define XB_SPIN(cond, bar) do { unsigned _sp = 0; while (cond) { __builtin_amdgcn_s_sleep(1); \
    if ((++_sp & 255u) == 0u) { if (xb_ld(&(bar)[XB_TMO])) break; if (_sp > XB_SPIN_CAP) { atomicAdd(&(bar)[XB_TMO], 1u); break; } } } } while (0)

struct XcdBarrier {
    unsigned* bar; unsigned x;
    volatile LAS unsigned* st;
};

__device__ __forceinline__ XcdBarrier xcd_barrier_post(unsigned* bar, volatile LAS unsigned* st) {
    XcdBarrier b; b.bar = bar; b.x = xb_xcc_id(); b.st = st;
    if (threadIdx.x == 0) (void)xb_add(&bar[XB_XCNT(b.x)], 1u);
    return b;
}
__device__ __forceinline__ void xcd_barrier_complete(unsigned* bar, unsigned x, unsigned& nloc, unsigned& nx) {
    const unsigned G = gridDim.x * gridDim.y * gridDim.z;
    unsigned sum, cnt, mine, sp = 0u;
    for (;;) {
        sum = 0u; cnt = 0u; mine = 0u;
#pragma unroll
        for (unsigned j = 0; j < 16; ++j) { const unsigned c = xb_ld(&bar[XB_XCNT(j)]); sum += c; cnt += (c > 0u) ? 1u : 0u; mine = (j == x) ? c : mine; }
        if (sum == G) break;
        __builtin_amdgcn_s_sleep(1);
        if ((++sp & 255u) == 0u) { if (xb_ld(&bar[XB_TMO])) break; if (sp > XB_SPIN_CAP) { atomicAdd(&bar[XB_TMO], 1u); break; } }
    }
    nloc = mine > 0u ? mine : 1u; nx = cnt > 0u ? cnt : 1u;
}

__device__ __forceinline__ void xcd_barrier(const XcdBarrier& b) {
    asm volatile("s_waitcnt vmcnt(0)" ::: "memory");
    __syncthreads();
    if (threadIdx.x == 0) {
        unsigned* bar = b.bar;
        __builtin_amdgcn_s_waitcnt(0);
        unsigned nloc = b.st[0], nx = b.st[1];
        if (nloc == 0u) { xcd_barrier_complete(bar, b.x, nloc, nx); b.st[0] = nloc; b.st[1] = nx; }
        const unsigned old = xb_add(&bar[XB_XSUB(b.x)], 1u);
        const unsigned gen = old / nloc;
        if (old + 1u == (gen + 1u) * nloc) {
            __builtin_amdgcn_fence(__ATOMIC_RELEASE, "");
            asm volatile("s_waitcnt vmcnt(0)" ::: "memory");
            const unsigned og = xb_add(&bar[XB_TOP], 1u);
            const unsigned tg = og / nx;
            if (og + 1u == (tg + 1u) * nx) xb_add(&bar[XB_TOPGEN], 1u);
            else XB_SPIN(xb_ld(&bar[XB_TOPGEN]) == tg, bar);
            __builtin_amdgcn_fence(__ATOMIC_ACQUIRE, "");
            xb_add(&bar[XB_XGEN(b.x)], 1u);
            asm volatile("s_waitcnt vmcnt(0)" ::: "memory");
        } else {
            XB_SPIN(xb_ld(&bar[XB_XGEN(b.x)]) == gen, bar);
            __builtin_amdgcn_fence(__ATOMIC_ACQUIRE, "");
            asm volatile("s_waitcnt vmcnt(0)" ::: "memory");
        }
    }
    __syncthreads();
}


struct Frame {
    LAS unsigned char* lds;
    volatile LAS unsigned* MISC;
    gu32* ctl;
    int tid, lane, wave;
    int vcu, G;
    float* out; unsigned char* ws;
};
struct Args { const float* in[28]; float* out; unsigned char* ws; int ph_lo, ph_hi, li, pad; };
__device__ __forceinline__ const float* inp(int k) {
    typedef const float* cfp;
    const __attribute__((address_space(4))) char* kp = (const __attribute__((address_space(4))) char*)__builtin_amdgcn_kernarg_segment_ptr();
    return *(volatile const __attribute__((address_space(4))) cfp*)(kp + 8 * k);
}
__device__ __forceinline__ float wave_sum(float v) {
#pragma unroll
    for (int o = 1; o < 64; o <<= 1) v += __shfl_xor(v, o);
    return v;
}

struct MapId { __device__ __forceinline__ int operator()(int n) const { return n; } };
struct MapGateUp { __device__ __forceinline__ int operator()(int n) const { return n < DFF ? 256 * (n >> 7) + (n & 127) : 256 * ((n - DFF) >> 7) + 128 + ((n - DFF) & 127); } };
struct MapBrA { __device__ __forceinline__ int operator()(int n) const { return 256 * (n >> 7) + (n & 127); } };
struct MapBrR { __device__ __forceinline__ int operator()(int n) const { return 256 * (n >> 7) + 128 + (n & 127); } };
struct MapWin { __device__ __forceinline__ int operator()(int n) const { if (n >= 640) return n; const int s = n & 63; if (s >= 16) return n; const int d = (s >= 4 && s < 8) ? s + 4 : ((s >= 8 && s < 12) ? s - 4 : s); return n - s + d; } };
template <class Map>
__device__ __forceinline__ void p0_transpose_item(const float* W, int K, int N, bf16* WT, LAS float* scr, int item, int lane, Map map, int ldk = 0, int kofs = 0) {
    if (ldk == 0) ldk = K;
    const int nblk = N / 32, kb = item / nblk, nb = item % nblk, k0 = 64 * kb, n0 = 32 * nb;
#pragma unroll 8
    for (int i = 0; i < 32; ++i) { const int kk = 2 * i + (lane >> 5); scr[kk * 33 + (lane & 31)] = W[(size_t)(k0 + kk) * N + n0 + (lane & 31)]; }
    LDS_WAIT(); asm volatile("" ::: "memory");
    const int c = lane & 7;
#pragma unroll
    for (int j = 0; j < 4; ++j) { const int n = (lane >> 3) + 8 * j; const LAS float* s = scr + (8 * c) * 33 + n;
        v4u o; o.x = pk2(s[0 * 33], s[1 * 33]); o.y = pk2(s[2 * 33], s[3 * 33]); o.z = pk2(s[4 * 33], s[5 * 33]); o.w = pk2(s[6 * 33], s[7 * 33]);
        *(GAS v4u*)(WT + (size_t)map(n0 + n) * ldk + kofs + k0 + 8 * c) = o; }
    LDS_WAIT(); asm volatile("" ::: "memory");
}
__device__ __forceinline__ void rms_row_to_bf16(int lane, const float* xrow, const float* gain, bf16* orow) {
    const f32x4* xr = (const f32x4*)xrow + lane; const f32x4* gr = (const f32x4*)gain + lane;
    f32x4 v[4]; float s = 0.f;
#pragma unroll
    for (int j = 0; j < 4; ++j) { v[j] = xr[64 * j]; s += (v[j].x * v[j].x + v[j].y * v[j].y) + (v[j].z * v[j].z + v[j].w * v[j].w); }
    const float rstd = 1.f / sqrtf(wave_sum(s) * (1.f / DM) + NORM_EPS);
    v2u* o8 = (v2u*)orow + lane;
#pragma unroll
    for (int j = 0; j < 4; ++j) { const f32x4 g = gr[64 * j]; v2u w; w.x = pk2(v[j].x * rstd * g.x, v[j].y * rstd * g.y); w.y = pk2(v[j].z * rstd * g.z, v[j].w * rstd * g.w); o8[64 * j] = w; }
}
#define XN1_BASE (F.out)
__device__ __forceinline__ void p0_prologue(Frame& F, const Args& A) {
    LAS float* scr = (LAS float*)(F.lds + RING_OFF + F.wave * 16384);
    const int gw = F.vcu * NWAVES + F.wave, NGW = F.G * NWAVES;
    unsigned char* ws = F.ws;
    constexpr int I_GU = (DM / 64) * (NHID2 / 32), I_D = (DFF / 64) * (DM / 32), I_IN = (DM / 64) * (NIN / 32), I_BR = (512 / 64) * (DM / 32), I_MIX = (DM / 64) * (DM / 32);
    constexpr int NITEMS = 2 * I_GU + 2 * I_D + I_IN + 2 * I_BR + I_MIX;
    for (int it = gw; it < NITEMS; it += NGW) {
        int r = it;
        if (r < I_GU) { p0_transpose_item(inp(3), DM, NHID2, (bf16*)(ws + WS_WGU1), scr, r, F.lane, MapGateUp()); continue; } r -= I_GU;
        if (r < I_GU) { p0_transpose_item(inp(25), DM, NHID2, (bf16*)(ws + WS_WGU2), scr, r, F.lane, MapGateUp()); continue; } r -= I_GU;
        if (r < I_D) { p0_transpose_item(inp(4), DFF, DM, (bf16*)(ws + WS_WD1), scr, r, F.lane, MapId()); continue; } r -= I_D;
        if (r < I_D) { p0_transpose_item(inp(26), DFF, DM, (bf16*)(ws + WS_WD2), scr, r, F.lane, MapId()); continue; } r -= I_D;
        if (r < I_IN) { p0_transpose_item(inp(7), DM, NIN, (bf16*)(ws + WS_WIN), scr, r, F.lane, MapWin()); continue; } r -= I_IN;
        if (r < I_BR) { p0_transpose_item(inp(20), 512, DM, (bf16*)(ws + WS_WBR), scr, r, F.lane, MapBrA(), 1024, 0); continue; } r -= I_BR;
        if (r < I_BR) { p0_transpose_item(inp(21), 512, DM, (bf16*)(ws + WS_WBR), scr, r, F.lane, MapBrR(), 1024, 512); continue; } r -= I_BR;
        p0_transpose_item(inp(22), DM, DM, (bf16*)(ws + WS_WMIX), scr, r, F.lane, MapId());
    }
    { const int gt = (F.vcu * NWAVES + F.wave) * 64 + F.lane, NGT = NGW * 64; bf16* WL = (bf16*)(ws + WS_WL);
      for (int e = gt; e < 1536 * 256; e += NGT) { const int n = e >> 8, k = e & 255; float v = 0.f;
          if (n < 512) { if (k < 64) v = inp(11)[k * 512 + n]; }
          else if (n < 1024) { if (k >= 64 && k < 128) v = inp(13)[(k - 64) * 512 + (n - 512)]; }
          else { if (k >= 128) v = inp(14)[(k - 128) * 512 + (n - 1024)]; }
          WL[e] = (bf16)f2bf(v); }
      { v4u* WB = (v4u*)(ws + WS_WBR);
        for (int e = gt; e < 2048 * 64; e += NGT) { const int row = e >> 6, pc = e & 63; WB[(size_t)row * 128 + ((row & 128) ? 0 : 64) + pc] = (v4u){0u, 0u, 0u, 0u}; } }
      float* rope = (float*)(ws + WS_ROPE);
      for (int e = gt; e < 8208 * 8; e += NGT) { const int pos = e >> 3, i = e & 7;
          const double fr = i == 0 ? 1.0 : i == 1 ? 0.19392274474868576 : i == 2 ? 0.03760603093086393 : i == 3 ? 0.007292664737217109 : i == 4 ? 0.001414213562373095 : i == 5 ? 0.0002742481756762073 : i == 6 ? 5.318295896944988e-05 : 1.031338537721246e-05;
          const double ang = (double)pos * fr; const double kq = __builtin_rint(ang * 0.15915494309189535); const double red = __builtin_fma(-kq, 6.283185307179586, ang) - kq * 2.4492935982947064e-16;
          const float rf = (float)red; rope[pos * 16 + i] = cosf(rf); rope[pos * 16 + 8 + i] = sinf(rf); }
    }
    for (int m = gw; m < MP; m += NGW) {
        bf16* orow = (bf16*)XN1_BASE + (size_t)m * DM;
        if (m < MR + NMETA) rms_row_to_bf16(F.lane, m < MR ? inp(0) + (size_t)m * DM : inp(1) + (size_t)(m - MR) * DM, inp(2), orow);
        else { v2u* o8 = (v2u*)orow + F.lane;
#pragma unroll
            for (int j = 0; j < 4; ++j) o8[64 * j] = (v2u){0u, 0u}; }
    }
}

template <int MODE>
__device__ __forceinline__ void row_pass(Frame& F, const Args& A, const float* gpost, const float* gpre, float scale) {
    const int gw = F.vcu * NWAVES + F.wave, NGW = F.G * NWAVES, lane = F.lane;
    const int nrows = MODE == 0 ? MR + NMETA : MR;
    const bf16* Fb = (const bf16*)(F.ws + WS_F); const float* SS = (const float*)(F.ws + WS_SS);
    for (int m = gw; m < nrows; m += NGW) {
        const float* hold; float* hnew;
        if (MODE == 0) { hold = m < MR ? inp(0) + (size_t)m * DM : inp(1) + (size_t)(m - MR) * DM; hnew = m < MR ? F.out + (size_t)m * DM : (float*)(F.ws + WS_HMETA) + (size_t)(m - MR) * DM; }
        else { hold = F.out + (size_t)m * DM; hnew = F.out + (size_t)m * DM; }
        float ssf = SS[((size_t)((lane & 15) >> 2) * MP + m) * 4 + (lane & 3)];
        ssf += __shfl_xor(ssf, 1); ssf += __shfl_xor(ssf, 2); ssf += __shfl_xor(ssf, 4); ssf += __shfl_xor(ssf, 8);
#ifdef MK_SS_FROM_F
        { float s2 = 0.f;
#pragma unroll
          for (int j = 0; j < 4; ++j) { const v2u fw = ((const v2u*)(Fb + (size_t)m * DM))[lane + 64 * j]; s2 += bflo(fw.x) * bflo(fw.x) + bfhi(fw.x) * bfhi(fw.x) + bflo(fw.y) * bflo(fw.y) + bfhi(fw.y) * bfhi(fw.y); }
          ssf = wave_sum(s2); }
#endif
        const float rf = scale / sqrtf(ssf * (1.f / DM) + NORM_EPS);
        f32x4 h[4]; float s = 0.f;
#pragma unroll
        for (int j = 0; j < 4; ++j) {
            const f32x4 hv = ((const f32x4*)hold)[lane + 64 * j]; const v2u fw = ((const v2u*)(Fb + (size_t)m * DM))[lane + 64 * j]; const f32x4 g = ((const f32x4*)gpost)[lane + 64 * j];
            f32x4 r; r.x = hv.x + bflo(fw.x) * rf * g.x; r.y = hv.y + bfhi(fw.x) * rf * g.y; r.z = hv.z + bflo(fw.y) * rf * g.z; r.w = hv.w + bfhi(fw.y) * rf * g.w;
#ifdef MK_ZERO_ROWS_BELOW
            if (MODE == 2 && m < MK_ZERO_ROWS_BELOW) r = (f32x4){0.f, 0.f, 0.f, 0.f};
#endif
#ifdef MK_ZERO_ROWS_FROM
            if (MODE == 2 && m >= MK_ZERO_ROWS_FROM) r = (f32x4){0.f, 0.f, 0.f, 0.f};
#endif
#ifdef MK_ZERO_FIRST
            if (MODE == 2 && (m & 8191) < MK_ZERO_FIRST) r = (f32x4){0.f, 0.f, 0.f, 0.f};
#endif
#ifdef MK_ZERO_AFTER
            if (MODE == 2 && (m & 8191) >= MK_ZERO_AFTER) r = (f32x4){0.f, 0.f, 0.f, 0.f};
#endif
            h[j] = r; s += (r.x * r.x + r.y * r.y) + (r.z * r.z + r.w * r.w);
            ((f32x4*)hnew)[lane + 64 * j] = r;
        }
        if (MODE != 2) {
            const float rstd = 1.f / sqrtf(wave_sum(s) * (1.f / DM) + NORM_EPS);
            v2u* o8 = (v2u*)((bf16*)(F.ws + WS_XN) + (size_t)m * DM) + lane;
#pragma unroll
            for (int j = 0; j < 4; ++j) { const f32x4 g = ((const f32x4*)gpre)[lane + 64 * j]; v2u w; w.x = pk2(h[j].x * rstd * g.x, h[j].y * rstd * g.y); w.y = pk2(h[j].z * rstd * g.z, h[j].w * rstd * g.w); o8[64 * j] = w; }
        }
    }
}

__device__ __forceinline__ int prev_row(int m) { return m < MR ? ((m & 8191) == 0 ? MR + 15 : m - 1) : (m == MR ? -1 : m - 1); }
__device__ __forceinline__ void lora_a_pass(Frame& F, const Args& A) {
    const int gw = F.vcu * NWAVES + F.wave, NGW = F.G * NWAVES, lane = F.lane;
    const bf16* ZR = (const bf16*)(F.ws + WS_ZR); bf16* LA = (bf16*)(F.ws + WS_LA); const float* mu = inp(9) + 1536;
    const f32x4 muv = ((const f32x4*)mu)[lane];
    for (int m = gw; m < MR + NMETA; m += NGW) {
        const int pm = prev_row(m);
        const v2u zc = ((const v2u*)(ZR + (size_t)m * 1792 + 1536))[lane];
        v2u zp = (v2u){0u, 0u}; if (pm >= 0) zp = ((const v2u*)(ZR + (size_t)pm * 1792 + 1536))[lane];
        float x[4] = {bflo(zc.x), bfhi(zc.x), bflo(zc.y), bfhi(zc.y)}; const float p[4] = {bflo(zp.x), bfhi(zp.x), bflo(zp.y), bfhi(zp.y)};
        x[0] += (p[0] - x[0]) * muv.x; x[1] += (p[1] - x[1]) * muv.y; x[2] += (p[2] - x[2]) * muv.z; x[3] += (p[3] - x[3]) * muv.w;
        if (lane < 16) {
#pragma unroll
            for (int j = 0; j < 4; ++j) x[j] = tanhf(x[j]);
        } else if (lane >= 32) {
#pragma unroll
            for (int j = 0; j < 4; ++j) x[j] = sigm(x[j]);
        }
        v2u w; w.x = pk2(x[0], x[1]); w.y = pk2(x[2], x[3]);
        ((v2u*)(LA + (size_t)m * 256))[lane] = w;
    }
}

#ifndef MK_ATT_SCALE
#define MK_ATT_SCALE 1.0f
#endif
__device__ __forceinline__ int crow(int r, int hi) { return (r & 3) + 8 * (r >> 2) + 4 * hi; }
__device__ __forceinline__ void attn_item(Frame& F, const Args& A, int b, int head, int qb) {
    const int lane = F.lane, r32 = lane & 31, hi = lane >> 5, kvh = head >> 2, t0 = qb * 32;
    const bf16* Q = (const bf16*)(F.ws + WS_Q); const bf16* KV = (const bf16*)(F.ws + WS_KV); bf16* AC = (bf16*)(F.ws + WS_F);
    const bf16* qrow = Q + (size_t)(b * SEQL + t0 + r32) * 512 + head * 64 + 8 * hi;
    bf16x8 qf[4];
#pragma unroll
    for (int s = 0; s < 4; ++s) qf[s] = *(const bf16x8*)(qrow + 16 * s);
    f32x16 S[5];
#pragma unroll
    for (int i = 0; i < 5; ++i) {
        const int tk = t0 - 128 + 32 * i + r32;
        const size_t krow = tk >= 0 ? (size_t)(b * SEQL + tk) : (tk >= -16 ? (size_t)(MR + 16 + tk) : (size_t)MR);
        const bf16* kp = KV + krow * 256 + kvh * 64 + 8 * hi;
        f32x16 a = {};
#pragma unroll
        for (int s = 0; s < 4; ++s) { const bf16x8 kf = *(const bf16x8*)(kp + 16 * s); a = __builtin_amdgcn_mfma_f32_32x32x16_bf16(kf, qf[s], a, 0, 0, 0); }
        S[i] = a;
    }
    const float sink = inp(8)[head];
    float mx = sink;
#pragma unroll
    for (int i = 0; i < 5; ++i)
#pragma unroll
        for (int r = 0; r < 16; ++r) {
            const int kk = 32 * i + crow(r, hi);
            const int rel = r32 + 128 - kk; const bool ok = (rel >= 0) && (rel < 128) && (t0 - 128 + kk >= -16);
            const float v = ok ? S[i][r] * 0.125f : -1e30f; S[i][r] = v; mx = fmaxf(mx, v);
        }
    mx = fmaxf(mx, __shfl_xor(mx, 32));
    float sum = 0.f;
#pragma unroll
    for (int i = 0; i < 5; ++i)
#pragma unroll
        for (int r = 0; r < 16; ++r) { const float p = S[i][r] > -1e29f ? __expf(S[i][r] - mx) : 0.f; S[i][r] = p; sum += p; }
    sum += __shfl_xor(sum, 32);
    const float inv = 1.0f / (sum + __expf(sink - mx));
    f32x16 O0 = {}, O1 = {};
    const bf16* vbase = KV + 128 + kvh * 64 + r32;
#pragma unroll
    for (int i = 0; i < 5; ++i)
#pragma unroll
        for (int s = 0; s < 2; ++s) {
            bf16x8 pa, v0, v1;
#pragma unroll
            for (int j = 0; j < 8; j += 2) { const unsigned w = pg8::cvt_pk_bf16(S[i][8 * s + j], S[i][8 * s + j + 1]); pa[j] = (short)(w & 0xffffu); pa[j + 1] = (short)(w >> 16); }
#pragma unroll
            for (int j = 0; j < 8; ++j) {
                const int tk = t0 - 128 + 32 * i + 16 * s + 8 * (j >> 2) + 4 * hi + (j & 3);
                const size_t krow = tk >= 0 ? (size_t)(b * SEQL + tk) : (tk >= -16 ? (size_t)(MR + 16 + tk) : (size_t)MR);
                v0[j] = (short)vbase[krow * 256]; v1[j] = (short)vbase[krow * 256 + 32];
            }
            O0 = __builtin_amdgcn_mfma_f32_32x32x16_bf16(pa, v0, O0, 0, 0, 0);
            O1 = __builtin_amdgcn_mfma_f32_32x32x16_bf16(pa, v1, O1, 0, 0, 0);
        }
    bf16* orow = AC + (size_t)(b * SEQL + t0) * 1024 + head * 64 + r32;
#pragma unroll
    for (int r = 0; r < 16; ++r) { const int q = crow(r, hi); const float iv = __shfl(inv, q);
#ifdef MK_ZERO_ATT
        orow[(size_t)q * 1024] = 0; orow[(size_t)q * 1024 + 32] = 0; (void)iv; }
#else
        orow[(size_t)q * 1024] = (bf16)f2bf(O0[r] * iv * MK_ATT_SCALE); orow[(size_t)q * 1024 + 32] = (bf16)f2bf(O1[r] * iv * MK_ATT_SCALE); }
#endif
}


__device__ __forceinline__ void lora_direct(Frame& F, const Args& A) {
    const int gw = F.vcu * NWAVES + F.wave, NGW = F.G * NWAVES, lane = F.lane, r32 = lane & 31, hi = lane >> 5;
    const bf16* LA = (const bf16*)(F.ws + WS_LA); const bf16* WL = (const bf16*)(F.ws + WS_WL);
    float* LW = (float*)(F.ws + WS_LW); bf16* AA = (bf16*)(F.ws + WS_AA); bf16* GG = (bf16*)(F.ws + WS_GG);
    constexpr int NRB = (MR + NMETA + 31) / 32;
    for (int it = gw; it < NRB * 3; it += NGW) {
        const int kind = it % 3, r0 = (it / 3) * 32, k0 = kind == 0 ? 0 : (kind == 1 ? 64 : 128), nk = kind == 2 ? 8 : 4;
        bf16x8 af[8];
#pragma unroll
        for (int s = 0; s < 8; ++s) af[s] = *(const bf16x8*)(LA + (size_t)(r0 + r32) * 256 + k0 + (s < nk ? 16 * s : 0) + 8 * hi);
        const float* bias = kind == 0 ? inp(10) : inp(12);
        for (int nb = 0; nb < 16; ++nb) {
            f32x16 acc = {};
            const bf16* wp = WL + (size_t)(kind * 512 + nb * 32 + r32) * 256 + k0 + 8 * hi;
#pragma unroll
            for (int s = 0; s < 8; ++s) if (s < nk) { const bf16x8 bfr = *(const bf16x8*)(wp + 16 * s); acc = __builtin_amdgcn_mfma_f32_32x32x16_bf16(af[s], bfr, acc, 0, 0, 0); }
            const int col = nb * 32 + r32; const float bv = kind == 2 ? 0.f : bias[col];
#pragma unroll
            for (int r = 0; r < 16; ++r) { const size_t o = (size_t)(r0 + crow(r, hi)) * 512 + col; const float v = acc[r] + bv;
                if (kind == 0) LW[o] = -0.6065306597126334f * sigm(v); else if (kind == 1) AA[o] = (bf16)f2bf(sigm(v)); else GG[o] = (bf16)f2bf(v); }
        }
    }
}

#ifndef MK_YN_SCALE
#define MK_YN_SCALE 1.0f
#endif
#ifndef MK_BONUS_SCALE
#define MK_BONUS_SCALE 1.0f
#endif
__device__ __forceinline__ float dpp_f(float v, const int ctrl_sel) {
    const int x = __builtin_bit_cast(int, v); int r;
    if (ctrl_sel == 0) r = __builtin_amdgcn_update_dpp(0, x, 0xB1, 0xF, 0xF, true);
    else if (ctrl_sel == 1) r = __builtin_amdgcn_update_dpp(0, x, 0x4E, 0xF, 0xF, true);
    else r = __builtin_amdgcn_update_dpp(0, x, 0x141, 0xF, 0xF, true);
    return __builtin_bit_cast(float, r);
}
__device__ __forceinline__ float red8(float v) { v += dpp_f(v, 0); v += dpp_f(v, 1); v += dpp_f(v, 2); return v; }
__device__ __forceinline__ float half_sum(float v) {
#pragma unroll
    for (int o = 1; o < 32; o <<= 1) v += __shfl_xor(v, o);
    return v;
}
struct ScanRaw { unsigned zr, zk, zv, pr, pk, pv, aa, gg; f32x2v lw; };
__device__ __forceinline__ void scan_load_raw(ScanRaw& R, int blk, int tok, int b, int hc, const bf16* ZR, const float* LW, const bf16* AA, const bf16* GG) {
    const int p = 16 * blk + tok; const int m = p < 16 ? MR + p : b * SEQL + p - 16; const int pm = p == 0 ? -1 : (p <= 16 ? MR + p - 1 : m - 1);
    const bf16* z = ZR + (size_t)m * 1792 + hc;
    R.zr = *(const unsigned*)(z); R.zk = *(const unsigned*)(z + 512); R.zv = *(const unsigned*)(z + 1024);
    if (pm >= 0) { const bf16* zp = ZR + (size_t)pm * 1792 + hc; R.pr = *(const unsigned*)(zp); R.pk = *(const unsigned*)(zp + 512); R.pv = *(const unsigned*)(zp + 1024); } else { R.pr = 0u; R.pk = 0u; R.pv = 0u; }
    R.lw = *(const f32x2v*)(LW + (size_t)m * 512 + hc); R.aa = *(const unsigned*)(AA + (size_t)m * 512 + hc); R.gg = *(const unsigned*)(GG + (size_t)m * 512 + hc);
}
__device__ __forceinline__ void scan_chain(Frame& F, const Args& A, int bh) {
    const int b = bh >> 3, h = bh & 7, tid = F.tid;
    LAS float* sR = (LAS float*)(F.lds);
    LAS float* sW = sR + 1024; LAS float* sK = sW + 1024; LAS float* sV = sK + 1024; LAS float* sA = sV + 1024; LAS float* sB = sA + 1024; LAS float* sG = sB + 1024; LAS float* sY = sG + 1024;
    const bf16* ZR = (const bf16*)(F.ws + WS_ZR); const float* LW = (const float*)(F.ws + WS_LW); const bf16* AA = (const bf16*)(F.ws + WS_AA); const bf16* GG = (const bf16*)(F.ws + WS_GG);
    bf16* AC = (bf16*)(F.ws + WS_F);
    const int tok = tid >> 5, cp = tid & 31, c = 2 * cp, hc = h * 64 + c;
    const float mur0 = inp(9)[hc], mur1 = inp(9)[hc + 1], muk0 = inp(9)[512 + hc], muk1 = inp(9)[512 + hc + 1], muv0 = inp(9)[1024 + hc], muv1 = inp(9)[1024 + hc + 1];
    const float kk0 = inp(15)[hc], kk1 = inp(15)[hc + 1], ka0 = inp(16)[hc], ka1 = inp(16)[hc + 1], rk0 = inp(17)[hc], rk1 = inp(17)[hc + 1];
    const float lnw0 = inp(18)[hc], lnw1 = inp(18)[hc + 1], lnb0 = inp(19)[hc], lnb1 = inp(19)[hc + 1];
    const int row = tid >> 3, cg = tid & 7;
    float St[8];
#pragma unroll
    for (int j = 0; j < 8; ++j) St[j] = 0.f;
    ScanRaw cur; scan_load_raw(cur, 0, tok, b, hc, ZR, LW, AA, GG);
    constexpr int NBLK = (SEQL + NMETA) / 16;
    for (int blk = 0; blk < NBLK; ++blk) {
        {
            float r0 = bflo(cur.zr), r1 = bfhi(cur.zr), k0 = bflo(cur.zk), k1 = bfhi(cur.zk), v0 = bflo(cur.zv), v1 = bfhi(cur.zv);
            r0 += (bflo(cur.pr) - r0) * mur0; r1 += (bfhi(cur.pr) - r1) * mur1; k0 += (bflo(cur.pk) - k0) * muk0; k1 += (bfhi(cur.pk) - k1) * muk1; v0 += (bflo(cur.pv) - v0) * muv0; v1 += (bfhi(cur.pv) - v1) * muv1;
            const float a0 = bflo(cur.aa), a1 = bfhi(cur.aa);
            float q0 = k0 * kk0, q1 = k1 * kk1; const float nrm = fmaxf(sqrtf(half_sum(q0 * q0 + q1 * q1)), 1e-12f); q0 /= nrm; q1 /= nrm;
            const float km0 = k0 * (1.f + (a0 - 1.f) * ka0), km1 = k1 * (1.f + (a1 - 1.f) * ka1);
            const int o = tok * 64 + c;
            *(LAS f32x2v*)(sR + o) = (f32x2v){r0, r1}; *(LAS f32x2v*)(sW + o) = (f32x2v){__expf(cur.lw.x), __expf(cur.lw.y)}; *(LAS f32x2v*)(sK + o) = (f32x2v){km0, km1};
            *(LAS f32x2v*)(sV + o) = (f32x2v){v0, v1}; *(LAS f32x2v*)(sA + o) = (f32x2v){-q0, -q1}; *(LAS f32x2v*)(sB + o) = (f32x2v){q0 * a0, q1 * a1}; *(LAS f32x2v*)(sG + o) = (f32x2v){bflo(cur.gg), bfhi(cur.gg)};
        }
        __syncthreads();
        if (blk + 1 < NBLK) scan_load_raw(cur, blk + 1, tok, b, hc, ZR, LW, AA, GG);
#pragma unroll 4
        for (int t = 0; t < 16; ++t) {
            const f32x4 a_lo = *(const LAS f32x4*)(sA + t * 64 + 8 * cg), a_hi = *(const LAS f32x4*)(sA + t * 64 + 8 * cg + 4);
            const f32x4 w_lo = *(const LAS f32x4*)(sW + t * 64 + 8 * cg), w_hi = *(const LAS f32x4*)(sW + t * 64 + 8 * cg + 4);
            const f32x4 b_lo = *(const LAS f32x4*)(sB + t * 64 + 8 * cg), b_hi = *(const LAS f32x4*)(sB + t * 64 + 8 * cg + 4);
            const f32x4 k_lo = *(const LAS f32x4*)(sK + t * 64 + 8 * cg), k_hi = *(const LAS f32x4*)(sK + t * 64 + 8 * cg + 4);
            const f32x4 r_lo = *(const LAS f32x4*)(sR + t * 64 + 8 * cg), r_hi = *(const LAS f32x4*)(sR + t * 64 + 8 * cg + 4);
            const float vv = sV[t * 64 + row];
            float sa = (St[0] * a_lo.x + St[1] * a_lo.y) + (St[2] * a_lo.z + St[3] * a_lo.w) + (St[4] * a_hi.x + St[5] * a_hi.y) + (St[6] * a_hi.z + St[7] * a_hi.w);
            sa = red8(sa);
            St[0] = St[0] * w_lo.x + sa * b_lo.x + vv * k_lo.x; St[1] = St[1] * w_lo.y + sa * b_lo.y + vv * k_lo.y; St[2] = St[2] * w_lo.z + sa * b_lo.z + vv * k_lo.z; St[3] = St[3] * w_lo.w + sa * b_lo.w + vv * k_lo.w;
            St[4] = St[4] * w_hi.x + sa * b_hi.x + vv * k_hi.x; St[5] = St[5] * w_hi.y + sa * b_hi.y + vv * k_hi.y; St[6] = St[6] * w_hi.z + sa * b_hi.z + vv * k_hi.z; St[7] = St[7] * w_hi.w + sa * b_hi.w + vv * k_hi.w;
            float y = (St[0] * r_lo.x + St[1] * r_lo.y) + (St[2] * r_lo.z + St[3] * r_lo.w) + (St[4] * r_hi.x + St[5] * r_hi.y) + (St[6] * r_hi.z + St[7] * r_hi.w);
            y = red8(y);
            if (cg == 0) sY[t * 64 + row] = y;
        }
        __syncthreads();
        if (blk > 0) {
            const int o = tok * 64 + c; const f32x2v y = *(const LAS f32x2v*)(sY + o), r = *(const LAS f32x2v*)(sR + o), k = *(const LAS f32x2v*)(sK + o), v = *(const LAS f32x2v*)(sV + o), g = *(const LAS f32x2v*)(sG + o);
            const float mean = half_sum(y.x + y.y) * (1.f / 64.f); const float d0 = y.x - mean, d1 = y.y - mean; const float var = half_sum(d0 * d0 + d1 * d1) * (1.f / 64.f);
            const float rs = 1.f / sqrtf(var + GN_EPS); const float dot = half_sum(r.x * k.x * rk0 + r.y * k.y * rk1);
            const float o0 = ((d0 * rs * lnw0 + lnb0) * MK_YN_SCALE + dot * v.x * MK_BONUS_SCALE) * g.x, o1 = ((d1 * rs * lnw1 + lnb1) * MK_YN_SCALE + dot * v.y * MK_BONUS_SCALE) * g.y;
            const int m = b * SEQL + 16 * blk + tok - 16;
            *(unsigned*)(AC + (size_t)m * 1024 + 512 + hc) = pk2(o0, o1);
        }
        __syncthreads();
    }
}

__device__ __forceinline__ void scan_chain_simple(Frame& F, const Args& A, int bh) {
    if (F.wave != 0) return;
    const int b = bh >> 3, h = bh & 7, lane = F.lane, hc = h * 64 + lane;
    LAS float* sx = (LAS float*)(F.lds);
    const bf16* ZR = (const bf16*)(F.ws + WS_ZR); const float* LW = (const float*)(F.ws + WS_LW); const bf16* AA = (const bf16*)(F.ws + WS_AA); const bf16* GG = (const bf16*)(F.ws + WS_GG);
    bf16* AC = (bf16*)(F.ws + WS_F);
    const float mur = inp(9)[hc], muk = inp(9)[512 + hc], muv = inp(9)[1024 + hc], kkc = inp(15)[hc], kac = inp(16)[hc], rkc = inp(17)[hc], lnw = inp(18)[hc], lnb = inp(19)[hc];
    float S[64];
#pragma unroll
    for (int j = 0; j < 64; ++j) S[j] = 0.f;
    float pr = 0.f, pk = 0.f, pv = 0.f, pxw = 0.f, pxa = 0.f;
    for (int p = 0; p < SEQL + NMETA; ++p) {
        const int m = p < 16 ? MR + p : b * SEQL + p - 16;
        const bf16* z = ZR + (size_t)m * 1792 + hc;
        const float zr = bf1(z[0]), zk = bf1(z[512]), zv = bf1(z[1024]);
        const float r = zr + (pr - zr) * mur, k = zk + (pk - zk) * muk, v = zv + (pv - zv) * muv;
        pr = zr; pk = zk; pv = zv;
#ifdef MK_SIMPLE_LORA
        const float g = bf1(GG[(size_t)m * 512 + hc]);
        float a, w;
        {
            const float zw = bf1(ZR[(size_t)m * 1792 + 1536 + lane]), za = bf1(ZR[(size_t)m * 1792 + 1600 + lane]);
            const float xw = zw + (pxw - zw) * inp(9)[1536 + lane], xa = za + (pxa - za) * inp(9)[1600 + lane];
            pxw = zw; pxa = za;
            sx[320 + lane] = tanhf(xw); sx[384 + lane] = xa;
            LDS_WAIT(); asm volatile("" ::: "memory");
            float accw = inp(10)[hc], acca = inp(12)[hc];
            for (int j = 0; j < 64; ++j) { accw += sx[320 + j] * inp(11)[j * 512 + hc]; acca += sx[384 + j] * inp(13)[j * 512 + hc]; }
            LDS_WAIT(); asm volatile("" ::: "memory");
            w = __expf(-0.6065306597126334f / (1.f + __expf(-accw))); a = 1.f / (1.f + __expf(-acca));
        }
#else
        const float a = bf1(AA[(size_t)m * 512 + hc]), g = bf1(GG[(size_t)m * 512 + hc]), w = __expf(LW[(size_t)m * 512 + hc]);
#endif
        float q = k * kkc; const float nrm = fmaxf(sqrtf(wave_sum(q * q)), 1e-12f); q = q / nrm;
        const float kmod = k * (1.f + (a - 1.f) * kac);
        sx[lane] = r; sx[64 + lane] = w; sx[128 + lane] = kmod; sx[192 + lane] = -q; sx[256 + lane] = q * a;
        LDS_WAIT(); asm volatile("" ::: "memory");
        float sa = 0.f;
#pragma unroll
        for (int j = 0; j < 64; ++j) sa += S[j] * sx[192 + j];
        float y = 0.f;
#pragma unroll
        for (int j = 0; j < 64; ++j) { S[j] = S[j] * sx[64 + j] + sa * sx[256 + j] + v * sx[128 + j]; y += S[j] * sx[j]; }
        LDS_WAIT(); asm volatile("" ::: "memory");
        const float mean = wave_sum(y) * (1.f / 64.f), d = y - mean, var = wave_sum(d * d) * (1.f / 64.f), rs = 1.f / sqrtf(var + GN_EPS);
        const float dot = wave_sum(r * kmod * rkc);
        const float o = (d * rs * lnw + lnb + dot * v) * g;
        if (p >= 16) AC[(size_t)m * 1024 + 512 + hc] = (bf16)f2bf(o);
    }
}

#ifdef MK_DUMP
__device__ __forceinline__ void dump_phase(const unsigned char* ws, float* out) {
    const size_t n = (size_t)MR * DM; const size_t i0 = (size_t)blockIdx.x * blockDim.x + threadIdx.x, st = (size_t)gridDim.x * blockDim.x;
    for (size_t i = i0; i < n; i += st) { const size_t m = i >> 10, c = i & 1023; float v = 0.f;
        if (MK_DUMP == 1) v = bf1(((const bf16*)(ws + WS_F))[m * 1024 + c]);
        else if (MK_DUMP == 2) v = bf1(((const bf16*)(ws + WS_ZR))[m * 1792 + c]);
        else if (MK_DUMP == 3) v = c < 512 ? ((const float*)(ws + WS_LW))[m * 512 + c] : bf1(((const bf16*)(ws + WS_AA))[m * 512 + c - 512]);
        else if (MK_DUMP == 4) v = bf1(((const bf16*)(ws + WS_MERGED))[m * 1024 + c]);
        else if (MK_DUMP == 5) v = c < 512 ? bf1(((const bf16*)(ws + WS_Q))[m * 512 + c]) : (c < 768 ? bf1(((const bf16*)(ws + WS_KV))[m * 256 + c - 512]) : bf1(((const bf16*)(ws + WS_LA))[m * 256 + c - 768]));
        else if (MK_DUMP == 6) v = bf1(((const bf16*)(ws + WS_GATES))[m * 2048 + c]);
        else if (MK_DUMP == 7) v = bf1(((const bf16*)(ws + WS_F))[m * 1024 + c]);
        else if (MK_DUMP == 8) v = c < 512 ? bf1(((const bf16*)(ws + WS_GG))[m * 512 + c]) : bf1(((const bf16*)(ws + WS_ZR))[m * 1792 + 1024 + c - 512]);
        else if (MK_DUMP == 9) v = ((const float*)(ws + WS_SS))[((size_t)((c & 15) >> 2) * MP + m) * 4 + (c & 3)];
        else if (MK_DUMP == 10) v = bf1(((const bf16*)(ws + WS_XN))[m * 1024 + c]);
        out[i] = v; }
}
#endif
#ifndef MK_N_LAUNCHES
#define MK_N_LAUNCHES 1
#endif
constexpr int N_PHASES = 15;
constexpr int N_LAUNCHES = MK_N_LAUNCHES;
__global__ void __launch_bounds__(NWAVES * 64, 2) hybrid_fwd(Args args) {
    extern __shared__ __attribute__((aligned(16))) unsigned char lds[];
    Frame F;
    F.lds = (LAS unsigned char*)lds;
    F.MISC = (volatile LAS unsigned*)(F.lds + MISC_OFF);
#define FRAME_REFRESH() do { int t_ = threadIdx.x; asm volatile("" : "+v"(t_)); F.tid = t_; F.lane = t_ & 63; F.wave = __builtin_amdgcn_readfirstlane(t_ >> 6); } while (0)
    FRAME_REFRESH();
    F.G = gridDim.x; { const int bx = blockIdx.x; F.vcu = (F.G % 8 == 0) ? (bx % 8) * (F.G / 8) + bx / 8 : bx; }
    unsigned char* ws = args.ws; F.ws = ws; F.out = args.out;
    F.ctl = (gu32*)(ws + WS_CTL);
    for (int u = F.tid; u < (LDS_BYTES - LDSCTL_OFF) / 4; u += NWAVES * 64) ((LAS unsigned*)(F.lds + LDSCTL_OFF))[u] = 0u;
    __syncthreads();
    XcdBarrier bar; bar.bar = (unsigned*)(F.ctl + CW_BAR); bar.x = 0; bar.st = nullptr;
    if (N_LAUNCHES == 1) bar = xcd_barrier_post((unsigned*)(F.ctl + CW_BAR), F.MISC + 8);
    const int lo = args.ph_lo, hi = args.ph_hi;
#ifndef PHASE_MASK
#define PHASE_MASK 0x7fff
#endif
#define IN(k) (((PHASE_MASK >> (k)) & 1) && lo <= (k) && (k) < hi)
#define SEAM(k) do { if (IN(k) && IN((k) + 1)) xcd_barrier(bar); } while (0)
#define GEMM_RUN(EpiT, Eobj, Aptr, lda_, Bptr, ldb_, M_, N_, K_) do { pg8::Gemm g_{(const pg8::bf16_t*)(Aptr), (const pg8::bf16_t*)(Bptr), (M_), (N_), (K_), (lda_), (ldb_)}; pg8::StaticOrder S_; S_.init((M_), (N_), F.G, (int)blockIdx.x); \
        pg8::gemm_phase<EpiT, pg8::StaticOrder, true, true>(F.lds + RING_OFF, g_, S_, Eobj); } while (0)

#ifdef MK_COH_TEST
    {
        float* Tb = (float*)(ws + WS_BIG + 300 * MiB); const int g = blockIdx.x, G = gridDim.x, nb = (g + 1) % G; float acc = 0.f; unsigned bad = 0;
        for (int rep = 0; rep < 4; ++rep) {
            for (int i = threadIdx.x; i < 8192; i += 512) Tb[(size_t)g * 8192 + i] = 1.0f + rep;
            xcd_barrier(bar);
            for (int i = threadIdx.x; i < 8192; i += 512) acc += Tb[(size_t)nb * 8192 + i];
            xcd_barrier(bar);
            for (int i = threadIdx.x; i < 8192; i += 512) Tb[(size_t)g * 8192 + i] = 100.0f + rep * 7 + i;
            xcd_barrier(bar);
            for (int i = threadIdx.x; i < 8192; i += 512) { const float v = Tb[(size_t)nb * 8192 + i]; bad += (v != 100.0f + rep * 7 + i) ? 1u : 0u; }
            xcd_barrier(bar);
        }
        if (acc == 12345.f) bad++;
        if (bad) atomicAdd((unsigned*)(F.ctl + 901), bad);
    }
#endif
    if (IN(0)) { FRAME_REFRESH(); p0_prologue(F, args); } SEAM(0);
    if (IN(1)) { pg8::EpiSwiGLU E{(pg8::bf16_t*)(ws + WS_HID)}; GEMM_RUN(pg8::EpiSwiGLU, E, (unsigned char*)F.out, DM, ws + WS_WGU1, DM, MP, NHID2, DM); } SEAM(1);
    if (IN(2)) { pg8::EpiFSS E{(pg8::bf16_t*)(ws + WS_F), (float*)(ws + WS_SS)}; GEMM_RUN(pg8::EpiFSS, E, ws + WS_HID, DFF, ws + WS_WD1, DFF, MP, DM, DFF); } SEAM(2);
    if (IN(3)) { FRAME_REFRESH(); row_pass<0>(F, args, inp(5), inp(6), 0.5f); } SEAM(3);
    if (IN(4)) { pg8::EpiWin E{(pg8::bf16_t*)(ws + WS_Q), (pg8::bf16_t*)(ws + WS_KV), (pg8::bf16_t*)(ws + WS_ZR), (const float*)(ws + WS_ROPE), MR}; GEMM_RUN(pg8::EpiWin, E, ws + WS_XN, DM, ws + WS_WIN, DM, MP, NIN_A, DM); } SEAM(4);
#ifdef MK_GEMM_CHECK4
    if (IN(4)) { xcd_barrier(bar);
        { unsigned char* w2 = ws + WS_BIG + 165 * MiB; pg8::EpiWin E{(pg8::bf16_t*)(w2), (pg8::bf16_t*)(w2 + (WS_KV - WS_Q)), (pg8::bf16_t*)(w2 + (WS_ZR - WS_Q)), (const float*)(ws + WS_ROPE), MR};
          pg8::Gemm g_{(const pg8::bf16_t*)(ws + WS_XN), (const pg8::bf16_t*)(ws + WS_WIN), MP, NIN_A, DM, DM, DM}; pg8::StaticOrder S_; S_.init(MP, NIN_A, F.G, (int)((blockIdx.x + 101) % gridDim.x));
          pg8::gemm_phase<pg8::EpiWin, pg8::StaticOrder, true, true>(F.lds + RING_OFF, g_, S_, E); }
        xcd_barrier(bar);
        { FRAME_REFRESH(); const unsigned* a = (const unsigned*)(ws + WS_Q); const unsigned* b = (const unsigned*)(ws + WS_BIG + 165 * MiB); unsigned bad = 0;
          for (size_t i = (size_t)blockIdx.x * 512 + F.tid; i < (size_t)MP * 2560 / 2; i += (size_t)gridDim.x * 512) bad += (a[i] != b[i]) ? 1u : 0u;
          if (bad) atomicAdd((unsigned*)(F.ctl + 900), bad); }
        xcd_barrier(bar);
    }
#endif
    if (IN(5)) { FRAME_REFRESH(); lora_a_pass(F, args); } SEAM(5);
    if (IN(6)) { FRAME_REFRESH(); lora_direct(F, args); } SEAM(6);
    if (IN(7)) { FRAME_REFRESH();
#ifdef MK_SCAN_SIMPLE
        if ((int)blockIdx.x < 32) scan_chain_simple(F, args, (int)blockIdx.x);
#else
        if ((int)blockIdx.x < 32) scan_chain(F, args, (int)blockIdx.x);
#endif
        else { const int gw = ((int)blockIdx.x - 32) * NWAVES + F.wave, NGW = (F.G - 32) * NWAVES;
            for (int it = gw; it < NB * 8 * (SEQL / 32); it += NGW) { const int head = it & 7, qb = (it >> 3) & 255, b = it >> 11; attn_item(F, args, b, head, qb); } }
    } SEAM(7);
    if (IN(8)) { pg8::EpiGates E{(pg8::bf16_t*)(ws + WS_GATES)}; GEMM_RUN(pg8::EpiGates, E, ws + WS_XN, DM, ws + WS_WIN + (size_t)NIN_A * DM * 2, DM, MR, 2048, DM); } SEAM(8);
#ifdef MK_GATE_SCAN
    if (IN(8)) { FRAME_REFRESH(); const unsigned* gp = (const unsigned*)(ws + WS_GATES); unsigned bad = 0;
        for (size_t i = (size_t)blockIdx.x * 512 + F.tid; i < (size_t)MR * 2048 / 2; i += (size_t)gridDim.x * 512) { const unsigned w = gp[i]; const float a = bflo(w), b = bfhi(w); const bool isbad = (a > 1.001f || a < 0.f || b > 1.001f || b < 0.f); bad += isbad ? 1u : 0u;
            if (isbad) { const unsigned row = (unsigned)(i >> 10), colp = (unsigned)(i & 1023);
#if MK_GATE_SCAN == 1
                atomicOr((unsigned*)(F.ctl + 902), 1u << (row >> 12));
#elif MK_GATE_SCAN == 2
                atomicOr((unsigned*)(F.ctl + 902), 1u << (colp >> 7));
#elif MK_GATE_SCAN == 3
                atomicOr((unsigned*)(F.ctl + 902), 1u << ((row >> 8) & 15));
#elif MK_GATE_SCAN == 4
                atomicOr((unsigned*)(F.ctl + 902), 1u << ((row >> 4) & 15));
#endif
            } }
        if (bad) atomicAdd((unsigned*)(F.ctl + 901), bad); }
#endif
    if (IN(9)) { pg8::EpiMerge E{(pg8::bf16_t*)(ws + WS_MERGED), (const pg8::bf16_t*)(ws + WS_GATES), (unsigned*)(F.ctl + 900)}; GEMM_RUN(pg8::EpiMerge, E, ws + WS_F, DM, ws + WS_WBR, DM, MR, 2048, DM); } SEAM(9);
    if (IN(10)) { pg8::EpiFSS E{(pg8::bf16_t*)(ws + WS_F), (float*)(ws + WS_SS)}; GEMM_RUN(pg8::EpiFSS, E, ws + WS_MERGED, DM, ws + WS_WMIX, DM, MR, DM, DM); } SEAM(10);
#ifdef MK_GEMM_CHECK
    if (IN(10)) { xcd_barrier(bar);
        { pg8::EpiFSS E{(pg8::bf16_t*)(ws + WS_BIG + 192 * MiB), (float*)(ws + WS_BIG + 256 * MiB)}; pg8::Gemm g_{(const pg8::bf16_t*)(ws + WS_MERGED), (const pg8::bf16_t*)(ws + WS_WMIX), MR, DM, DM, DM, DM}; pg8::StaticOrder S_; S_.init(MR, DM, F.G, (int)((blockIdx.x + 37) % gridDim.x));
          pg8::gemm_phase<pg8::EpiFSS, pg8::StaticOrder, true, true>(F.lds + RING_OFF, g_, S_, E); }
        xcd_barrier(bar);
        { FRAME_REFRESH(); const unsigned* a = (const unsigned*)(ws + WS_F); const unsigned* b = (const unsigned*)(ws + WS_BIG + 192 * MiB); unsigned bad = 0;
          for (size_t i = (size_t)blockIdx.x * 512 + F.tid; i < (size_t)MR * DM / 2; i += (size_t)gridDim.x * 512) bad += (a[i] != b[i]) ? 1u : 0u;
          if (bad) atomicAdd((unsigned*)(F.ctl + 900), bad); }
    }
#endif
    if (IN(11)) { FRAME_REFRESH(); row_pass<1>(F, args, inp(23), inp(24), 1.0f); } SEAM(11);
    if (IN(12)) { pg8::EpiSwiGLU E{(pg8::bf16_t*)(ws + WS_HID)}; GEMM_RUN(pg8::EpiSwiGLU, E, ws + WS_XN, DM, ws + WS_WGU2, DM, MR, NHID2, DM); } SEAM(12);
    if (IN(13)) { pg8::EpiFSS E{(pg8::bf16_t*)(ws + WS_F), (float*)(ws + WS_SS)}; GEMM_RUN(pg8::EpiFSS, E, ws + WS_HID, DFF, ws + WS_WD2, DFF, MR, DM, DFF); } SEAM(13);
    if (IN(14)) { FRAME_REFRESH(); row_pass<2>(F, args, inp(27), inp(27), 0.5f); }
#if defined(MK_GEMM_CHECK) || defined(MK_COH_TEST) || defined(MK_GEMM_CHECK4) || defined(MK_GATE_CHECK) || defined(MK_GATE_SCAN)
    { xcd_barrier(bar); if (blockIdx.x == 0 && threadIdx.x == 0) { const unsigned nb = __hip_atomic_load((unsigned*)(F.ctl + 900), __ATOMIC_RELAXED, __HIP_MEMORY_SCOPE_AGENT); const unsigned nc = __hip_atomic_load((unsigned*)(F.ctl + 901), __ATOMIC_RELAXED, __HIP_MEMORY_SCOPE_AGENT); if (nb) F.out[0] = 1.0e4f; if (nc) { const unsigned msk = __hip_atomic_load((unsigned*)(F.ctl + 902), __ATOMIC_RELAXED, __HIP_MEMORY_SCOPE_AGENT); F.out[1] = 1.0e6f + 1000.f * (float)nc; F.out[2] = 1.0e10f * (float)msk; } } }
#endif
#ifdef MK_DUMP
    xcd_barrier(bar); dump_phase(ws, F.out);
#endif
#undef IN
#undef SEAM
#undef GEMM_RUN
}


extern "C" void kernel_launch(void* const* d_in, const int* in_sizes, int n_in, void* d_out, int out_size, void* d_ws, size_t ws_size, hipStream_t stream) {
    static int grid = 0;
    if (grid == 0) {
        if (n_in != 28 || in_sizes[0] != MR * DM || out_size != MR * DM || ws_size < WS_END) { fprintf(stderr, "kernel_launch: unexpected shapes / workspace (n_in %d, in0 %d, out %d, ws %zu, need %zu); nothing launched\n", n_in, n_in > 0 ? in_sizes[0] : -1, out_size, ws_size, (size_t)WS_END); grid = -1; return; }
        int dev = 0, cus = 0, per_cu = 0;
        if (hipGetDevice(&dev) != hipSuccess || hipDeviceGetAttribute(&cus, hipDeviceAttributeMultiprocessorCount, dev) != hipSuccess) { grid = -1; return; }
        if (hipFuncSetAttribute((const void*)hybrid_fwd, hipFuncAttributeMaxDynamicSharedMemorySize, LDS_BYTES) != hipSuccess) { fprintf(stderr, "kernel_launch: hipFuncSetAttribute failed\n"); grid = -1; return; }
        if (hipOccupancyMaxActiveBlocksPerMultiprocessor(&per_cu, (const void*)hybrid_fwd, NWAVES * 64, LDS_BYTES) != hipSuccess || per_cu < 1) { fprintf(stderr, "kernel_launch: occupancy query reports %d workgroups per CU\n", per_cu); per_cu = 1; }
        (void)hipGetLastError();
        grid = cus;
        if (grid < 64) { fprintf(stderr, "kernel_launch: %d CUs: too few\n", grid); grid = -1; return; }
    }
    if (grid < 0) return;
    if (hipMemsetAsync((char*)d_ws + WS_CTL, 0, CTL_ZERO_BYTES, stream) != hipSuccess) return;
    Args a{};
    for (int i = 0; i < 28; ++i) a.in[i] = (const float*)d_in[i];
    a.out = (float*)d_out; a.ws = (unsigned char*)d_ws;
#ifndef MK_LAST_PHASE
#define MK_LAST_PHASE (N_PHASES - 1)
#endif
    for (int li = 0; li < N_LAUNCHES && li <= MK_LAST_PHASE; ++li) {
        if (N_LAUNCHES == 1) { a.ph_lo = 0; a.ph_hi = MK_LAST_PHASE + 1; } else { a.ph_lo = li; a.ph_hi = li + 1; }
        a.li = li;
        hipLaunchKernelGGL(hybrid_fwd, dim3(grid), dim3(NWAVES * 64), LDS_BYTES, stream, a);
        const hipError_t le = hipPeekAtLastError();
        if (le != hipSuccess) { fprintf(stderr, "kernel_launch: launch %d failed: %s\n", li, hipGetErrorName(le)); break; }
    }
}
```

```cpp
#include <hip/hip_runtime.h>
#include <cstdio>
#include <cstdint>

namespace pg8 {
#define PG8_LAS __attribute__((address_space(3)))
typedef unsigned short bf16_t;
typedef short bf16x8 __attribute__((ext_vector_type(8)));
typedef float f32x4 __attribute__((ext_vector_type(4)));
typedef unsigned u32x4 __attribute__((ext_vector_type(4)));
constexpr int BM = 256, BK = 64, HALF = 128, HTB = HALF * BK * 2  , STAGE_BYTES = 8 * HTB, NXCD = 8, WGM = 8;

__host__ __device__ __forceinline__ int lds_byte(int r, int c) { const int st = (r >> 4) * 2 + (c >> 5), rr = r & 15, cc = c & 31, ob = rr * 64 + cc * 2; return st * 1024 + (ob ^ (((ob >> 9) & 1) << 5)); }
__host__ __device__ __forceinline__ void stage_rc(int b, int& R, int& C) { const int st = b / 1024, sb = b % 1024, swz = sb ^ (((sb >> 9) & 1) << 5); R = (st >> 1) * 16 + swz / 64; C = (st & 1) * 32 + (swz % 64) / 2; }
__host__ __device__ __forceinline__ int perm32(int rho) { const int n = rho >> 4, i = rho & 15; return 8 * (i >> 2) + 4 * n + (i & 3); }

struct Unit { int pm, pn; };
struct Gemm { const bf16_t* A; const bf16_t* Bt; int M, N, K, lda, ldb; const bf16_t* A2 = nullptr; int nsplit = 1 << 30; };

struct StaticOrder {
    int nM, nN, nwg, G, c;
    __host__ __device__ void init(int M, int N, int G_, int c_) { nM = M / BM; nN = N / BM; nwg = nM * nN; G = G_; c = c_; }
    __host__ __device__ bool next(int i, Unit& u) const {
        const long L = (long)i * G + c; if (L >= nwg) return false;
        int wgid = (int)L; { const int q = nwg / NXCD, r = nwg % NXCD, xcd = wgid % NXCD, off = wgid / NXCD; wgid = (xcd < r ? xcd * (q + 1) : r * (q + 1) + (xcd - r) * q) + off; }
        const int nig = WGM * nN, gid = wgid / nig, fm = gid * WGM, gsz = (nM - fm) < WGM ? (nM - fm) : WGM;
        u.pm = fm + ((wgid % nig) % gsz); u.pn = (wgid % nig) / gsz; return true;
    }
    __device__ __forceinline__ void a_ready(const Unit&) const {}
    __device__ __forceinline__ void done(const Unit&) const {}
};

typedef float f32x2_cv __attribute__((ext_vector_type(2))); typedef __bf16 bf16x2_cv __attribute__((ext_vector_type(2)));
__device__ __forceinline__ unsigned cvt_pk_bf16(float lo, float hi) { const f32x2_cv v = {lo, hi}; const bf16x2_cv b = __builtin_convertvector(v, bf16x2_cv); return __builtin_bit_cast(unsigned, b); }
typedef float f32x2 __attribute__((ext_vector_type(2)));
#define EPI_IDS int t_ = threadIdx.x; asm volatile("" : "+v"(t_)); const int wr = t_ >> 8, wc = (t_ >> 6) & 3, fr = t_ & 15, fq = (t_ >> 4) & 3; (void)wr_; (void)wc_; (void)fr_; (void)fq_
__device__ __forceinline__ u32x4 pack8(const f32x4 a, const f32x4 b) { u32x4 w; w.x = cvt_pk_bf16(a[0], a[1]); w.y = cvt_pk_bf16(a[2], a[3]); w.z = cvt_pk_bf16(b[0], b[1]); w.w = cvt_pk_bf16(b[2], b[3]); return w; }
__device__ __forceinline__ float bf_lo(unsigned w) { return __builtin_bit_cast(float, w << 16); }
__device__ __forceinline__ float bf_hi(unsigned w) { return __builtin_bit_cast(float, w & 0xffff0000u); }
__device__ __forceinline__ float sigmoidf_(float x) { return __builtin_amdgcn_rcpf(1.0f + __expf(-x)); }
__device__ __forceinline__ float siluf_(float x) { return x * sigmoidf_(x); }

struct EpiSwiGLU {
    static constexpr bool PERM = true, AFTER_DRAIN = false, PRE = true;
    bf16_t* H;
    const float* RS;
    __device__ __forceinline__ void pre(const Unit& u, int wr, int fr, float (&rsv)[8]) const {
#pragma unroll
        for (int i = 0; i < 8; ++i) rsv[i] = RS ? RS[u.pm * BM + wr * 64 + fr + (i >> 2) * HALF + (i & 3) * 16] : 1.f;
    }
    __device__ __forceinline__ void operator()(const f32x4 (&acc)[2][2][4][2], const Unit& u, int wr_, int wc_, int fr_, int fq_, const float (&rsv)[8]) const {
        EPI_IDS;
        const int row0 = u.pm * BM + wr * 64 + fr, col = u.pn * HALF + wc * 32 + 8 * fq;
#pragma unroll
        for (int ai = 0; ai < 2; ++ai)
#pragma unroll
            for (int m = 0; m < 4; ++m) { const float rs = rsv[4 * ai + m];
                const f32x4 g0 = acc[ai][0][m][0] * rs, g1 = acc[ai][0][m][1] * rs, u0 = acc[ai][1][m][0] * rs, u1 = acc[ai][1][m][1] * rs;
                f32x4 h0, h1;
#pragma unroll
                for (int j = 0; j < 4; ++j) { h0[j] = siluf_(g0[j]) * u0[j]; h1[j] = siluf_(g1[j]) * u1[j]; }
                *(u32x4*)(H + (size_t)(row0 + ai * HALF + m * 16) * 2816 + col) = pack8(h0, h1);
            }
    }
};
struct EpiFSS {
    static constexpr bool PERM = true, AFTER_DRAIN = false, PRE = false;
    bf16_t* Fo; float* SS;
    __device__ __forceinline__ void operator()(const f32x4 (&acc)[2][2][4][2], const Unit& u, int wr_, int wc_, int fr_, int fq_) const {
        EPI_IDS;
        const int row0 = u.pm * BM + wr * 64 + fr, col = u.pn * BM + wc * 32 + 8 * fq;
#pragma unroll
        for (int ai = 0; ai < 2; ++ai)
#pragma unroll
            for (int m = 0; m < 4; ++m) {
                const int row = row0 + ai * HALF + m * 16; float ss = 0.f;
#pragma unroll
                for (int bj = 0; bj < 2; ++bj) { const f32x4 v0 = acc[ai][bj][m][0], v1 = acc[ai][bj][m][1];
                    ss += (v0[0] * v0[0] + v0[1] * v0[1]) + (v0[2] * v0[2] + v0[3] * v0[3]) + (v1[0] * v1[0] + v1[1] * v1[1]) + (v1[2] * v1[2] + v1[3] * v1[3]);
                    *(u32x4*)(Fo + (size_t)row * 1024 + col + bj * HALF) = pack8(v0, v1); }
                ss += __shfl_xor(ss, 16); ss += __shfl_xor(ss, 32);
                if (fq == 0) SS[((size_t)u.pn * 33024 + row) * 4 + wc] = ss;
            }
    }
};
struct EpiWin {
    static constexpr bool PERM = true, AFTER_DRAIN = false, PRE = true;
    const float* RS;
    __device__ __forceinline__ void pre(const Unit& u, int wr, int fr, float (&rsv)[8]) const {
#pragma unroll
        for (int i = 0; i < 8; ++i) rsv[i] = RS ? RS[u.pm * BM + wr * 64 + fr + (i >> 2) * HALF + (i & 3) * 16] : 1.f;
    }
    bf16_t* Q; bf16_t* KV; bf16_t* ZR; const float* rope; int MR; bf16_t* VT;
    __device__ __forceinline__ void operator()(const f32x4 (&acc)[2][2][4][2], const Unit& u, int wr_, int wc_, int fr_, int fq_, const float (&rsv)[8]) const {
        EPI_IDS;
        const int row0 = u.pm * BM + wr * 64 + fr, pn = u.pn;
        bf16_t* base; int ld, colt;
        if (pn < 2) { base = Q; ld = 512; colt = pn * 256; } else if (pn == 2) { base = KV; ld = 256; colt = 0; } else { base = ZR; ld = 1792; colt = (pn - 3) * 256; }
        const bool rope_lane = (pn <= 2) && ((wc & 1) == 0) && (fq < 2);
        f32x4 css[2][4], sns[2][4];
#pragma unroll
        for (int ai = 0; ai < 2; ++ai)
#pragma unroll
            for (int m = 0; m < 4; ++m) { css[ai][m] = (f32x4){1.f, 1.f, 1.f, 1.f}; sns[ai][m] = (f32x4){0.f, 0.f, 0.f, 0.f};
                if (rope_lane) { const int row = row0 + ai * HALF + m * 16; const int pos = row < MR ? (row & 8191) + 16 : (row < MR + 16 ? row - MR : 0);
                    css[ai][m] = *(const f32x4*)(rope + pos * 16 + 4 * fq); sns[ai][m] = *(const f32x4*)(rope + pos * 16 + 8 + 4 * fq); } }
#pragma unroll
        for (int ai = 0; ai < 2; ++ai)
#pragma unroll
            for (int m = 0; m < 4; ++m) {
                const int row = row0 + ai * HALF + m * 16;
                const f32x4 cs = css[ai][m], sn = sns[ai][m];
#pragma unroll
                for (int bj = 0; bj < 2; ++bj) { f32x4 v0 = acc[ai][bj][m][0] * rsv[4 * ai + m], v1 = acc[ai][bj][m][1] * rsv[4 * ai + m];
                    if (rope_lane && (pn < 2 || bj == 0)) { const f32x4 x1 = v0, x2 = v1; v0 = x1 * cs - x2 * sn; v1 = x2 * cs + x1 * sn; }
                    const u32x4 pk = pack8(v0, v1);
                    if (pn == 2 && bj == 1) {
                        const int dv = wc * 32 + 8 * fq, pos = (row & 8191) + 16; bf16_t* vt = VT + (((size_t)((row >> 13) * 2 + (dv >> 6)) * 513 + (pos >> 4)) * 64 + (dv & 63)) * 16 + (pos & 15);
#pragma unroll
                        for (int j = 0; j < 8; ++j) vt[j * 16] = (bf16_t)((j & 1) ? (pk[j >> 1] >> 16) : (pk[j >> 1] & 0xffffu));
                    } else *(u32x4*)(base + (size_t)row * ld + colt + bj * HALF + wc * 32 + 8 * fq) = pk; }
                asm volatile("" ::: "memory");
            }
    }
};
struct EpiLora {
    static constexpr bool PERM = true, AFTER_DRAIN = false, PRE = false;
    bf16_t* LW; bf16_t* Aa; bf16_t* Gg; const float* w0; const float* a0;
    __device__ __forceinline__ void operator()(const f32x4 (&acc)[2][2][4][2], const Unit& u, int wr_, int wc_, int fr_, int fq_) const {
        EPI_IDS;
        const int row0 = u.pm * BM + wr * 64 + fr, pn = u.pn, kind = pn >> 1, colt = (pn & 1) * 256 + wc * 32 + 8 * fq;
#pragma unroll
        for (int bj = 0; bj < 2; ++bj) {
            const int col = colt + bj * HALF;
            f32x4 b0 = (f32x4){0.f, 0.f, 0.f, 0.f}, b1 = b0;
            if (kind == 0) { b0 = *(const f32x4*)(w0 + col); b1 = *(const f32x4*)(w0 + col + 4); }
            else if (kind == 1) { b0 = *(const f32x4*)(a0 + col); b1 = *(const f32x4*)(a0 + col + 4); }
#pragma unroll
            for (int ai = 0; ai < 2; ++ai)
#pragma unroll
                for (int m = 0; m < 4; ++m) {
                    const int row = row0 + ai * HALF + m * 16;
                    f32x4 v0 = acc[ai][bj][m][0] + b0, v1 = acc[ai][bj][m][1] + b1;
                    if (kind == 0) {
#pragma unroll
                        for (int j = 0; j < 4; ++j) { v0[j] = -0.6065306597126334f * sigmoidf_(v0[j]); v1[j] = -0.6065306597126334f * sigmoidf_(v1[j]); }
                        *(u32x4*)(LW + (size_t)row * 512 + col) = pack8(v0, v1);
                    } else if (kind == 1) {
#pragma unroll
                        for (int j = 0; j < 4; ++j) { v0[j] = sigmoidf_(v0[j]); v1[j] = sigmoidf_(v1[j]); }
                        *(u32x4*)(Aa + (size_t)row * 512 + col) = pack8(v0, v1);
                    } else {
                        *(u32x4*)(Gg + (size_t)row * 512 + col) = pack8(v0, v1);
                    }
                    asm volatile("" ::: "memory");
                }
        }
    }
};
struct EpiGates {
    static constexpr bool PERM = true, AFTER_DRAIN = false, PRE = false;
    bf16_t* Go;
    __device__ __forceinline__ void operator()(const f32x4 (&acc)[2][2][4][2], const Unit& u, int wr_, int wc_, int fr_, int fq_) const {
        EPI_IDS;
        const int row0 = u.pm * BM + wr * 64 + fr, col = u.pn * BM + wc * 32 + 8 * fq;
#pragma unroll
        for (int ai = 0; ai < 2; ++ai)
#pragma unroll
            for (int m = 0; m < 4; ++m)
#pragma unroll
                for (int bj = 0; bj < 2; ++bj) { f32x4 v0 = acc[ai][bj][m][0], v1 = acc[ai][bj][m][1];
#pragma unroll
                    for (int j = 0; j < 4; ++j) { v0[j] = sigmoidf_(v0[j]); v1[j] = sigmoidf_(v1[j]); }
                    *(u32x4*)(Go + (size_t)(row0 + ai * HALF + m * 16) * 2048 + col + bj * HALF) = pack8(v0, v1); }
    }
};
template <bool SECOND> struct EpiBranch {
    static constexpr bool PERM = true, AFTER_DRAIN = false, PRE = false;
    bf16_t* Mg; const bf16_t* Gt;
    __device__ __forceinline__ void operator()(const f32x4 (&acc)[2][2][4][2], const Unit& u, int wr_, int wc_, int fr_, int fq_) const {
        EPI_IDS;
        const int row0 = u.pm * BM + wr * 64 + fr, col = u.pn * BM + wc * 32 + 8 * fq;
#pragma unroll
        for (int ai = 0; ai < 2; ++ai)
#pragma unroll
            for (int m = 0; m < 4; ++m)
#pragma unroll
                for (int bj = 0; bj < 2; ++bj) {
                    const size_t row = (size_t)(row0 + ai * HALF + m * 16);
                    const u32x4 gw = *(const u32x4*)(Gt + row * 2048 + col + bj * HALF);
                    f32x4 v0 = acc[ai][bj][m][0], v1 = acc[ai][bj][m][1];
                    v0[0] *= bf_lo(gw.x); v0[1] *= bf_hi(gw.x); v0[2] *= bf_lo(gw.y); v0[3] *= bf_hi(gw.y);
                    v1[0] *= bf_lo(gw.z); v1[1] *= bf_hi(gw.z); v1[2] *= bf_lo(gw.w); v1[3] *= bf_hi(gw.w);
                    u32x4* dst = (u32x4*)(Mg + row * 1024 + col + bj * HALF);
                    if (SECOND) { const u32x4 pw = *dst;
                        v0[0] += bf_lo(pw.x); v0[1] += bf_hi(pw.x); v0[2] += bf_lo(pw.y); v0[3] += bf_hi(pw.y);
                        v1[0] += bf_lo(pw.z); v1[1] += bf_hi(pw.z); v1[2] += bf_lo(pw.w); v1[3] += bf_hi(pw.w); }
                    *dst = pack8(v0, v1);
                    asm volatile("" ::: "memory");
                }
    }
};
struct EpiMerge {
    static constexpr bool PERM = true, AFTER_DRAIN = false, PRE = false;
    bf16_t* Mg; const bf16_t* Gt; unsigned* cnt;
    __device__ __forceinline__ void operator()(const f32x4 (&acc)[2][2][4][2], const Unit& u, int wr_, int wc_, int fr_, int fq_) const {
        EPI_IDS;
        const int row0 = u.pm * BM + wr * 64 + fr, col = u.pn * HALF + wc * 32 + 8 * fq;
#pragma unroll
        for (int ai = 0; ai < 2; ++ai)
#pragma unroll
            for (int m = 0; m < 4; ++m) {
                const size_t row = (size_t)(row0 + ai * HALF + m * 16);
#ifdef MK_GATE_SC
                u32x4 ga, gr;
                { const unsigned long long* pa = (const unsigned long long*)(Gt + row * 2048 + col); const unsigned long long* pr = (const unsigned long long*)(Gt + row * 2048 + 1024 + col);
                  const unsigned long long a0_ = __hip_atomic_load(pa, __ATOMIC_RELAXED, __HIP_MEMORY_SCOPE_SYSTEM), a1_ = __hip_atomic_load(pa + 1, __ATOMIC_RELAXED, __HIP_MEMORY_SCOPE_SYSTEM);
                  const unsigned long long r0_ = __hip_atomic_load(pr, __ATOMIC_RELAXED, __HIP_MEMORY_SCOPE_SYSTEM), r1_ = __hip_atomic_load(pr + 1, __ATOMIC_RELAXED, __HIP_MEMORY_SCOPE_SYSTEM);
                  ga.x = (unsigned)a0_; ga.y = (unsigned)(a0_ >> 32); ga.z = (unsigned)a1_; ga.w = (unsigned)(a1_ >> 32); gr.x = (unsigned)r0_; gr.y = (unsigned)(r0_ >> 32); gr.z = (unsigned)r1_; gr.w = (unsigned)(r1_ >> 32); }
#else
                const u32x4 ga = *(const u32x4*)(Gt + row * 2048 + col), gr = *(const u32x4*)(Gt + row * 2048 + 1024 + col);
#endif
#ifdef MK_GATE_CHECK
                { const float gmx = fmaxf(fmaxf(fmaxf(bf_lo(ga.x), bf_hi(ga.x)), fmaxf(bf_lo(ga.y), bf_hi(ga.y))), fmaxf(fmaxf(bf_lo(gr.z), bf_hi(gr.z)), fmaxf(bf_lo(gr.w), bf_hi(gr.w))));
                  const float gmn = fminf(fminf(fminf(bf_lo(ga.x), bf_hi(ga.x)), fminf(bf_lo(ga.y), bf_hi(ga.y))), fminf(fminf(bf_lo(gr.z), bf_hi(gr.z)), fminf(bf_lo(gr.w), bf_hi(gr.w))));
                  if (gmx > 1.001f || gmn < 0.f) atomicAdd(cnt, 1u); }
#endif
                const f32x4 a0 = acc[ai][0][m][0], a1 = acc[ai][0][m][1], r0 = acc[ai][1][m][0], r1 = acc[ai][1][m][1];
                f32x4 v0, v1;
                v0[0] = a0[0] * bf_lo(ga.x) + r0[0] * bf_lo(gr.x); v0[1] = a0[1] * bf_hi(ga.x) + r0[1] * bf_hi(gr.x); v0[2] = a0[2] * bf_lo(ga.y) + r0[2] * bf_lo(gr.y); v0[3] = a0[3] * bf_hi(ga.y) + r0[3] * bf_hi(gr.y);
                v1[0] = a1[0] * bf_lo(ga.z) + r1[0] * bf_lo(gr.z); v1[1] = a1[1] * bf_hi(ga.z) + r1[1] * bf_hi(gr.z); v1[2] = a1[2] * bf_lo(ga.w) + r1[2] * bf_lo(gr.w); v1[3] = a1[3] * bf_hi(ga.w) + r1[3] * bf_hi(gr.w);
                *(u32x4*)(Mg + row * 1024 + col) = pack8(v0, v1);
                asm volatile("" ::: "memory");
            }
    }
};
struct EpiPlain {
    static constexpr bool PERM = true, AFTER_DRAIN = false, PRE = false;
    bf16_t* O; int ldc; int npl; size_t plane;
    __device__ __forceinline__ void operator()(const f32x4 (&acc)[2][2][4][2], const Unit& u, int wr_, int wc_, int fr_, int fq_) const {
        EPI_IDS;
        const int row0 = u.pm * BM + wr * 64 + fr, col = (u.pn % npl) * BM + wc * 32 + 8 * fq; bf16_t* O = this->O + (size_t)(u.pn / npl) * plane;
#pragma unroll
        for (int ai = 0; ai < 2; ++ai)
#pragma unroll
            for (int m = 0; m < 4; ++m)
#pragma unroll
                for (int bj = 0; bj < 2; ++bj) *(u32x4*)(O + (size_t)(row0 + ai * HALF + m * 16) * ldc + col + bj * HALF) = pack8(acc[ai][bj][m][0], acc[ai][bj][m][1]);
    }
};
struct EpiGateMerge {
    static constexpr bool PERM = true, AFTER_DRAIN = false, PRE = true;
    const float* RS;
    __device__ __forceinline__ void pre(const Unit& u, int wr, int fr, float (&rsv)[8]) const {
#pragma unroll
        for (int i = 0; i < 8; ++i) rsv[i] = RS ? RS[u.pm * BM + wr * 64 + fr + (i >> 2) * HALF + (i & 3) * 16] : 1.f;
    }
    bf16_t* Mg; const bf16_t* Y1; const bf16_t* Y2;
    __device__ __forceinline__ void operator()(const f32x4 (&acc)[2][2][4][2], const Unit& u, int wr_, int wc_, int fr_, int fq_, const float (&rsv)[8]) const {
        EPI_IDS;
        const int row0 = u.pm * BM + wr * 64 + fr, col = u.pn * HALF + wc * 32 + 8 * fq;
        u32x4 y1s[2][4], y2s[2][4];
#pragma unroll
        for (int ai = 0; ai < 2; ++ai)
#pragma unroll
            for (int m = 0; m < 4; ++m) { const size_t o = (size_t)(row0 + ai * HALF + m * 16) * 1024 + col; y1s[ai][m] = *(const u32x4*)(Y1 + o); y2s[ai][m] = *(const u32x4*)(Y2 + o); }
#pragma unroll
        for (int ai = 0; ai < 2; ++ai)
#pragma unroll
            for (int m = 0; m < 4; ++m) {
                const size_t o = (size_t)(row0 + ai * HALF + m * 16) * 1024 + col;
                const u32x4 y1 = y1s[ai][m], y2 = y2s[ai][m];
                const float rs = rsv[4 * ai + m];
                const f32x4 a0 = acc[ai][0][m][0] * rs, a1 = acc[ai][0][m][1] * rs, r0 = acc[ai][1][m][0] * rs, r1 = acc[ai][1][m][1] * rs;
                f32x4 v0, v1;
                v0[0] = sigmoidf_(a0[0]) * bf_lo(y1.x) + sigmoidf_(r0[0]) * bf_lo(y2.x); v0[1] = sigmoidf_(a0[1]) * bf_hi(y1.x) + sigmoidf_(r0[1]) * bf_hi(y2.x);
                v0[2] = sigmoidf_(a0[2]) * bf_lo(y1.y) + sigmoidf_(r0[2]) * bf_lo(y2.y); v0[3] = sigmoidf_(a0[3]) * bf_hi(y1.y) + sigmoidf_(r0[3]) * bf_hi(y2.y);
                v1[0] = sigmoidf_(a1[0]) * bf_lo(y1.z) + sigmoidf_(r1[0]) * bf_lo(y2.z); v1[1] = sigmoidf_(a1[1]) * bf_hi(y1.z) + sigmoidf_(r1[1]) * bf_hi(y2.z);
                v1[2] = sigmoidf_(a1[2]) * bf_lo(y1.w) + sigmoidf_(r1[2]) * bf_lo(y2.w); v1[3] = sigmoidf_(a1[3]) * bf_hi(y1.w) + sigmoidf_(r1[3]) * bf_hi(y2.w);
                *(u32x4*)(Mg + o) = pack8(v0, v1);
                asm volatile("" ::: "memory");
            }
    }
};
template <class Epi, class Sched, bool ALIGN_EPI = false, bool SP2 = false>
__device__ __forceinline__ void gemm_phase(PG8_LAS unsigned char* lds, const Gemm g, const Sched& S, const Epi& E) {
    int tid_ = threadIdx.x; asm volatile("" : "+v"(tid_));
    const int tid = tid_, wid = __builtin_amdgcn_readfirstlane(tid >> 6), lane = tid & 63, wr = wid >> 2, wc = wid & 3, fr = lane & 15, fq = lane >> 4;
    const int K = g.K, nt = K / BK;
    unsigned voffA[2], voffB[2];
#pragma unroll
    for (int i = 0; i < 2; ++i) { int R, C; stage_rc(tid * 16 + i * 8192, R, C); const int Rb = Epi::PERM ? ((R & ~31) + perm32(R & 31)) : R;
        voffA[i] = (unsigned)(R * g.lda + C) * 2u; voffB[i] = (unsigned)(Rb * g.ldb + C) * 2u; }
    const size_t kstep = (size_t)(BK * 2);
    const size_t hstepA = (size_t)HALF * g.lda * 2, hstepB = (size_t)HALF * g.ldb * 2;
    const size_t tstepA = 2 * hstepA, tstepB = 2 * hstepB;
    const unsigned ldsw = (unsigned)wid * 1024u;
    const int aoff = lds_byte(wr * 64 + fr, fq * 8), boff = lds_byte(wc * 32 + fr, fq * 8);
#define PG8_SA(b, h) (((b) * 2 + (h)) * HTB)
#define PG8_SB(b, h) ((4 + (b) * 2 + (h)) * HTB)
#define PG8_STAGE(bufoff, gbase, voff) do { _Pragma("unroll") for (int _i = 0; _i < 2; ++_i) \
        __builtin_amdgcn_global_load_lds((const unsigned*)((const char*)(gbase) + (voff)[_i]), (PG8_LAS unsigned*)(lds + (bufoff) + ldsw + _i * 8192), 16, 0, 0); } while (0)
#define PG8_LDA(dst, b, h) do { _Pragma("unroll") for (int m = 0; m < 4; ++m) _Pragma("unroll") for (int k = 0; k < 2; ++k) dst[m][k] = *(const PG8_LAS bf16x8*)(lds + PG8_SA(b, h) + aoff + m * 2048 + k * 1024); } while (0)
#define PG8_LDB(dst, b, h) do { _Pragma("unroll") for (int n = 0; n < 2; ++n) _Pragma("unroll") for (int k = 0; k < 2; ++k) dst[n][k] = *(const PG8_LAS bf16x8*)(lds + PG8_SB(b, h) + boff + n * 2048 + k * 1024); } while (0)
#define PG8_MMA(ai, bj, At, Bt) do { __builtin_amdgcn_s_setprio(1); _Pragma("unroll") for (int m = 0; m < 4; ++m) _Pragma("unroll") for (int n = 0; n < 2; ++n) _Pragma("unroll") for (int k = 0; k < 2; ++k) \
        acc[ai][bj][m][n] = __builtin_amdgcn_mfma_f32_16x16x32_bf16(Bt[n][k], At[m][k], acc[ai][bj][m][n], 0, 0, 0); __builtin_amdgcn_s_setprio(0); } while (0)
#define PG8_WAIT_V(n) asm volatile("s_waitcnt vmcnt(" #n ")" ::: "memory")
#define PG8_WAIT_L(n) asm volatile("s_waitcnt lgkmcnt(" #n ")" ::: "memory")
#define PG8_BAR __builtin_amdgcn_s_barrier()
#define PG8_SCHED __builtin_amdgcn_sched_barrier(0)
    Unit cur, nxt; int ui = 0;
    if (!S.next(0, cur)) return;
    f32x4 acc[2][2][4][2];
#pragma unroll
    for (int a = 0; a < 2; ++a)
#pragma unroll
        for (int b = 0; b < 2; ++b)
#pragma unroll
            for (int m = 0; m < 4; ++m)
#pragma unroll
                for (int n = 0; n < 2; ++n) acc[a][b][m][n] = (f32x4){0.f, 0.f, 0.f, 0.f};
    bf16x8 At[4][2], B0[2][2], B1[2][2];
    const char* cA = (const char*)(cur.pn >= g.nsplit ? g.A2 : g.A) + (size_t)cur.pm * tstepA; const char* cB = (const char*)g.Bt + (size_t)cur.pn * tstepB;
    S.a_ready(cur);
    float rsv[8]; if constexpr (Epi::PRE) E.pre(cur, wr, fr, rsv);
    if constexpr (SP2) {
        PG8_STAGE(PG8_SB(0, 0), cB, voffB); PG8_STAGE(PG8_SB(0, 1), cB + hstepB, voffB); PG8_STAGE(PG8_SA(0, 0), cA, voffA); PG8_STAGE(PG8_SA(0, 1), cA + hstepA, voffA);
        if (wr == 1) PG8_BAR;
        PG8_WAIT_V(2); PG8_BAR;
        PG8_STAGE(PG8_SB(1, 0), cB + kstep, voffB); PG8_STAGE(PG8_SA(1, 0), cA + kstep, voffA); PG8_STAGE(PG8_SB(1, 1), cB + hstepB + kstep, voffB);
        PG8_WAIT_V(6); PG8_BAR;
    } else {
        PG8_STAGE(PG8_SB(0, 0), cB, voffB); PG8_STAGE(PG8_SA(0, 0), cA, voffA); PG8_STAGE(PG8_SB(0, 1), cB + hstepB, voffB); PG8_STAGE(PG8_SA(0, 1), cA + hstepA, voffA);
        if (wr == 1) PG8_BAR;
        PG8_WAIT_V(4); PG8_BAR;
        PG8_STAGE(PG8_SB(1, 0), cB + kstep, voffB); PG8_STAGE(PG8_SA(1, 0), cA + kstep, voffA); PG8_STAGE(PG8_SB(1, 1), cB + hstepB + kstep, voffB);
        PG8_WAIT_V(6); PG8_BAR;
    }
    for (;;) {
        const bool has_next = S.next(ui + 1, nxt);
        const char* nA = has_next ? (const char*)(nxt.pn >= g.nsplit ? g.A2 : g.A) + (size_t)nxt.pm * tstepA : cA; const char* nB = has_next ? (const char*)g.Bt + (size_t)nxt.pn * tstepB : cB;
        for (int t = 0; t < nt; t += 2) {
            const bool last = (t == nt - 2);
            const char* a1 = cA + (size_t)(t + 1) * kstep;
            const char* a2 = last ? nA : cA + (size_t)(t + 2) * kstep; const char* b2 = last ? nB : cB + (size_t)(t + 2) * kstep;
            const char* a3 = a2 + kstep; const char* b3 = b2 + kstep;
            if (last && has_next) S.a_ready(nxt);
            if constexpr (SP2) {
            PG8_LDB(B0, 0, 0); PG8_LDB(B1, 0, 1); PG8_SCHED; PG8_LDA(At, 0, 0); PG8_STAGE(PG8_SA(1, 1), a1 + hstepA, voffA);
            PG8_WAIT_V(8); PG8_WAIT_L(0); PG8_BAR; PG8_MMA(0, 0, At, B0); PG8_MMA(0, 1, At, B1); PG8_BAR; PG8_SCHED;
            PG8_LDA(At, 0, 1); PG8_STAGE(PG8_SB(0, 0), b2, voffB); PG8_STAGE(PG8_SB(0, 1), b2 + hstepB, voffB); PG8_STAGE(PG8_SA(0, 0), a2, voffA);
            PG8_WAIT_V(8); PG8_WAIT_L(0); PG8_BAR; PG8_MMA(1, 0, At, B0); PG8_MMA(1, 1, At, B1); PG8_BAR; PG8_SCHED;
            PG8_LDB(B0, 1, 0); PG8_LDB(B1, 1, 1); PG8_SCHED; PG8_LDA(At, 1, 0); PG8_STAGE(PG8_SA(0, 1), a2 + hstepA, voffA);
            PG8_WAIT_V(8); PG8_WAIT_L(0); PG8_BAR; PG8_MMA(0, 0, At, B0); PG8_MMA(0, 1, At, B1); PG8_BAR; PG8_SCHED;
            PG8_LDA(At, 1, 1); PG8_STAGE(PG8_SB(1, 0), b3, voffB); PG8_STAGE(PG8_SB(1, 1), b3 + hstepB, voffB); PG8_STAGE(PG8_SA(1, 0), a3, voffA);
            PG8_WAIT_V(8); PG8_WAIT_L(0); PG8_BAR; PG8_MMA(1, 0, At, B0); PG8_MMA(1, 1, At, B1); PG8_BAR; PG8_SCHED;
            } else {
            PG8_LDB(B0, 0, 0); PG8_SCHED; PG8_LDA(At, 0, 0); PG8_STAGE(PG8_SA(1, 1), a1 + hstepA, voffA);
            PG8_WAIT_L(8); PG8_BAR; PG8_WAIT_L(0); PG8_MMA(0, 0, At, B0); PG8_BAR; PG8_SCHED;
            PG8_LDB(B1, 0, 1); PG8_STAGE(PG8_SB(0, 0), b2, voffB);
            PG8_BAR; PG8_WAIT_L(0); PG8_MMA(0, 1, At, B1); PG8_BAR;
            PG8_LDA(At, 0, 1); PG8_STAGE(PG8_SA(0, 0), a2, voffA);
            PG8_BAR; PG8_WAIT_L(0); PG8_MMA(1, 0, At, B0); PG8_BAR; PG8_SCHED;
            PG8_STAGE(PG8_SB(0, 1), b2 + hstepB, voffB);
            PG8_WAIT_V(6); PG8_BAR; PG8_MMA(1, 1, At, B1); PG8_BAR;
            PG8_LDB(B0, 1, 0); PG8_SCHED; PG8_LDA(At, 1, 0); PG8_STAGE(PG8_SA(0, 1), a2 + hstepA, voffA);
            PG8_WAIT_L(8); PG8_BAR; PG8_WAIT_L(0); PG8_MMA(0, 0, At, B0); PG8_BAR; PG8_SCHED;
            PG8_LDB(B1, 1, 1); PG8_STAGE(PG8_SB(1, 0), b3, voffB);
            PG8_BAR; PG8_WAIT_L(0); PG8_MMA(0, 1, At, B1); PG8_BAR;
            PG8_LDA(At, 1, 1); PG8_STAGE(PG8_SA(1, 0), a3, voffA);
            PG8_BAR; PG8_WAIT_L(0); PG8_MMA(1, 0, At, B0); PG8_BAR; PG8_SCHED;
            PG8_STAGE(PG8_SB(1, 1), b3 + hstepB, voffB);
            PG8_WAIT_V(6); PG8_BAR; PG8_MMA(1, 1, At, B1); PG8_BAR;
            }
        }
        if constexpr (ALIGN_EPI) { if (wr == 0) PG8_BAR; }
        if constexpr (!Epi::AFTER_DRAIN) { if constexpr (Epi::PRE) E(acc, cur, wr, wc, fr, fq, rsv); else E(acc, cur, wr, wc, fr, fq); S.done(cur); }
        if (!has_next) break;
#pragma unroll
        for (int a = 0; a < 2; ++a)
#pragma unroll
            for (int b = 0; b < 2; ++b)
#pragma unroll
                for (int m = 0; m < 4; ++m)
#pragma unroll
                    for (int n = 0; n < 2; ++n) acc[a][b][m][n] = (f32x4){0.f, 0.f, 0.f, 0.f};
        cur = nxt; cA = nA; cB = nB; ++ui;
        if constexpr (Epi::PRE) E.pre(cur, wr, fr, rsv);
        if constexpr (ALIGN_EPI) { if (wr == 1) PG8_BAR; }
    }
    PG8_WAIT_V(0);
    if constexpr (!ALIGN_EPI) { if (wr == 0) PG8_BAR; }
    PG8_BAR;
    if constexpr (Epi::AFTER_DRAIN) { E.fused(acc, cur, wr, wc, fr, fq, lds, wid, lane); S.done(cur); }
#undef PG8_SA
#undef PG8_SB
#undef PG8_STAGE
#undef PG8_LDA
#undef PG8_LDB
#undef PG8_MMA
#undef PG8_WAIT_V
#undef PG8_WAIT_L
#undef PG8_BAR
#undef PG8_SCHED
}
}

constexpr int NWAVES = 8;
constexpr int DM = 1024, NB = 4, SEQL = 8192, NMETA = 16, DFF = 2816;
constexpr int MR = NB * SEQL;
constexpr int MP = MR + 256;
constexpr int NHID2 = 2 * DFF;
constexpr int NIN = 4608, NIN_A = 2560;
#ifndef MK_GN_EPS
#define MK_GN_EPS 64e-5f
#endif
constexpr float NORM_EPS = 1e-6f, GN_EPS = MK_GN_EPS;

constexpr size_t MiB = 1u << 20;
constexpr size_t WS_CTL = 0, CTL_ZERO_BYTES = 64 * 1024;
constexpr size_t WS_WGU1 = 128 * 1024;
constexpr size_t WS_WD1  = WS_WGU1 + (size_t)NHID2 * DM * 2;
constexpr size_t WS_WIN  = WS_WD1 + (size_t)DM * DFF * 2;
constexpr size_t WS_WBR = WS_WIN + (size_t)NIN * DM * 2;
constexpr size_t WS_WATT = WS_WBR, WS_WRWKV = WS_WBR + (size_t)DM * 512 * 2;
constexpr size_t WS_WMIX = WS_WBR + (size_t)2048 * DM * 2;
constexpr size_t WS_WGU2 = WS_WMIX + (size_t)DM * DM * 2;
constexpr size_t WS_WD2  = WS_WGU2 + (size_t)NHID2 * DM * 2;
constexpr size_t WS_WL   = WS_WD2 + (size_t)DM * DFF * 2;
constexpr size_t WS_ROPE = WS_WL + (size_t)1536 * 256 * 2;
constexpr size_t WS_SS   = WS_ROPE + (size_t)8208 * 16 * 4;
constexpr size_t WS_HMETA = WS_SS + (size_t)MP * 16 * 4;
constexpr size_t WS_SMALL_END = WS_HMETA + 16 * 1024 * 4;
constexpr size_t WS_XN = 52 * MiB;
constexpr size_t WS_HM = WS_XN, WS_RS2 = WS_XN + 1 * MiB, WS_RS3 = WS_XN + 2 * MiB;
constexpr size_t WS_F  = WS_XN + (size_t)MP * DM * 2;
constexpr size_t WS_BIG = WS_F + (size_t)MP * DM * 2;
constexpr size_t WS_HID = WS_BIG;
constexpr size_t WS_Q  = WS_BIG;
constexpr size_t WS_KV = WS_Q + (size_t)MP * 512 * 2;
constexpr size_t WS_ZR = WS_KV + (size_t)MP * 256 * 2;
constexpr size_t WS_LW = WS_ZR + (size_t)MP * 1792 * 2;
constexpr size_t WS_AA = WS_LW + (size_t)MP * 512 * 2;
constexpr size_t WS_GG = WS_AA + (size_t)MP * 512 * 2;
constexpr size_t WS_LA = WS_GG + (size_t)MP * 512 * 2;
constexpr size_t WS_MIX_END = WS_LA + (size_t)MP * 256 * 2;
constexpr size_t WS_QY = WS_LA;
constexpr size_t WS_SST = WS_LW;
constexpr size_t WS_DOTS = WS_SS;
static_assert(WS_QY + (size_t)4128 * 16384 <= 512 * MiB && (size_t)4128 * 8192 <= (size_t)MP * 512 * 4, "rwkv images");
constexpr size_t WS_GATES = WS_LW;
constexpr size_t WS_MERGED = WS_ZR;
constexpr size_t WS_VT = 503 * MiB + 512 * 1024;
constexpr int PV = 8208;
constexpr size_t WS_END = 512 * MiB;
static_assert(WS_QY + (size_t)4128 * 16384 <= WS_VT && WS_VT + (size_t)NB * 2 * 64 * PV * 2 <= WS_END, "VT");
static_assert(WS_SMALL_END <= WS_XN && WS_HID + (size_t)MP * DFF * 2 <= WS_END && WS_MIX_END <= WS_END && WS_MERGED + (size_t)MR * DM * 2 <= WS_LW && WS_GATES + (size_t)MR * 2048 * 2 <= WS_END, "d_ws map");
constexpr int CW_BAR = 1024;

constexpr int RING_OFF = 0, RING_BYTES = 131072;
constexpr int LDSCTL_OFF = RING_BYTES, MISC_OFF = LDSCTL_OFF + 320;
constexpr int LDS_BYTES = 147456;

#define GAS __attribute__((address_space(1)))
#define LAS __attribute__((address_space(3)))
typedef unsigned short bf16;
typedef unsigned v4u __attribute__((ext_vector_type(4)));
typedef unsigned v2u __attribute__((ext_vector_type(2)));
typedef float f32x4 __attribute__((ext_vector_type(4)));
typedef float f32x2v __attribute__((ext_vector_type(2)));
typedef float f32x16 __attribute__((ext_vector_type(16)));
typedef short bf16x8 __attribute__((ext_vector_type(8)));
typedef GAS unsigned gu32;
#define RLX_AGENT __ATOMIC_RELAXED, __HIP_MEMORY_SCOPE_AGENT
#define LDS_WAIT() asm volatile("s_waitcnt lgkmcnt(0)" ::: "memory")
#define VM_WAIT() asm volatile("s_waitcnt vmcnt(0)" ::: "memory")
__device__ __forceinline__ unsigned pk2(float lo, float hi) { return pg8::cvt_pk_bf16(lo, hi); }
__device__ __forceinline__ unsigned f2bf(float f) { return pg8::cvt_pk_bf16(f, 0.f) & 0xffffu; }
__device__ __forceinline__ float bflo(unsigned w) { return __builtin_bit_cast(float, w << 16); }
__device__ __forceinline__ float bfhi(unsigned w) { return __builtin_bit_cast(float, w & 0xffff0000u); }
__device__ __forceinline__ float bf1(bf16 h) { return __builtin_bit_cast(float, (unsigned)h << 16); }
__device__ __forceinline__ float sigm(float x) { return 1.0f / (1.0f + __expf(-x)); }

#define XB_TMO      128
#define XB_XCNT(j)  (256  + 64 * (j))
#define XB_XSUB(j)  (1280 + 64 * (j))
#define XB_XGEN(j)  (2304 + 64 * (j))
#define XB_TOP      3328
#define XB_TOPGEN   3392
#define XCD_BAR_WORDS 3456
#define XB_SPIN_CAP (1u << 24)

__device__ __forceinline__ unsigned xb_ld(unsigned* p)              { return __hip_atomic_load(p, __ATOMIC_RELAXED, __HIP_MEMORY_SCOPE_AGENT); }
__device__ __forceinline__ unsigned xb_add(unsigned* p, unsigned v) { return __hip_atomic_fetch_add(p, v, __ATOMIC_RELAXED, __HIP_MEMORY_SCOPE_AGENT); }
__device__ __forceinline__ unsigned xb_xcc_id() { return (unsigned)__builtin_amdgcn_s_getreg((3 << 11) | 20) & 0xFu; }
#define XB_SPIN(cond, bar) do { unsigned _sp = 0; while (cond) { __builtin_amdgcn_s_sleep(1); \
    if ((++_sp & 255u) == 0u) { if (xb_ld(&(bar)[XB_TMO])) break; if (_sp > XB_SPIN_CAP) { atomicAdd(&(bar)[XB_TMO], 1u); break; } } } } while (0)

struct XcdBarrier {
    unsigned* bar; unsigned x;
    volatile LAS unsigned* st;
};

__device__ __forceinline__ XcdBarrier xcd_barrier_post(unsigned* bar, volatile LAS unsigned* st) {
    XcdBarrier b; b.bar = bar; b.x = xb_xcc_id(); b.st = st;
    if (threadIdx.x == 0) (void)xb_add(&bar[XB_XCNT(b.x)], 1u);
    return b;
}
__device__ __forceinline__ void xcd_barrier_complete(unsigned* bar, unsigned x, unsigned& nloc, unsigned& nx) {
    const unsigned G = gridDim.x * gridDim.y * gridDim.z;
    unsigned sum, cnt, mine, sp = 0u;
    for (;;) {
        sum = 0u; cnt = 0u; mine = 0u;
#pragma unroll
        for (unsigned j = 0; j < 16; ++j) { const unsigned c = xb_ld(&bar[XB_XCNT(j)]); sum += c; cnt += (c > 0u) ? 1u : 0u; mine = (j == x) ? c : mine; }
        if (sum == G) break;
        __builtin_amdgcn_s_sleep(1);
        if ((++sp & 255u) == 0u) { if (xb_ld(&bar[XB_TMO])) break; if (sp > XB_SPIN_CAP) { atomicAdd(&bar[XB_TMO], 1u); break; } }
    }
    nloc = mine > 0u ? mine : 1u; nx = cnt > 0u ? cnt : 1u;
}

__device__ __forceinline__ void xcd_barrier(const XcdBarrier& b) {
    asm volatile("s_waitcnt vmcnt(0)" ::: "memory");
    __syncthreads();
    if (threadIdx.x == 0) {
        unsigned* bar = b.bar;
        __builtin_amdgcn_s_waitcnt(0);
        unsigned nloc = b.st[0], nx = b.st[1];
        if (nloc == 0u) { xcd_barrier_complete(bar, b.x, nloc, nx); b.st[0] = nloc; b.st[1] = nx; }
        const unsigned old = xb_add(&bar[XB_XSUB(b.x)], 1u);
        const unsigned gen = old / nloc;
        if (old + 1u == (gen + 1u) * nloc) {
            __builtin_amdgcn_fence(__ATOMIC_RELEASE, "");
            asm volatile("s_waitcnt vmcnt(0)" ::: "memory");
            const unsigned og = xb_add(&bar[XB_TOP], 1u);
            const unsigned tg = og / nx;
            if (og + 1u == (tg + 1u) * nx) xb_add(&bar[XB_TOPGEN], 1u);
            else XB_SPIN(xb_ld(&bar[XB_TOPGEN]) == tg, bar);
            __builtin_amdgcn_fence(__ATOMIC_ACQUIRE, "");
            xb_add(&bar[XB_XGEN(b.x)], 1u);
            asm volatile("s_waitcnt vmcnt(0)" ::: "memory");
        } else {
            XB_SPIN(xb_ld(&bar[XB_XGEN(b.x)]) == gen, bar);
            __builtin_amdgcn_fence(__ATOMIC_ACQUIRE, "");
            asm volatile("s_waitcnt vmcnt(0)" ::: "memory");
        }
    }
    __syncthreads();
}


struct Frame {
    LAS unsigned char* lds;
    volatile LAS unsigned* MISC;
    gu32* ctl;
    int tid, lane, wave;
    int vcu, G;
    float* out; unsigned char* ws;
};
struct Args { const float* in[28]; float* out; unsigned char* ws; int ph_lo, ph_hi, li, pad; };
__device__ __forceinline__ const float* inp(int k) {
    typedef const float* cfp;
    const __attribute__((address_space(4))) char* kp = (const __attribute__((address_space(4))) char*)__builtin_amdgcn_kernarg_segment_ptr();
    return *(volatile const __attribute__((address_space(4))) cfp*)(kp + 8 * k);
}
__device__ __forceinline__ float wave_sum(float v) {
#pragma unroll
    for (int o = 1; o < 64; o <<= 1) v += __shfl_xor(v, o);
    return v;
}

__device__ __forceinline__ float dpp_f(float v, const int ctrl_sel) {
    const int x = __builtin_bit_cast(int, v); int r;
    if (ctrl_sel == 0) r = __builtin_amdgcn_update_dpp(0, x, 0xB1, 0xF, 0xF, true);
    else if (ctrl_sel == 1) r = __builtin_amdgcn_update_dpp(0, x, 0x4E, 0xF, 0xF, true);
    else r = __builtin_amdgcn_update_dpp(0, x, 0x141, 0xF, 0xF, true);
    return __builtin_bit_cast(float, r);
}
__device__ __forceinline__ float wave_sum_dpp(float v) {
    v += dpp_f(v, 0); v += dpp_f(v, 1); v += dpp_f(v, 2);
    { const int x = __builtin_bit_cast(int, v); v += __builtin_bit_cast(float, __builtin_amdgcn_update_dpp(0, x, 0x140, 0xF, 0xF, true)); }
    const int xi = __builtin_bit_cast(int, v);
    return (__builtin_bit_cast(float, __builtin_amdgcn_readlane(xi, 0)) + __builtin_bit_cast(float, __builtin_amdgcn_readlane(xi, 16))) + (__builtin_bit_cast(float, __builtin_amdgcn_readlane(xi, 32)) + __builtin_bit_cast(float, __builtin_amdgcn_readlane(xi, 48)));
}
struct MapId { __device__ __forceinline__ int operator()(int n) const { return n; } };
struct MapGateUp { __device__ __forceinline__ int operator()(int n) const { return n < DFF ? 256 * (n >> 7) + (n & 127) : 256 * ((n - DFF) >> 7) + 128 + ((n - DFF) & 127); } };
struct MapBrA { __device__ __forceinline__ int operator()(int n) const { return 256 * (n >> 7) + (n & 127); } };
struct MapBrR { __device__ __forceinline__ int operator()(int n) const { return 256 * (n >> 7) + 128 + (n & 127); } };
struct MapWin { __device__ __forceinline__ int operator()(int n) const { if (n >= 2560) { const int j = n - 2560; return j < 1024 ? 2560 + 256 * (j >> 7) + (j & 127) : 2560 + 256 * ((j - 1024) >> 7) + 128 + ((j - 1024) & 127); } if (n >= 640) return n; const int s = n & 63; if (s >= 16) return n; const int d = (s >= 4 && s < 8) ? s + 4 : ((s >= 8 && s < 12) ? s - 4 : s); return n - s + d; } };
template <class Map>
__device__ __forceinline__ void p0_transpose_item(const float* W, int K, int N, bf16* WT, LAS float* scr, int item, int lane, Map map, const float* kgain = nullptr) {
    const int ldk = K, kofs = 0;
    const int nblk = N / 32, kb = item / nblk, nb = item % nblk, k0 = 64 * kb, n0 = 32 * nb;
#pragma unroll 8
    for (int i = 0; i < 32; ++i) { const int kk = 2 * i + (lane >> 5); scr[kk * 33 + (lane & 31)] = W[(size_t)(k0 + kk) * N + n0 + (lane & 31)]; }
    LDS_WAIT(); asm volatile("" ::: "memory");
    const int c = lane & 7;
    f32x4 ga = (f32x4){1.f, 1.f, 1.f, 1.f}, gb = ga; if (kgain) { ga = *(const f32x4*)(kgain + k0 + 8 * c); gb = *(const f32x4*)(kgain + k0 + 8 * c + 4); }
#pragma unroll
    for (int j = 0; j < 4; ++j) { const int n = (lane >> 3) + 8 * j; const LAS float* s = scr + (8 * c) * 33 + n;
        v4u o; o.x = pk2(s[0 * 33] * ga.x, s[1 * 33] * ga.y); o.y = pk2(s[2 * 33] * ga.z, s[3 * 33] * ga.w); o.z = pk2(s[4 * 33] * gb.x, s[5 * 33] * gb.y); o.w = pk2(s[6 * 33] * gb.z, s[7 * 33] * gb.w);
        *(GAS v4u*)(WT + (size_t)map(n0 + n) * ldk + kofs + k0 + 8 * c) = o; }
    LDS_WAIT(); asm volatile("" ::: "memory");
}
__device__ __forceinline__ void rms_row_to_bf16(int lane, const float* xrow, const float* gain, bf16* orow) {
    const f32x4* xr = (const f32x4*)xrow + lane; const f32x4* gr = (const f32x4*)gain + lane;
    f32x4 v[4]; float s = 0.f;
#pragma unroll
    for (int j = 0; j < 4; ++j) { v[j] = xr[64 * j]; s += (v[j].x * v[j].x + v[j].y * v[j].y) + (v[j].z * v[j].z + v[j].w * v[j].w); }
    const float rstd = 1.f / sqrtf(wave_sum(s) * (1.f / DM) + NORM_EPS);
    v2u* o8 = (v2u*)orow + lane;
#pragma unroll
    for (int j = 0; j < 4; ++j) { const f32x4 g = gr[64 * j]; v2u w; w.x = pk2(v[j].x * rstd * g.x, v[j].y * rstd * g.y); w.y = pk2(v[j].z * rstd * g.z, v[j].w * rstd * g.w); o8[64 * j] = w; }
}
#define XN1_BASE (F.out)
__device__ __forceinline__ void p0_prologue(Frame& F, const Args& A) {
    LAS float* scr = (LAS float*)(F.lds + RING_OFF + F.wave * 16384);
    const int gw = F.vcu * NWAVES + F.wave, NGW = F.G * NWAVES;
    unsigned char* ws = F.ws;
    constexpr int I_GU = (DM / 64) * (NHID2 / 32), I_D = (DFF / 64) * (DM / 32), I_IN = (DM / 64) * (NIN / 32);
    constexpr int NITEMS = I_GU + I_D + I_IN;
    for (int it = gw; it < NITEMS; it += NGW) {
        int r = it;
        if (r < I_GU) { p0_transpose_item(inp(3), DM, NHID2, (bf16*)(ws + WS_WGU1), scr, r, F.lane, MapGateUp()); continue; } r -= I_GU;
        if (r < I_D) { p0_transpose_item(inp(4), DFF, DM, (bf16*)(ws + WS_WD1), scr, r, F.lane, MapId()); continue; } r -= I_D;
        p0_transpose_item(inp(7), DM, NIN, (bf16*)(ws + WS_WIN), scr, r, F.lane, MapWin(), inp(6));
    }
    { const int gt = (F.vcu * NWAVES + F.wave) * 64 + F.lane, NGT = NGW * 64; bf16* WL = (bf16*)(ws + WS_WL);
      for (int e = gt; e < 1536 * 256; e += NGT) { const int n = e >> 8, k = e & 255; float v = 0.f;
          if (n < 512) { if (k < 64) v = inp(11)[k * 512 + n]; }
          else if (n < 1024) { if (k >= 64 && k < 128) v = inp(13)[(k - 64) * 512 + (n - 512)]; }
          else { if (k >= 128) v = inp(14)[(k - 128) * 512 + (n - 1024)]; }
          WL[e] = (bf16)f2bf(v); }
      float* rope = (float*)(ws + WS_ROPE);
      for (int e = gt; e < 8208 * 8; e += NGT) { const int pos = e >> 3, i = e & 7;
          const double fr = i == 0 ? 1.0 : i == 1 ? 0.19392274474868576 : i == 2 ? 0.03760603093086393 : i == 3 ? 0.007292664737217109 : i == 4 ? 0.001414213562373095 : i == 5 ? 0.0002742481756762073 : i == 6 ? 5.318295896944988e-05 : 1.031338537721246e-05;
          const double ang = (double)pos * fr; const double kq = __builtin_rint(ang * 0.15915494309189535); const double red = __builtin_fma(-kq, 6.283185307179586, ang) - kq * 2.4492935982947064e-16;
          const float rf = (float)red; rope[pos * 16 + i] = cosf(rf); rope[pos * 16 + 8 + i] = sinf(rf); }
    }
    f32x4 g1[4];
#pragma unroll
    for (int j = 0; j < 4; ++j) g1[j] = ((const f32x4*)inp(2))[F.lane + 64 * j];
    for (int m0 = gw; m0 < MR + NMETA; m0 += 4 * NGW) {
        f32x4 v[4][4];
#pragma unroll
        for (int u = 0; u < 4; ++u) { const int m = m0 + u * NGW < MR + NMETA ? m0 + u * NGW : m0; const f32x4* xr = (const f32x4*)(m < MR ? inp(0) + (size_t)m * DM : inp(1) + (size_t)(m - MR) * DM) + F.lane;
#pragma unroll
            for (int j = 0; j < 4; ++j) v[u][j] = xr[64 * j]; }
#pragma unroll
        for (int u = 0; u < 4; ++u) { const int m = m0 + u * NGW; if (m < MR + NMETA) { float s = 0.f;
#pragma unroll
            for (int j = 0; j < 4; ++j) s += (v[u][j].x * v[u][j].x + v[u][j].y * v[u][j].y) + (v[u][j].z * v[u][j].z + v[u][j].w * v[u][j].w);
            const float rstd = 1.f / sqrtf(wave_sum_dpp(s) * (1.f / DM) + NORM_EPS); v2u* o8 = (v2u*)((bf16*)XN1_BASE + (size_t)m * DM) + F.lane;
#pragma unroll
            for (int j = 0; j < 4; ++j) { const f32x4 g = g1[j]; v2u w; w.x = pk2(v[u][j].x * rstd * g.x, v[u][j].y * rstd * g.y); w.y = pk2(v[u][j].z * rstd * g.z, v[u][j].w * rstd * g.w); o8[64 * j] = w; } } }
    }
}


__device__ __forceinline__ void convert_late_weights(Frame& F, const Args& A, int gw, int NGW, LAS unsigned char* ldsbase) {
    LAS float* scr = (LAS float*)(ldsbase + F.wave * 16384); unsigned char* ws = F.ws;
    constexpr int I_GU = (DM / 64) * (NHID2 / 32), I_D = (DFF / 64) * (DM / 32), I_BR = (512 / 64) * (DM / 32), I_MIX = (DM / 64) * (DM / 32);
    constexpr int NITEMS = I_GU + I_D + 2 * I_BR + I_MIX;
    for (int it = gw; it < NITEMS; it += NGW) {
        int r = it;
        if (r < I_GU) { p0_transpose_item(inp(25), DM, NHID2, (bf16*)(ws + WS_WGU2), scr, r, F.lane, MapGateUp(), inp(24)); continue; } r -= I_GU;
        if (r < I_D) { p0_transpose_item(inp(26), DFF, DM, (bf16*)(ws + WS_WD2), scr, r, F.lane, MapId()); continue; } r -= I_D;
        if (r < I_BR) { p0_transpose_item(inp(20), 512, DM, (bf16*)(ws + WS_WATT), scr, r, F.lane, MapId()); continue; } r -= I_BR;
        if (r < I_BR) { p0_transpose_item(inp(21), 512, DM, (bf16*)(ws + WS_WRWKV), scr, r, F.lane, MapId()); continue; } r -= I_BR;
        p0_transpose_item(inp(22), DM, DM, (bf16*)(ws + WS_WMIX), scr, r, F.lane, MapId());
    }
}

constexpr size_t WS_H2 = WS_BIG + 180 * MiB;
template <int MODE>
__device__ __forceinline__ void row_pass(Frame& F, const Args& A, const float* gpost, const float* gpre, float scale) {
    const int gw = F.vcu * NWAVES + F.wave, NGW = F.G * NWAVES, lane = F.lane;
    const int nrows = MODE == 0 ? MR + NMETA : MR;
    const bf16* Fb = (const bf16*)(F.ws + WS_F); const float* SS = (const float*)(F.ws + WS_SS);
    constexpr int NR = 4;
    f32x4 gpo[4], gpr[4];
#pragma unroll
    for (int j = 0; j < 4; ++j) { gpo[j] = ((const f32x4*)gpost)[lane + 64 * j]; gpr[j] = gpo[j]; }
    for (int m0 = gw; m0 < nrows; m0 += NR * NGW) {
        float ssf[NR]; v2u fw[NR][4]; f32x4 hv[NR][4]; bool on[NR];
#pragma unroll
        for (int u = 0; u < NR; ++u) { const int m = m0 + u * NGW; on[u] = m < nrows; const int mc = on[u] ? m : m0;
            ssf[u] = SS[((size_t)((lane & 15) >> 2) * MP + mc) * 4 + (lane & 3)];
#pragma unroll
            for (int j = 0; j < 4; ++j) { fw[u][j] = ((const v2u*)(Fb + (size_t)mc * DM))[lane + 64 * j];
                if (MODE == 0) hv[u][j] = ((const f32x4*)(mc < MR ? inp(0) + (size_t)mc * DM : inp(1) + (size_t)(mc - MR) * DM))[lane + 64 * j];
                else { const v2u hw = ((const v2u*)((MODE == 1 ? (const bf16*)F.out : (const bf16*)(F.ws + WS_H2)) + (size_t)mc * DM))[lane + 64 * j]; hv[u][j] = (f32x4){bflo(hw.x), bfhi(hw.x), bflo(hw.y), bfhi(hw.y)}; } } }
#pragma unroll
        for (int u = 0; u < NR; ++u) if (on[u]) { const int m = m0 + u * NGW;
            float sf = ssf[u]; sf += dpp_f(sf, 0); sf += dpp_f(sf, 1); sf += dpp_f(sf, 2); { const int x = __builtin_bit_cast(int, sf); sf += __builtin_bit_cast(float, __builtin_amdgcn_update_dpp(0, x, 0x140, 0xF, 0xF, true)); }
            if (MODE == 0 && m >= MR) { float s2 = 0.f;
#pragma unroll
                for (int j = 0; j < 4; ++j) s2 += bflo(fw[u][j].x) * bflo(fw[u][j].x) + bfhi(fw[u][j].x) * bfhi(fw[u][j].x) + bflo(fw[u][j].y) * bflo(fw[u][j].y) + bfhi(fw[u][j].y) * bfhi(fw[u][j].y);
                sf = wave_sum_dpp(s2); }
            const float rf = scale / sqrtf(sf * (1.f / DM) + NORM_EPS);
            f32x4 h[4]; float s = 0.f;
#pragma unroll
            for (int j = 0; j < 4; ++j) {
                const f32x4 g = gpo[j]; const f32x4 hq = hv[u][j];
                f32x4 r; r.x = hq.x + bflo(fw[u][j].x) * rf * g.x; r.y = hq.y + bfhi(fw[u][j].x) * rf * g.y; r.z = hq.z + bflo(fw[u][j].y) * rf * g.z; r.w = hq.w + bfhi(fw[u][j].y) * rf * g.w;
                h[j] = r; s += (r.x * r.x + r.y * r.y) + (r.z * r.z + r.w * r.w);
                if (MODE == 2) ((f32x4*)(F.out + (size_t)m * DM))[lane + 64 * j] = r;
                else { v2u w; w.x = pk2(r.x, r.y); w.y = pk2(r.z, r.w); bf16* hb = MODE == 1 ? (bf16*)(F.ws + WS_H2) + (size_t)m * DM : (m < MR ? (bf16*)F.out + (size_t)m * DM : (bf16*)(F.ws + WS_HM) + (size_t)(m - MR) * DM); ((v2u*)hb)[lane + 64 * j] = w; }
            }
            if (MODE != 2) { const float rstd = 1.f / sqrtf(wave_sum_dpp(s) * (1.f / DM) + NORM_EPS); if (lane == 0) ((float*)(F.ws + (MODE == 0 ? WS_RS2 : WS_RS3)))[m] = rstd; }
        }
    }
}

__device__ __forceinline__ int prev_row(int m) { return m < MR ? ((m & 8191) == 0 ? MR + 15 : m - 1) : (m == MR ? -1 : m - 1); }
__device__ __forceinline__ void lora_a_pass(Frame& F, const Args& A) {
    const int gw = F.vcu * NWAVES + F.wave, NGW = F.G * NWAVES, lane = F.lane;
    const bf16* ZR = (const bf16*)(F.ws + WS_ZR); bf16* LA = (bf16*)(F.ws + WS_LA); const float* mu = inp(9) + 1536;
    const f32x4 muv = ((const f32x4*)mu)[lane];
    for (int g4 = gw; 4 * g4 < MR + NMETA; g4 += NGW) { const int m0 = 4 * g4;
        v2u zc[4], zp0 = (v2u){0u, 0u};
        { const int pm = prev_row(m0); if (pm >= 0) zp0 = ((const v2u*)(ZR + (size_t)pm * 1792 + 1536))[lane]; }
#pragma unroll
        for (int u = 0; u < 4; ++u) zc[u] = ((const v2u*)(ZR + (size_t)(m0 + u) * 1792 + 1536))[lane];
#pragma unroll
        for (int u = 0; u < 4; ++u) { const int m = m0 + u; const v2u zpv = u == 0 ? zp0 : zc[u > 0 ? u - 1 : 0];
            float x[4] = {bflo(zc[u].x), bfhi(zc[u].x), bflo(zc[u].y), bfhi(zc[u].y)}; const float p[4] = {bflo(zpv.x), bfhi(zpv.x), bflo(zpv.y), bfhi(zpv.y)};
            x[0] += (p[0] - x[0]) * muv.x; x[1] += (p[1] - x[1]) * muv.y; x[2] += (p[2] - x[2]) * muv.z; x[3] += (p[3] - x[3]) * muv.w;
            if (lane < 16) {
#pragma unroll
                for (int j = 0; j < 4; ++j) x[j] = tanhf(x[j]);
            } else if (lane >= 32) {
#pragma unroll
                for (int j = 0; j < 4; ++j) x[j] = sigm(x[j]);
            }
            v2u w; w.x = pk2(x[0], x[1]); w.y = pk2(x[2], x[3]);
            ((v2u*)(LA + (size_t)m * 256))[lane] = w; }
    }
}

#ifndef MK_ATT_SCALE
#define MK_ATT_SCALE 1.0f
#endif
__device__ __forceinline__ int crow(int r, int hi) { return (r & 3) + 8 * (r >> 2) + 4 * hi; }
constexpr int AT_KP = 144, AT_VP = 80, AT_KBYTES = 32 * AT_KP;
__device__ __forceinline__ void attn_item(Frame& F, const Args& A, int b, int head, int qb) {
    const int lane = F.lane, r32 = lane & 31, hi = lane >> 5, kvh = head >> 2, t0 = qb * 32, rr = lane >> 3, ck = lane & 7;
    const bf16* Q = (const bf16*)(F.ws + WS_Q); const bf16* KV = (const bf16*)(F.ws + WS_KV); bf16* AC = (bf16*)(F.ws + WS_Q);
    LAS unsigned char* Kl = F.lds + RING_OFF + F.wave * 16384; LAS unsigned char* Vl = Kl + AT_KBYTES;
    const float sink2 = inp(8)[head] * 1.4426950408889634f;
    v4u qg[4], kg[5][4], vg[5][4];
#pragma unroll
    for (int j = 0; j < 4; ++j) qg[j] = *(const v4u*)(Q + (size_t)(b * SEQL + t0 + 8 * j + rr) * 512 + head * 64 + 8 * ck);
#pragma unroll
    for (int i = 0; i < 5; ++i)
#pragma unroll
        for (int j = 0; j < 4; ++j) { const int tk = t0 - 128 + 32 * i + 8 * j + rr;
            const size_t krow = tk >= 0 ? (size_t)(b * SEQL + tk) : (tk >= -16 ? (size_t)(MR + 16 + tk) : (size_t)MR);
            kg[i][j] = *(const v4u*)(KV + krow * 256 + kvh * 64 + 8 * ck); }
    const bf16* vtb = (const bf16*)(F.ws + WS_VT) + (size_t)(b * 2 + kvh) * (PV / 16) * 1024;
#pragma unroll
    for (int i = 0; i < 5; ++i)
#pragma unroll
        for (int j = 0; j < 4; ++j) { const int x = 64 * j + lane; int pb = ((t0 - 112 + 32 * i) >> 4) + (x >> 7); pb = pb < 0 ? 0 : pb;
            vg[i][j] = *(const v4u*)(vtb + (size_t)pb * 1024 + (x & 127) * 8); }
    __builtin_amdgcn_sched_barrier(0);
    bf16x8 qf[4];
#pragma unroll
    for (int j = 0; j < 4; ++j) *(LAS v4u*)(Kl + (8 * j + rr) * AT_KP + 16 * ck) = qg[j];
#pragma unroll
    for (int s = 0; s < 4; ++s) qf[s] = *(const LAS bf16x8*)(Kl + r32 * AT_KP + 32 * s + 16 * hi);
    f32x16 S[5];
#pragma unroll
    for (int i = 0; i < 5; ++i) {
#pragma unroll
        for (int j = 0; j < 4; ++j) *(LAS v4u*)(Kl + (8 * j + rr) * AT_KP + 16 * ck) = kg[i][j];
        bf16x8 kf[4];
#pragma unroll
        for (int s = 0; s < 4; ++s) kf[s] = *(const LAS bf16x8*)(Kl + r32 * AT_KP + 32 * s + 16 * hi);
        f32x16 a = {};
#pragma unroll
        for (int s = 0; s < 4; ++s) a = __builtin_amdgcn_mfma_f32_32x32x16_bf16(kf[s], qf[s], a, 0, 0, 0);
        S[i] = a;
    }
    const float sc = 0.125f * 1.4426950408889634f; const int dq = r32 - 4 * hi;
#pragma unroll
    for (int r = 0; r < 16; ++r) { const int cr = (r & 3) + 8 * (r >> 2);
        S[0][r] = cr > dq ? S[0][r] * sc : -1e30f; S[4][r] = cr <= dq ? S[4][r] * sc : -1e30f;
        S[1][r] *= sc; S[2][r] *= sc; S[3][r] *= sc; }
    if (t0 < 112) {
#pragma unroll
        for (int i = 0; i < 4; ++i)
#pragma unroll
            for (int r = 0; r < 16; ++r) if (t0 - 128 + 32 * i + crow(r, hi) < -16) S[i][r] = -1e30f;
    }
    float mx = sink2;
#pragma unroll
    for (int i = 0; i < 5; ++i)
#pragma unroll
        for (int r = 0; r < 16; ++r) mx = fmaxf(mx, S[i][r]);
    mx = fmaxf(mx, __shfl_xor(mx, 32));
    float sum = 0.f;
#pragma unroll
    for (int i = 0; i < 5; ++i)
#pragma unroll
        for (int r = 0; r < 16; ++r) { const float p = __builtin_amdgcn_exp2f(S[i][r] - mx); S[i][r] = p; sum += p; }
    sum += __shfl_xor(sum, 32);
    const float inv = 1.0f / (sum + __builtin_amdgcn_exp2f(sink2 - mx));
    f32x16 O0 = {}, O1 = {};
#pragma unroll
    for (int i = 0; i < 5; ++i) {
#pragma unroll
        for (int j = 0; j < 4; ++j) { const int x = 64 * j + lane; *(LAS v4u*)(Vl + ((x & 127) >> 1) * AT_VP + (x >> 7) * 32 + (x & 1) * 16) = vg[i][j]; }
#pragma unroll
        for (int s = 0; s < 2; ++s) {
            bf16x8 pa;
#pragma unroll
            for (int j = 0; j < 8; j += 2) { const unsigned w = pg8::cvt_pk_bf16(S[i][8 * s + j], S[i][8 * s + j + 1]); pa[j] = (short)(w & 0xffffu); pa[j + 1] = (short)(w >> 16); }
            const v2u a0 = *(const LAS v2u*)(Vl + r32 * AT_VP + 32 * s + 8 * hi), a1 = *(const LAS v2u*)(Vl + r32 * AT_VP + 32 * s + 16 + 8 * hi);
            const v2u c0 = *(const LAS v2u*)(Vl + (r32 + 32) * AT_VP + 32 * s + 8 * hi), c1 = *(const LAS v2u*)(Vl + (r32 + 32) * AT_VP + 32 * s + 16 + 8 * hi);
            const v4u v0 = {a0.x, a0.y, a1.x, a1.y}, v1 = {c0.x, c0.y, c1.x, c1.y};
            O0 = __builtin_amdgcn_mfma_f32_32x32x16_bf16(__builtin_bit_cast(bf16x8, v0), pa, O0, 0, 0, 0);
            O1 = __builtin_amdgcn_mfma_f32_32x32x16_bf16(__builtin_bit_cast(bf16x8, v1), pa, O1, 0, 0, 0);
        }
    }
    const float iv = inv * MK_ATT_SCALE;
#pragma unroll
    for (int g = 0; g < 4; ++g) {
        *(LAS v2u*)(Kl + r32 * AT_KP + (8 * g + 4 * hi) * 2) = (v2u){pk2(O0[4 * g] * iv, O0[4 * g + 1] * iv), pk2(O0[4 * g + 2] * iv, O0[4 * g + 3] * iv)};
        *(LAS v2u*)(Kl + r32 * AT_KP + (32 + 8 * g + 4 * hi) * 2) = (v2u){pk2(O1[4 * g] * iv, O1[4 * g + 1] * iv), pk2(O1[4 * g + 2] * iv, O1[4 * g + 3] * iv)}; }
#pragma unroll
    for (int j = 0; j < 4; ++j) *(v4u*)(AC + (size_t)(b * SEQL + t0 + 8 * j + rr) * 512 + head * 64 + 8 * ck) = *(const LAS v4u*)(Kl + (8 * j + rr) * AT_KP + 16 * ck);
}


__device__ __forceinline__ bf16x8 lora_afrag(const bf16* ZR, size_t m, long pm, int chan, const float* mu, int kind) {
    const v4u zc = *(const v4u*)(ZR + m * 1792 + chan); v4u zp = (v4u){0u, 0u, 0u, 0u}; if (pm >= 0) zp = *(const v4u*)(ZR + (size_t)pm * 1792 + chan);
    const f32x4 m0 = *(const f32x4*)(mu + chan), m1 = *(const f32x4*)(mu + chan + 4); const float mv[8] = {m0.x, m0.y, m0.z, m0.w, m1.x, m1.y, m1.z, m1.w};
    float x[8];
#pragma unroll
    for (int j = 0; j < 4; ++j) { const float c0 = bflo(zc[j]), c1 = bfhi(zc[j]), p0 = bflo(zp[j]), p1 = bfhi(zp[j]); x[2 * j] = c0 + (p0 - c0) * mv[2 * j]; x[2 * j + 1] = c1 + (p1 - c1) * mv[2 * j + 1]; }
#pragma unroll
    for (int j = 0; j < 8; ++j) x[j] = kind == 0 ? tanhf(x[j]) : (kind == 2 ? sigm(x[j]) : x[j]);
    bf16x8 r;
#pragma unroll
    for (int j = 0; j < 8; j += 2) { const unsigned w = pk2(x[j], x[j + 1]); r[j] = (short)(w & 0xffffu); r[j + 1] = (short)(w >> 16); }
    return r;
}
__device__ __forceinline__ void lora_fused(Frame& F, const Args& A) {
    const int gw = F.vcu * NWAVES + F.wave, NGW = F.G * NWAVES, lane = F.lane, r32 = lane & 31, hi = lane >> 5;
    const bf16* ZR = (const bf16*)(F.ws + WS_ZR); const bf16* WL = (const bf16*)(F.ws + WS_WL); const float* mu = inp(9);
    bf16* LW = (bf16*)(F.ws + WS_LW); bf16* AA = (bf16*)(F.ws + WS_AA); bf16* GG = (bf16*)(F.ws + WS_GG);
    constexpr int NRB = (MR + NMETA + 31) / 32;
    for (int it = gw; it < NRB * 3; it += NGW) {
        const int kind = it % 3, r0 = (it / 3) * 32, k0 = kind == 0 ? 0 : (kind == 1 ? 64 : 128), nk = kind == 2 ? 8 : 4;
        const int mrow = r0 + r32 < MR + NMETA ? r0 + r32 : MR + NMETA - 1; const long pm = prev_row(mrow);
        bf16x8 af[8];
#pragma unroll
        for (int s = 0; s < 8; ++s) af[s] = lora_afrag(ZR, (size_t)mrow, pm, 1536 + k0 + (s < nk ? 16 * s : 0) + 8 * hi, mu, kind);
        const float* bias = kind == 0 ? inp(10) : inp(12);
        const bf16* wbase = WL + (size_t)(kind * 512 + r32) * 256 + k0 + 8 * hi;
        bf16x8 bcur[8], bnxt[8];
#pragma unroll
        for (int s = 0; s < 8; ++s) bcur[s] = *(const bf16x8*)(wbase + (s < nk ? 16 * s : 0));
        for (int nb = 0; nb < 16; ++nb) {
            const bf16* wn = wbase + (size_t)((nb + 1 < 16 ? nb + 1 : nb) * 32) * 256;
#pragma unroll
            for (int s = 0; s < 8; ++s) bnxt[s] = *(const bf16x8*)(wn + (s < nk ? 16 * s : 0));
            f32x16 acc = {};
#pragma unroll
            for (int s = 0; s < 8; ++s) if (s < nk) acc = __builtin_amdgcn_mfma_f32_32x32x16_bf16(af[s], bcur[s], acc, 0, 0, 0);
            const int col = nb * 32 + r32; const float bv = kind == 2 ? 0.f : bias[col];
#pragma unroll
            for (int r = 0; r < 16; ++r) { const int row = r0 + crow(r, hi); if (row < MR + NMETA) { const size_t o = (size_t)row * 512 + col; const float v = acc[r] + bv;
                if (kind == 0) LW[o] = (bf16)f2bf(-0.6065306597126334f * sigm(v)); else if (kind == 1) AA[o] = (bf16)f2bf(sigm(v)); else GG[o] = (bf16)f2bf(v); } }
#pragma unroll
            for (int s = 0; s < 8; ++s) bcur[s] = bnxt[s];
        }
    }
}

#ifndef MK_YN_SCALE
#define MK_YN_SCALE 1.0f
#endif
#ifndef MK_BONUS_SCALE
#define MK_BONUS_SCALE 1.0f
#endif
__device__ __forceinline__ float half_sum(float v) {
    v += dpp_f(v, 0); v += dpp_f(v, 1); v += dpp_f(v, 2);
    { const int x = __builtin_bit_cast(int, v); v += __builtin_bit_cast(float, __builtin_amdgcn_update_dpp(0, x, 0x140, 0xF, 0xF, true)); }
    { const int x = __builtin_bit_cast(int, v); v += __builtin_bit_cast(float, __builtin_amdgcn_ds_swizzle(x, 0x401F)); }
    return v;
}


typedef float f32x4m __attribute__((ext_vector_type(4)));
__device__ __forceinline__ f32x4m mini16(const bf16* A16, int lda, const bf16* Brow0, int ldb, int K, int lane) {
    const int r = lane & 15, q = lane >> 4; f32x4m acc = {0.f, 0.f, 0.f, 0.f};
    const bf16* ap = A16 + (size_t)r * lda + 8 * q; const bf16* bp = Brow0 + (size_t)r * ldb + 8 * q;
#pragma unroll 8
    for (int ks = 0; ks < K / 32; ++ks) { const bf16x8 a = *(const bf16x8*)(ap + 32 * ks), b = *(const bf16x8*)(bp + 32 * ks); acc = __builtin_amdgcn_mfma_f32_16x16x32_bf16(a, b, acc, 0, 0, 0); }
    return acc;
}
template <int K, int NB>
__device__ __forceinline__ void mini16_wg(Frame& F, const bf16* A16, int lda, const bf16* B0, const bf16* B1, int ldb, f32x4m (&out)[NB]) {
    constexpr int NKS = K / 256; static_assert(K % 256 == 0 && NB >= 1 && NB <= 2, "mini16_wg");
    const int lane = F.lane, wave = F.wave, r = lane & 15, q = lane >> 4;
    const bf16* ap = A16 + (size_t)r * lda + 8 * q + 32 * NKS * wave; const bf16* bp0 = B0 + (size_t)r * ldb + 8 * q + 32 * NKS * wave; const bf16* bp1 = B1 + (size_t)r * ldb + 8 * q + 32 * NKS * wave;
    bf16x8 a[NKS], b0[NKS], b1[NKS];
#pragma unroll
    for (int ks = 0; ks < NKS; ++ks) { a[ks] = *(const bf16x8*)(ap + 32 * ks); b0[ks] = *(const bf16x8*)(bp0 + 32 * ks); if (NB == 2) b1[ks] = *(const bf16x8*)(bp1 + 32 * ks); }
    f32x4m acc0 = {0.f, 0.f, 0.f, 0.f}, acc1 = acc0;
#pragma unroll
    for (int ks = 0; ks < NKS; ++ks) { acc0 = __builtin_amdgcn_mfma_f32_16x16x32_bf16(a[ks], b0[ks], acc0, 0, 0, 0); if (NB == 2) acc1 = __builtin_amdgcn_mfma_f32_16x16x32_bf16(a[ks], b1[ks], acc1, 0, 0, 0); }
    LAS f32x4m* red = (LAS f32x4m*)(F.lds + RING_OFF);
    red[wave * 64 + lane] = acc0; if (NB == 2) red[(8 + wave) * 64 + lane] = acc1;
    __syncthreads();
    if (wave == 0) {
#pragma unroll
        for (int nb = 0; nb < NB; ++nb) { f32x4m s = red[(nb * 8) * 64 + lane];
#pragma unroll
            for (int w = 1; w < 8; ++w) s += red[(nb * 8 + w) * 64 + lane];
            out[nb] = s; } }
    __syncthreads();
}
__device__ __forceinline__ float row16_sum(float v) { v += dpp_f(v, 0); v += dpp_f(v, 1); v += dpp_f(v, 2); const int x = __builtin_bit_cast(int, v); return v + __builtin_bit_cast(float, __builtin_amdgcn_update_dpp(0, x, 0x140, 0xF, 0xF, true)); }
__device__ __forceinline__ void meta_gateup(Frame& F, const bf16* Wgu, int i) {
    const int lane = F.lane, r = lane & 15, q = lane >> 4, j0 = 16 * i; const bf16* A16 = (const bf16*)F.out + (size_t)MR * DM;
    const int grow = 256 * (j0 >> 7) + (j0 & 127);
    f32x4m gu[2]; mini16_wg<DM, 2>(F, A16, DM, Wgu + (size_t)grow * DM, Wgu + (size_t)(grow + 128) * DM, DM, gu);
    if (F.wave != 0) return;
    const f32x4m g = gu[0], u = gu[1];
    bf16* H = (bf16*)(F.ws + WS_HID);
#pragma unroll
    for (int x = 0; x < 4; ++x) H[(size_t)(MR + 4 * q + x) * DFF + j0 + r] = (bf16)f2bf(g[x] * sigm(g[x]) * u[x]);
}
__device__ __forceinline__ void meta_down(Frame& F, const bf16* Wd, int i) {
    const int lane = F.lane, r = lane & 15, q = lane >> 4, n0 = 16 * i; const bf16* A16 = (const bf16*)(F.ws + WS_HID) + (size_t)MR * DFF; bf16* Fo = (bf16*)(F.ws + WS_F);
    f32x4m av[1]; mini16_wg<DFF, 1>(F, A16, DFF, Wd + (size_t)n0 * DFF, Wd + (size_t)n0 * DFF, DFF, av);
    if (F.wave != 0) return;
    const f32x4m a = av[0];
#pragma unroll
    for (int x = 0; x < 4; ++x) Fo[(size_t)(MR + 4 * q + x) * DM + n0 + r] = (bf16)f2bf(a[x]);
}
__device__ __forceinline__ void meta_win(Frame& F, int i) {
    const int lane = F.lane, r = lane & 15, q = lane >> 4, c0 = 512 + 16 * i; const bf16* A16 = (const bf16*)(F.ws + WS_HM);
    f32x4m av[1]; mini16_wg<DM, 1>(F, A16, DM, (const bf16*)(F.ws + WS_WIN) + (size_t)c0 * DM, (const bf16*)(F.ws + WS_WIN) + (size_t)c0 * DM, DM, av);
    if (F.wave != 0) return;
    f32x4m a = av[0];
    { const float* RS = (const float*)(F.ws + WS_RS2) + MR;
#pragma unroll
      for (int x = 0; x < 4; ++x) a[x] *= RS[4 * q + x]; }
    if (c0 < 640 && (c0 & 63) == 0) {
        const float* rope = (const float*)(F.ws + WS_ROPE); const bool lo = (r & 4) == 0; const int fi = r < 8 ? (r & 3) : 4 + (r & 3);
#pragma unroll
        for (int x = 0; x < 4; ++x) { const float other = __shfl_xor(a[x], 4); const int pos = 4 * q + x; const float cs = rope[pos * 16 + fi], sn = rope[pos * 16 + 8 + fi];
            a[x] = lo ? a[x] * cs - other * sn : a[x] * cs + other * sn; }
    }
    if (c0 >= 640 && c0 < 768) {
        const int dv = c0 - 640 + r; const v2u w = {pk2(a[0], a[1]), pk2(a[2], a[3])};
#pragma unroll
        for (int b = 0; b < NB; ++b) *(v2u*)((bf16*)(F.ws + WS_VT) + ((size_t)(b * 2 + (dv >> 6)) * (PV / 16) * 64 + (dv & 63)) * 16 + 4 * q) = w;
        return; }
    bf16* dst; int ld, col;
    if (c0 < 768) { dst = (bf16*)(F.ws + WS_KV); ld = 256; col = c0 - 512; } else { dst = (bf16*)(F.ws + WS_ZR); ld = 1792; col = c0 - 768; }
#pragma unroll
    for (int x = 0; x < 4; ++x) dst[(size_t)(MR + 4 * q + x) * ld + col + r] = (bf16)f2bf(a[x]);
}
__device__ __forceinline__ void meta_lora(Frame& F, int i) {
    const int lane = F.lane, r = lane & 15, q = lane >> 4, n0 = 16 * i, kind = n0 >> 9, col = (n0 & 511) + r; const bf16* A16 = (const bf16*)(F.ws + WS_LA) + (size_t)MR * 256;
    const f32x4m a = mini16(A16, 256, (const bf16*)(F.ws + WS_WL) + (size_t)n0 * 256, 256, 256, lane);
    const float bias = kind == 0 ? inp(10)[col] : (kind == 1 ? inp(12)[col] : 0.f);
    bf16* dst = (bf16*)(F.ws + (kind == 0 ? WS_LW : (kind == 1 ? WS_AA : WS_GG)));
#pragma unroll
    for (int x = 0; x < 4; ++x) { const float v = a[x] + bias; const float o = kind == 0 ? -0.6065306597126334f * sigm(v) : (kind == 1 ? sigm(v) : v); dst[(size_t)(MR + 4 * q + x) * 512 + col] = (bf16)f2bf(o); }
}

constexpr int RW_P = 72;
constexpr int RW_NCH = 129;
constexpr int RW_AT = 0, RW_RT = 9216, RW_BT = 18432, RW_KT = 27648;
constexpr int RW_RHS = RW_BT;
constexpr int RW_VT = 36864, RW_BHT = 46080, RW_KHT = 55296, RW_WT = 64512, RW_UT = 73728;
constexpr int RW_AAB = 82944;
constexpr int RW_AAK = 99328, RW_ARB = 108544, RW_ARK = 117760;
constexpr int RW_TINV = 92160;
constexpr int RW_MISC = 126976;
static_assert(RW_MISC + 2048 + 512 <= RING_BYTES, "rwkv LDS map");
typedef short s16x4v __attribute__((ext_vector_type(4)));

__device__ __forceinline__ f32x16 rw_mm(f32x16 acc, const LAS bf16* X, int ti, const LAS bf16* Yt, int tn, int lane) {
    const LAS bf16* xp = X + (32 * ti + (lane & 31)) * RW_P + 8 * (lane >> 5); const LAS bf16* yp = Yt + (32 * tn + (lane & 31)) * RW_P + 8 * (lane >> 5);
#pragma unroll
    for (int ks = 0; ks < 4; ++ks) { const bf16x8 a = *(const LAS bf16x8*)(xp + 16 * ks), b = *(const LAS bf16x8*)(yp + 16 * ks); acc = __builtin_amdgcn_mfma_f32_32x32x16_bf16(a, b, acc, 0, 0, 0); }
    return acc;
}
__device__ __forceinline__ bf16x8 rw_pack8(const f32x16& v, int s) {
    bf16x8 r;
#pragma unroll
    for (int j = 0; j < 8; j += 2) { const unsigned w = pg8::cvt_pk_bf16(v[8 * s + j], v[8 * s + j + 1]); r[j] = (short)(w & 0xffffu); r[j + 1] = (short)(w >> 16); }
    return r;
}
__device__ __forceinline__ size_t rw_item(int bh, int c) { return (size_t)bh * RW_NCH + c; }

struct RwRaw { unsigned zr[9], zk[9], zv[9], al[8], lw[8]; float par[6]; };
__device__ __forceinline__ void rw_load_raw(RwRaw& R, Frame& F, int b, int h, int c) {
    const int ch = F.tid & 63, tg = F.tid >> 6, hc = h * 64 + ch;
    const bf16* ZR = (const bf16*)(F.ws + WS_ZR); const bf16* LW = (const bf16*)(F.ws + WS_LW); const bf16* AA = (const bf16*)(F.ws + WS_AA);
#pragma unroll
    for (int j = 0; j < 9; ++j) { const int p = 64 * c - 48 + 8 * tg + j - 1; const int pc = p < 0 ? 0 : p;
        const size_t m = pc < 16 ? (size_t)(MR + pc) : (size_t)(b * SEQL + pc - 16); const bf16* z = ZR + m * 1792 + hc;
        R.zr[j] = z[0]; R.zk[j] = z[512]; R.zv[j] = z[1024];
        if (j > 0) { R.al[j - 1] = AA[m * 512 + hc]; R.lw[j - 1] = LW[m * 512 + hc]; } }
    R.par[0] = inp(9)[hc]; R.par[1] = inp(9)[512 + hc]; R.par[2] = inp(9)[1024 + hc]; R.par[3] = inp(15)[hc]; R.par[4] = inp(16)[hc]; R.par[5] = inp(17)[hc];
}
__device__ __forceinline__ float bfw(unsigned w) { return __builtin_bit_cast(float, w << 16); }
#ifdef MK_ITEM_PROF
#define RWP(k) do { if (blockIdx.x == 0 && threadIdx.x == 0) { const unsigned long long t_ = __builtin_amdgcn_s_memrealtime(); ((unsigned long long*)(F.ws + 32768))[k] += t_ - tprev_; tprev_ = t_; } } while (0)
#elif defined(MK_ITEM_MARK)
#define RWP(k) asm volatile("; RWP_MARK " #k ::: "memory")
#else
#define RWP(k) do { } while (0)
#endif
__device__ __forceinline__ void rwkv_item(Frame& F, int b, int h, int c, RwRaw& raw, int nb, int nh, int nc) {
    constexpr int MODE = 1;
#ifdef MK_ITEM_PROF
    unsigned long long tprev_ = __builtin_amdgcn_s_memrealtime();
#endif
    const int tid = F.tid, lane = F.lane, wave = F.wave, r32 = lane & 31, hi = lane >> 5;
    LAS unsigned char* L = F.lds;
    LAS bf16* At = (LAS bf16*)(L + RW_AT); LAS bf16* Rt = (LAS bf16*)(L + RW_RT); LAS bf16* Bt = (LAS bf16*)(L + RW_BT); LAS bf16* Kt = (LAS bf16*)(L + RW_KT);
    LAS bf16* Vt = (LAS bf16*)(L + RW_VT); LAS bf16* Bht = (LAS bf16*)(L + RW_BHT); LAS bf16* Kht = (LAS bf16*)(L + RW_KHT); LAS bf16* Wt = (LAS bf16*)(L + RW_WT); LAS bf16* Ut = (LAS bf16*)(L + RW_UT);
    LAS bf16* Aab = (LAS bf16*)(L + RW_AAB); LAS bf16* RhsB = (LAS bf16*)(L + RW_RHS);
    LAS bf16* Aak = (LAS bf16*)(L + RW_AAK); LAS bf16* Arb = (LAS bf16*)(L + RW_ARB); LAS bf16* Ark = (LAS bf16*)(L + RW_ARK); LAS bf16* Qm = Aak;
    LAS float* gtot = (LAS float*)(L + RW_MISC); LAS float* dots = gtot + 512; LAS float* lend = dots + 64;
    const bf16* ZR = (const bf16*)(F.ws + WS_ZR); const bf16* LW = (const bf16*)(F.ws + WS_LW); const bf16* AA = (const bf16*)(F.ws + WS_AA);
    const int bh = b * 8 + h;
    {
        const int ch = tid & 63, tg = tid >> 6, hc = h * 64 + ch;
        const float mur = raw.par[0], muk = raw.par[1], muv = raw.par[2], kkc = raw.par[3], kac = raw.par[4], rkc = raw.par[5];
        float zr_[9], zk_[9], zv_[9], al_[8], lwr_[8];
#pragma unroll
        for (int j = 0; j < 9; ++j) { zr_[j] = bfw(raw.zr[j]); zk_[j] = bfw(raw.zk[j]); zv_[j] = bfw(raw.zv[j]); if (j > 0) { al_[j - 1] = bfw(raw.al[j - 1]); lwr_[j - 1] = bfw(raw.lw[j - 1]); } }
        if (c == 0) {
#pragma unroll
            for (int j = 0; j < 9; ++j) { const float ok = 8 * tg + j - 1 >= 48 ? 1.f : 0.f; zr_[j] *= ok; zk_[j] *= ok; zv_[j] *= ok; if (j > 0) { al_[j - 1] *= ok; lwr_[j - 1] *= ok; } } }
        if (nc >= 0) rw_load_raw(raw, F, nb, nh, nc);
        float rr[8], kq[8], km[8], vv[8], bb[8], lw8[8];
        float run = 0.f;
        float V[16];
#pragma unroll
        for (int j = 0; j < 8; ++j) {
            const float r = zr_[j + 1] + (zr_[j] - zr_[j + 1]) * mur, k = zk_[j + 1] + (zk_[j] - zk_[j + 1]) * muk, v = zv_[j + 1] + (zv_[j] - zv_[j + 1]) * muv;
            const float al = al_[j], lw = lwr_[j];
            const float q = k * kkc, kmod = k * (1.f + (al - 1.f) * kac);
            V[2 * j] = q * q; V[2 * j + 1] = r * kmod * rkc;
            rr[j] = r; kq[j] = q; km[j] = kmod; vv[j] = v; run += lw; lw8[j] = run;
        }
        {
            const int ln = F.lane; const bool b3 = (ln & 8) != 0, b2 = (ln & 4) != 0, b1 = (ln & 2) != 0, b0 = (ln & 1) != 0;
#define RS_STEP(N, BIT, CTRL) _Pragma("unroll") for (int k_ = 0; k_ < (N); ++k_) { const float mine_ = BIT ? V[k_ + (N)] : V[k_], send_ = BIT ? V[k_] : V[k_ + (N)]; \
                V[k_] = mine_ + __builtin_bit_cast(float, __builtin_amdgcn_update_dpp(0, __builtin_bit_cast(int, send_), CTRL, 0xF, 0xF, true)); }
            RS_STEP(8, b3, 0x140)
            RS_STEP(4, b2, 0x141)
            RS_STEP(2, b1, 0x1B)
            RS_STEP(1, b0, 0xB1)
#undef RS_STEP
            float x = V[0];
            x += __builtin_bit_cast(float, __builtin_amdgcn_ds_swizzle(__builtin_bit_cast(int, x), 0x401F));
            x += __shfl_xor(x, 32);
            if (ln < 16 && (ln & 1)) ((float*)(F.ws + WS_DOTS))[rw_item(bh, c) * 64 + 8 * tg + (ln >> 1)] = x;
            const float rn = __builtin_amdgcn_rsqf(fmaxf(x, 1e-24f));
#pragma unroll
            for (int j = 0; j < 8; ++j) { const float rj = __builtin_bit_cast(float, __builtin_amdgcn_readlane(__builtin_bit_cast(int, rn), 2 * j)); kq[j] *= rj; bb[j] = kq[j] * al_[j]; }
        }
        gtot[tg * 64 + ch] = run;
        __syncthreads();
        float off = 0.f, tot = 0.f;
#pragma unroll
        for (int g2 = 0; g2 < 8; ++g2) { const float x = gtot[g2 * 64 + ch]; tot += x; if (g2 < tg) off += x; }
        if (tg == 0) lend[ch] = tot;
        unsigned vt_[4], bh_[4], kh_[4];
        const float eT = __expf(tot); float ePrev = __expf(off);
#pragma unroll
        for (int j = 0; j < 8; ++j) {
            const int t = 8 * tg + j; const float Lt = off + lw8[j];
            const float eL = __expf(Lt), eP = ePrev, eN = __expf(-Lt), eE = eT * eN; ePrev = eL;
            At[t * RW_P + ch] = (bf16)f2bf(-kq[j] * eP); Rt[t * RW_P + ch] = (bf16)f2bf(rr[j] * eL); Bt[t * RW_P + ch] = (bf16)f2bf(bb[j] * eN); Kt[t * RW_P + ch] = (bf16)f2bf(km[j] * eN);
            const unsigned v_ = f2bf(vv[j]), b_ = f2bf(bb[j] * eE), k_ = f2bf(km[j] * eE);
            if (j & 1) { vt_[j >> 1] |= v_ << 16; bh_[j >> 1] |= b_ << 16; kh_[j >> 1] |= k_ << 16; } else { vt_[j >> 1] = v_; bh_[j >> 1] = b_; kh_[j >> 1] = k_; }
        }
        *(LAS v4u*)(Vt + ch * RW_P + 8 * tg) = (v4u){vt_[0], vt_[1], vt_[2], vt_[3]};
        *(LAS v4u*)(Bht + ch * RW_P + 8 * tg) = (v4u){bh_[0], bh_[1], bh_[2], bh_[3]};
        *(LAS v4u*)(Kht + ch * RW_P + 8 * tg) = (v4u){kh_[0], kh_[1], kh_[2], kh_[3]};
    }
    __syncthreads(); RWP(0);
#pragma unroll
    for (int rnd = 0; rnd < 2; ++rnd) {
        const int mat = (wave >> 2) + 2 * rnd, ti = (wave >> 1) & 1, tn = wave & 1;
        f32x16 acc = {};
        acc = rw_mm(acc, (const LAS bf16*)(L + ((mat & 1) ? RW_KT : RW_BT)), tn, (const LAS bf16*)(L + (mat < 2 ? RW_AT : RW_RT)), ti, lane);
        LAS bf16* dstm = (LAS bf16*)(L + (mat == 0 ? RW_AAB : RW_AAK + (mat - 1) * 9216));
        const int t = 32 * ti + r32, lim = t + (mat >> 1);
#pragma unroll
        for (int g = 0; g < 4; ++g) { const int sb = 32 * tn + 8 * g + 4 * hi;
            const float v0 = sb < lim ? acc[4 * g] : 0.f, v1 = sb + 1 < lim ? acc[4 * g + 1] : 0.f, v2 = sb + 2 < lim ? acc[4 * g + 2] : 0.f, v3 = sb + 3 < lim ? acc[4 * g + 3] : 0.f;
            *(LAS v2u*)(dstm + t * RW_P + sb) = (v2u){pk2(v0, v1), pk2(v2, v3)}; }
    }
    __syncthreads(); RWP(1);
    if (wave < 4) { const int ti = wave >> 1, tn = wave & 1; f32x16 acc = {}; acc = rw_mm(acc, Aak, ti, Vt, tn, lane);
#pragma unroll
        for (int g = 0; g < 4; ++g) *(LAS v2u*)(RhsB + (32 * tn + r32) * RW_P + 32 * ti + 8 * g + 4 * hi) = (v2u){pk2(acc[4 * g], acc[4 * g + 1]), pk2(acc[4 * g + 2], acc[4 * g + 3])};
    } else {
        const int d = wave & 3, cl = lane & 15, q = lane >> 4;
        const LAS bf16* Ad = Aab + (16 * d) * RW_P + 16 * d;
        f32x4m aN, aT;
#pragma unroll
        for (int r = 0; r < 4; ++r) aN[r] = bf1(Ad[(4 * q + r) * RW_P + cl]);
        { const v2u w = *(const LAS v2u*)(Ad + cl * RW_P + 4 * q); aT[0] = bflo(w.x); aT[1] = bfhi(w.x); aT[2] = bflo(w.y); aT[3] = bfhi(w.y); }
#define MM4(dst_, a_, b_, init_) { f32x4m z_ = init_; _Pragma("unroll") for (int s_ = 0; s_ < 4; ++s_) z_ = __builtin_amdgcn_mfma_f32_16x16x4f32(a_[s_], b_[s_], z_, 0, 0, 0); dst_ = z_; }
        const f32x4m zero4 = {0.f, 0.f, 0.f, 0.f};
        f32x4m a2N, a2T, a4N, a4T, a8N, b1T, b2T, b3T, iaT;
        MM4(a2N, aT, aN, zero4); MM4(a2T, aN, aT, zero4);
#pragma unroll
        for (int r = 0; r < 4; ++r) iaT[r] = aT[r] + (cl == 4 * q + r ? 1.f : 0.f);
        MM4(a4N, a2T, a2N, zero4); MM4(a4T, a2N, a2T, zero4);
        MM4(b1T, a2N, iaT, iaT);
        MM4(a8N, a4T, a4N, zero4);
        MM4(b2T, a4N, b1T, b1T);
        MM4(b3T, a8N, b2T, b2T);
#undef MM4
        *(LAS f32x4m*)(L + RW_TINV + (d * 64 + lane) * 16) = b3T;
    }
    __syncthreads(); RWP(2);
    {
        const int cl = lane & 15, q = lane >> 4, cc = (wave & 3) * 16 + cl;
        LAS bf16* xrow = (wave < 4 ? Ut : Wt) + cc * RW_P;
        f32x4m Tt[4];
#pragma unroll
        for (int b = 0; b < 4; ++b) Tt[b] = *(const LAS f32x4m*)(L + RW_TINV + (b * 64 + lane) * 16);
        unsigned xp[4][2];
#pragma unroll
        for (int b = 0; b < 4; ++b) {
            f32x4m acc;
            if (wave < 4) { const v2u w = *(const LAS v2u*)(RhsB + cc * RW_P + 16 * b + 4 * q); acc[0] = bflo(w.x); acc[1] = bfhi(w.x); acc[2] = bflo(w.y); acc[3] = bfhi(w.y); }
            else {
#pragma unroll
                for (int r = 0; r < 4; ++r) acc[r] = bf1(At[(16 * b + 4 * q + r) * RW_P + cc]); }
#pragma unroll
            for (int mq = 0; mq < 2; ++mq) if (32 * mq < 16 * b) {
                const v2u a0 = *(const LAS v2u*)(Aab + (16 * b + cl) * RW_P + 32 * mq + 4 * q), a1 = *(const LAS v2u*)(Aab + (16 * b + cl) * RW_P + 32 * mq + 16 + 4 * q);
                const bool second = 2 * mq + 1 < b;
                const v4u au = {a0.x, a0.y, a1.x, a1.y}, xu = {xp[2 * mq][0], xp[2 * mq][1], second ? xp[2 * mq + 1][0] : 0u, second ? xp[2 * mq + 1][1] : 0u};
                acc = __builtin_amdgcn_mfma_f32_16x16x32_bf16(__builtin_bit_cast(bf16x8, au), __builtin_bit_cast(bf16x8, xu), acc, 0, 0, 0);
            }
            f32x4m x = {0.f, 0.f, 0.f, 0.f};
#pragma unroll
            for (int s = 0; s < 4; ++s) x = __builtin_amdgcn_mfma_f32_16x16x4f32(Tt[b][s], acc[s], x, 0, 0, 0);
            xp[b][0] = pk2(x[0], x[1]); xp[b][1] = pk2(x[2], x[3]);
            *(LAS v2u*)(xrow + 16 * b + 4 * q) = (v2u){xp[b][0], xp[b][1]};
        }
    }
    __syncthreads(); RWP(3);
    {
        const int ti = (wave >> 1) & 1, tn = wave & 1; f32x16 acc = {};
        unsigned char* dst = F.ws + WS_F + rw_item(bh, c) * 16384;
        if (wave < 4) { acc = rw_mm(acc, Wt, tn, Bht, ti, lane);
            bf16* MT = (bf16*)dst; const int k2 = 32 * ti + r32; const float ed = __expf(lend[k2]);
#pragma unroll
            for (int g = 0; g < 4; ++g) { const int k1 = 32 * tn + 8 * g + 4 * hi;
                const float v0 = acc[4 * g] + (k1 == k2 ? ed : 0.f), v1 = acc[4 * g + 1] + (k1 + 1 == k2 ? ed : 0.f), v2 = acc[4 * g + 2] + (k1 + 2 == k2 ? ed : 0.f), v3 = acc[4 * g + 3] + (k1 + 3 == k2 ? ed : 0.f);
                *(v2u*)(MT + k2 * 64 + k1) = (v2u){pk2(v0, v1), pk2(v2, v3)}; }
        } else { acc = rw_mm(acc, Bht, ti, Ut, tn, lane); acc = rw_mm(acc, Kht, ti, Vt, tn, lane);
            v4u* GT = (v4u*)(dst + 8192) + ((ti * 2 + tn) * 64 + lane) * 2;
            const bf16x8 g0 = rw_pack8(acc, 0), g1 = rw_pack8(acc, 1); GT[0] = __builtin_bit_cast(v4u, g0); GT[1] = __builtin_bit_cast(v4u, g1); }
    }
    RWP(4);
    if (c > 0) {
        const int ti = (wave >> 1) & 1, tn = wave & 1; f32x16 acc = {};
        unsigned char* dst = F.ws + WS_QY + rw_item(bh, c) * 16384;
        if (wave < 4) { acc = rw_mm(acc, Wt, tn, Arb, ti, lane);
            bf16* Qg = (bf16*)dst; const int t = 32 * ti + r32;
#pragma unroll
            for (int g = 0; g < 4; ++g) { const int k = 32 * tn + 8 * g + 4 * hi; const v2u rw = *(const LAS v2u*)(Rt + t * RW_P + k);
                *(v2u*)(Qg + t * 64 + k) = (v2u){pk2(acc[4 * g] + bflo(rw.x), acc[4 * g + 1] + bfhi(rw.x)), pk2(acc[4 * g + 2] + bflo(rw.y), acc[4 * g + 3] + bfhi(rw.y))}; }
        } else { acc = rw_mm(acc, Ut, tn, Arb, ti, lane); acc = rw_mm(acc, Vt, tn, Ark, ti, lane);
            v4u* YT = (v4u*)(dst + 8192) + ((ti * 2 + tn) * 64 + lane) * 2;
            const bf16x8 g0 = rw_pack8(acc, 0), g1 = rw_pack8(acc, 1); YT[0] = __builtin_bit_cast(v4u, g0); YT[1] = __builtin_bit_cast(v4u, g1); }
    }
    __syncthreads(); RWP(5);
}

struct OutRaw { v4u qg[4], s0[4], s1[4]; };
__device__ __forceinline__ void rwkv_out_load(OutRaw& R, Frame& F, int bh, int c, int ti) {
    const int lane = F.lane, r32 = lane & 31, b = bh >> 3, h = bh & 7, rr = lane >> 3, ck = lane & 7;
    const unsigned char* src = F.ws + WS_QY + rw_item(bh, c) * 16384; const bf16* Qg = (const bf16*)src; const v4u* YT = (const v4u*)(src + 8192);
    const v4u* SI = (const v4u*)(F.ws + WS_SST + rw_item(bh, c) * 8192);
#pragma unroll
    for (int j = 0; j < 4; ++j) R.qg[j] = *(const v4u*)(Qg + (32 * ti + 8 * j + rr) * 64 + 8 * ck);
#pragma unroll
    for (int e = 0; e < 4; ++e) { R.s0[e] = SI[(((e >> 1) * 2 + 0) * 2 + (e & 1)) * 64 + lane]; R.s1[e] = SI[(((e >> 1) * 2 + 1) * 2 + (e & 1)) * 64 + lane]; }
}
__device__ __forceinline__ void rwkv_out(Frame& F, const OutRaw& R, int bh, int c, int ti) {
    constexpr int P_ = 144;
    const int lane = F.lane, r32 = lane & 31, hi = lane >> 5, b = bh >> 3, h = bh & 7, rr = lane >> 3, ck = lane & 7;
    LAS unsigned char* Zl = F.lds + RING_OFF + F.wave * 16384; LAS unsigned char* Gl = Zl + 33 * P_; LAS unsigned char* Ql = Gl + 32 * P_;
    const int tok0 = 64 * (c - 1) + 32 * ti; const size_t m0 = (size_t)(b * SEQL + tok0);
    bf16* RO = (bf16*)(F.ws + WS_F);
    const size_t pm0 = tok0 == 0 ? (size_t)(MR + 15) : m0 - 1;
    const bf16* ZR = (const bf16*)(F.ws + WS_ZR); const bf16* GG = (const bf16*)(F.ws + WS_GG);
    const v4u* YT = (const v4u*)(F.ws + WS_QY + rw_item(bh, c) * 16384 + 8192);
    const float dt = ((const float*)(F.ws + WS_DOTS))[rw_item(bh, c) * 64 + 32 * ti + r32];
    const v4u a0 = YT[((ti * 2 + 0) * 64 + lane) * 2], a1 = YT[((ti * 2 + 0) * 64 + lane) * 2 + 1], b0 = YT[((ti * 2 + 1) * 64 + lane) * 2], b1 = YT[((ti * 2 + 1) * 64 + lane) * 2 + 1];
    v4u qg[4], zg[4], gg4[4], s0[4], s1[4];
#pragma unroll
    for (int j = 0; j < 4; ++j) { qg[j] = R.qg[j]; s0[j] = R.s0[j]; s1[j] = R.s1[j]; }
    const v4u zprev = *(const v4u*)(ZR + pm0 * 1792 + 1024 + h * 64 + 8 * ck);
#pragma unroll
    for (int j = 0; j < 4; ++j) { zg[j] = *(const v4u*)(ZR + (m0 + 8 * j + rr) * 1792 + 1024 + h * 64 + 8 * ck); gg4[j] = *(const v4u*)(GG + (m0 + 8 * j + rr) * 512 + h * 64 + 8 * ck); }
    __builtin_amdgcn_sched_barrier(0);
#pragma unroll
    for (int j = 0; j < 4; ++j) *(LAS v4u*)(Ql + (8 * j + rr) * P_ + 16 * ck) = qg[j];
    f32x16 y0, y1;
#pragma unroll
    for (int j = 0; j < 4; ++j) { y0[2 * j] = bflo(a0[j]); y0[2 * j + 1] = bfhi(a0[j]); y0[8 + 2 * j] = bflo(a1[j]); y0[8 + 2 * j + 1] = bfhi(a1[j]);
                                  y1[2 * j] = bflo(b0[j]); y1[2 * j + 1] = bfhi(b0[j]); y1[8 + 2 * j] = bflo(b1[j]); y1[8 + 2 * j + 1] = bfhi(b1[j]); }
#pragma unroll
    for (int e = 0; e < 4; ++e) {
        const v2u qa = *(const LAS v2u*)(Ql + r32 * P_ + (32 * (e >> 1) + 16 * (e & 1) + 4 * hi) * 2), qb = *(const LAS v2u*)(Ql + r32 * P_ + (32 * (e >> 1) + 16 * (e & 1) + 8 + 4 * hi) * 2);
        const v4u qf = {qa.x, qa.y, qb.x, qb.y};
        y0 = __builtin_amdgcn_mfma_f32_32x32x16_bf16(__builtin_bit_cast(bf16x8, s0[e]), __builtin_bit_cast(bf16x8, qf), y0, 0, 0, 0);
        y1 = __builtin_amdgcn_mfma_f32_32x32x16_bf16(__builtin_bit_cast(bf16x8, s1[e]), __builtin_bit_cast(bf16x8, qf), y1, 0, 0, 0);
    }
    if (lane < 8) *(LAS v4u*)(Zl + 16 * ck) = zprev;
#pragma unroll
    for (int j = 0; j < 4; ++j) { *(LAS v4u*)(Zl + (1 + 8 * j + rr) * P_ + 16 * ck) = zg[j]; *(LAS v4u*)(Gl + (8 * j + rr) * P_ + 16 * ck) = gg4[j]; }
    float sm = 0.f;
#pragma unroll
    for (int r = 0; r < 16; ++r) sm += y0[r] + y1[r];
    sm += __shfl_xor(sm, 32);
    const float mean = sm * (1.f / 64.f);
    float sv = 0.f;
#pragma unroll
    for (int r = 0; r < 16; ++r) { y0[r] -= mean; y1[r] -= mean; sv += y0[r] * y0[r] + y1[r] * y1[r]; }
    sv += __shfl_xor(sv, 32);
    const float rs = 1.f / sqrtf(sv * (1.f / 64.f) + GN_EPS);
    const float* lnw = inp(18) + h * 64 + 4 * hi; const float* lnb = inp(19) + h * 64 + 4 * hi; const float* mvp = inp(9) + 1024 + h * 64 + 4 * hi;
#pragma unroll
    for (int tn = 0; tn < 2; ++tn)
#pragma unroll
        for (int g = 0; g < 4; ++g) { const int co = (32 * tn + 8 * g + 4 * hi) * 2;
            const f32x4 w4 = *(const f32x4*)(lnw + 32 * tn + 8 * g), b4 = *(const f32x4*)(lnb + 32 * tn + 8 * g), m4 = *(const f32x4*)(mvp + 32 * tn + 8 * g);
            const v2u zv = *(const LAS v2u*)(Zl + (1 + r32) * P_ + co), pv = *(const LAS v2u*)(Zl + r32 * P_ + co), gv = *(const LAS v2u*)(Gl + r32 * P_ + co);
            const float z[4] = {bflo(zv.x), bfhi(zv.x), bflo(zv.y), bfhi(zv.y)}, p[4] = {bflo(pv.x), bfhi(pv.x), bflo(pv.y), bfhi(pv.y)}, gt[4] = {bflo(gv.x), bfhi(gv.x), bflo(gv.y), bfhi(gv.y)};
            float o[4];
#pragma unroll
            for (int x = 0; x < 4; ++x) { const float d = tn == 0 ? y0[4 * g + x] : y1[4 * g + x]; const float v = z[x] + (p[x] - z[x]) * m4[x]; o[x] = (d * rs * w4[x] + b4[x] + dt * v) * gt[x]; }
            *(LAS v2u*)(Gl + r32 * P_ + co) = (v2u){pk2(o[0], o[1]), pk2(o[2], o[3])};
        }
#pragma unroll
    for (int j = 0; j < 4; ++j) *(v4u*)(RO + (m0 + 8 * j + rr) * 512 + h * 64 + 8 * ck) = *(const LAS v4u*)(Gl + (8 * j + rr) * P_ + 16 * ck);
}

constexpr int RWC_MP = 68;
constexpr int RWC_SLOT = 64 * RWC_MP * 2 + 4096;
constexpr int RWC_FLAGS = 7 * RWC_SLOT;
__device__ __forceinline__ void rwkv_chain_wg(Frame& F, int bh, int tv) {
    const int lane = F.lane, wave = F.wave, r32 = lane & 31, hi = lane >> 5;
    LAS unsigned char* L = F.lds; volatile LAS unsigned* flag = (volatile LAS unsigned*)(L + RWC_FLAGS);
    if (F.tid < 7) flag[F.tid] = 0u;
    __syncthreads();
    if (wave != 0) {
        const int slot = wave - 1; LAS unsigned char* sb = L + slot * RWC_SLOT;
        v4u mv[8], gv[4];
#define RWC_LOAD(MV, GV, CC) do { const unsigned char* src_ = F.ws + WS_F + rw_item(bh, (CC)) * 16384; const v4u* MT_ = (const v4u*)src_; const v4u* GT_ = (const v4u*)(src_ + 8192); \
            _Pragma("unroll") for (int i = 0; i < 8; ++i) MV[i] = MT_[lane + 64 * i]; \
            _Pragma("unroll") for (int i = 0; i < 4; ++i) { const int idx = lane + 64 * i, t2 = idx >> 7, l = (idx >> 1) & 63, hf = idx & 1; GV[i] = GT_[((t2 * 2 + tv) * 64 + l) * 2 + hf]; } } while (0)
        RWC_LOAD(mv, gv, slot);
        for (int c = slot; c < RW_NCH; c += 7) {
            v4u mn[8], gn[4];
            RWC_LOAD(mn, gn, (c + 7 < RW_NCH ? c + 7 : c));
            asm volatile("s_waitcnt vmcnt(12)" ::: "memory");
            while (flag[slot] != 0u) __builtin_amdgcn_s_sleep(2);
#pragma unroll
            for (int i = 0; i < 8; ++i) { const int idx = lane + 64 * i; *(LAS v4u*)(sb + (idx >> 3) * (RWC_MP * 2) + (idx & 7) * 16) = mv[i]; }
#pragma unroll
            for (int i = 0; i < 4; ++i) *(LAS v4u*)(sb + 64 * RWC_MP * 2 + (lane + 64 * i) * 16) = gv[i];
            asm volatile("s_waitcnt lgkmcnt(0)" ::: "memory");
            if (lane == 0) flag[slot] = 1u;
#pragma unroll
            for (int i = 0; i < 8; ++i) mv[i] = mn[i];
#pragma unroll
            for (int i = 0; i < 4; ++i) gv[i] = gn[i];
        }
#undef RWC_LOAD
        return;
    }
    f32x16 s0 = {}, s1 = {};
    for (int c = 0; c < RW_NCH; ++c) {
        const int slot = c % 7; const LAS unsigned char* sb = L + slot * RWC_SLOT;
        v4u* SI = (v4u*)(F.ws + WS_SST + rw_item(bh, c) * 8192);
        const bf16x8 b00 = rw_pack8(s0, 0), b01 = rw_pack8(s0, 1), b10 = rw_pack8(s1, 0), b11 = rw_pack8(s1, 1);
        SI[((0 * 2 + tv) * 2 + 0) * 64 + lane] = __builtin_bit_cast(v4u, b00); SI[((0 * 2 + tv) * 2 + 1) * 64 + lane] = __builtin_bit_cast(v4u, b01);
        SI[((1 * 2 + tv) * 2 + 0) * 64 + lane] = __builtin_bit_cast(v4u, b10); SI[((1 * 2 + tv) * 2 + 1) * 64 + lane] = __builtin_bit_cast(v4u, b11);
        while (flag[slot] == 0u) __builtin_amdgcn_s_sleep(1);
        asm volatile("" ::: "memory");
        s16x4v ma[2][2][2], mb[2][2][2]; v4u g[2][2];
#pragma unroll
        for (int tk = 0; tk < 2; ++tk)
#pragma unroll
            for (int s = 0; s < 2; ++s)
#pragma unroll
                for (int t2 = 0; t2 < 2; ++t2) { const LAS bf16* mp = (const LAS bf16*)sb + (32 * t2 + r32) * RWC_MP + 32 * tk + 16 * s + 4 * hi; ma[tk][s][t2] = *(const LAS s16x4v*)(mp); mb[tk][s][t2] = *(const LAS s16x4v*)(mp + 8); }
#pragma unroll
        for (int t2 = 0; t2 < 2; ++t2) { g[t2][0] = *(const LAS v4u*)(sb + 64 * RWC_MP * 2 + ((t2 * 64 + lane) * 2) * 16); g[t2][1] = *(const LAS v4u*)(sb + 64 * RWC_MP * 2 + ((t2 * 64 + lane) * 2 + 1) * 16); }
        asm volatile("s_waitcnt lgkmcnt(0)" ::: "memory");
        if (lane == 0) flag[slot] = 0u;
        f32x16 n0, n1;
#pragma unroll
        for (int j = 0; j < 4; ++j) { n0[2 * j] = bflo(g[0][0][j]); n0[2 * j + 1] = bfhi(g[0][0][j]); n0[8 + 2 * j] = bflo(g[0][1][j]); n0[8 + 2 * j + 1] = bfhi(g[0][1][j]);
                                      n1[2 * j] = bflo(g[1][0][j]); n1[2 * j + 1] = bfhi(g[1][0][j]); n1[8 + 2 * j] = bflo(g[1][1][j]); n1[8 + 2 * j + 1] = bfhi(g[1][1][j]); }
#pragma unroll
        for (int tk = 0; tk < 2; ++tk)
#pragma unroll
            for (int s = 0; s < 2; ++s) {
                const bf16x8 bfr = tk == 0 ? (s == 0 ? b00 : b01) : (s == 0 ? b10 : b11);
#pragma unroll
                for (int t2 = 0; t2 < 2; ++t2) {
                    const s16x4v xa = ma[tk][s][t2], xb = mb[tk][s][t2];
                    const bf16x8 af = {xa[0], xa[1], xa[2], xa[3], xb[0], xb[1], xb[2], xb[3]};
                    if (t2 == 0) n0 = __builtin_amdgcn_mfma_f32_32x32x16_bf16(af, bfr, n0, 0, 0, 0); else n1 = __builtin_amdgcn_mfma_f32_32x32x16_bf16(af, bfr, n1, 0, 0, 0);
                }
            }
        s0 = n0; s1 = n1;
    }
}

#ifdef MK_DUMP
__device__ __forceinline__ void dump_phase(const unsigned char* ws, float* out) {
    const size_t n = (size_t)MR * DM; const size_t i0 = (size_t)blockIdx.x * blockDim.x + threadIdx.x, st = (size_t)gridDim.x * blockDim.x;
    for (size_t i = i0; i < n; i += st) { const size_t m = i >> 10, c = i & 1023; float v = 0.f;
        if (MK_DUMP == 1) v = bf1(((const bf16*)(ws + WS_F))[m * 1024 + c]);
        else if (MK_DUMP == 2) v = bf1(((const bf16*)(ws + WS_ZR))[m * 1792 + c]);
        else if (MK_DUMP == 3) v = c < 512 ? ((const float*)(ws + WS_LW))[m * 512 + c] : bf1(((const bf16*)(ws + WS_AA))[m * 512 + c - 512]);
        else if (MK_DUMP == 4) v = bf1(((const bf16*)(ws + WS_MERGED))[m * 1024 + c]);
        else if (MK_DUMP == 5) v = c < 512 ? bf1(((const bf16*)(ws + WS_Q))[m * 512 + c]) : (c < 768 ? bf1(((const bf16*)(ws + WS_KV))[m * 256 + c - 512]) : bf1(((const bf16*)(ws + WS_LA))[m * 256 + c - 768]));
        else if (MK_DUMP == 6) v = bf1(((const bf16*)(ws + WS_GATES))[m * 2048 + c]);
        else if (MK_DUMP == 7) v = bf1(((const bf16*)(ws + WS_F))[m * 1024 + c]);
        else if (MK_DUMP == 8) v = c < 512 ? bf1(((const bf16*)(ws + WS_GG))[m * 512 + c]) : bf1(((const bf16*)(ws + WS_ZR))[m * 1792 + 1024 + c - 512]);
        else if (MK_DUMP == 9) v = ((const float*)(ws + WS_SS))[((size_t)((c & 15) >> 2) * MP + m) * 4 + (c & 3)];
        else if (MK_DUMP == 10) v = bf1(((const bf16*)(ws + WS_XN))[m * 1024 + c]);
        out[i] = v; }
}
#endif
#ifndef MK_N_LAUNCHES
#define MK_N_LAUNCHES 1
#endif
constexpr int N_PHASES = 15;
constexpr int N_LAUNCHES = MK_N_LAUNCHES;
__global__ void __launch_bounds__(NWAVES * 64, 2) hybrid_fwd(Args args) {
    extern __shared__ __attribute__((aligned(16))) unsigned char lds[];
    Frame F;
    F.lds = (LAS unsigned char*)lds;
    F.MISC = (volatile LAS unsigned*)(F.lds + MISC_OFF);
#define FRAME_REFRESH() do { int t_ = threadIdx.x; asm volatile("" : "+v"(t_)); F.tid = t_; F.lane = t_ & 63; F.wave = __builtin_amdgcn_readfirstlane(t_ >> 6); } while (0)
    FRAME_REFRESH();
    F.G = gridDim.x; { const int bx = blockIdx.x; F.vcu = (F.G % 8 == 0) ? (bx % 8) * (F.G / 8) + bx / 8 : bx; }
    unsigned char* ws = args.ws; F.ws = ws; F.out = args.out;
    F.ctl = (gu32*)(ws + WS_CTL);
    for (int u = F.tid; u < (LDS_BYTES - LDSCTL_OFF) / 4; u += NWAVES * 64) ((LAS unsigned*)(F.lds + LDSCTL_OFF))[u] = 0u;
    __syncthreads();
    XcdBarrier bar; bar.bar = (unsigned*)(F.ctl + CW_BAR); bar.x = 0; bar.st = nullptr;
    if (N_LAUNCHES == 1) bar = xcd_barrier_post((unsigned*)(F.ctl + CW_BAR), F.MISC + 8);
    const int lo = args.ph_lo, hi = args.ph_hi;
#ifndef PHASE_MASK
#define PHASE_MASK 0x7fff
#endif
#define IN(k) (((PHASE_MASK >> (k)) & 1) && lo <= (k) && (k) < hi)
#ifndef MK_TIME_SCALE
#define MK_TIME_SCALE 0.001f
#endif
#ifdef MK_TIME_PHASE
#define SEAM(k) do { if (IN(k) && IN((k) + 1)) xcd_barrier(bar); if (blockIdx.x == 0 && threadIdx.x == 0) { const unsigned long long t_ = __builtin_amdgcn_s_memrealtime(); ((unsigned long long*)(ws + 16384))[(k) + 1] = t_; } } while (0)
#else
#define SEAM(k) do { if (IN(k) && IN((k) + 1)) xcd_barrier(bar); } while (0)
#endif
#define GEMM_RUN(EpiT, Eobj, Aptr, lda_, Bptr, ldb_, M_, N_, K_) do { pg8::Gemm g_{(const pg8::bf16_t*)(Aptr), (const pg8::bf16_t*)(Bptr), (M_), (N_), (K_), (lda_), (ldb_)}; pg8::StaticOrder S_; S_.init((M_), (N_), F.G, (int)blockIdx.x); \
        pg8::gemm_phase<EpiT, pg8::StaticOrder, true, true>(F.lds + RING_OFF, g_, S_, Eobj); } while (0)

#ifdef MK_COH_TEST
    {
        float* Tb = (float*)(ws + WS_BIG + 300 * MiB); const int g = blockIdx.x, G = gridDim.x, nb = (g + 1) % G; float acc = 0.f; unsigned bad = 0;
        for (int rep = 0; rep < 4; ++rep) {
            for (int i = threadIdx.x; i < 8192; i += 512) Tb[(size_t)g * 8192 + i] = 1.0f + rep;
            xcd_barrier(bar);
            for (int i = threadIdx.x; i < 8192; i += 512) acc += Tb[(size_t)nb * 8192 + i];
            xcd_barrier(bar);
            for (int i = threadIdx.x; i < 8192; i += 512) Tb[(size_t)g * 8192 + i] = 100.0f + rep * 7 + i;
            xcd_barrier(bar);
            for (int i = threadIdx.x; i < 8192; i += 512) { const float v = Tb[(size_t)nb * 8192 + i]; bad += (v != 100.0f + rep * 7 + i) ? 1u : 0u; }
            xcd_barrier(bar);
        }
        if (acc == 12345.f) bad++;
        if (bad) atomicAdd((unsigned*)(F.ctl + 901), bad);
    }
#endif
#ifdef MK_ITEM_PROF
    if (blockIdx.x == 0 && threadIdx.x == 0) { for (int i_ = 0; i_ < 8; ++i_) ((unsigned long long*)(ws + 32768))[i_] = 0ull; }
#endif
#ifdef MK_TIME_PHASE
    if (blockIdx.x == 0 && threadIdx.x == 0) ((unsigned long long*)(ws + 16384))[0] = __builtin_amdgcn_s_memrealtime();
#endif
    if (IN(0)) { FRAME_REFRESH(); p0_prologue(F, args); } SEAM(0);
    if (IN(1)) { FRAME_REFRESH(); { for (int it = F.vcu; it < DFF / 16; it += F.G) meta_gateup(F, (const bf16*)(ws + WS_WGU1), it); }
        pg8::EpiSwiGLU E{(pg8::bf16_t*)(ws + WS_HID), nullptr}; GEMM_RUN(pg8::EpiSwiGLU, E, (unsigned char*)F.out, DM, ws + WS_WGU1, DM, MR, NHID2, DM); } SEAM(1);
    if (IN(2)) { FRAME_REFRESH(); { for (int it = F.vcu; it < 64; it += F.G) meta_down(F, (const bf16*)(ws + WS_WD1), it); }
        pg8::EpiFSS E{(pg8::bf16_t*)(ws + WS_F), (float*)(ws + WS_SS)}; GEMM_RUN(pg8::EpiFSS, E, ws + WS_HID, DFF, ws + WS_WD1, DFF, MR, DM, DFF); } SEAM(2);
    if (IN(3)) { FRAME_REFRESH(); row_pass<0>(F, args, inp(5), inp(6), 0.5f); } SEAM(3);
    if (IN(4)) { pg8::EpiWin E{(const float*)(ws + WS_RS2), (pg8::bf16_t*)(ws + WS_Q), (pg8::bf16_t*)(ws + WS_KV), (pg8::bf16_t*)(ws + WS_ZR), (const float*)(ws + WS_ROPE), MR, (pg8::bf16_t*)(ws + WS_VT)}; FRAME_REFRESH(); { for (int it = F.vcu; it < 128; it += F.G) meta_win(F, it); }
        GEMM_RUN(pg8::EpiWin, E, (unsigned char*)F.out, DM, ws + WS_WIN, DM, MR, NIN_A, DM); } SEAM(4);
#ifdef MK_GEMM_CHECK4
    if (IN(4)) { xcd_barrier(bar);
        { unsigned char* w2 = ws + WS_BIG + 165 * MiB; pg8::EpiWin E{(const float*)(ws + WS_RS2), (pg8::bf16_t*)(w2), (pg8::bf16_t*)(w2 + (WS_KV - WS_Q)), (pg8::bf16_t*)(w2 + (WS_ZR - WS_Q)), (const float*)(ws + WS_ROPE), MR, (pg8::bf16_t*)(ws + WS_VT)};
          pg8::Gemm g_{(const pg8::bf16_t*)(ws + WS_XN), (const pg8::bf16_t*)(ws + WS_WIN), MP, NIN_A, DM, DM, DM}; pg8::StaticOrder S_; S_.init(MP, NIN_A, F.G, (int)((blockIdx.x + 101) % gridDim.x));
          pg8::gemm_phase<pg8::EpiWin, pg8::StaticOrder, true, true>(F.lds + RING_OFF, g_, S_, E); }
        xcd_barrier(bar);
        { FRAME_REFRESH(); const unsigned* a = (const unsigned*)(ws + WS_Q); const unsigned* b = (const unsigned*)(ws + WS_BIG + 165 * MiB); unsigned bad = 0;
          for (size_t i = (size_t)blockIdx.x * 512 + F.tid; i < (size_t)MP * 2560 / 2; i += (size_t)gridDim.x * 512) bad += (a[i] != b[i]) ? 1u : 0u;
          if (bad) atomicAdd((unsigned*)(F.ctl + 900), bad); }
        xcd_barrier(bar);
    }
#endif
    if (IN(5)) { FRAME_REFRESH(); lora_a_pass(F, args);
#ifdef MK_PROBE_BAR
        xcd_barrier(bar); xcd_barrier(bar); xcd_barrier(bar); xcd_barrier(bar);
#endif
    } SEAM(5);
    if (IN(6)) { pg8::EpiLora E{(pg8::bf16_t*)(ws + WS_LW), (pg8::bf16_t*)(ws + WS_AA), (pg8::bf16_t*)(ws + WS_GG), inp(10), inp(12)}; FRAME_REFRESH(); { const int gw = F.vcu * NWAVES + F.wave, NGW = F.G * NWAVES; for (int it = gw; it < 96; it += NGW) meta_lora(F, it); }
        int kl_ = 256; asm volatile("" : "+s"(kl_)); GEMM_RUN(pg8::EpiLora, E, ws + WS_LA, 256, ws + WS_WL, 256, MR, 1536, kl_); } SEAM(6);
    if (IN(7)) { FRAME_REFRESH();
        { RwRaw raw; { const int it0 = (int)blockIdx.x, bh0 = it0 / RW_NCH; rw_load_raw(raw, F, bh0 >> 3, bh0 & 7, it0 - bh0 * RW_NCH); }
          for (int it = (int)blockIdx.x; it < 32 * RW_NCH; it += F.G) { const int bh = it / RW_NCH, c = it - bh * RW_NCH; const int itn = it + F.G, bhn = itn / RW_NCH, cn = itn < 32 * RW_NCH ? itn - bhn * RW_NCH : -1;
              rwkv_item(F, bh >> 3, bh & 7, c, raw, bhn >> 3, bhn & 7, cn); } }
        xcd_barrier(bar);
#ifdef MK_TIME_PHASE
        if (blockIdx.x == 0 && threadIdx.x == 0) ((unsigned long long*)(ws + 16384))[21] = __builtin_amdgcn_s_memrealtime();
#endif
        FRAME_REFRESH();
#ifdef MK_SKIP_CHAIN
        if ((int)blockIdx.x < 64) { if (F.G == 12345) rwkv_chain_wg(F, (int)blockIdx.x >> 1, (int)blockIdx.x & 1); }
#else
        if ((int)blockIdx.x < 64) { rwkv_chain_wg(F, (int)blockIdx.x >> 1, (int)blockIdx.x & 1);
#ifdef MK_TIME_PHASE
            if (blockIdx.x == 0 && threadIdx.x == 0) ((unsigned long long*)(ws + 16384))[23] = __builtin_amdgcn_s_memrealtime();
#endif
        }
#endif
#ifdef MK_SKIP_ATT
        else if (false) {
#else
        else {
#endif
            const int gw = ((int)blockIdx.x - 64) * NWAVES + F.wave, NGW = (F.G - 64) * NWAVES;
            for (int it = gw; it < NB * 8 * (SEQL / 32); it += NGW) { const int head = it & 7, qb = (it >> 3) & 255, b = it >> 11; attn_item(F, args, b, head, qb); }
#ifdef MK_TIME_PHASE
            if (blockIdx.x == MK_TS_WG && threadIdx.x == 0) ((unsigned long long*)(ws + 16384))[24] = __builtin_amdgcn_s_memrealtime();
            if (F.lane == 0 && F.wave == MK_TS_WAVE) atomicMax((unsigned long long*)(ws + 16384) + 26, (unsigned long long)__builtin_amdgcn_s_memrealtime());
#endif
#ifndef MK_SKIP_CONV
            convert_late_weights(F, args, gw, NGW, F.lds);
#endif
#ifdef MK_TIME_PHASE
            if (blockIdx.x == MK_TS_WG && threadIdx.x == 0) ((unsigned long long*)(ws + 16384))[25] = __builtin_amdgcn_s_memrealtime();
            if (F.lane == 0) atomicMax((unsigned long long*)(ws + 16384) + 27, (unsigned long long)__builtin_amdgcn_s_memrealtime());
#endif
            }
        xcd_barrier(bar);
#ifdef MK_TIME_PHASE
        if (blockIdx.x == 0 && threadIdx.x == 0) ((unsigned long long*)(ws + 16384))[22] = __builtin_amdgcn_s_memrealtime();
#endif
        FRAME_REFRESH();
        { const int gw = (int)blockIdx.x * NWAVES + F.wave, NGW = F.G * NWAVES;
          constexpr int T_ = 32 * 128 * 2; OutRaw R;
          if (gw < T_) rwkv_out_load(R, F, gw >> 8, ((gw >> 1) & 127) + 1, gw & 1);
          for (int it = gw; it < T_; it += NGW) { const int ti = it & 1, c = ((it >> 1) & 127) + 1, bh = it >> 8; const int itn = it + NGW < T_ ? it + NGW : it;
              OutRaw N; rwkv_out_load(N, F, itn >> 8, ((itn >> 1) & 127) + 1, itn & 1);
              rwkv_out(F, R, bh, c, ti); R = N; } }
    }
    SEAM(7);
    if (IN(8)) {
        static_assert(WS_WRWKV == WS_WATT + (size_t)DM * 512 * 2, "branch weights adjacent");
        { pg8::EpiPlain E{(pg8::bf16_t*)(ws + WS_GATES), DM, 4, (size_t)MR * DM};
          pg8::Gemm g_{(const pg8::bf16_t*)(ws + WS_Q), (const pg8::bf16_t*)(ws + WS_WATT), MR, 2 * DM, 512, 512, 512, (const pg8::bf16_t*)(ws + WS_F), 4}; pg8::StaticOrder S_; S_.init(MR, 2 * DM, F.G, (int)blockIdx.x);
          pg8::gemm_phase<pg8::EpiPlain, pg8::StaticOrder, true, true>(F.lds + RING_OFF, g_, S_, E); }
    } SEAM(8);
    if (IN(9)) { pg8::EpiGateMerge E{(const float*)(ws + WS_RS2), (pg8::bf16_t*)(ws + WS_MERGED), (const pg8::bf16_t*)(ws + WS_GATES), (const pg8::bf16_t*)(ws + WS_GATES) + (size_t)MR * DM};
        GEMM_RUN(pg8::EpiGateMerge, E, (unsigned char*)F.out, DM, ws + WS_WIN + (size_t)NIN_A * DM * 2, DM, MR, 2048, DM); } SEAM(9);
    if (IN(10)) { pg8::EpiFSS E{(pg8::bf16_t*)(ws + WS_F), (float*)(ws + WS_SS)}; GEMM_RUN(pg8::EpiFSS, E, ws + WS_MERGED, DM, ws + WS_WMIX, DM, MR, DM, DM); } SEAM(10);
#ifdef MK_GEMM_CHECK
    if (IN(10)) { xcd_barrier(bar);
        { pg8::EpiFSS E{(pg8::bf16_t*)(ws + WS_BIG + 192 * MiB), (float*)(ws + WS_BIG + 256 * MiB)}; pg8::Gemm g_{(const pg8::bf16_t*)(ws + WS_MERGED), (const pg8::bf16_t*)(ws + WS_WMIX), MR, DM, DM, DM, DM}; pg8::StaticOrder S_; S_.init(MR, DM, F.G, (int)((blockIdx.x + 37) % gridDim.x));
          pg8::gemm_phase<pg8::EpiFSS, pg8::StaticOrder, true, true>(F.lds + RING_OFF, g_, S_, E); }
        xcd_barrier(bar);
        { FRAME_REFRESH(); const unsigned* a = (const unsigned*)(ws + WS_F); const unsigned* b = (const unsigned*)(ws + WS_BIG + 192 * MiB); unsigned bad = 0;
          for (size_t i = (size_t)blockIdx.x * 512 + F.tid; i < (size_t)MR * DM / 2; i += (size_t)gridDim.x * 512) bad += (a[i] != b[i]) ? 1u : 0u;
          if (bad) atomicAdd((unsigned*)(F.ctl + 900), bad); }
    }
#endif
    if (IN(11)) { FRAME_REFRESH(); row_pass<1>(F, args, inp(23), inp(24), 1.0f); } SEAM(11);
    if (IN(12)) { pg8::EpiSwiGLU E{(pg8::bf16_t*)(ws + WS_HID), (const float*)(ws + WS_RS3)}; GEMM_RUN(pg8::EpiSwiGLU, E, ws + WS_H2, DM, ws + WS_WGU2, DM, MR, NHID2, DM); } SEAM(12);
    if (IN(13)) { pg8::EpiFSS E{(pg8::bf16_t*)(ws + WS_F), (float*)(ws + WS_SS)}; GEMM_RUN(pg8::EpiFSS, E, ws + WS_HID, DFF, ws + WS_WD2, DFF, MR, DM, DFF); } SEAM(13);
    if (IN(14)) { FRAME_REFRESH(); row_pass<2>(F, args, inp(27), inp(27), 0.5f); }
#if defined(MK_GEMM_CHECK) || defined(MK_COH_TEST) || defined(MK_GEMM_CHECK4) || defined(MK_GATE_CHECK) || defined(MK_GATE_SCAN)
    { xcd_barrier(bar); if (blockIdx.x == 0 && threadIdx.x == 0) { const unsigned nb = __hip_atomic_load((unsigned*)(F.ctl + 900), __ATOMIC_RELAXED, __HIP_MEMORY_SCOPE_AGENT); const unsigned nc = __hip_atomic_load((unsigned*)(F.ctl + 901), __ATOMIC_RELAXED, __HIP_MEMORY_SCOPE_AGENT); if (nb) F.out[0] = 1.0e4f; if (nc) { const unsigned msk = __hip_atomic_load((unsigned*)(F.ctl + 902), __ATOMIC_RELAXED, __HIP_MEMORY_SCOPE_AGENT); F.out[1] = 1.0e6f + 1000.f * (float)nc; F.out[2] = 1.0e10f * (float)msk; } } }
#endif
#ifdef MK_ITEM_PROF
    if (blockIdx.x == 0 && threadIdx.x == 0) F.out[0] = 0.001f * (float)((const unsigned long long*)(ws + 32768))[MK_ITEM_PROF];
#endif
#ifdef MK_TIME_PHASE
    if (blockIdx.x == 0 && threadIdx.x == 0) { const unsigned long long* ts = (const unsigned long long*)(ws + 16384); const unsigned long long te = __builtin_amdgcn_s_memrealtime();
        const int kk_ = MK_TIME_PHASE; unsigned long long t0_ = ts[kk_ < 20 ? kk_ : 7], t1 = kk_ == 14 ? te : ts[(kk_ < 20 ? kk_ : 7) + 1];
        if (kk_ == 20) t1 = ts[21]; if (kk_ == 21) { t0_ = ts[21]; t1 = ts[22]; } if (kk_ == 22) t0_ = ts[22]; if (kk_ >= 23 && kk_ <= 27) { t0_ = ts[21]; t1 = ts[kk_]; }
#ifdef MK_TIME_CUM
        t0_ = ts[0];
#endif
        F.out[0] = MK_TIME_SCALE * (float)(t1 - t0_); }
#endif
#ifdef MK_DUMP
    xcd_barrier(bar); dump_phase(ws, F.out);
#endif
#undef IN
#undef SEAM
#undef GEMM_RUN
}


extern "C" void kernel_launch(void* const* d_in, const int* in_sizes, int n_in, void* d_out, int out_size, void* d_ws, size_t ws_size, hipStream_t stream) {
    static int grid = 0;
    if (grid == 0) {
        if (n_in != 28 || in_sizes[0] != MR * DM || out_size != MR * DM || ws_size < WS_END) { fprintf(stderr, "kernel_launch: unexpected shapes / workspace (n_in %d, in0 %d, out %d, ws %zu, need %zu); nothing launched\n", n_in, n_in > 0 ? in_sizes[0] : -1, out_size, ws_size, (size_t)WS_END); grid = -1; return; }
        int dev = 0, cus = 0, per_cu = 0;
        if (hipGetDevice(&dev) != hipSuccess || hipDeviceGetAttribute(&cus, hipDeviceAttributeMultiprocessorCount, dev) != hipSuccess) { grid = -1; return; }
        if (hipFuncSetAttribute((const void*)hybrid_fwd, hipFuncAttributeMaxDynamicSharedMemorySize, LDS_BYTES) != hipSuccess) { fprintf(stderr, "kernel_launch: hipFuncSetAttribute failed\n"); grid = -1; return; }
        if (hipOccupancyMaxActiveBlocksPerMultiprocessor(&per_cu, (const void*)hybrid_fwd, NWAVES * 64, LDS_BYTES) != hipSuccess || per_cu < 1) { fprintf(stderr, "kernel_launch: occupancy query reports %d workgroups per CU\n", per_cu); per_cu = 1; }
        (void)hipGetLastError();
        grid = cus;
        if (grid < 64) { fprintf(stderr, "kernel_launch: %d CUs: too few\n", grid); grid = -1; return; }
    }
    if (grid < 0) return;
    if (hipMemsetAsync((char*)d_ws + WS_CTL, 0, CTL_ZERO_BYTES, stream) != hipSuccess) return;
    Args a{};
    for (int i = 0; i < 28; ++i) a.in[i] = (const float*)d_in[i];
    a.out = (float*)d_out; a.ws = (unsigned char*)d_ws;
#ifndef MK_LAST_PHASE
#define MK_LAST_PHASE (N_PHASES - 1)
#endif
    for (int li = 0; li < N_LAUNCHES && li <= MK_LAST_PHASE; ++li) {
        if (N_LAUNCHES == 1) { a.ph_lo = 0; a.ph_hi = MK_LAST_PHASE + 1; } else { a.ph_lo = li; a.ph_hi = li + 1; }
        a.li = li;
        hipLaunchKernelGGL(hybrid_fwd, dim3(grid), dim3(NWAVES * 64), LDS_BYTES, stream, a);
        const hipError_t le = hipPeekAtLastError();
        if (le != hipSuccess) { fprintf(stderr, "kernel_launch: launch %d failed: %s\n", li, hipGetErrorName(le)); break; }
    }
}
```

```cpp
#include <hip/hip_runtime.h>
#include <cstdio>
#include <cstdint>

namespace pg8 {
#define PG8_LAS __attribute__((address_space(3)))
typedef unsigned short bf16_t;
typedef short bf16x8 __attribute__((ext_vector_type(8)));
typedef float f32x4 __attribute__((ext_vector_type(4)));
typedef unsigned u32x4 __attribute__((ext_vector_type(4)));
constexpr int BM = 256, BK = 64, HALF = 128, HTB = HALF * BK * 2  , STAGE_BYTES = 8 * HTB, NXCD = 8, WGM = 8;

__host__ __device__ __forceinline__ int lds_byte(int r, int c) { const int st = (r >> 4) * 2 + (c >> 5), rr = r & 15, cc = c & 31, ob = rr * 64 + cc * 2; return st * 1024 + (ob ^ (((ob >> 9) & 1) << 5)); }
__host__ __device__ __forceinline__ void stage_rc(int b, int& R, int& C) { const int st = b / 1024, sb = b % 1024, swz = sb ^ (((sb >> 9) & 1) << 5); R = (st >> 1) * 16 + swz / 64; C = (st & 1) * 32 + (swz % 64) / 2; }
__host__ __device__ __forceinline__ int perm32(int rho) { const int n = rho >> 4, i = rho & 15; return 8 * (i >> 2) + 4 * n + (i & 3); }

struct Unit { int pm, pn; };
struct Gemm { const bf16_t* A; const bf16_t* Bt; int M, N, K, lda, ldb; const bf16_t* A2 = nullptr; int nsplit = 1 << 30; };

struct StaticOrder {
    int nM, nN, nwg, G, c;
    __host__ __device__ void init(int M, int N, int G_, int c_) { nM = M / BM; nN = N / BM; nwg = nM * nN; G = G_; c = c_; }
    __host__ __device__ bool next(int i, Unit& u) const {
        const long L = (long)i * G + c; if (L >= nwg) return false;
        int wgid = (int)L; { const int q = nwg / NXCD, r = nwg % NXCD, xcd = wgid % NXCD, off = wgid / NXCD; wgid = (xcd < r ? xcd * (q + 1) : r * (q + 1) + (xcd - r) * q) + off; }
        const int nig = WGM * nN, gid = wgid / nig, fm = gid * WGM, gsz = (nM - fm) < WGM ? (nM - fm) : WGM;
        u.pm = fm + ((wgid % nig) % gsz); u.pn = (wgid % nig) / gsz; return true;
    }
    __device__ __forceinline__ void a_ready(const Unit&) const {}
    __device__ __forceinline__ void done(const Unit&) const {}
};

typedef float f32x2_cv __attribute__((ext_vector_type(2))); typedef __bf16 bf16x2_cv __attribute__((ext_vector_type(2)));
__device__ __forceinline__ unsigned cvt_pk_bf16(float lo, float hi) { const f32x2_cv v = {lo, hi}; const bf16x2_cv b = __builtin_convertvector(v, bf16x2_cv); return __builtin_bit_cast(unsigned, b); }
typedef float f32x2 __attribute__((ext_vector_type(2)));
#define EPI_IDS int t_ = threadIdx.x; asm volatile("" : "+v"(t_)); const int wr = t_ >> 8, wc = (t_ >> 6) & 3, fr = t_ & 15, fq = (t_ >> 4) & 3; (void)wr_; (void)wc_; (void)fr_; (void)fq_
__device__ __forceinline__ u32x4 pack8(const f32x4 a, const f32x4 b) { u32x4 w; w.x = cvt_pk_bf16(a[0], a[1]); w.y = cvt_pk_bf16(a[2], a[3]); w.z = cvt_pk_bf16(b[0], b[1]); w.w = cvt_pk_bf16(b[2], b[3]); return w; }
__device__ __forceinline__ float bf_lo(unsigned w) { return __builtin_bit_cast(float, w << 16); }
__device__ __forceinline__ float bf_hi(unsigned w) { return __builtin_bit_cast(float, w & 0xffff0000u); }
__device__ __forceinline__ float sigmoidf_(float x) { return __builtin_amdgcn_rcpf(1.0f + __expf(-x)); }
__device__ __forceinline__ float siluf_(float x) { return x * sigmoidf_(x); }

struct EpiSwiGLU {
    static constexpr bool PERM = true, AFTER_DRAIN = false, PRE = true;
    bf16_t* H;
    const float* RS;
    __device__ __forceinline__ void pre(const Unit& u, int wr, int fr, float (&rsv)[8]) const {
#pragma unroll
        for (int i = 0; i < 8; ++i) rsv[i] = RS ? RS[u.pm * BM + wr * 64 + fr + (i >> 2) * HALF + (i & 3) * 16] : 1.f;
    }
    __device__ __forceinline__ void operator()(const f32x4 (&acc)[2][2][4][2], const Unit& u, int wr_, int wc_, int fr_, int fq_, const float (&rsv)[8]) const {
        EPI_IDS;
        const int row0 = u.pm * BM + wr * 64 + fr, col = u.pn * HALF + wc * 32 + 8 * fq;
#pragma unroll
        for (int ai = 0; ai < 2; ++ai)
#pragma unroll
            for (int m = 0; m < 4; ++m) { const float rs = rsv[4 * ai + m];
                const f32x4 g0 = acc[ai][0][m][0] * rs, g1 = acc[ai][0][m][1] * rs, u0 = acc[ai][1][m][0] * rs, u1 = acc[ai][1][m][1] * rs;
                f32x4 h0, h1;
#pragma unroll
                for (int j = 0; j < 4; ++j) { h0[j] = siluf_(g0[j]) * u0[j]; h1[j] = siluf_(g1[j]) * u1[j]; }
                *(u32x4*)(H + (size_t)(row0 + ai * HALF + m * 16) * 2816 + col) = pack8(h0, h1);
            }
    }
};
struct EpiFSS {
    static constexpr bool PERM = true, AFTER_DRAIN = false, PRE = false;
    bf16_t* Fo; float* SS;
    __device__ __forceinline__ void operator()(const f32x4 (&acc)[2][2][4][2], const Unit& u, int wr_, int wc_, int fr_, int fq_) const {
        EPI_IDS;
        const int row0 = u.pm * BM + wr * 64 + fr, col = u.pn * BM + wc * 32 + 8 * fq;
#pragma unroll
        for (int ai = 0; ai < 2; ++ai)
#pragma unroll
            for (int m = 0; m < 4; ++m) {
                const int row = row0 + ai * HALF + m * 16; float ss = 0.f;
#pragma unroll
                for (int bj = 0; bj < 2; ++bj) { const f32x4 v0 = acc[ai][bj][m][0], v1 = acc[ai][bj][m][1];
                    ss += (v0[0] * v0[0] + v0[1] * v0[1]) + (v0[2] * v0[2] + v0[3] * v0[3]) + (v1[0] * v1[0] + v1[1] * v1[1]) + (v1[2] * v1[2] + v1[3] * v1[3]);
                    *(u32x4*)(Fo + (size_t)row * 1024 + col + bj * HALF) = pack8(v0, v1); }
                ss += __shfl_xor(ss, 16); ss += __shfl_xor(ss, 32);
                if (fq == 0) SS[((size_t)u.pn * 33024 + row) * 4 + wc] = ss;
            }
    }
};
struct EpiWin {
    static constexpr bool PERM = true, AFTER_DRAIN = false, PRE = true;
    const float* RS;
    __device__ __forceinline__ void pre(const Unit& u, int wr, int fr, float (&rsv)[8]) const {
#pragma unroll
        for (int i = 0; i < 8; ++i) rsv[i] = RS ? RS[u.pm * BM + wr * 64 + fr + (i >> 2) * HALF + (i & 3) * 16] : 1.f;
    }
    bf16_t* Q; bf16_t* KV; bf16_t* ZR; const float* rope; int MR; bf16_t* VT;
    __device__ __forceinline__ void operator()(const f32x4 (&acc)[2][2][4][2], const Unit& u, int wr_, int wc_, int fr_, int fq_, const float (&rsv)[8]) const {
        EPI_IDS;
        const int row0 = u.pm * BM + wr * 64 + fr, pn = u.pn;
        bf16_t* base; int ld, colt;
        if (pn < 2) { base = Q; ld = 512; colt = pn * 256; } else if (pn == 2) { base = KV; ld = 256; colt = 0; } else { base = ZR; ld = 1792; colt = (pn - 3) * 256; }
        const bool rope_lane = (pn <= 2) && ((wc & 1) == 0) && (fq < 2);
        f32x4 css[2][4], sns[2][4];
#pragma unroll
        for (int ai = 0; ai < 2; ++ai)
#pragma unroll
            for (int m = 0; m < 4; ++m) { css[ai][m] = (f32x4){1.f, 1.f, 1.f, 1.f}; sns[ai][m] = (f32x4){0.f, 0.f, 0.f, 0.f};
                if (rope_lane) { const int row = row0 + ai * HALF + m * 16; const int pos = row < MR ? (row & 8191) + 16 : (row < MR + 16 ? row - MR : 0);
                    css[ai][m] = *(const f32x4*)(rope + pos * 16 + 4 * fq); sns[ai][m] = *(const f32x4*)(rope + pos * 16 + 8 + 4 * fq); } }
#pragma unroll
        for (int ai = 0; ai < 2; ++ai)
#pragma unroll
            for (int m = 0; m < 4; ++m) {
                const int row = row0 + ai * HALF + m * 16;
                const f32x4 cs = css[ai][m], sn = sns[ai][m];
#pragma unroll
                for (int bj = 0; bj < 2; ++bj) { f32x4 v0 = acc[ai][bj][m][0] * rsv[4 * ai + m], v1 = acc[ai][bj][m][1] * rsv[4 * ai + m];
                    if (rope_lane && (pn < 2 || bj == 0)) { const f32x4 x1 = v0, x2 = v1; v0 = x1 * cs - x2 * sn; v1 = x2 * cs + x1 * sn; }
                    const u32x4 pk = pack8(v0, v1);
                    if (pn == 2 && bj == 1) {
                        const int dv = wc * 32 + 8 * fq, pos = (row & 8191) + 16; bf16_t* vt = VT + (((size_t)((row >> 13) * 2 + (dv >> 6)) * 513 + (pos >> 4)) * 64 + (dv & 63)) * 16 + (pos & 15);
#pragma unroll
                        for (int j = 0; j < 8; ++j) vt[j * 16] = (bf16_t)((j & 1) ? (pk[j >> 1] >> 16) : (pk[j >> 1] & 0xffffu));
                    } else *(u32x4*)(base + (size_t)row * ld + colt + bj * HALF + wc * 32 + 8 * fq) = pk; }
                asm volatile("" ::: "memory");
            }
    }
};
struct EpiLora {
    static constexpr bool PERM = true, AFTER_DRAIN = false, PRE = false;
    bf16_t* LW; bf16_t* Aa; bf16_t* Gg; const float* w0; const float* a0;
    __device__ __forceinline__ void operator()(const f32x4 (&acc)[2][2][4][2], const Unit& u, int wr_, int wc_, int fr_, int fq_) const {
        EPI_IDS;
        const int row0 = u.pm * BM + wr * 64 + fr, pn = u.pn, kind = pn >> 1, colt = (pn & 1) * 256 + wc * 32 + 8 * fq;
#pragma unroll
        for (int bj = 0; bj < 2; ++bj) {
            const int col = colt + bj * HALF;
            f32x4 b0 = (f32x4){0.f, 0.f, 0.f, 0.f}, b1 = b0;
            if (kind == 0) { b0 = *(const f32x4*)(w0 + col); b1 = *(const f32x4*)(w0 + col + 4); }
            else if (kind == 1) { b0 = *(const f32x4*)(a0 + col); b1 = *(const f32x4*)(a0 + col + 4); }
#pragma unroll
            for (int ai = 0; ai < 2; ++ai)
#pragma unroll
                for (int m = 0; m < 4; ++m) {
                    const int row = row0 + ai * HALF + m * 16;
                    f32x4 v0 = acc[ai][bj][m][0] + b0, v1 = acc[ai][bj][m][1] + b1;
                    if (kind == 0) {
#pragma unroll
                        for (int j = 0; j < 4; ++j) { v0[j] = -0.6065306597126334f * sigmoidf_(v0[j]); v1[j] = -0.6065306597126334f * sigmoidf_(v1[j]); }
                        *(u32x4*)(LW + (size_t)row * 512 + col) = pack8(v0, v1);
                    } else if (kind == 1) {
#pragma unroll
                        for (int j = 0; j < 4; ++j) { v0[j] = sigmoidf_(v0[j]); v1[j] = sigmoidf_(v1[j]); }
                        *(u32x4*)(Aa + (size_t)row * 512 + col) = pack8(v0, v1);
                    } else {
                        *(u32x4*)(Gg + (size_t)row * 512 + col) = pack8(v0, v1);
                    }
                    asm volatile("" ::: "memory");
                }
        }
    }
};
struct EpiGates {
    static constexpr bool PERM = true, AFTER_DRAIN = false, PRE = false;
    bf16_t* Go;
    __device__ __forceinline__ void operator()(const f32x4 (&acc)[2][2][4][2], const Unit& u, int wr_, int wc_, int fr_, int fq_) const {
        EPI_IDS;
        const int row0 = u.pm * BM + wr * 64 + fr, col = u.pn * BM + wc * 32 + 8 * fq;
#pragma unroll
        for (int ai = 0; ai < 2; ++ai)
#pragma unroll
            for (int m = 0; m < 4; ++m)
#pragma unroll
                for (int bj = 0; bj < 2; ++bj) { f32x4 v0 = acc[ai][bj][m][0], v1 = acc[ai][bj][m][1];
#pragma unroll
                    for (int j = 0; j < 4; ++j) { v0[j] = sigmoidf_(v0[j]); v1[j] = sigmoidf_(v1[j]); }
                    *(u32x4*)(Go + (size_t)(row0 + ai * HALF + m * 16) * 2048 + col + bj * HALF) = pack8(v0, v1); }
    }
};
template <bool SECOND> struct EpiBranch {
    static constexpr bool PERM = true, AFTER_DRAIN = false, PRE = false;
    bf16_t* Mg; const bf16_t* Gt;
    __device__ __forceinline__ void operator()(const f32x4 (&acc)[2][2][4][2], const Unit& u, int wr_, int wc_, int fr_, int fq_) const {
        EPI_IDS;
        const int row0 = u.pm * BM + wr * 64 + fr, col = u.pn * BM + wc * 32 + 8 * fq;
#pragma unroll
        for (int ai = 0; ai < 2; ++ai)
#pragma unroll
            for (int m = 0; m < 4; ++m)
#pragma unroll
                for (int bj = 0; bj < 2; ++bj) {
                    const size_t row = (size_t)(row0 + ai * HALF + m * 16);
                    const u32x4 gw = *(const u32x4*)(Gt + row * 2048 + col + bj * HALF);
                    f32x4 v0 = acc[ai][bj][m][0], v1 = acc[ai][bj][m][1];
                    v0[0] *= bf_lo(gw.x); v0[1] *= bf_hi(gw.x); v0[2] *= bf_lo(gw.y); v0[3] *= bf_hi(gw.y);
                    v1[0] *= bf_lo(gw.z); v1[1] *= bf_hi(gw.z); v1[2] *= bf_lo(gw.w); v1[3] *= bf_hi(gw.w);
                    u32x4* dst = (u32x4*)(Mg + row * 1024 + col + bj * HALF);
                    if (SECOND) { const u32x4 pw = *dst;
                        v0[0] += bf_lo(pw.x); v0[1] += bf_hi(pw.x); v0[2] += bf_lo(pw.y); v0[3] += bf_hi(pw.y);
                        v1[0] += bf_lo(pw.z); v1[1] += bf_hi(pw.z); v1[2] += bf_lo(pw.w); v1[3] += bf_hi(pw.w); }
                    *dst = pack8(v0, v1);
                    asm volatile("" ::: "memory");
                }
    }
};
struct EpiMerge {
    static constexpr bool PERM = true, AFTER_DRAIN = false, PRE = false;
    bf16_t* Mg; const bf16_t* Gt; unsigned* cnt;
    __device__ __forceinline__ void operator()(const f32x4 (&acc)[2][2][4][2], const Unit& u, int wr_, int wc_, int fr_, int fq_) const {
        EPI_IDS;
        const int row0 = u.pm * BM + wr * 64 + fr, col = u.pn * HALF + wc * 32 + 8 * fq;
#pragma unroll
        for (int ai = 0; ai < 2; ++ai)
#pragma unroll
            for (int m = 0; m < 4; ++m) {
                const size_t row = (size_t)(row0 + ai * HALF + m * 16);
#ifdef MK_GATE_SC
                u32x4 ga, gr;
                { const unsigned long long* pa = (const unsigned long long*)(Gt + row * 2048 + col); const unsigned long long* pr = (const unsigned long long*)(Gt + row * 2048 + 1024 + col);
                  const unsigned long long a0_ = __hip_atomic_load(pa, __ATOMIC_RELAXED, __HIP_MEMORY_SCOPE_SYSTEM), a1_ = __hip_atomic_load(pa + 1, __ATOMIC_RELAXED, __HIP_MEMORY_SCOPE_SYSTEM);
                  const unsigned long long r0_ = __hip_atomic_load(pr, __ATOMIC_RELAXED, __HIP_MEMORY_SCOPE_SYSTEM), r1_ = __hip_atomic_load(pr + 1, __ATOMIC_RELAXED, __HIP_MEMORY_SCOPE_SYSTEM);
                  ga.x = (unsigned)a0_; ga.y = (unsigned)(a0_ >> 32); ga.z = (unsigned)a1_; ga.w = (unsigned)(a1_ >> 32); gr.x = (unsigned)r0_; gr.y = (unsigned)(r0_ >> 32); gr.z = (unsigned)r1_; gr.w = (unsigned)(r1_ >> 32); }
#else
                const u32x4 ga = *(const u32x4*)(Gt + row * 2048 + col), gr = *(const u32x4*)(Gt + row * 2048 + 1024 + col);
#endif
#ifdef MK_GATE_CHECK
                { const float gmx = fmaxf(fmaxf(fmaxf(bf_lo(ga.x), bf_hi(ga.x)), fmaxf(bf_lo(ga.y), bf_hi(ga.y))), fmaxf(fmaxf(bf_lo(gr.z), bf_hi(gr.z)), fmaxf(bf_lo(gr.w), bf_hi(gr.w))));
                  const float gmn = fminf(fminf(fminf(bf_lo(ga.x), bf_hi(ga.x)), fminf(bf_lo(ga.y), bf_hi(ga.y))), fminf(fminf(bf_lo(gr.z), bf_hi(gr.z)), fminf(bf_lo(gr.w), bf_hi(gr.w))));
                  if (gmx > 1.001f || gmn < 0.f) atomicAdd(cnt, 1u); }
#endif
                const f32x4 a0 = acc[ai][0][m][0], a1 = acc[ai][0][m][1], r0 = acc[ai][1][m][0], r1 = acc[ai][1][m][1];
                f32x4 v0, v1;
                v0[0] = a0[0] * bf_lo(ga.x) + r0[0] * bf_lo(gr.x); v0[1] = a0[1] * bf_hi(ga.x) + r0[1] * bf_hi(gr.x); v0[2] = a0[2] * bf_lo(ga.y) + r0[2] * bf_lo(gr.y); v0[3] = a0[3] * bf_hi(ga.y) + r0[3] * bf_hi(gr.y);
                v1[0] = a1[0] * bf_lo(ga.z) + r1[0] * bf_lo(gr.z); v1[1] = a1[1] * bf_hi(ga.z) + r1[1] * bf_hi(gr.z); v1[2] = a1[2] * bf_lo(ga.w) + r1[2] * bf_lo(gr.w); v1[3] = a1[3] * bf_hi(ga.w) + r1[3] * bf_hi(gr.w);
                *(u32x4*)(Mg + row * 1024 + col) = pack8(v0, v1);
                asm volatile("" ::: "memory");
            }
    }
};
struct EpiPlain {
    static constexpr bool PERM = true, AFTER_DRAIN = false, PRE = false;
    bf16_t* O; int ldc; int npl; size_t plane;
    __device__ __forceinline__ void operator()(const f32x4 (&acc)[2][2][4][2], const Unit& u, int wr_, int wc_, int fr_, int fq_) const {
        EPI_IDS;
        const int row0 = u.pm * BM + wr * 64 + fr, col = (u.pn % npl) * BM + wc * 32 + 8 * fq; bf16_t* O = this->O + (size_t)(u.pn / npl) * plane;
#pragma unroll
        for (int ai = 0; ai < 2; ++ai)
#pragma unroll
            for (int m = 0; m < 4; ++m)
#pragma unroll
                for (int bj = 0; bj < 2; ++bj) *(u32x4*)(O + (size_t)(row0 + ai * HALF + m * 16) * ldc + col + bj * HALF) = pack8(acc[ai][bj][m][0], acc[ai][bj][m][1]);
    }
};
struct EpiGateMerge {
    static constexpr bool PERM = true, AFTER_DRAIN = false, PRE = true;
    const float* RS;
    __device__ __forceinline__ void pre(const Unit& u, int wr, int fr, float (&rsv)[8]) const {
#pragma unroll
        for (int i = 0; i < 8; ++i) rsv[i] = RS ? RS[u.pm * BM + wr * 64 + fr + (i >> 2) * HALF + (i & 3) * 16] : 1.f;
    }
    bf16_t* Mg; const bf16_t* Y1; const bf16_t* Y2;
    __device__ __forceinline__ void operator()(const f32x4 (&acc)[2][2][4][2], const Unit& u, int wr_, int wc_, int fr_, int fq_, const float (&rsv)[8]) const {
        EPI_IDS;
        const int row0 = u.pm * BM + wr * 64 + fr, col = u.pn * HALF + wc * 32 + 8 * fq;
        u32x4 y1s[2][4], y2s[2][4];
#pragma unroll
        for (int ai = 0; ai < 2; ++ai)
#pragma unroll
            for (int m = 0; m < 4; ++m) { const size_t o = (size_t)(row0 + ai * HALF + m * 16) * 1024 + col; y1s[ai][m] = *(const u32x4*)(Y1 + o); y2s[ai][m] = *(const u32x4*)(Y2 + o); }
#pragma unroll
        for (int ai = 0; ai < 2; ++ai)
#pragma unroll
            for (int m = 0; m < 4; ++m) {
                const size_t o = (size_t)(row0 + ai * HALF + m * 16) * 1024 + col;
                const u32x4 y1 = y1s[ai][m], y2 = y2s[ai][m];
                const float rs = rsv[4 * ai + m];
                const f32x4 a0 = acc[ai][0][m][0] * rs, a1 = acc[ai][0][m][1] * rs, r0 = acc[ai][1][m][0] * rs, r1 = acc[ai][1][m][1] * rs;
                f32x4 v0, v1;
                v0[0] = sigmoidf_(a0[0]) * bf_lo(y1.x) + sigmoidf_(r0[0]) * bf_lo(y2.x); v0[1] = sigmoidf_(a0[1]) * bf_hi(y1.x) + sigmoidf_(r0[1]) * bf_hi(y2.x);
                v0[2] = sigmoidf_(a0[2]) * bf_lo(y1.y) + sigmoidf_(r0[2]) * bf_lo(y2.y); v0[3] = sigmoidf_(a0[3]) * bf_hi(y1.y) + sigmoidf_(r0[3]) * bf_hi(y2.y);
                v1[0] = sigmoidf_(a1[0]) * bf_lo(y1.z) + sigmoidf_(r1[0]) * bf_lo(y2.z); v1[1] = sigmoidf_(a1[1]) * bf_hi(y1.z) + sigmoidf_(r1[1]) * bf_hi(y2.z);
                v1[2] = sigmoidf_(a1[2]) * bf_lo(y1.w) + sigmoidf_(r1[2]) * bf_lo(y2.w); v1[3] = sigmoidf_(a1[3]) * bf_hi(y1.w) + sigmoidf_(r1[3]) * bf_hi(y2.w);
                *(u32x4*)(Mg + o) = pack8(v0, v1);
                asm volatile("" ::: "memory");
            }
    }
};
template <class Epi, class Sched, bool ALIGN_EPI = false, bool SP2 = false>
__device__ __forceinline__ void gemm_phase(PG8_LAS unsigned char* lds, const Gemm g, const Sched& S, const Epi& E) {
    int tid_ = threadIdx.x; asm volatile("" : "+v"(tid_));
    const int tid = tid_, wid = __builtin_amdgcn_readfirstlane(tid >> 6), lane = tid & 63, wr = wid >> 2, wc = wid & 3, fr = lane & 15, fq = lane >> 4;
    const int K = g.K, nt = K / BK;
    unsigned voffA[2], voffB[2];
#pragma unroll
    for (int i = 0; i < 2; ++i) { int R, C; stage_rc(tid * 16 + i * 8192, R, C); const int Rb = Epi::PERM ? ((R & ~31) + perm32(R & 31)) : R;
        voffA[i] = (unsigned)(R * g.lda + C) * 2u; voffB[i] = (unsigned)(Rb * g.ldb + C) * 2u; }
    const size_t kstep = (size_t)(BK * 2);
    const size_t hstepA = (size_t)HALF * g.lda * 2, hstepB = (size_t)HALF * g.ldb * 2;
    const size_t tstepA = 2 * hstepA, tstepB = 2 * hstepB;
    const unsigned ldsw = (unsigned)wid * 1024u;
    const int aoff = lds_byte(wr * 64 + fr, fq * 8), boff = lds_byte(wc * 32 + fr, fq * 8);
#define PG8_SA(b, h) (((b) * 2 + (h)) * HTB)
#define PG8_SB(b, h) ((4 + (b) * 2 + (h)) * HTB)
#define PG8_STAGE(bufoff, gbase, voff) do { _Pragma("unroll") for (int _i = 0; _i < 2; ++_i) \
        __builtin_amdgcn_global_load_lds((const unsigned*)((const char*)(gbase) + (voff)[_i]), (PG8_LAS unsigned*)(lds + (bufoff) + ldsw + _i * 8192), 16, 0, 0); } while (0)
#define PG8_LDA(dst, b, h) do { _Pragma("unroll") for (int m = 0; m < 4; ++m) _Pragma("unroll") for (int k = 0; k < 2; ++k) dst[m][k] = *(const PG8_LAS bf16x8*)(lds + PG8_SA(b, h) + aoff + m * 2048 + k * 1024); } while (0)
#define PG8_LDB(dst, b, h) do { _Pragma("unroll") for (int n = 0; n < 2; ++n) _Pragma("unroll") for (int k = 0; k < 2; ++k) dst[n][k] = *(const PG8_LAS bf16x8*)(lds + PG8_SB(b, h) + boff + n * 2048 + k * 1024); } while (0)
#define PG8_MMA(ai, bj, At, Bt) do { __builtin_amdgcn_s_setprio(1); _Pragma("unroll") for (int m = 0; m < 4; ++m) _Pragma("unroll") for (int n = 0; n < 2; ++n) _Pragma("unroll") for (int k = 0; k < 2; ++k) \
        acc[ai][bj][m][n] = __builtin_amdgcn_mfma_f32_16x16x32_bf16(Bt[n][k], At[m][k], acc[ai][bj][m][n], 0, 0, 0); __builtin_amdgcn_s_setprio(0); } while (0)
#define PG8_WAIT_V(n) asm volatile("s_waitcnt vmcnt(" #n ")" ::: "memory")
#define PG8_WAIT_L(n) asm volatile("s_waitcnt lgkmcnt(" #n ")" ::: "memory")
#define PG8_BAR __builtin_amdgcn_s_barrier()
#define PG8_SCHED __builtin_amdgcn_sched_barrier(0)
    Unit cur, nxt; int ui = 0;
    if (!S.next(0, cur)) return;
    f32x4 acc[2][2][4][2];
#pragma unroll
    for (int a = 0; a < 2; ++a)
#pragma unroll
        for (int b = 0; b < 2; ++b)
#pragma unroll
            for (int m = 0; m < 4; ++m)
#pragma unroll
                for (int n = 0; n < 2; ++n) acc[a][b][m][n] = (f32x4){0.f, 0.f, 0.f, 0.f};
    bf16x8 At[4][2], B0[2][2], B1[2][2];
    const char* cA = (const char*)(cur.pn >= g.nsplit ? g.A2 : g.A) + (size_t)cur.pm * tstepA; const char* cB = (const char*)g.Bt + (size_t)cur.pn * tstepB;
    S.a_ready(cur);
    float rsv[8]; if constexpr (Epi::PRE) E.pre(cur, wr, fr, rsv);
    if constexpr (SP2) {
        PG8_STAGE(PG8_SB(0, 0), cB, voffB); PG8_STAGE(PG8_SB(0, 1), cB + hstepB, voffB); PG8_STAGE(PG8_SA(0, 0), cA, voffA); PG8_STAGE(PG8_SA(0, 1), cA + hstepA, voffA);
        if (wr == 1) PG8_BAR;
        PG8_WAIT_V(2); PG8_BAR;
        PG8_STAGE(PG8_SB(1, 0), cB + kstep, voffB); PG8_STAGE(PG8_SA(1, 0), cA + kstep, voffA); PG8_STAGE(PG8_SB(1, 1), cB + hstepB + kstep, voffB);
        PG8_WAIT_V(6); PG8_BAR;
    } else {
        PG8_STAGE(PG8_SB(0, 0), cB, voffB); PG8_STAGE(PG8_SA(0, 0), cA, voffA); PG8_STAGE(PG8_SB(0, 1), cB + hstepB, voffB); PG8_STAGE(PG8_SA(0, 1), cA + hstepA, voffA);
        if (wr == 1) PG8_BAR;
        PG8_WAIT_V(4); PG8_BAR;
        PG8_STAGE(PG8_SB(1, 0), cB + kstep, voffB); PG8_STAGE(PG8_SA(1, 0), cA + kstep, voffA); PG8_STAGE(PG8_SB(1, 1), cB + hstepB + kstep, voffB);
        PG8_WAIT_V(6); PG8_BAR;
    }
    for (;;) {
        const bool has_next = S.next(ui + 1, nxt);
        const char* nA = has_next ? (const char*)(nxt.pn >= g.nsplit ? g.A2 : g.A) + (size_t)nxt.pm * tstepA : cA; const char* nB = has_next ? (const char*)g.Bt + (size_t)nxt.pn * tstepB : cB;
        for (int t = 0; t < nt; t += 2) {
            const bool last = (t == nt - 2);
            const char* a1 = cA + (size_t)(t + 1) * kstep;
            const char* a2 = last ? nA : cA + (size_t)(t + 2) * kstep; const char* b2 = last ? nB : cB + (size_t)(t + 2) * kstep;
            const char* a3 = a2 + kstep; const char* b3 = b2 + kstep;
            if (last && has_next) S.a_ready(nxt);
            if constexpr (SP2) {
            PG8_LDB(B0, 0, 0); PG8_LDB(B1, 0, 1); PG8_SCHED; PG8_LDA(At, 0, 0); PG8_STAGE(PG8_SA(1, 1), a1 + hstepA, voffA);
            PG8_WAIT_V(8); PG8_WAIT_L(0); PG8_BAR; PG8_MMA(0, 0, At, B0); PG8_MMA(0, 1, At, B1); PG8_BAR; PG8_SCHED;
            PG8_LDA(At, 0, 1); PG8_STAGE(PG8_SB(0, 0), b2, voffB); PG8_STAGE(PG8_SB(0, 1), b2 + hstepB, voffB); PG8_STAGE(PG8_SA(0, 0), a2, voffA);
            PG8_WAIT_V(8); PG8_WAIT_L(0); PG8_BAR; PG8_MMA(1, 0, At, B0); PG8_MMA(1, 1, At, B1); PG8_BAR; PG8_SCHED;
            PG8_LDB(B0, 1, 0); PG8_LDB(B1, 1, 1); PG8_SCHED; PG8_LDA(At, 1, 0); PG8_STAGE(PG8_SA(0, 1), a2 + hstepA, voffA);
            PG8_WAIT_V(8); PG8_WAIT_L(0); PG8_BAR; PG8_MMA(0, 0, At, B0); PG8_MMA(0, 1, At, B1); PG8_BAR; PG8_SCHED;
            PG8_LDA(At, 1, 1); PG8_STAGE(PG8_SB(1, 0), b3, voffB); PG8_STAGE(PG8_SB(1, 1), b3 + hstepB, voffB); PG8_STAGE(PG8_SA(1, 0), a3, voffA);
            PG8_WAIT_V(8); PG8_WAIT_L(0); PG8_BAR; PG8_MMA(1, 0, At, B0); PG8_MMA(1, 1, At, B1); PG8_BAR; PG8_SCHED;
            } else {
            PG8_LDB(B0, 0, 0); PG8_SCHED; PG8_LDA(At, 0, 0); PG8_STAGE(PG8_SA(1, 1), a1 + hstepA, voffA);
            PG8_WAIT_L(8); PG8_BAR; PG8_WAIT_L(0); PG8_MMA(0, 0, At, B0); PG8_BAR; PG8_SCHED;
            PG8_LDB(B1, 0, 1); PG8_STAGE(PG8_SB(0, 0), b2, voffB);
            PG8_BAR; PG8_WAIT_L(0); PG8_MMA(0, 1, At, B1); PG8_BAR;
            PG8_LDA(At, 0, 1); PG8_STAGE(PG8_SA(0, 0), a2, voffA);
            PG8_BAR; PG8_WAIT_L(0); PG8_MMA(1, 0, At, B0); PG8_BAR; PG8_SCHED;
            PG8_STAGE(PG8_SB(0, 1), b2 + hstepB, voffB);
            PG8_WAIT_V(6); PG8_BAR; PG8_MMA(1, 1, At, B1); PG8_BAR;
            PG8_LDB(B0, 1, 0); PG8_SCHED; PG8_LDA(At, 1, 0); PG8_STAGE(PG8_SA(0, 1), a2 + hstepA, voffA);
            PG8_WAIT_L(8); PG8_BAR; PG8_WAIT_L(0); PG8_MMA(0, 0, At, B0); PG8_BAR; PG8_SCHED;
            PG8_LDB(B1, 1, 1); PG8_STAGE(PG8_SB(1, 0), b3, voffB);
            PG8_BAR; PG8_WAIT_L(0); PG8_MMA(0, 1, At, B1); PG8_BAR;
            PG8_LDA(At, 1, 1); PG8_STAGE(PG8_SA(1, 0), a3, voffA);
            PG8_BAR; PG8_WAIT_L(0); PG8_MMA(1, 0, At, B0); PG8_BAR; PG8_SCHED;
            PG8_STAGE(PG8_SB(1, 1), b3 + hstepB, voffB);
            PG8_WAIT_V(6); PG8_BAR; PG8_MMA(1, 1, At, B1); PG8_BAR;
            }
        }
        if constexpr (ALIGN_EPI) { if (wr == 0) PG8_BAR; }
        if constexpr (!Epi::AFTER_DRAIN) { if constexpr (Epi::PRE) E(acc, cur, wr, wc, fr, fq, rsv); else E(acc, cur, wr, wc, fr, fq); S.done(cur); }
        if (!has_next) break;
#pragma unroll
        for (int a = 0; a < 2; ++a)
#pragma unroll
            for (int b = 0; b < 2; ++b)
#pragma unroll
                for (int m = 0; m < 4; ++m)
#pragma unroll
                    for (int n = 0; n < 2; ++n) acc[a][b][m][n] = (f32x4){0.f, 0.f, 0.f, 0.f};
        cur = nxt; cA = nA; cB = nB; ++ui;
        if constexpr (Epi::PRE) E.pre(cur, wr, fr, rsv);
        if constexpr (ALIGN_EPI) { if (wr == 1) PG8_BAR; }
    }
    PG8_WAIT_V(0);
    if constexpr (!ALIGN_EPI) { if (wr == 0) PG8_BAR; }
    PG8_BAR;
    if constexpr (Epi::AFTER_DRAIN) { E.fused(acc, cur, wr, wc, fr, fq, lds, wid, lane); S.done(cur); }
#undef PG8_SA
#undef PG8_SB
#undef PG8_STAGE
#undef PG8_LDA
#undef PG8_LDB
#undef PG8_MMA
#undef PG8_WAIT_V
#undef PG8_WAIT_L
#undef PG8_BAR
#undef PG8_SCHED
}
}

constexpr int NWAVES = 8;
constexpr int DM = 1024, NB = 4, SEQL = 8192, NMETA = 16, DFF = 2816;
constexpr int MR = NB * SEQL;
constexpr int MP = MR + 256;
constexpr int NHID2 = 2 * DFF;
constexpr int NIN = 4608, NIN_A = 2560;
#ifndef MK_GN_EPS
#define MK_GN_EPS 64e-5f
#endif
constexpr float NORM_EPS = 1e-6f, GN_EPS = MK_GN_EPS;

constexpr size_t MiB = 1u << 20;
constexpr size_t WS_CTL = 0, CTL_ZERO_BYTES = 64 * 1024;
constexpr size_t WS_WGU1 = 128 * 1024;
constexpr size_t WS_WD1  = WS_WGU1 + (size_t)NHID2 * DM * 2;
constexpr size_t WS_WIN  = WS_WD1 + (size_t)DM * DFF * 2;
constexpr size_t WS_WBR = WS_WIN + (size_t)NIN * DM * 2;
constexpr size_t WS_WATT = WS_WBR, WS_WRWKV = WS_WBR + (size_t)DM * 512 * 2;
constexpr size_t WS_WMIX = WS_WBR + (size_t)2048 * DM * 2;
constexpr size_t WS_WGU2 = WS_WMIX + (size_t)DM * DM * 2;
constexpr size_t WS_WD2  = WS_WGU2 + (size_t)NHID2 * DM * 2;
constexpr size_t WS_WL   = WS_WD2 + (size_t)DM * DFF * 2;
constexpr size_t WS_ROPE = WS_WL + (size_t)1536 * 256 * 2;
constexpr size_t WS_SS   = WS_ROPE + (size_t)8208 * 16 * 4;
constexpr size_t WS_HMETA = WS_SS + (size_t)MP * 16 * 4;
constexpr size_t WS_SMALL_END = WS_HMETA + 16 * 1024 * 4;
constexpr size_t WS_XN = 52 * MiB;
constexpr size_t WS_HM = WS_XN, WS_RS2 = WS_XN + 1 * MiB, WS_RS3 = WS_XN + 2 * MiB;
constexpr size_t WS_F  = WS_XN + (size_t)MP * DM * 2;
constexpr size_t WS_BIG = WS_F + (size_t)MP * DM * 2;
constexpr size_t WS_HID = WS_BIG;
constexpr size_t WS_Q  = WS_BIG;
constexpr size_t WS_KV = WS_Q + (size_t)MP * 512 * 2;
constexpr size_t WS_ZR = WS_KV + (size_t)MP * 256 * 2;
constexpr size_t WS_LW = WS_ZR + (size_t)MP * 1792 * 2;
constexpr size_t WS_AA = WS_LW + (size_t)MP * 512 * 2;
constexpr size_t WS_GG = WS_AA + (size_t)MP * 512 * 2;
constexpr size_t WS_LA = WS_GG + (size_t)MP * 512 * 2;
constexpr size_t WS_MIX_END = WS_LA + (size_t)MP * 256 * 2;
constexpr size_t WS_QY = WS_LA;
constexpr size_t WS_SST = WS_LW;
constexpr size_t WS_DOTS = WS_SS;
static_assert(WS_QY + (size_t)4128 * 16384 <= 512 * MiB && (size_t)4128 * 8192 <= (size_t)MP * 512 * 4, "rwkv images");
constexpr size_t WS_GATES = WS_LW;
constexpr size_t WS_MERGED = WS_ZR;
constexpr size_t WS_VT = 503 * MiB + 512 * 1024;
constexpr int PV = 8208;
constexpr size_t WS_END = 512 * MiB;
static_assert(WS_QY + (size_t)4128 * 16384 <= WS_VT && WS_VT + (size_t)NB * 2 * 64 * PV * 2 <= WS_END, "VT");
static_assert(WS_SMALL_END <= WS_XN && WS_HID + (size_t)MP * DFF * 2 <= WS_END && WS_MIX_END <= WS_END && WS_MERGED + (size_t)MR * DM * 2 <= WS_LW && WS_GATES + (size_t)MR * 2048 * 2 <= WS_END, "d_ws map");
constexpr int CW_BAR = 1024;

constexpr int RING_OFF = 0, RING_BYTES = 131072;
constexpr int LDSCTL_OFF = RING_BYTES, MISC_OFF = LDSCTL_OFF + 320;
constexpr int LDS_BYTES = 147456;

#define GAS __attribute__((address_space(1)))
#define LAS __attribute__((address_space(3)))
typedef unsigned short bf16;
typedef unsigned v4u __attribute__((ext_vector_type(4)));
typedef unsigned v2u __attribute__((ext_vector_type(2)));
typedef float f32x4 __attribute__((ext_vector_type(4)));
typedef float f32x2v __attribute__((ext_vector_type(2)));
typedef float f32x16 __attribute__((ext_vector_type(16)));
typedef short bf16x8 __attribute__((ext_vector_type(8)));
typedef GAS unsigned gu32;
#define RLX_AGENT __ATOMIC_RELAXED, __HIP_MEMORY_SCOPE_AGENT
#define LDS_WAIT() asm volatile("s_waitcnt lgkmcnt(0)" ::: "memory")
#define VM_WAIT() asm volatile("s_waitcnt vmcnt(0)" ::: "memory")
__device__ __forceinline__ unsigned pk2(float lo, float hi) { return pg8::cvt_pk_bf16(lo, hi); }
__device__ __forceinline__ unsigned f2bf(float f) { return pg8::cvt_pk_bf16(f, 0.f) & 0xffffu; }
__device__ __forceinline__ float bflo(unsigned w) { return __builtin_bit_cast(float, w << 16); }
__device__ __forceinline__ float bfhi(unsigned w) { return __builtin_bit_cast(float, w & 0xffff0000u); }
__device__ __forceinline__ float bf1(bf16 h) { return __builtin_bit_cast(float, (unsigned)h << 16); }
__device__ __forceinline__ float sigm(float x) { return 1.0f / (1.0f + __expf(-x)); }

#define XB_TMO      128
#define XB_XCNT(j)  (256  + 64 * (j))
#define XB_XSUB(j)  (1280 + 64 * (j))
#define XB_XGEN(j)  (2304 + 64 * (j))
#define XB_TOP      3328
#define XB_TOPGEN   3392
#define XCD_BAR_WORDS 3456
#define XB_SPIN_CAP (1u << 24)

__device__ __forceinline__ unsigned xb_ld(unsigned* p)              { return __hip_atomic_load(p, __ATOMIC_RELAXED, __HIP_MEMORY_SCOPE_AGENT); }
__device__ __forceinline__ unsigned xb_add(unsigned* p, unsigned v) { return __hip_atomic_fetch_add(p, v, __ATOMIC_RELAXED, __HIP_MEMORY_SCOPE_AGENT); }
__device__ __forceinline__ unsigned xb_xcc_id() { return (unsigned)__builtin_amdgcn_s_getreg((3 << 11) | 20) & 0xFu; }
#define XB_SPIN(cond, bar) do { unsigned _sp = 0; while (cond) { __builtin_amdgcn_s_sleep(1); \
    if ((++_sp & 255u) == 0u) { if (xb_ld(&(bar)[XB_TMO])) break; if (_sp > XB_SPIN_CAP) { atomicAdd(&(bar)[XB_TMO], 1u); break; } } } } while (0)

struct XcdBarrier {
    unsigned* bar; unsigned x;
    volatile LAS unsigned* st;
};

__device__ __forceinline__ XcdBarrier xcd_barrier_post(unsigned* bar, volatile LAS unsigned* st) {
    XcdBarrier b; b.bar = bar; b.x = xb_xcc_id(); b.st = st;
    if (threadIdx.x == 0) (void)xb_add(&bar[XB_XCNT(b.x)], 1u);
    return b;
}
__device__ __forceinline__ void xcd_barrier_complete(unsigned* bar, unsigned x, unsigned& nloc, unsigned& nx) {
    const unsigned G = gridDim.x * gridDim.y * gridDim.z;
    unsigned sum, cnt, mine, sp = 0u;
    for (;;) {
        sum = 0u; cnt = 0u; mine = 0u;
#pragma unroll
        for (unsigned j = 0; j < 16; ++j) { const unsigned c = xb_ld(&bar[XB_XCNT(j)]); sum += c; cnt += (c > 0u) ? 1u : 0u; mine = (j == x) ? c : mine; }
        if (sum == G) break;
        __builtin_amdgcn_s_sleep(1);
        if ((++sp & 255u) == 0u) { if (xb_ld(&bar[XB_TMO])) break; if (sp > XB_SPIN_CAP) { atomicAdd(&bar[XB_TMO], 1u); break; } }
    }
    nloc = mine > 0u ? mine : 1u; nx = cnt > 0u ? cnt : 1u;
}

__device__ __forceinline__ void xcd_barrier(const XcdBarrier& b) {
    asm volatile("s_waitcnt vmcnt(0)" ::: "memory");
    __syncthreads();
    if (threadIdx.x == 0) {
        unsigned* bar = b.bar;
        __builtin_amdgcn_s_waitcnt(0);
        unsigned nloc = b.st[0], nx = b.st[1];
        if (nloc == 0u) { xcd_barrier_complete(bar, b.x, nloc, nx); b.st[0] = nloc; b.st[1] = nx; }
        const unsigned old = xb_add(&bar[XB_XSUB(b.x)], 1u);
        const unsigned gen = old / nloc;
        if (old + 1u == (gen + 1u) * nloc) {
            __builtin_amdgcn_fence(__ATOMIC_RELEASE, "");
            asm volatile("s_waitcnt vmcnt(0)" ::: "memory");
            const unsigned og = xb_add(&bar[XB_TOP], 1u);
            const unsigned tg = og / nx;
            if (og + 1u == (tg + 1u) * nx) xb_add(&bar[XB_TOPGEN], 1u);
            else XB_SPIN(xb_ld(&bar[XB_TOPGEN]) == tg, bar);
            __builtin_amdgcn_fence(__ATOMIC_ACQUIRE, "");
            xb_add(&bar[XB_XGEN(b.x)], 1u);
            asm volatile("s_waitcnt vmcnt(0)" ::: "memory");
        } else {
            XB_SPIN(xb_ld(&bar[XB_XGEN(b.x)]) == gen, bar);
            __builtin_amdgcn_fence(__ATOMIC_ACQUIRE, "");
            asm volatile("s_waitcnt vmcnt(0)" ::: "memory");
        }
    }
    __syncthreads();
}


struct Frame {
    LAS unsigned char* lds;
    volatile LAS unsigned* MISC;
    gu32* ctl;
    int tid, lane, wave;
    int vcu, G;
    float* out; unsigned char* ws;
};
struct Args { const float* in[28]; float* out; unsigned char* ws; int ph_lo, ph_hi, li, pad; };
__device__ __forceinline__ const float* inp(int k) {
    typedef const float* cfp;
    const __attribute__((address_space(4))) char* kp = (const __attribute__((address_space(4))) char*)__builtin_amdgcn_kernarg_segment_ptr();
    return *(volatile const __attribute__((address_space(4))) cfp*)(kp + 8 * k);
}
__device__ __forceinline__ float wave_sum(float v) {
#pragma unroll
    for (int o = 1; o < 64; o <<= 1) v += __shfl_xor(v, o);
    return v;
}

__device__ __forceinline__ float dpp_f(float v, const int ctrl_sel) {
    const int x = __builtin_bit_cast(int, v); int r;
    if (ctrl_sel == 0) r = __builtin_amdgcn_update_dpp(0, x, 0xB1, 0xF, 0xF, true);
    else if (ctrl_sel == 1) r = __builtin_amdgcn_update_dpp(0, x, 0x4E, 0xF, 0xF, true);
    else r = __builtin_amdgcn_update_dpp(0, x, 0x141, 0xF, 0xF, true);
    return __builtin_bit_cast(float, r);
}
__device__ __forceinline__ float wave_sum_dpp(float v) {
    v += dpp_f(v, 0); v += dpp_f(v, 1); v += dpp_f(v, 2);
    { const int x = __builtin_bit_cast(int, v); v += __builtin_bit_cast(float, __builtin_amdgcn_update_dpp(0, x, 0x140, 0xF, 0xF, true)); }
    const int xi = __builtin_bit_cast(int, v);
    return (__builtin_bit_cast(float, __builtin_amdgcn_readlane(xi, 0)) + __builtin_bit_cast(float, __builtin_amdgcn_readlane(xi, 16))) + (__builtin_bit_cast(float, __builtin_amdgcn_readlane(xi, 32)) + __builtin_bit_cast(float, __builtin_amdgcn_readlane(xi, 48)));
}
struct MapId { __device__ __forceinline__ int operator()(int n) const { return n; } };
struct MapGateUp { __device__ __forceinline__ int operator()(int n) const { return n < DFF ? 256 * (n >> 7) + (n & 127) : 256 * ((n - DFF) >> 7) + 128 + ((n - DFF) & 127); } };
struct MapBrA { __device__ __forceinline__ int operator()(int n) const { return 256 * (n >> 7) + (n & 127); } };
struct MapBrR { __device__ __forceinline__ int operator()(int n) const { return 256 * (n >> 7) + 128 + (n & 127); } };
struct MapWin { __device__ __forceinline__ int operator()(int n) const { if (n >= 2560) { const int j = n - 2560; return j < 1024 ? 2560 + 256 * (j >> 7) + (j & 127) : 2560 + 256 * ((j - 1024) >> 7) + 128 + ((j - 1024) & 127); } if (n >= 640) return n; const int s = n & 63; if (s >= 16) return n; const int d = (s >= 4 && s < 8) ? s + 4 : ((s >= 8 && s < 12) ? s - 4 : s); return n - s + d; } };
template <class Map>
__device__ __forceinline__ void p0_transpose_item(const float* W, int K, int N, bf16* WT, LAS float* scr, int item, int lane, Map map, const float* kgain = nullptr) {
    const int ldk = K, kofs = 0;
    const int nblk = N / 32, kb = item / nblk, nb = item % nblk, k0 = 64 * kb, n0 = 32 * nb;
#pragma unroll 8
    for (int i = 0; i < 32; ++i) { const int kk = 2 * i + (lane >> 5); scr[kk * 33 + (lane & 31)] = W[(size_t)(k0 + kk) * N + n0 + (lane & 31)]; }
    LDS_WAIT(); asm volatile("" ::: "memory");
    const int c = lane & 7;
    f32x4 ga = (f32x4){1.f, 1.f, 1.f, 1.f}, gb = ga; if (kgain) { ga = *(const f32x4*)(kgain + k0 + 8 * c); gb = *(const f32x4*)(kgain + k0 + 8 * c + 4); }
#pragma unroll
    for (int j = 0; j < 4; ++j) { const int n = (lane >> 3) + 8 * j; const LAS float* s = scr + (8 * c) * 33 + n;
        v4u o; o.x = pk2(s[0 * 33] * ga.x, s[1 * 33] * ga.y); o.y = pk2(s[2 * 33] * ga.z, s[3 * 33] * ga.w); o.z = pk2(s[4 * 33] * gb.x, s[5 * 33] * gb.y); o.w = pk2(s[6 * 33] * gb.z, s[7 * 33] * gb.w);
        *(GAS v4u*)(WT + (size_t)map(n0 + n) * ldk + kofs + k0 + 8 * c) = o; }
    LDS_WAIT(); asm volatile("" ::: "memory");
}
__device__ __forceinline__ void rms_row_to_bf16(int lane, const float* xrow, const float* gain, bf16* orow) {
    const f32x4* xr = (const f32x4*)xrow + lane; const f32x4* gr = (const f32x4*)gain + lane;
    f32x4 v[4]; float s = 0.f;
#pragma unroll
    for (int j = 0; j < 4; ++j) { v[j] = xr[64 * j]; s += (v[j].x * v[j].x + v[j].y * v[j].y) + (v[j].z * v[j].z + v[j].w * v[j].w); }
    const float rstd = 1.f / sqrtf(wave_sum(s) * (1.f / DM) + NORM_EPS);
    v2u* o8 = (v2u*)orow + lane;
#pragma unroll
    for (int j = 0; j < 4; ++j) { const f32x4 g = gr[64 * j]; v2u w; w.x = pk2(v[j].x * rstd * g.x, v[j].y * rstd * g.y); w.y = pk2(v[j].z * rstd * g.z, v[j].w * rstd * g.w); o8[64 * j] = w; }
}
#define XN1_BASE (F.out)
__device__ __forceinline__ void p0_prologue(Frame& F, const Args& A) {
    LAS float* scr = (LAS float*)(F.lds + RING_OFF + F.wave * 16384);
    const int gw = F.vcu * NWAVES + F.wave, NGW = F.G * NWAVES;
    unsigned char* ws = F.ws;
    constexpr int I_GU = (DM / 64) * (NHID2 / 32), I_D = (DFF / 64) * (DM / 32), I_IN = (DM / 64) * (NIN / 32);
    constexpr int NITEMS = I_GU + I_D + I_IN;
    for (int it = gw; it < NITEMS; it += NGW) {
        int r = it;
        if (r < I_GU) { p0_transpose_item(inp(3), DM, NHID2, (bf16*)(ws + WS_WGU1), scr, r, F.lane, MapGateUp()); continue; } r -= I_GU;
        if (r < I_D) { p0_transpose_item(inp(4), DFF, DM, (bf16*)(ws + WS_WD1), scr, r, F.lane, MapId()); continue; } r -= I_D;
        p0_transpose_item(inp(7), DM, NIN, (bf16*)(ws + WS_WIN), scr, r, F.lane, MapWin(), inp(6));
    }
    { const int gt = (F.vcu * NWAVES + F.wave) * 64 + F.lane, NGT = NGW * 64; bf16* WL = (bf16*)(ws + WS_WL);
      for (int e = gt; e < 1536 * 256; e += NGT) { const int n = e >> 8, k = e & 255; float v = 0.f;
          if (n < 512) { if (k < 64) v = inp(11)[k * 512 + n]; }
          else if (n < 1024) { if (k >= 64 && k < 128) v = inp(13)[(k - 64) * 512 + (n - 512)]; }
          else { if (k >= 128) v = inp(14)[(k - 128) * 512 + (n - 1024)]; }
          WL[e] = (bf16)f2bf(v); }
      float* rope = (float*)(ws + WS_ROPE);
      for (int e = gt; e < 8208 * 8; e += NGT) { const int pos = e >> 3, i = e & 7;
          const double fr = i == 0 ? 1.0 : i == 1 ? 0.19392274474868576 : i == 2 ? 0.03760603093086393 : i == 3 ? 0.007292664737217109 : i == 4 ? 0.001414213562373095 : i == 5 ? 0.0002742481756762073 : i == 6 ? 5.318295896944988e-05 : 1.031338537721246e-05;
          const double ang = (double)pos * fr; const double kq = __builtin_rint(ang * 0.15915494309189535); const double red = __builtin_fma(-kq, 6.283185307179586, ang) - kq * 2.4492935982947064e-16;
          const float rf = (float)red; rope[pos * 16 + i] = cosf(rf); rope[pos * 16 + 8 + i] = sinf(rf); }
    }
    f32x4 g1[4];
#pragma unroll
    for (int j = 0; j < 4; ++j) g1[j] = ((const f32x4*)inp(2))[F.lane + 64 * j];
    for (int m0 = gw; m0 < MR + NMETA; m0 += 4 * NGW) {
        f32x4 v[4][4];
#pragma unroll
        for (int u = 0; u < 4; ++u) { const int m = m0 + u * NGW < MR + NMETA ? m0 + u * NGW : m0; const f32x4* xr = (const f32x4*)(m < MR ? inp(0) + (size_t)m * DM : inp(1) + (size_t)(m - MR) * DM) + F.lane;
#pragma unroll
            for (int j = 0; j < 4; ++j) v[u][j] = xr[64 * j]; }
#pragma unroll
        for (int u = 0; u < 4; ++u) { const int m = m0 + u * NGW; if (m < MR + NMETA) { float s = 0.f;
#pragma unroll
            for (int j = 0; j < 4; ++j) s += (v[u][j].x * v[u][j].x + v[u][j].y * v[u][j].y) + (v[u][j].z * v[u][j].z + v[u][j].w * v[u][j].w);
            const float rstd = 1.f / sqrtf(wave_sum_dpp(s) * (1.f / DM) + NORM_EPS); v2u* o8 = (v2u*)((bf16*)XN1_BASE + (size_t)m * DM) + F.lane;
#pragma unroll
            for (int j = 0; j < 4; ++j) { const f32x4 g = g1[j]; v2u w; w.x = pk2(v[u][j].x * rstd * g.x, v[u][j].y * rstd * g.y); w.y = pk2(v[u][j].z * rstd * g.z, v[u][j].w * rstd * g.w); o8[64 * j] = w; } } }
    }
}


__device__ __forceinline__ void convert_late_weights(Frame& F, const Args& A, int gw, int NGW, LAS unsigned char* ldsbase) {
    LAS float* scr = (LAS float*)(ldsbase + F.wave * 16384); unsigned char* ws = F.ws;
    constexpr int I_GU = (DM / 64) * (NHID2 / 32), I_D = (DFF / 64) * (DM / 32), I_BR = (512 / 64) * (DM / 32), I_MIX = (DM / 64) * (DM / 32);
    constexpr int NITEMS = I_GU + I_D + 2 * I_BR + I_MIX;
    for (int it = gw; it < NITEMS; it += NGW) {
        int r = it;
        if (r < I_GU) { p0_transpose_item(inp(25), DM, NHID2, (bf16*)(ws + WS_WGU2), scr, r, F.lane, MapGateUp(), inp(24)); continue; } r -= I_GU;
        if (r < I_D) { p0_transpose_item(inp(26), DFF, DM, (bf16*)(ws + WS_WD2), scr, r, F.lane, MapId()); continue; } r -= I_D;
        if (r < I_BR) { p0_transpose_item(inp(20), 512, DM, (bf16*)(ws + WS_WATT), scr, r, F.lane, MapId()); continue; } r -= I_BR;
        if (r < I_BR) { p0_transpose_item(inp(21), 512, DM, (bf16*)(ws + WS_WRWKV), scr, r, F.lane, MapId()); continue; } r -= I_BR;
        p0_transpose_item(inp(22), DM, DM, (bf16*)(ws + WS_WMIX), scr, r, F.lane, MapId());
    }
}

constexpr size_t WS_H2 = WS_BIG + 180 * MiB;
template <int MODE>
__device__ __forceinline__ void row_pass(Frame& F, const Args& A, const float* gpost, const float* gpre, float scale) {
    const int gw = F.vcu * NWAVES + F.wave, NGW = F.G * NWAVES, lane = F.lane;
    const int nrows = MODE == 0 ? MR + NMETA : MR;
    const bf16* Fb = (const bf16*)(F.ws + WS_F); const float* SS = (const float*)(F.ws + WS_SS);
    constexpr int NR = 4;
    f32x4 gpo[4], gpr[4];
#pragma unroll
    for (int j = 0; j < 4; ++j) { gpo[j] = ((const f32x4*)gpost)[lane + 64 * j]; gpr[j] = gpo[j]; }
    for (int m0 = gw; m0 < nrows; m0 += NR * NGW) {
        float ssf[NR]; v2u fw[NR][4]; f32x4 hv[NR][4]; bool on[NR];
#pragma unroll
        for (int u = 0; u < NR; ++u) { const int m = m0 + u * NGW; on[u] = m < nrows; const int mc = on[u] ? m : m0;
            ssf[u] = SS[((size_t)((lane & 15) >> 2) * MP + mc) * 4 + (lane & 3)];
#pragma unroll
            for (int j = 0; j < 4; ++j) { fw[u][j] = ((const v2u*)(Fb + (size_t)mc * DM))[lane + 64 * j];
                if (MODE == 0) hv[u][j] = ((const f32x4*)(mc < MR ? inp(0) + (size_t)mc * DM : inp(1) + (size_t)(mc - MR) * DM))[lane + 64 * j];
                else { const v2u hw = ((const v2u*)((MODE == 1 ? (const bf16*)F.out : (const bf16*)(F.ws + WS_H2)) + (size_t)mc * DM))[lane + 64 * j]; hv[u][j] = (f32x4){bflo(hw.x), bfhi(hw.x), bflo(hw.y), bfhi(hw.y)}; } } }
#pragma unroll
        for (int u = 0; u < NR; ++u) if (on[u]) { const int m = m0 + u * NGW;
            float sf = ssf[u]; sf += dpp_f(sf, 0); sf += dpp_f(sf, 1); sf += dpp_f(sf, 2); { const int x = __builtin_bit_cast(int, sf); sf += __builtin_bit_cast(float, __builtin_amdgcn_update_dpp(0, x, 0x140, 0xF, 0xF, true)); }
            if (MODE == 0 && m >= MR) { float s2 = 0.f;
#pragma unroll
                for (int j = 0; j < 4; ++j) s2 += bflo(fw[u][j].x) * bflo(fw[u][j].x) + bfhi(fw[u][j].x) * bfhi(fw[u][j].x) + bflo(fw[u][j].y) * bflo(fw[u][j].y) + bfhi(fw[u][j].y) * bfhi(fw[u][j].y);
                sf = wave_sum_dpp(s2); }
            const float rf = scale / sqrtf(sf * (1.f / DM) + NORM_EPS);
            f32x4 h[4]; float s = 0.f;
#pragma unroll
            for (int j = 0; j < 4; ++j) {
                const f32x4 g = gpo[j]; const f32x4 hq = hv[u][j];
                f32x4 r; r.x = hq.x + bflo(fw[u][j].x) * rf * g.x; r.y = hq.y + bfhi(fw[u][j].x) * rf * g.y; r.z = hq.z + bflo(fw[u][j].y) * rf * g.z; r.w = hq.w + bfhi(fw[u][j].y) * rf * g.w;
                h[j] = r; s += (r.x * r.x + r.y * r.y) + (r.z * r.z + r.w * r.w);
                if (MODE == 2) ((f32x4*)(F.out + (size_t)m * DM))[lane + 64 * j] = r;
                else { v2u w; w.x = pk2(r.x, r.y); w.y = pk2(r.z, r.w); bf16* hb = MODE == 1 ? (bf16*)(F.ws + WS_H2) + (size_t)m * DM : (m < MR ? (bf16*)F.out + (size_t)m * DM : (bf16*)(F.ws + WS_HM) + (size_t)(m - MR) * DM); ((v2u*)hb)[lane + 64 * j] = w; }
            }
            if (MODE != 2) { const float rstd = 1.f / sqrtf(wave_sum_dpp(s) * (1.f / DM) + NORM_EPS); if (lane == 0) ((float*)(F.ws + (MODE == 0 ? WS_RS2 : WS_RS3)))[m] = rstd; }
        }
    }
}

__device__ __forceinline__ int prev_row(int m) { return m < MR ? ((m & 8191) == 0 ? MR + 15 : m - 1) : (m == MR ? -1 : m - 1); }
__device__ __forceinline__ void lora_a_pass(Frame& F, const Args& A) {
    const int gw = F.vcu * NWAVES + F.wave, NGW = F.G * NWAVES, lane = F.lane;
    const bf16* ZR = (const bf16*)(F.ws + WS_ZR); bf16* LA = (bf16*)(F.ws + WS_LA); const float* mu = inp(9) + 1536;
    const f32x4 muv = ((const f32x4*)mu)[lane];
    for (int g4 = gw; 4 * g4 < MR + NMETA; g4 += NGW) { const int m0 = 4 * g4;
        v2u zc[4], zp0 = (v2u){0u, 0u};
        { const int pm = prev_row(m0); if (pm >= 0) zp0 = ((const v2u*)(ZR + (size_t)pm * 1792 + 1536))[lane]; }
#pragma unroll
        for (int u = 0; u < 4; ++u) zc[u] = ((const v2u*)(ZR + (size_t)(m0 + u) * 1792 + 1536))[lane];
#pragma unroll
        for (int u = 0; u < 4; ++u) { const int m = m0 + u; const v2u zpv = u == 0 ? zp0 : zc[u > 0 ? u - 1 : 0];
            float x[4] = {bflo(zc[u].x), bfhi(zc[u].x), bflo(zc[u].y), bfhi(zc[u].y)}; const float p[4] = {bflo(zpv.x), bfhi(zpv.x), bflo(zpv.y), bfhi(zpv.y)};
            x[0] += (p[0] - x[0]) * muv.x; x[1] += (p[1] - x[1]) * muv.y; x[2] += (p[2] - x[2]) * muv.z; x[3] += (p[3] - x[3]) * muv.w;
            if (lane < 16) {
#pragma unroll
                for (int j = 0; j < 4; ++j) x[j] = tanhf(x[j]);
            } else if (lane >= 32) {
#pragma unroll
                for (int j = 0; j < 4; ++j) x[j] = sigm(x[j]);
            }
            v2u w; w.x = pk2(x[0], x[1]); w.y = pk2(x[2], x[3]);
            ((v2u*)(LA + (size_t)m * 256))[lane] = w; }
    }
}

#ifndef MK_ATT_SCALE
#define MK_ATT_SCALE 1.0f
#endif
__device__ __forceinline__ int crow(int r, int hi) { return (r & 3) + 8 * (r >> 2) + 4 * hi; }
constexpr int AT_KP = 144, AT_VP = 80, AT_KBYTES = 32 * AT_KP;
__device__ __forceinline__ void attn_item(Frame& F, const Args& A, int b, int head, int qb) {
    const int lane = F.lane, r32 = lane & 31, hi = lane >> 5, kvh = head >> 2, t0 = qb * 32, rr = lane >> 3, ck = lane & 7;
    const bf16* Q = (const bf16*)(F.ws + WS_Q); const bf16* KV = (const bf16*)(F.ws + WS_KV); bf16* AC = (bf16*)(F.ws + WS_Q);
    LAS unsigned char* Kl = F.lds + RING_OFF + F.wave * 16384; LAS unsigned char* Vl = Kl + AT_KBYTES;
    const float sink2 = inp(8)[head] * 1.4426950408889634f;
    v4u qg[4], kg[5][4], vg[5][4];
#pragma unroll
    for (int j = 0; j < 4; ++j) qg[j] = *(const v4u*)(Q + (size_t)(b * SEQL + t0 + 8 * j + rr) * 512 + head * 64 + 8 * ck);
#pragma unroll
    for (int i = 0; i < 5; ++i)
#pragma unroll
        for (int j = 0; j < 4; ++j) { const int tk = t0 - 128 + 32 * i + 8 * j + rr;
            const size_t krow = tk >= 0 ? (size_t)(b * SEQL + tk) : (tk >= -16 ? (size_t)(MR + 16 + tk) : (size_t)MR);
            kg[i][j] = *(const v4u*)(KV + krow * 256 + kvh * 64 + 8 * ck); }
    const bf16* vtb = (const bf16*)(F.ws + WS_VT) + (size_t)(b * 2 + kvh) * (PV / 16) * 1024;
#pragma unroll
    for (int i = 0; i < 5; ++i)
#pragma unroll
        for (int j = 0; j < 4; ++j) { const int x = 64 * j + lane; int pb = ((t0 - 112 + 32 * i) >> 4) + (x >> 7); pb = pb < 0 ? 0 : pb;
            vg[i][j] = *(const v4u*)(vtb + (size_t)pb * 1024 + (x & 127) * 8); }
    __builtin_amdgcn_sched_barrier(0);
    bf16x8 qf[4];
#pragma unroll
    for (int j = 0; j < 4; ++j) *(LAS v4u*)(Kl + (8 * j + rr) * AT_KP + 16 * ck) = qg[j];
#pragma unroll
    for (int s = 0; s < 4; ++s) qf[s] = *(const LAS bf16x8*)(Kl + r32 * AT_KP + 32 * s + 16 * hi);
    f32x16 S[5];
#pragma unroll
    for (int i = 0; i < 5; ++i) {
#pragma unroll
        for (int j = 0; j < 4; ++j) *(LAS v4u*)(Kl + (8 * j + rr) * AT_KP + 16 * ck) = kg[i][j];
        bf16x8 kf[4];
#pragma unroll
        for (int s = 0; s < 4; ++s) kf[s] = *(const LAS bf16x8*)(Kl + r32 * AT_KP + 32 * s + 16 * hi);
        f32x16 a = {};
#pragma unroll
        for (int s = 0; s < 4; ++s) a = __builtin_amdgcn_mfma_f32_32x32x16_bf16(kf[s], qf[s], a, 0, 0, 0);
        S[i] = a;
    }
    const float sc = 0.125f * 1.4426950408889634f; const int dq = r32 - 4 * hi;
#pragma unroll
    for (int r = 0; r < 16; ++r) { const int cr = (r & 3) + 8 * (r >> 2);
        S[0][r] = cr > dq ? S[0][r] * sc : -1e30f; S[4][r] = cr <= dq ? S[4][r] * sc : -1e30f;
        S[1][r] *= sc; S[2][r] *= sc; S[3][r] *= sc; }
    if (t0 < 112) {
#pragma unroll
        for (int i = 0; i < 4; ++i)
#pragma unroll
            for (int r = 0; r < 16; ++r) if (t0 - 128 + 32 * i + crow(r, hi) < -16) S[i][r] = -1e30f;
    }
    float mx = sink2;
#pragma unroll
    for (int i = 0; i < 5; ++i)
#pragma unroll
        for (int r = 0; r < 16; ++r) mx = fmaxf(mx, S[i][r]);
    mx = fmaxf(mx, __shfl_xor(mx, 32));
    float sum = 0.f;
#pragma unroll
    for (int i = 0; i < 5; ++i)
#pragma unroll
        for (int r = 0; r < 16; ++r) { const float p = __builtin_amdgcn_exp2f(S[i][r] - mx); S[i][r] = p; sum += p; }
    sum += __shfl_xor(sum, 32);
    const float inv = 1.0f / (sum + __builtin_amdgcn_exp2f(sink2 - mx));
    f32x16 O0 = {}, O1 = {};
#pragma unroll
    for (int i = 0; i < 5; ++i) {
#pragma unroll
        for (int j = 0; j < 4; ++j) { const int x = 64 * j + lane; *(LAS v4u*)(Vl + ((x & 127) >> 1) * AT_VP + (x >> 7) * 32 + (x & 1) * 16) = vg[i][j]; }
#pragma unroll
        for (int s = 0; s < 2; ++s) {
            bf16x8 pa;
#pragma unroll
            for (int j = 0; j < 8; j += 2) { const unsigned w = pg8::cvt_pk_bf16(S[i][8 * s + j], S[i][8 * s + j + 1]); pa[j] = (short)(w & 0xffffu); pa[j + 1] = (short)(w >> 16); }
            const v2u a0 = *(const LAS v2u*)(Vl + r32 * AT_VP + 32 * s + 8 * hi), a1 = *(const LAS v2u*)(Vl + r32 * AT_VP + 32 * s + 16 + 8 * hi);
            const v2u c0 = *(const LAS v2u*)(Vl + (r32 + 32) * AT_VP + 32 * s + 8 * hi), c1 = *(const LAS v2u*)(Vl + (r32 + 32) * AT_VP + 32 * s + 16 + 8 * hi);
            const v4u v0 = {a0.x, a0.y, a1.x, a1.y}, v1 = {c0.x, c0.y, c1.x, c1.y};
            O0 = __builtin_amdgcn_mfma_f32_32x32x16_bf16(__builtin_bit_cast(bf16x8, v0), pa, O0, 0, 0, 0);
            O1 = __builtin_amdgcn_mfma_f32_32x32x16_bf16(__builtin_bit_cast(bf16x8, v1), pa, O1, 0, 0, 0);
        }
    }
    const float iv = inv * MK_ATT_SCALE;
#pragma unroll
    for (int g = 0; g < 4; ++g) {
        *(LAS v2u*)(Kl + r32 * AT_KP + (8 * g + 4 * hi) * 2) = (v2u){pk2(O0[4 * g] * iv, O0[4 * g + 1] * iv), pk2(O0[4 * g + 2] * iv, O0[4 * g + 3] * iv)};
        *(LAS v2u*)(Kl + r32 * AT_KP + (32 + 8 * g + 4 * hi) * 2) = (v2u){pk2(O1[4 * g] * iv, O1[4 * g + 1] * iv), pk2(O1[4 * g + 2] * iv, O1[4 * g + 3] * iv)}; }
#pragma unroll
    for (int j = 0; j < 4; ++j) *(v4u*)(AC + (size_t)(b * SEQL + t0 + 8 * j + rr) * 512 + head * 64 + 8 * ck) = *(const LAS v4u*)(Kl + (8 * j + rr) * AT_KP + 16 * ck);
}


__device__ __forceinline__ bf16x8 lora_afrag(const bf16* ZR, size_t m, long pm, int chan, const float* mu, int kind) {
    const v4u zc = *(const v4u*)(ZR + m * 1792 + chan); v4u zp = (v4u){0u, 0u, 0u, 0u}; if (pm >= 0) zp = *(const v4u*)(ZR + (size_t)pm * 1792 + chan);
    const f32x4 m0 = *(const f32x4*)(mu + chan), m1 = *(const f32x4*)(mu + chan + 4); const float mv[8] = {m0.x, m0.y, m0.z, m0.w, m1.x, m1.y, m1.z, m1.w};
    float x[8];
#pragma unroll
    for (int j = 0; j < 4; ++j) { const float c0 = bflo(zc[j]), c1 = bfhi(zc[j]), p0 = bflo(zp[j]), p1 = bfhi(zp[j]); x[2 * j] = c0 + (p0 - c0) * mv[2 * j]; x[2 * j + 1] = c1 + (p1 - c1) * mv[2 * j + 1]; }
#pragma unroll
    for (int j = 0; j < 8; ++j) x[j] = kind == 0 ? tanhf(x[j]) : (kind == 2 ? sigm(x[j]) : x[j]);
    bf16x8 r;
#pragma unroll
    for (int j = 0; j < 8; j += 2) { const unsigned w = pk2(x[j], x[j + 1]); r[j] = (short)(w & 0xffffu); r[j + 1] = (short)(w >> 16); }
    return r;
}
__device__ __forceinline__ void lora_fused(Frame& F, const Args& A) {
    const int gw = F.vcu * NWAVES + F.wave, NGW = F.G * NWAVES, lane = F.lane, r32 = lane & 31, hi = lane >> 5;
    const bf16* ZR = (const bf16*)(F.ws + WS_ZR); const bf16* WL = (const bf16*)(F.ws + WS_WL); const float* mu = inp(9);
    bf16* LW = (bf16*)(F.ws + WS_LW); bf16* AA = (bf16*)(F.ws + WS_AA); bf16* GG = (bf16*)(F.ws + WS_GG);
    constexpr int NRB = (MR + NMETA + 31) / 32;
    for (int it = gw; it < NRB * 3; it += NGW) {
        const int kind = it % 3, r0 = (it / 3) * 32, k0 = kind == 0 ? 0 : (kind == 1 ? 64 : 128), nk = kind == 2 ? 8 : 4;
        const int mrow = r0 + r32 < MR + NMETA ? r0 + r32 : MR + NMETA - 1; const long pm = prev_row(mrow);
        bf16x8 af[8];
#pragma unroll
        for (int s = 0; s < 8; ++s) af[s] = lora_afrag(ZR, (size_t)mrow, pm, 1536 + k0 + (s < nk ? 16 * s : 0) + 8 * hi, mu, kind);
        const float* bias = kind == 0 ? inp(10) : inp(12);
        const bf16* wbase = WL + (size_t)(kind * 512 + r32) * 256 + k0 + 8 * hi;
        bf16x8 bcur[8], bnxt[8];
#pragma unroll
        for (int s = 0; s < 8; ++s) bcur[s] = *(const bf16x8*)(wbase + (s < nk ? 16 * s : 0));
        for (int nb = 0; nb < 16; ++nb) {
            const bf16* wn = wbase + (size_t)((nb + 1 < 16 ? nb + 1 : nb) * 32) * 256;
#pragma unroll
            for (int s = 0; s < 8; ++s) bnxt[s] = *(const bf16x8*)(wn + (s < nk ? 16 * s : 0));
            f32x16 acc = {};
#pragma unroll
            for (int s = 0; s < 8; ++s) if (s < nk) acc = __builtin_amdgcn_mfma_f32_32x32x16_bf16(af[s], bcur[s], acc, 0, 0, 0);
            const int col = nb * 32 + r32; const float bv = kind == 2 ? 0.f : bias[col];
#pragma unroll
            for (int r = 0; r < 16; ++r) { const int row = r0 + crow(r, hi); if (row < MR + NMETA) { const size_t o = (size_t)row * 512 + col; const float v = acc[r] + bv;
                if (kind == 0) LW[o] = (bf16)f2bf(-0.6065306597126334f * sigm(v)); else if (kind == 1) AA[o] = (bf16)f2bf(sigm(v)); else GG[o] = (bf16)f2bf(v); } }
#pragma unroll
            for (int s = 0; s < 8; ++s) bcur[s] = bnxt[s];
        }
    }
}

#ifndef MK_YN_SCALE
#define MK_YN_SCALE 1.0f
#endif
#ifndef MK_BONUS_SCALE
#define MK_BONUS_SCALE 1.0f
#endif
__device__ __forceinline__ float half_sum(float v) {
    v += dpp_f(v, 0); v += dpp_f(v, 1); v += dpp_f(v, 2);
    { const int x = __builtin_bit_cast(int, v); v += __builtin_bit_cast(float, __builtin_amdgcn_update_dpp(0, x, 0x140, 0xF, 0xF, true)); }
    { const int x = __builtin_bit_cast(int, v); v += __builtin_bit_cast(float, __builtin_amdgcn_ds_swizzle(x, 0x401F)); }
    return v;
}


typedef float f32x4m __attribute__((ext_vector_type(4)));
__device__ __forceinline__ f32x4m mini16(const bf16* A16, int lda, const bf16* Brow0, int ldb, int K, int lane) {
    const int r = lane & 15, q = lane >> 4; f32x4m acc = {0.f, 0.f, 0.f, 0.f};
    const bf16* ap = A16 + (size_t)r * lda + 8 * q; const bf16* bp = Brow0 + (size_t)r * ldb + 8 * q;
#pragma unroll 8
    for (int ks = 0; ks < K / 32; ++ks) { const bf16x8 a = *(const bf16x8*)(ap + 32 * ks), b = *(const bf16x8*)(bp + 32 * ks); acc = __builtin_amdgcn_mfma_f32_16x16x32_bf16(a, b, acc, 0, 0, 0); }
    return acc;
}
template <int K, int NB>
__device__ __forceinline__ void mini16_wg(Frame& F, const bf16* A16, int lda, const bf16* B0, const bf16* B1, int ldb, f32x4m (&out)[NB]) {
    constexpr int NKS = K / 256; static_assert(K % 256 == 0 && NB >= 1 && NB <= 2, "mini16_wg");
    const int lane = F.lane, wave = F.wave, r = lane & 15, q = lane >> 4;
    const bf16* ap = A16 + (size_t)r * lda + 8 * q + 32 * NKS * wave; const bf16* bp0 = B0 + (size_t)r * ldb + 8 * q + 32 * NKS * wave; const bf16* bp1 = B1 + (size_t)r * ldb + 8 * q + 32 * NKS * wave;
    bf16x8 a[NKS], b0[NKS], b1[NKS];
#pragma unroll
    for (int ks = 0; ks < NKS; ++ks) { a[ks] = *(const bf16x8*)(ap + 32 * ks); b0[ks] = *(const bf16x8*)(bp0 + 32 * ks); if (NB == 2) b1[ks] = *(const bf16x8*)(bp1 + 32 * ks); }
    f32x4m acc0 = {0.f, 0.f, 0.f, 0.f}, acc1 = acc0;
#pragma unroll
    for (int ks = 0; ks < NKS; ++ks) { acc0 = __builtin_amdgcn_mfma_f32_16x16x32_bf16(a[ks], b0[ks], acc0, 0, 0, 0); if (NB == 2) acc1 = __builtin_amdgcn_mfma_f32_16x16x32_bf16(a[ks], b1[ks], acc1, 0, 0, 0); }
    LAS f32x4m* red = (LAS f32x4m*)(F.lds + RING_OFF);
    red[wave * 64 + lane] = acc0; if (NB == 2) red[(8 + wave) * 64 + lane] = acc1;
    __syncthreads();
    if (wave == 0) {
#pragma unroll
        for (int nb = 0; nb < NB; ++nb) { f32x4m s = red[(nb * 8) * 64 + lane];
#pragma unroll
            for (int w = 1; w < 8; ++w) s += red[(nb * 8 + w) * 64 + lane];
            out[nb] = s; } }
    __syncthreads();
}
__device__ __forceinline__ float row16_sum(float v) { v += dpp_f(v, 0); v += dpp_f(v, 1); v += dpp_f(v, 2); const int x = __builtin_bit_cast(int, v); return v + __builtin_bit_cast(float, __builtin_amdgcn_update_dpp(0, x, 0x140, 0xF, 0xF, true)); }
__device__ __forceinline__ void meta_gateup(Frame& F, const bf16* Wgu, int i) {
    const int lane = F.lane, r = lane & 15, q = lane >> 4, j0 = 16 * i; const bf16* A16 = (const bf16*)F.out + (size_t)MR * DM;
    const int grow = 256 * (j0 >> 7) + (j0 & 127);
    f32x4m gu[2]; mini16_wg<DM, 2>(F, A16, DM, Wgu + (size_t)grow * DM, Wgu + (size_t)(grow + 128) * DM, DM, gu);
    if (F.wave != 0) return;
    const f32x4m g = gu[0], u = gu[1];
    bf16* H = (bf16*)(F.ws + WS_HID);
#pragma unroll
    for (int x = 0; x < 4; ++x) H[(size_t)(MR + 4 * q + x) * DFF + j0 + r] = (bf16)f2bf(g[x] * sigm(g[x]) * u[x]);
}
__device__ __forceinline__ void meta_down(Frame& F, const bf16* Wd, int i) {
    const int lane = F.lane, r = lane & 15, q = lane >> 4, n0 = 16 * i; const bf16* A16 = (const bf16*)(F.ws + WS_HID) + (size_t)MR * DFF; bf16* Fo = (bf16*)(F.ws + WS_F);
    f32x4m av[1]; mini16_wg<DFF, 1>(F, A16, DFF, Wd + (size_t)n0 * DFF, Wd + (size_t)n0 * DFF, DFF, av);
    if (F.wave != 0) return;
    const f32x4m a = av[0];
#pragma unroll
    for (int x = 0; x < 4; ++x) Fo[(size_t)(MR + 4 * q + x) * DM + n0 + r] = (bf16)f2bf(a[x]);
}
__device__ __forceinline__ void meta_win(Frame& F, int i) {
    const int lane = F.lane, r = lane & 15, q = lane >> 4, c0 = 512 + 16 * i; const bf16* A16 = (const bf16*)(F.ws + WS_HM);
    f32x4m av[1]; mini16_wg<DM, 1>(F, A16, DM, (const bf16*)(F.ws + WS_WIN) + (size_t)c0 * DM, (const bf16*)(F.ws + WS_WIN) + (size_t)c0 * DM, DM, av);
    if (F.wave != 0) return;
    f32x4m a = av[0];
    { const float* RS = (const float*)(F.ws + WS_RS2) + MR;
#pragma unroll
      for (int x = 0; x < 4; ++x) a[x] *= RS[4 * q + x]; }
    if (c0 < 640 && (c0 & 63) == 0) {
        const float* rope = (const float*)(F.ws + WS_ROPE); const bool lo = (r & 4) == 0; const int fi = r < 8 ? (r & 3) : 4 + (r & 3);
#pragma unroll
        for (int x = 0; x < 4; ++x) { const float other = __shfl_xor(a[x], 4); const int pos = 4 * q + x; const float cs = rope[pos * 16 + fi], sn = rope[pos * 16 + 8 + fi];
            a[x] = lo ? a[x] * cs - other * sn : a[x] * cs + other * sn; }
    }
    if (c0 >= 640 && c0 < 768) {
        const int dv = c0 - 640 + r; const v2u w = {pk2(a[0], a[1]), pk2(a[2], a[3])};
#pragma unroll
        for (int b = 0; b < NB; ++b) *(v2u*)((bf16*)(F.ws + WS_VT) + ((size_t)(b * 2 + (dv >> 6)) * (PV / 16) * 64 + (dv & 63)) * 16 + 4 * q) = w;
        return; }
    bf16* dst; int ld, col;
    if (c0 < 768) { dst = (bf16*)(F.ws + WS_KV); ld = 256; col = c0 - 512; } else { dst = (bf16*)(F.ws + WS_ZR); ld = 1792; col = c0 - 768; }
#pragma unroll
    for (int x = 0; x < 4; ++x) dst[(size_t)(MR + 4 * q + x) * ld + col + r] = (bf16)f2bf(a[x]);
}
__device__ __forceinline__ void meta_lora(Frame& F, int i) {
    const int lane = F.lane, r = lane & 15, q = lane >> 4, n0 = 16 * i, kind = n0 >> 9, col = (n0 & 511) + r; const bf16* A16 = (const bf16*)(F.ws + WS_LA) + (size_t)MR * 256;
    const f32x4m a = mini16(A16, 256, (const bf16*)(F.ws + WS_WL) + (size_t)n0 * 256, 256, 256, lane);
    const float bias = kind == 0 ? inp(10)[col] : (kind == 1 ? inp(12)[col] : 0.f);
    bf16* dst = (bf16*)(F.ws + (kind == 0 ? WS_LW : (kind == 1 ? WS_AA : WS_GG)));
#pragma unroll
    for (int x = 0; x < 4; ++x) { const float v = a[x] + bias; const float o = kind == 0 ? -0.6065306597126334f * sigm(v) : (kind == 1 ? sigm(v) : v); dst[(size_t)(MR + 4 * q + x) * 512 + col] = (bf16)f2bf(o); }
}

constexpr int RW_P = 72;
constexpr int RW_NCH = 129;
constexpr int RW_AT = 0, RW_RT = 9216, RW_BT = 18432, RW_KT = 27648;
constexpr int RW_RHS = RW_BT;
constexpr int RW_VT = 36864, RW_BHT = 46080, RW_KHT = 55296, RW_WT = 64512, RW_UT = 73728;
constexpr int RW_AAB = 82944;
constexpr int RW_AAK = 99328, RW_ARB = 108544, RW_ARK = 117760;
constexpr int RW_TINV = 92160;
constexpr int RW_MISC = 126976;
static_assert(RW_MISC + 2048 + 512 <= RING_BYTES, "rwkv LDS map");
typedef short s16x4v __attribute__((ext_vector_type(4)));

__device__ __forceinline__ f32x16 rw_mm(f32x16 acc, const LAS bf16* X, int ti, const LAS bf16* Yt, int tn, int lane) {
    const LAS bf16* xp = X + (32 * ti + (lane & 31)) * RW_P + 8 * (lane >> 5); const LAS bf16* yp = Yt + (32 * tn + (lane & 31)) * RW_P + 8 * (lane >> 5);
#pragma unroll
    for (int ks = 0; ks < 4; ++ks) { const bf16x8 a = *(const LAS bf16x8*)(xp + 16 * ks), b = *(const LAS bf16x8*)(yp + 16 * ks); acc = __builtin_amdgcn_mfma_f32_32x32x16_bf16(a, b, acc, 0, 0, 0); }
    return acc;
}
__device__ __forceinline__ bf16x8 rw_pack8(const f32x16& v, int s) {
    bf16x8 r;
#pragma unroll
    for (int j = 0; j < 8; j += 2) { const unsigned w = pg8::cvt_pk_bf16(v[8 * s + j], v[8 * s + j + 1]); r[j] = (short)(w & 0xffffu); r[j + 1] = (short)(w >> 16); }
    return r;
}
__device__ __forceinline__ size_t rw_item(int bh, int c) { return (size_t)bh * RW_NCH + c; }

struct RwRaw { unsigned zr[9], zk[9], zv[9], al[8], lw[8]; float par[6]; };
__device__ __forceinline__ void rw_load_raw(RwRaw& R, Frame& F, int b, int h, int c) {
    const int ch = F.tid & 63, tg = F.tid >> 6, hc = h * 64 + ch;
    const bf16* ZR = (const bf16*)(F.ws + WS_ZR); const bf16* LW = (const bf16*)(F.ws + WS_LW); const bf16* AA = (const bf16*)(F.ws + WS_AA);
#pragma unroll
    for (int j = 0; j < 9; ++j) { const int p = 64 * c - 48 + 8 * tg + j - 1; const int pc = p < 0 ? 0 : p;
        const size_t m = pc < 16 ? (size_t)(MR + pc) : (size_t)(b * SEQL + pc - 16); const bf16* z = ZR + m * 1792 + hc;
        R.zr[j] = z[0]; R.zk[j] = z[512]; R.zv[j] = z[1024];
        if (j > 0) { R.al[j - 1] = AA[m * 512 + hc]; R.lw[j - 1] = LW[m * 512 + hc]; } }
    R.par[0] = inp(9)[hc]; R.par[1] = inp(9)[512 + hc]; R.par[2] = inp(9)[1024 + hc]; R.par[3] = inp(15)[hc]; R.par[4] = inp(16)[hc]; R.par[5] = inp(17)[hc];
}
__device__ __forceinline__ float bfw(unsigned w) { return __builtin_bit_cast(float, w << 16); }
#ifdef MK_ITEM_PROF
#define RWP(k) do { if (blockIdx.x == 0 && threadIdx.x == 0) { const unsigned long long t_ = __builtin_amdgcn_s_memrealtime(); ((unsigned long long*)(F.ws + 32768))[k] += t_ - tprev_; tprev_ = t_; } } while (0)
#elif defined(MK_ITEM_MARK)
#define RWP(k) asm volatile("; RWP_MARK " #k ::: "memory")
#else
#define RWP(k) do { } while (0)
#endif
__device__ __forceinline__ void rwkv_item(Frame& F, int b, int h, int c, RwRaw& raw, int nb, int nh, int nc) {
    constexpr int MODE = 1;
#ifdef MK_ITEM_PROF
    unsigned long long tprev_ = __builtin_amdgcn_s_memrealtime();
#endif
    const int tid = F.tid, lane = F.lane, wave = F.wave, r32 = lane & 31, hi = lane >> 5;
    LAS unsigned char* L = F.lds;
    LAS bf16* At = (LAS bf16*)(L + RW_AT); LAS bf16* Rt = (LAS bf16*)(L + RW_RT); LAS bf16* Bt = (LAS bf16*)(L + RW_BT); LAS bf16* Kt = (LAS bf16*)(L + RW_KT);
    LAS bf16* Vt = (LAS bf16*)(L + RW_VT); LAS bf16* Bht = (LAS bf16*)(L + RW_BHT); LAS bf16* Kht = (LAS bf16*)(L + RW_KHT); LAS bf16* Wt = (LAS bf16*)(L + RW_WT); LAS bf16* Ut = (LAS bf16*)(L + RW_UT);
    LAS bf16* Aab = (LAS bf16*)(L + RW_AAB); LAS bf16* RhsB = (LAS bf16*)(L + RW_RHS);
    LAS bf16* Aak = (LAS bf16*)(L + RW_AAK); LAS bf16* Arb = (LAS bf16*)(L + RW_ARB); LAS bf16* Ark = (LAS bf16*)(L + RW_ARK); LAS bf16* Qm = Aak;
    LAS float* gtot = (LAS float*)(L + RW_MISC); LAS float* dots = gtot + 512; LAS float* lend = dots + 64;
    const bf16* ZR = (const bf16*)(F.ws + WS_ZR); const bf16* LW = (const bf16*)(F.ws + WS_LW); const bf16* AA = (const bf16*)(F.ws + WS_AA);
    const int bh = b * 8 + h;
    {
        const int ch = tid & 63, tg = tid >> 6, hc = h * 64 + ch;
        const float mur = raw.par[0], muk = raw.par[1], muv = raw.par[2], kkc = raw.par[3], kac = raw.par[4], rkc = raw.par[5];
        float zr_[9], zk_[9], zv_[9], al_[8], lwr_[8];
#pragma unroll
        for (int j = 0; j < 9; ++j) { zr_[j] = bfw(raw.zr[j]); zk_[j] = bfw(raw.zk[j]); zv_[j] = bfw(raw.zv[j]); if (j > 0) { al_[j - 1] = bfw(raw.al[j - 1]); lwr_[j - 1] = bfw(raw.lw[j - 1]); } }
        if (c == 0) {
#pragma unroll
            for (int j = 0; j < 9; ++j) { const float ok = 8 * tg + j - 1 >= 48 ? 1.f : 0.f; zr_[j] *= ok; zk_[j] *= ok; zv_[j] *= ok; if (j > 0) { al_[j - 1] *= ok; lwr_[j - 1] *= ok; } } }
        if (nc >= 0) rw_load_raw(raw, F, nb, nh, nc);
        float rr[8], kq[8], km[8], vv[8], bb[8], lw8[8];
        float run = 0.f;
        float V[16];
#pragma unroll
        for (int j = 0; j < 8; ++j) {
            const float r = zr_[j + 1] + (zr_[j] - zr_[j + 1]) * mur, k = zk_[j + 1] + (zk_[j] - zk_[j + 1]) * muk, v = zv_[j + 1] + (zv_[j] - zv_[j + 1]) * muv;
            const float al = al_[j], lw = lwr_[j];
            const float q = k * kkc, kmod = k * (1.f + (al - 1.f) * kac);
            V[2 * j] = q * q; V[2 * j + 1] = r * kmod * rkc;
            rr[j] = r; kq[j] = q; km[j] = kmod; vv[j] = v; run += lw; lw8[j] = run;
        }
        {
            const int ln = F.lane; const bool b3 = (ln & 8) != 0, b2 = (ln & 4) != 0, b1 = (ln & 2) != 0, b0 = (ln & 1) != 0;
#define RS_STEP(N, BIT, CTRL) _Pragma("unroll") for (int k_ = 0; k_ < (N); ++k_) { const float mine_ = BIT ? V[k_ + (N)] : V[k_], send_ = BIT ? V[k_] : V[k_ + (N)]; \
                V[k_] = mine_ + __builtin_bit_cast(float, __builtin_amdgcn_update_dpp(0, __builtin_bit_cast(int, send_), CTRL, 0xF, 0xF, true)); }
            RS_STEP(8, b3, 0x140)
            RS_STEP(4, b2, 0x141)
            RS_STEP(2, b1, 0x1B)
            RS_STEP(1, b0, 0xB1)
#undef RS_STEP
            float x = V[0];
            x += __builtin_bit_cast(float, __builtin_amdgcn_ds_swizzle(__builtin_bit_cast(int, x), 0x401F));
            x += __shfl_xor(x, 32);
            if (ln < 16 && (ln & 1)) ((float*)(F.ws + WS_DOTS))[rw_item(bh, c) * 64 + 8 * tg + (ln >> 1)] = x;
            const float rn = __builtin_amdgcn_rsqf(fmaxf(x, 1e-24f));
#pragma unroll
            for (int j = 0; j < 8; ++j) { const float rj = __builtin_bit_cast(float, __builtin_amdgcn_readlane(__builtin_bit_cast(int, rn), 2 * j)); kq[j] *= rj; bb[j] = kq[j] * al_[j]; }
        }
        gtot[tg * 64 + ch] = run;
        __syncthreads();
        float off = 0.f, tot = 0.f;
#pragma unroll
        for (int g2 = 0; g2 < 8; ++g2) { const float x = gtot[g2 * 64 + ch]; tot += x; if (g2 < tg) off += x; }
        if (tg == 0) lend[ch] = tot;
        unsigned vt_[4], bh_[4], kh_[4];
        const float eT = __expf(tot); float ePrev = __expf(off);
#pragma unroll
        for (int j = 0; j < 8; ++j) {
            const int t = 8 * tg + j; const float Lt = off + lw8[j];
            const float eL = __expf(Lt), eP = ePrev, eN = __expf(-Lt), eE = eT * eN; ePrev = eL;
            At[t * RW_P + ch] = (bf16)f2bf(-kq[j] * eP); Rt[t * RW_P + ch] = (bf16)f2bf(rr[j] * eL); Bt[t * RW_P + ch] = (bf16)f2bf(bb[j] * eN); Kt[t * RW_P + ch] = (bf16)f2bf(km[j] * eN);
            const unsigned v_ = f2bf(vv[j]), b_ = f2bf(bb[j] * eE), k_ = f2bf(km[j] * eE);
            if (j & 1) { vt_[j >> 1] |= v_ << 16; bh_[j >> 1] |= b_ << 16; kh_[j >> 1] |= k_ << 16; } else { vt_[j >> 1] = v_; bh_[j >> 1] = b_; kh_[j >> 1] = k_; }
        }
        *(LAS v4u*)(Vt + ch * RW_P + 8 * tg) = (v4u){vt_[0], vt_[1], vt_[2], vt_[3]};
        *(LAS v4u*)(Bht + ch * RW_P + 8 * tg) = (v4u){bh_[0], bh_[1], bh_[2], bh_[3]};
        *(LAS v4u*)(Kht + ch * RW_P + 8 * tg) = (v4u){kh_[0], kh_[1], kh_[2], kh_[3]};
    }
    __syncthreads(); RWP(0);
#pragma unroll
    for (int rnd = 0; rnd < 2; ++rnd) {
        const int mat = (wave >> 2) + 2 * rnd, ti = (wave >> 1) & 1, tn = wave & 1;
        f32x16 acc = {};
        acc = rw_mm(acc, (const LAS bf16*)(L + ((mat & 1) ? RW_KT : RW_BT)), tn, (const LAS bf16*)(L + (mat < 2 ? RW_AT : RW_RT)), ti, lane);
        LAS bf16* dstm = (LAS bf16*)(L + (mat == 0 ? RW_AAB : RW_AAK + (mat - 1) * 9216));
        const int t = 32 * ti + r32, lim = t + (mat >> 1);
#pragma unroll
        for (int g = 0; g < 4; ++g) { const int sb = 32 * tn + 8 * g + 4 * hi;
            const float v0 = sb < lim ? acc[4 * g] : 0.f, v1 = sb + 1 < lim ? acc[4 * g + 1] : 0.f, v2 = sb + 2 < lim ? acc[4 * g + 2] : 0.f, v3 = sb + 3 < lim ? acc[4 * g + 3] : 0.f;
            *(LAS v2u*)(dstm + t * RW_P + sb) = (v2u){pk2(v0, v1), pk2(v2, v3)}; }
    }
    __syncthreads(); RWP(1);
    if (wave < 4) { const int ti = wave >> 1, tn = wave & 1; f32x16 acc = {}; acc = rw_mm(acc, Aak, ti, Vt, tn, lane);
#pragma unroll
        for (int g = 0; g < 4; ++g) *(LAS v2u*)(RhsB + (32 * tn + r32) * RW_P + 32 * ti + 8 * g + 4 * hi) = (v2u){pk2(acc[4 * g], acc[4 * g + 1]), pk2(acc[4 * g + 2], acc[4 * g + 3])};
    } else {
        const int d = wave & 3, cl = lane & 15, q = lane >> 4;
        const LAS bf16* Ad = Aab + (16 * d) * RW_P + 16 * d;
        f32x4m aN, aT;
#pragma unroll
        for (int r = 0; r < 4; ++r) aN[r] = bf1(Ad[(4 * q + r) * RW_P + cl]);
        { const v2u w = *(const LAS v2u*)(Ad + cl * RW_P + 4 * q); aT[0] = bflo(w.x); aT[1] = bfhi(w.x); aT[2] = bflo(w.y); aT[3] = bfhi(w.y); }
#define MM4(dst_, a_, b_, init_) { f32x4m z_ = init_; _Pragma("unroll") for (int s_ = 0; s_ < 4; ++s_) z_ = __builtin_amdgcn_mfma_f32_16x16x4f32(a_[s_], b_[s_], z_, 0, 0, 0); dst_ = z_; }
        const f32x4m zero4 = {0.f, 0.f, 0.f, 0.f};
        f32x4m a2N, a2T, a4N, a4T, a8N, b1T, b2T, b3T, iaT;
        MM4(a2N, aT, aN, zero4); MM4(a2T, aN, aT, zero4);
#pragma unroll
        for (int r = 0; r < 4; ++r) iaT[r] = aT[r] + (cl == 4 * q + r ? 1.f : 0.f);
        MM4(a4N, a2T, a2N, zero4); MM4(a4T, a2N, a2T, zero4);
        MM4(b1T, a2N, iaT, iaT);
        MM4(a8N, a4T, a4N, zero4);
        MM4(b2T, a4N, b1T, b1T);
        MM4(b3T, a8N, b2T, b2T);
#undef MM4
        *(LAS f32x4m*)(L + RW_TINV + (d * 64 + lane) * 16) = b3T;
    }
    __syncthreads(); RWP(2);
    {
        const int cl = lane & 15, q = lane >> 4, cc = (wave & 3) * 16 + cl;
        LAS bf16* xrow = (wave < 4 ? Ut : Wt) + cc * RW_P;
        f32x4m Tt[4];
#pragma unroll
        for (int b = 0; b < 4; ++b) Tt[b] = *(const LAS f32x4m*)(L + RW_TINV + (b * 64 + lane) * 16);
        unsigned xp[4][2];
#pragma unroll
        for (int b = 0; b < 4; ++b) {
            f32x4m acc;
            if (wave < 4) { const v2u w = *(const LAS v2u*)(RhsB + cc * RW_P + 16 * b + 4 * q); acc[0] = bflo(w.x); acc[1] = bfhi(w.x); acc[2] = bflo(w.y); acc[3] = bfhi(w.y); }
            else {
#pragma unroll
                for (int r = 0; r < 4; ++r) acc[r] = bf1(At[(16 * b + 4 * q + r) * RW_P + cc]); }
#pragma unroll
            for (int mq = 0; mq < 2; ++mq) if (32 * mq < 16 * b) {
                const v2u a0 = *(const LAS v2u*)(Aab + (16 * b + cl) * RW_P + 32 * mq + 4 * q), a1 = *(const LAS v2u*)(Aab + (16 * b + cl) * RW_P + 32 * mq + 16 + 4 * q);
                const bool second = 2 * mq + 1 < b;
                const v4u au = {a0.x, a0.y, a1.x, a1.y}, xu = {xp[2 * mq][0], xp[2 * mq][1], second ? xp[2 * mq + 1][0] : 0u, second ? xp[2 * mq + 1][1] : 0u};
                acc = __builtin_amdgcn_mfma_f32_16x16x32_bf16(__builtin_bit_cast(bf16x8, au), __builtin_bit_cast(bf16x8, xu), acc, 0, 0, 0);
            }
            f32x4m x = {0.f, 0.f, 0.f, 0.f};
#pragma unroll
            for (int s = 0; s < 4; ++s) x = __builtin_amdgcn_mfma_f32_16x16x4f32(Tt[b][s], acc[s], x, 0, 0, 0);
            xp[b][0] = pk2(x[0], x[1]); xp[b][1] = pk2(x[2], x[3]);
            *(LAS v2u*)(xrow + 16 * b + 4 * q) = (v2u){xp[b][0], xp[b][1]};
        }
    }
    __syncthreads(); RWP(3);
    {
        const int ti = (wave >> 1) & 1, tn = wave & 1; f32x16 acc = {};
        unsigned char* dst = F.ws + WS_F + rw_item(bh, c) * 16384;
        if (wave < 4) { acc = rw_mm(acc, Wt, tn, Bht, ti, lane);
            bf16* MT = (bf16*)dst; const int k2 = 32 * ti + r32; const float ed = __expf(lend[k2]);
#pragma unroll
            for (int g = 0; g < 4; ++g) { const int k1 = 32 * tn + 8 * g + 4 * hi;
                const float v0 = acc[4 * g] + (k1 == k2 ? ed : 0.f), v1 = acc[4 * g + 1] + (k1 + 1 == k2 ? ed : 0.f), v2 = acc[4 * g + 2] + (k1 + 2 == k2 ? ed : 0.f), v3 = acc[4 * g + 3] + (k1 + 3 == k2 ? ed : 0.f);
                *(v2u*)(MT + k2 * 64 + k1) = (v2u){pk2(v0, v1), pk2(v2, v3)}; }
        } else { acc = rw_mm(acc, Bht, ti, Ut, tn, lane); acc = rw_mm(acc, Kht, ti, Vt, tn, lane);
            v4u* GT = (v4u*)(dst + 8192) + ((ti * 2 + tn) * 64 + lane) * 2;
            const bf16x8 g0 = rw_pack8(acc, 0), g1 = rw_pack8(acc, 1); GT[0] = __builtin_bit_cast(v4u, g0); GT[1] = __builtin_bit_cast(v4u, g1); }
    }
    RWP(4);
    if (c > 0) {
        const int ti = (wave >> 1) & 1, tn = wave & 1; f32x16 acc = {};
        unsigned char* dst = F.ws + WS_QY + rw_item(bh, c) * 16384;
        if (wave < 4) { acc = rw_mm(acc, Wt, tn, Arb, ti, lane);
            bf16* Qg = (bf16*)dst; const int t = 32 * ti + r32;
#pragma unroll
            for (int g = 0; g < 4; ++g) { const int k = 32 * tn + 8 * g + 4 * hi; const v2u rw = *(const LAS v2u*)(Rt + t * RW_P + k);
                *(v2u*)(Qg + t * 64 + k) = (v2u){pk2(acc[4 * g] + bflo(rw.x), acc[4 * g + 1] + bfhi(rw.x)), pk2(acc[4 * g + 2] + bflo(rw.y), acc[4 * g + 3] + bfhi(rw.y))}; }
        } else { acc = rw_mm(acc, Ut, tn, Arb, ti, lane); acc = rw_mm(acc, Vt, tn, Ark, ti, lane);
            v4u* YT = (v4u*)(dst + 8192) + ((ti * 2 + tn) * 64 + lane) * 2;
            const bf16x8 g0 = rw_pack8(acc, 0), g1 = rw_pack8(acc, 1); YT[0] = __builtin_bit_cast(v4u, g0); YT[1] = __builtin_bit_cast(v4u, g1); }
    }
    __syncthreads(); RWP(5);
}

struct OutRaw { v4u qg[4], s0[4], s1[4]; };
__device__ __forceinline__ void rwkv_out_load(OutRaw& R, Frame& F, int bh, int c, int ti) {
    const int lane = F.lane, r32 = lane & 31, b = bh >> 3, h = bh & 7, rr = lane >> 3, ck = lane & 7;
    const unsigned char* src = F.ws + WS_QY + rw_item(bh, c) * 16384; const bf16* Qg = (const bf16*)src; const v4u* YT = (const v4u*)(src + 8192);
    const v4u* SI = (const v4u*)(F.ws + WS_SST + rw_item(bh, c) * 8192);
#pragma unroll
    for (int j = 0; j < 4; ++j) R.qg[j] = *(const v4u*)(Qg + (32 * ti + 8 * j + rr) * 64 + 8 * ck);
#pragma unroll
    for (int e = 0; e < 4; ++e) { R.s0[e] = SI[(((e >> 1) * 2 + 0) * 2 + (e & 1)) * 64 + lane]; R.s1[e] = SI[(((e >> 1) * 2 + 1) * 2 + (e & 1)) * 64 + lane]; }
}
__device__ __forceinline__ void rwkv_out(Frame& F, const OutRaw& R, int bh, int c, int ti) {
    constexpr int P_ = 144;
    const int lane = F.lane, r32 = lane & 31, hi = lane >> 5, b = bh >> 3, h = bh & 7, rr = lane >> 3, ck = lane & 7;
    LAS unsigned char* Zl = F.lds + RING_OFF + F.wave * 16384; LAS unsigned char* Gl = Zl + 33 * P_; LAS unsigned char* Ql = Gl + 32 * P_;
    const int tok0 = 64 * (c - 1) + 32 * ti; const size_t m0 = (size_t)(b * SEQL + tok0);
    bf16* RO = (bf16*)(F.ws + WS_F);
    const size_t pm0 = tok0 == 0 ? (size_t)(MR + 15) : m0 - 1;
    const bf16* ZR = (const bf16*)(F.ws + WS_ZR); const bf16* GG = (const bf16*)(F.ws + WS_GG);
    const v4u* YT = (const v4u*)(F.ws + WS_QY + rw_item(bh, c) * 16384 + 8192);
    const float dt = ((const float*)(F.ws + WS_DOTS))[rw_item(bh, c) * 64 + 32 * ti + r32];
    const v4u a0 = YT[((ti * 2 + 0) * 64 + lane) * 2], a1 = YT[((ti * 2 + 0) * 64 + lane) * 2 + 1], b0 = YT[((ti * 2 + 1) * 64 + lane) * 2], b1 = YT[((ti * 2 + 1) * 64 + lane) * 2 + 1];
    v4u qg[4], zg[4], gg4[4], s0[4], s1[4];
#pragma unroll
    for (int j = 0; j < 4; ++j) { qg[j] = R.qg[j]; s0[j] = R.s0[j]; s1[j] = R.s1[j]; }
    const v4u zprev = *(const v4u*)(ZR + pm0 * 1792 + 1024 + h * 64 + 8 * ck);
#pragma unroll
    for (int j = 0; j < 4; ++j) { zg[j] = *(const v4u*)(ZR + (m0 + 8 * j + rr) * 1792 + 1024 + h * 64 + 8 * ck); gg4[j] = *(const v4u*)(GG + (m0 + 8 * j + rr) * 512 + h * 64 + 8 * ck); }
    __builtin_amdgcn_sched_barrier(0);
#pragma unroll
    for (int j = 0; j < 4; ++j) *(LAS v4u*)(Ql + (8 * j + rr) * P_ + 16 * ck) = qg[j];
    f32x16 y0, y1;
#pragma unroll
    for (int j = 0; j < 4; ++j) { y0[2 * j] = bflo(a0[j]); y0[2 * j + 1] = bfhi(a0[j]); y0[8 + 2 * j] = bflo(a1[j]); y0[8 + 2 * j + 1] = bfhi(a1[j]);
                                  y1[2 * j] = bflo(b0[j]); y1[2 * j + 1] = bfhi(b0[j]); y1[8 + 2 * j] = bflo(b1[j]); y1[8 + 2 * j + 1] = bfhi(b1[j]); }
#pragma unroll
    for (int e = 0; e < 4; ++e) {
        const v2u qa = *(const LAS v2u*)(Ql + r32 * P_ + (32 * (e >> 1) + 16 * (e & 1) + 4 * hi) * 2), qb = *(const LAS v2u*)(Ql + r32 * P_ + (32 * (e >> 1) + 16 * (e & 1) + 8 + 4 * hi) * 2);
        const v4u qf = {qa.x, qa.y, qb.x, qb.y};
        y0 = __builtin_amdgcn_mfma_f32_32x32x16_bf16(__builtin_bit_cast(bf16x8, s0[e]), __builtin_bit_cast(bf16x8, qf), y0, 0, 0, 0);
        y1 = __builtin_amdgcn_mfma_f32_32x32x16_bf16(__builtin_bit_cast(bf16x8, s1[e]), __builtin_bit_cast(bf16x8, qf), y1, 0, 0, 0);
    }
    if (lane < 8) *(LAS v4u*)(Zl + 16 * ck) = zprev;
#pragma unroll
    for (int j = 0; j < 4; ++j) { *(LAS v4u*)(Zl + (1 + 8 * j + rr) * P_ + 16 * ck) = zg[j]; *(LAS v4u*)(Gl + (8 * j + rr) * P_ + 16 * ck) = gg4[j]; }
    float sm = 0.f;
#pragma unroll
    for (int r = 0; r < 16; ++r) sm += y0[r] + y1[r];
    sm += __shfl_xor(sm, 32);
    const float mean = sm * (1.f / 64.f);
    float sv = 0.f;
#pragma unroll
    for (int r = 0; r < 16; ++r) { y0[r] -= mean; y1[r] -= mean; sv += y0[r] * y0[r] + y1[r] * y1[r]; }
    sv += __shfl_xor(sv, 32);
    const float rs = 1.f / sqrtf(sv * (1.f / 64.f) + GN_EPS);
    const float* lnw = inp(18) + h * 64 + 4 * hi; const float* lnb = inp(19) + h * 64 + 4 * hi; const float* mvp = inp(9) + 1024 + h * 64 + 4 * hi;
#pragma unroll
    for (int tn = 0; tn < 2; ++tn)
#pragma unroll
        for (int g = 0; g < 4; ++g) { const int co = (32 * tn + 8 * g + 4 * hi) * 2;
            const f32x4 w4 = *(const f32x4*)(lnw + 32 * tn + 8 * g), b4 = *(const f32x4*)(lnb + 32 * tn + 8 * g), m4 = *(const f32x4*)(mvp + 32 * tn + 8 * g);
            const v2u zv = *(const LAS v2u*)(Zl + (1 + r32) * P_ + co), pv = *(const LAS v2u*)(Zl + r32 * P_ + co), gv = *(const LAS v2u*)(Gl + r32 * P_ + co);
            const float z[4] = {bflo(zv.x), bfhi(zv.x), bflo(zv.y), bfhi(zv.y)}, p[4] = {bflo(pv.x), bfhi(pv.x), bflo(pv.y), bfhi(pv.y)}, gt[4] = {bflo(gv.x), bfhi(gv.x), bflo(gv.y), bfhi(gv.y)};
            float o[4];
#pragma unroll
            for (int x = 0; x < 4; ++x) { const float d = tn == 0 ? y0[4 * g + x] : y1[4 * g + x]; const float v = z[x] + (p[x] - z[x]) * m4[x]; o[x] = (d * rs * w4[x] + b4[x] + dt * v) * gt[x]; }
            *(LAS v2u*)(Gl + r32 * P_ + co) = (v2u){pk2(o[0], o[1]), pk2(o[2], o[3])};
        }
#pragma unroll
    for (int j = 0; j < 4; ++j) *(v4u*)(RO + (m0 + 8 * j + rr) * 512 + h * 64 + 8 * ck) = *(const LAS v4u*)(Gl + (8 * j + rr) * P_ + 16 * ck);
}

constexpr int RWC_MP = 68;
constexpr int RWC_SLOT = 64 * RWC_MP * 2 + 4096;
constexpr int RWC_FLAGS = 7 * RWC_SLOT;
__device__ __forceinline__ void rwkv_chain_wg(Frame& F, int bh, int tv) {
    const int lane = F.lane, wave = F.wave, r32 = lane & 31, hi = lane >> 5;
    LAS unsigned char* L = F.lds; volatile LAS unsigned* flag = (volatile LAS unsigned*)(L + RWC_FLAGS);
    if (F.tid < 7) flag[F.tid] = 0u;
    __syncthreads();
    if (wave != 0) {
        const int slot = wave - 1; LAS unsigned char* sb = L + slot * RWC_SLOT;
        v4u mv[8], gv[4];
#define RWC_LOAD(MV, GV, CC) do { const unsigned char* src_ = F.ws + WS_F + rw_item(bh, (CC)) * 16384; const v4u* MT_ = (const v4u*)src_; const v4u* GT_ = (const v4u*)(src_ + 8192); \
            _Pragma("unroll") for (int i = 0; i < 8; ++i) MV[i] = MT_[lane + 64 * i]; \
            _Pragma("unroll") for (int i = 0; i < 4; ++i) { const int idx = lane + 64 * i, t2 = idx >> 7, l = (idx >> 1) & 63, hf = idx & 1; GV[i] = GT_[((t2 * 2 + tv) * 64 + l) * 2 + hf]; } } while (0)
        RWC_LOAD(mv, gv, slot);
        for (int c = slot; c < RW_NCH; c += 7) {
            v4u mn[8], gn[4];
            RWC_LOAD(mn, gn, (c + 7 < RW_NCH ? c + 7 : c));
            asm volatile("s_waitcnt vmcnt(12)" ::: "memory");
            while (flag[slot] != 0u) __builtin_amdgcn_s_sleep(2);
#pragma unroll
            for (int i = 0; i < 8; ++i) { const int idx = lane + 64 * i; *(LAS v4u*)(sb + (idx >> 3) * (RWC_MP * 2) + (idx & 7) * 16) = mv[i]; }
#pragma unroll
            for (int i = 0; i < 4; ++i) *(LAS v4u*)(sb + 64 * RWC_MP * 2 + (lane + 64 * i) * 16) = gv[i];
            asm volatile("s_waitcnt lgkmcnt(0)" ::: "memory");
            if (lane == 0) flag[slot] = 1u;
#pragma unroll
            for (int i = 0; i < 8; ++i) mv[i] = mn[i];
#pragma unroll
            for (int i = 0; i < 4; ++i) gv[i] = gn[i];
        }
#undef RWC_LOAD
        return;
    }
    f32x16 s0 = {}, s1 = {};
    __builtin_amdgcn_s_setprio(3);
    for (int c = 0; c < RW_NCH; ++c) {
        const int slot = c % 7; const LAS unsigned char* sb = L + slot * RWC_SLOT;
        v4u* SI = (v4u*)(F.ws + WS_SST + rw_item(bh, c) * 8192);
        const bf16x8 b00 = rw_pack8(s0, 0), b01 = rw_pack8(s0, 1), b10 = rw_pack8(s1, 0), b11 = rw_pack8(s1, 1);
        SI[((0 * 2 + tv) * 2 + 0) * 64 + lane] = __builtin_bit_cast(v4u, b00); SI[((0 * 2 + tv) * 2 + 1) * 64 + lane] = __builtin_bit_cast(v4u, b01);
        SI[((1 * 2 + tv) * 2 + 0) * 64 + lane] = __builtin_bit_cast(v4u, b10); SI[((1 * 2 + tv) * 2 + 1) * 64 + lane] = __builtin_bit_cast(v4u, b11);
        while (flag[slot] == 0u) __builtin_amdgcn_s_sleep(1);
        asm volatile("" ::: "memory");
        s16x4v ma[2][2][2], mb[2][2][2]; v4u g[2][2];
#pragma unroll
        for (int tk = 0; tk < 2; ++tk)
#pragma unroll
            for (int s = 0; s < 2; ++s)
#pragma unroll
                for (int t2 = 0; t2 < 2; ++t2) { const LAS bf16* mp = (const LAS bf16*)sb + (32 * t2 + r32) * RWC_MP + 32 * tk + 16 * s + 4 * hi; ma[tk][s][t2] = *(const LAS s16x4v*)(mp); mb[tk][s][t2] = *(const LAS s16x4v*)(mp + 8); }
#pragma unroll
        for (int t2 = 0; t2 < 2; ++t2) { g[t2][0] = *(const LAS v4u*)(sb + 64 * RWC_MP * 2 + ((t2 * 64 + lane) * 2) * 16); g[t2][1] = *(const LAS v4u*)(sb + 64 * RWC_MP * 2 + ((t2 * 64 + lane) * 2 + 1) * 16); }
        asm volatile("s_waitcnt lgkmcnt(0)" ::: "memory");
        if (lane == 0) flag[slot] = 0u;
        f32x16 n0, n1;
#pragma unroll
        for (int j = 0; j < 4; ++j) { n0[2 * j] = bflo(g[0][0][j]); n0[2 * j + 1] = bfhi(g[0][0][j]); n0[8 + 2 * j] = bflo(g[0][1][j]); n0[8 + 2 * j + 1] = bfhi(g[0][1][j]);
                                      n1[2 * j] = bflo(g[1][0][j]); n1[2 * j + 1] = bfhi(g[1][0][j]); n1[8 + 2 * j] = bflo(g[1][1][j]); n1[8 + 2 * j + 1] = bfhi(g[1][1][j]); }
#pragma unroll
        for (int tk = 0; tk < 2; ++tk)
#pragma unroll
            for (int s = 0; s < 2; ++s) {
                const bf16x8 bfr = tk == 0 ? (s == 0 ? b00 : b01) : (s == 0 ? b10 : b11);
#pragma unroll
                for (int t2 = 0; t2 < 2; ++t2) {
                    const s16x4v xa = ma[tk][s][t2], xb = mb[tk][s][t2];
                    const bf16x8 af = {xa[0], xa[1], xa[2], xa[3], xb[0], xb[1], xb[2], xb[3]};
                    if (t2 == 0) n0 = __builtin_amdgcn_mfma_f32_32x32x16_bf16(af, bfr, n0, 0, 0, 0); else n1 = __builtin_amdgcn_mfma_f32_32x32x16_bf16(af, bfr, n1, 0, 0, 0);
                }
            }
        s0 = n0; s1 = n1;
    }
    __builtin_amdgcn_s_setprio(0);
}

#ifdef MK_DUMP
__device__ __forceinline__ void dump_phase(const unsigned char* ws, float* out) {
    const size_t n = (size_t)MR * DM; const size_t i0 = (size_t)blockIdx.x * blockDim.x + threadIdx.x, st = (size_t)gridDim.x * blockDim.x;
    for (size_t i = i0; i < n; i += st) { const size_t m = i >> 10, c = i & 1023; float v = 0.f;
        if (MK_DUMP == 1) v = bf1(((const bf16*)(ws + WS_F))[m * 1024 + c]);
        else if (MK_DUMP == 2) v = bf1(((const bf16*)(ws + WS_ZR))[m * 1792 + c]);
        else if (MK_DUMP == 3) v = c < 512 ? ((const float*)(ws + WS_LW))[m * 512 + c] : bf1(((const bf16*)(ws + WS_AA))[m * 512 + c - 512]);
        else if (MK_DUMP == 4) v = bf1(((const bf16*)(ws + WS_MERGED))[m * 1024 + c]);
        else if (MK_DUMP == 5) v = c < 512 ? bf1(((const bf16*)(ws + WS_Q))[m * 512 + c]) : (c < 768 ? bf1(((const bf16*)(ws + WS_KV))[m * 256 + c - 512]) : bf1(((const bf16*)(ws + WS_LA))[m * 256 + c - 768]));
        else if (MK_DUMP == 6) v = bf1(((const bf16*)(ws + WS_GATES))[m * 2048 + c]);
        else if (MK_DUMP == 7) v = bf1(((const bf16*)(ws + WS_F))[m * 1024 + c]);
        else if (MK_DUMP == 8) v = c < 512 ? bf1(((const bf16*)(ws + WS_GG))[m * 512 + c]) : bf1(((const bf16*)(ws + WS_ZR))[m * 1792 + 1024 + c - 512]);
        else if (MK_DUMP == 9) v = ((const float*)(ws + WS_SS))[((size_t)((c & 15) >> 2) * MP + m) * 4 + (c & 3)];
        else if (MK_DUMP == 10) v = bf1(((const bf16*)(ws + WS_XN))[m * 1024 + c]);
        out[i] = v; }
}
#endif
#ifndef MK_N_LAUNCHES
#define MK_N_LAUNCHES 1
#endif
constexpr int N_PHASES = 15;
constexpr int N_LAUNCHES = MK_N_LAUNCHES;
__global__ void __launch_bounds__(NWAVES * 64, 2) hybrid_fwd(Args args) {
    extern __shared__ __attribute__((aligned(16))) unsigned char lds[];
    Frame F;
    F.lds = (LAS unsigned char*)lds;
    F.MISC = (volatile LAS unsigned*)(F.lds + MISC_OFF);
#define FRAME_REFRESH() do { int t_ = threadIdx.x; asm volatile("" : "+v"(t_)); F.tid = t_; F.lane = t_ & 63; F.wave = __builtin_amdgcn_readfirstlane(t_ >> 6); } while (0)
    FRAME_REFRESH();
    F.G = gridDim.x; { const int bx = blockIdx.x; F.vcu = (F.G % 8 == 0) ? (bx % 8) * (F.G / 8) + bx / 8 : bx; }
    unsigned char* ws = args.ws; F.ws = ws; F.out = args.out;
    F.ctl = (gu32*)(ws + WS_CTL);
    for (int u = F.tid; u < (LDS_BYTES - LDSCTL_OFF) / 4; u += NWAVES * 64) ((LAS unsigned*)(F.lds + LDSCTL_OFF))[u] = 0u;
    __syncthreads();
    XcdBarrier bar; bar.bar = (unsigned*)(F.ctl + CW_BAR); bar.x = 0; bar.st = nullptr;
    if (N_LAUNCHES == 1) bar = xcd_barrier_post((unsigned*)(F.ctl + CW_BAR), F.MISC + 8);
    const int lo = args.ph_lo, hi = args.ph_hi;
#ifndef PHASE_MASK
#define PHASE_MASK 0x7fff
#endif
#define IN(k) (((PHASE_MASK >> (k)) & 1) && lo <= (k) && (k) < hi)
#ifndef MK_TIME_SCALE
#define MK_TIME_SCALE 0.001f
#endif
#ifdef MK_TIME_PHASE
#define SEAM(k) do { if (IN(k) && IN((k) + 1)) xcd_barrier(bar); if (blockIdx.x == 0 && threadIdx.x == 0) { const unsigned long long t_ = __builtin_amdgcn_s_memrealtime(); ((unsigned long long*)(ws + 16384))[(k) + 1] = t_; } } while (0)
#else
#define SEAM(k) do { if (IN(k) && IN((k) + 1)) xcd_barrier(bar); } while (0)
#endif
#define GEMM_RUN(EpiT, Eobj, Aptr, lda_, Bptr, ldb_, M_, N_, K_) do { pg8::Gemm g_{(const pg8::bf16_t*)(Aptr), (const pg8::bf16_t*)(Bptr), (M_), (N_), (K_), (lda_), (ldb_)}; pg8::StaticOrder S_; S_.init((M_), (N_), F.G, (int)blockIdx.x); \
        pg8::gemm_phase<EpiT, pg8::StaticOrder, true, true>(F.lds + RING_OFF, g_, S_, Eobj); } while (0)

#ifdef MK_COH_TEST
    {
        float* Tb = (float*)(ws + WS_BIG + 300 * MiB); const int g = blockIdx.x, G = gridDim.x, nb = (g + 1) % G; float acc = 0.f; unsigned bad = 0;
        for (int rep = 0; rep < 4; ++rep) {
            for (int i = threadIdx.x; i < 8192; i += 512) Tb[(size_t)g * 8192 + i] = 1.0f + rep;
            xcd_barrier(bar);
            for (int i = threadIdx.x; i < 8192; i += 512) acc += Tb[(size_t)nb * 8192 + i];
            xcd_barrier(bar);
            for (int i = threadIdx.x; i < 8192; i += 512) Tb[(size_t)g * 8192 + i] = 100.0f + rep * 7 + i;
            xcd_barrier(bar);
            for (int i = threadIdx.x; i < 8192; i += 512) { const float v = Tb[(size_t)nb * 8192 + i]; bad += (v != 100.0f + rep * 7 + i) ? 1u : 0u; }
            xcd_barrier(bar);
        }
        if (acc == 12345.f) bad++;
        if (bad) atomicAdd((unsigned*)(F.ctl + 901), bad);
    }
#endif
#ifdef MK_ITEM_PROF
    if (blockIdx.x == 0 && threadIdx.x == 0) { for (int i_ = 0; i_ < 8; ++i_) ((unsigned long long*)(ws + 32768))[i_] = 0ull; }
#endif
#ifdef MK_TIME_PHASE
    if (blockIdx.x == 0 && threadIdx.x == 0) ((unsigned long long*)(ws + 16384))[0] = __builtin_amdgcn_s_memrealtime();
#endif
    if (IN(0)) { FRAME_REFRESH(); p0_prologue(F, args); } SEAM(0);
    if (IN(1)) { FRAME_REFRESH(); { for (int it = F.vcu; it < DFF / 16; it += F.G) meta_gateup(F, (const bf16*)(ws + WS_WGU1), it); }
        pg8::EpiSwiGLU E{(pg8::bf16_t*)(ws + WS_HID), nullptr}; GEMM_RUN(pg8::EpiSwiGLU, E, (unsigned char*)F.out, DM, ws + WS_WGU1, DM, MR, NHID2, DM); } SEAM(1);
    if (IN(2)) { FRAME_REFRESH(); { for (int it = F.vcu; it < 64; it += F.G) meta_down(F, (const bf16*)(ws + WS_WD1), it); }
        pg8::EpiFSS E{(pg8::bf16_t*)(ws + WS_F), (float*)(ws + WS_SS)}; GEMM_RUN(pg8::EpiFSS, E, ws + WS_HID, DFF, ws + WS_WD1, DFF, MR, DM, DFF); } SEAM(2);
    if (IN(3)) { FRAME_REFRESH(); row_pass<0>(F, args, inp(5), inp(6), 0.5f); } SEAM(3);
    if (IN(4)) { pg8::EpiWin E{(const float*)(ws + WS_RS2), (pg8::bf16_t*)(ws + WS_Q), (pg8::bf16_t*)(ws + WS_KV), (pg8::bf16_t*)(ws + WS_ZR), (const float*)(ws + WS_ROPE), MR, (pg8::bf16_t*)(ws + WS_VT)}; FRAME_REFRESH(); { for (int it = F.vcu; it < 128; it += F.G) meta_win(F, it); }
        GEMM_RUN(pg8::EpiWin, E, (unsigned char*)F.out, DM, ws + WS_WIN, DM, MR, NIN_A, DM); } SEAM(4);
#ifdef MK_GEMM_CHECK4
    if (IN(4)) { xcd_barrier(bar);
        { unsigned char* w2 = ws + WS_BIG + 165 * MiB; pg8::EpiWin E{(const float*)(ws + WS_RS2), (pg8::bf16_t*)(w2), (pg8::bf16_t*)(w2 + (WS_KV - WS_Q)), (pg8::bf16_t*)(w2 + (WS_ZR - WS_Q)), (const float*)(ws + WS_ROPE), MR, (pg8::bf16_t*)(ws + WS_VT)};
          pg8::Gemm g_{(const pg8::bf16_t*)(ws + WS_XN), (const pg8::bf16_t*)(ws + WS_WIN), MP, NIN_A, DM, DM, DM}; pg8::StaticOrder S_; S_.init(MP, NIN_A, F.G, (int)((blockIdx.x + 101) % gridDim.x));
          pg8::gemm_phase<pg8::EpiWin, pg8::StaticOrder, true, true>(F.lds + RING_OFF, g_, S_, E); }
        xcd_barrier(bar);
        { FRAME_REFRESH(); const unsigned* a = (const unsigned*)(ws + WS_Q); const unsigned* b = (const unsigned*)(ws + WS_BIG + 165 * MiB); unsigned bad = 0;
          for (size_t i = (size_t)blockIdx.x * 512 + F.tid; i < (size_t)MP * 2560 / 2; i += (size_t)gridDim.x * 512) bad += (a[i] != b[i]) ? 1u : 0u;
          if (bad) atomicAdd((unsigned*)(F.ctl + 900), bad); }
        xcd_barrier(bar);
    }
#endif
    if (IN(5)) { FRAME_REFRESH(); lora_a_pass(F, args);
#ifdef MK_PROBE_BAR
        xcd_barrier(bar); xcd_barrier(bar); xcd_barrier(bar); xcd_barrier(bar);
#endif
    } SEAM(5);
    if (IN(6)) { pg8::EpiLora E{(pg8::bf16_t*)(ws + WS_LW), (pg8::bf16_t*)(ws + WS_AA), (pg8::bf16_t*)(ws + WS_GG), inp(10), inp(12)}; FRAME_REFRESH(); { const int gw = F.vcu * NWAVES + F.wave, NGW = F.G * NWAVES; for (int it = gw; it < 96; it += NGW) meta_lora(F, it); }
        int kl_ = 256; asm volatile("" : "+s"(kl_)); GEMM_RUN(pg8::EpiLora, E, ws + WS_LA, 256, ws + WS_WL, 256, MR, 1536, kl_); } SEAM(6);
    if (IN(7)) { FRAME_REFRESH();
        { RwRaw raw; { const int it0 = (int)blockIdx.x, bh0 = it0 / RW_NCH; rw_load_raw(raw, F, bh0 >> 3, bh0 & 7, it0 - bh0 * RW_NCH); }
          for (int it = (int)blockIdx.x; it < 32 * RW_NCH; it += F.G) { const int bh = it / RW_NCH, c = it - bh * RW_NCH; const int itn = it + F.G, bhn = itn / RW_NCH, cn = itn < 32 * RW_NCH ? itn - bhn * RW_NCH : -1;
              rwkv_item(F, bh >> 3, bh & 7, c, raw, bhn >> 3, bhn & 7, cn); } }
        xcd_barrier(bar);
#ifdef MK_TIME_PHASE
        if (blockIdx.x == 0 && threadIdx.x == 0) ((unsigned long long*)(ws + 16384))[21] = __builtin_amdgcn_s_memrealtime();
#endif
        FRAME_REFRESH();
#ifdef MK_SKIP_CHAIN
        if ((int)blockIdx.x < 64) { if (F.G == 12345) rwkv_chain_wg(F, (int)blockIdx.x >> 1, (int)blockIdx.x & 1); }
#else
        if ((int)blockIdx.x < 64) { rwkv_chain_wg(F, (int)blockIdx.x >> 1, (int)blockIdx.x & 1);
#ifdef MK_TIME_PHASE
            if (blockIdx.x == 0 && threadIdx.x == 0) ((unsigned long long*)(ws + 16384))[23] = __builtin_amdgcn_s_memrealtime();
#endif
        }
#endif
#ifdef MK_SKIP_ATT
        else if (false) {
#else
        else {
#endif
            const int gw = ((int)blockIdx.x - 64) * NWAVES + F.wave, NGW = (F.G - 64) * NWAVES;
            for (int it = gw; it < NB * 8 * (SEQL / 32); it += NGW) { const int head = it & 7, qb = (it >> 3) & 255, b = it >> 11; attn_item(F, args, b, head, qb); }
#ifdef MK_TIME_PHASE
            if (blockIdx.x == MK_TS_WG && threadIdx.x == 0) ((unsigned long long*)(ws + 16384))[24] = __builtin_amdgcn_s_memrealtime();
            if (F.lane == 0 && F.wave == MK_TS_WAVE) atomicMax((unsigned long long*)(ws + 16384) + 26, (unsigned long long)__builtin_amdgcn_s_memrealtime());
#endif
#ifndef MK_SKIP_CONV
            convert_late_weights(F, args, gw, NGW, F.lds);
#endif
#ifdef MK_TIME_PHASE
            if (blockIdx.x == MK_TS_WG && threadIdx.x == 0) ((unsigned long long*)(ws + 16384))[25] = __builtin_amdgcn_s_memrealtime();
            if (F.lane == 0) atomicMax((unsigned long long*)(ws + 16384) + 27, (unsigned long long)__builtin_amdgcn_s_memrealtime());
#endif
            }
        xcd_barrier(bar);
#ifdef MK_TIME_PHASE
        if (blockIdx.x == 0 && threadIdx.x == 0) ((unsigned long long*)(ws + 16384))[22] = __builtin_amdgcn_s_memrealtime();
#endif
        FRAME_REFRESH();
        { const int gw = (int)blockIdx.x * NWAVES + F.wave, NGW = F.G * NWAVES;
          constexpr int T_ = 32 * 128 * 2; OutRaw R;
          if (gw < T_) rwkv_out_load(R, F, gw >> 8, ((gw >> 1) & 127) + 1, gw & 1);
          for (int it = gw; it < T_; it += NGW) { const int ti = it & 1, c = ((it >> 1) & 127) + 1, bh = it >> 8; const int itn = it + NGW < T_ ? it + NGW : it;
              OutRaw N; rwkv_out_load(N, F, itn >> 8, ((itn >> 1) & 127) + 1, itn & 1);
              rwkv_out(F, R, bh, c, ti); R = N; } }
    }
    SEAM(7);
    if (IN(8)) {
        static_assert(WS_WRWKV == WS_WATT + (size_t)DM * 512 * 2, "branch weights adjacent");
        { pg8::EpiPlain E{(pg8::bf16_t*)(ws + WS_GATES), DM, 4, (size_t)MR * DM};
          pg8::Gemm g_{(const pg8::bf16_t*)(ws + WS_Q), (const pg8::bf16_t*)(ws + WS_WATT), MR, 2 * DM, 512, 512, 512, (const pg8::bf16_t*)(ws + WS_F), 4}; pg8::StaticOrder S_; S_.init(MR, 2 * DM, F.G, (int)blockIdx.x);
          pg8::gemm_phase<pg8::EpiPlain, pg8::StaticOrder, true, true>(F.lds + RING_OFF, g_, S_, E); }
    } SEAM(8);
    if (IN(9)) { pg8::EpiGateMerge E{(const float*)(ws + WS_RS2), (pg8::bf16_t*)(ws + WS_MERGED), (const pg8::bf16_t*)(ws + WS_GATES), (const pg8::bf16_t*)(ws + WS_GATES) + (size_t)MR * DM};
        GEMM_RUN(pg8::EpiGateMerge, E, (unsigned char*)F.out, DM, ws + WS_WIN + (size_t)NIN_A * DM * 2, DM, MR, 2048, DM); } SEAM(9);
    if (IN(10)) { pg8::EpiFSS E{(pg8::bf16_t*)(ws + WS_F), (float*)(ws + WS_SS)}; GEMM_RUN(pg8::EpiFSS, E, ws + WS_MERGED, DM, ws + WS_WMIX, DM, MR, DM, DM); } SEAM(10);
#ifdef MK_GEMM_CHECK
    if (IN(10)) { xcd_barrier(bar);
        { pg8::EpiFSS E{(pg8::bf16_t*)(ws + WS_BIG + 192 * MiB), (float*)(ws + WS_BIG + 256 * MiB)}; pg8::Gemm g_{(const pg8::bf16_t*)(ws + WS_MERGED), (const pg8::bf16_t*)(ws + WS_WMIX), MR, DM, DM, DM, DM}; pg8::StaticOrder S_; S_.init(MR, DM, F.G, (int)((blockIdx.x + 37) % gridDim.x));
          pg8::gemm_phase<pg8::EpiFSS, pg8::StaticOrder, true, true>(F.lds + RING_OFF, g_, S_, E); }
        xcd_barrier(bar);
        { FRAME_REFRESH(); const unsigned* a = (const unsigned*)(ws + WS_F); const unsigned* b = (const unsigned*)(ws + WS_BIG + 192 * MiB); unsigned bad = 0;
          for (size_t i = (size_t)blockIdx.x * 512 + F.tid; i < (size_t)MR * DM / 2; i += (size_t)gridDim.x * 512) bad += (a[i] != b[i]) ? 1u : 0u;
          if (bad) atomicAdd((unsigned*)(F.ctl + 900), bad); }
    }
#endif
    if (IN(11)) { FRAME_REFRESH(); row_pass<1>(F, args, inp(23), inp(24), 1.0f); } SEAM(11);
    if (IN(12)) { pg8::EpiSwiGLU E{(pg8::bf16_t*)(ws + WS_HID), (const float*)(ws + WS_RS3)}; GEMM_RUN(pg8::EpiSwiGLU, E, ws + WS_H2, DM, ws + WS_WGU2, DM, MR, NHID2, DM); } SEAM(12);
    if (IN(13)) { pg8::EpiFSS E{(pg8::bf16_t*)(ws + WS_F), (float*)(ws + WS_SS)}; GEMM_RUN(pg8::EpiFSS, E, ws + WS_HID, DFF, ws + WS_WD2, DFF, MR, DM, DFF); } SEAM(13);
    if (IN(14)) { FRAME_REFRESH(); row_pass<2>(F, args, inp(27), inp(27), 0.5f); }
#if defined(MK_GEMM_CHECK) || defined(MK_COH_TEST) || defined(MK_GEMM_CHECK4) || defined(MK_GATE_CHECK) || defined(MK_GATE_SCAN)
    { xcd_barrier(bar); if (blockIdx.x == 0 && threadIdx.x == 0) { const unsigned nb = __hip_atomic_load((unsigned*)(F.ctl + 900), __ATOMIC_RELAXED, __HIP_MEMORY_SCOPE_AGENT); const unsigned nc = __hip_atomic_load((unsigned*)(F.ctl + 901), __ATOMIC_RELAXED, __HIP_MEMORY_SCOPE_AGENT); if (nb) F.out[0] = 1.0e4f; if (nc) { const unsigned msk = __hip_atomic_load((unsigned*)(F.ctl + 902), __ATOMIC_RELAXED, __HIP_MEMORY_SCOPE_AGENT); F.out[1] = 1.0e6f + 1000.f * (float)nc; F.out[2] = 1.0e10f * (float)msk; } } }
#endif
#ifdef MK_ITEM_PROF
    if (blockIdx.x == 0 && threadIdx.x == 0) F.out[0] = 0.001f * (float)((const unsigned long long*)(ws + 32768))[MK_ITEM_PROF];
#endif
#ifdef MK_TIME_PHASE
    if (blockIdx.x == 0 && threadIdx.x == 0) { const unsigned long long* ts = (const unsigned long long*)(ws + 16384); const unsigned long long te = __builtin_amdgcn_s_memrealtime();
        const int kk_ = MK_TIME_PHASE; unsigned long long t0_ = ts[kk_ < 20 ? kk_ : 7], t1 = kk_ == 14 ? te : ts[(kk_ < 20 ? kk_ : 7) + 1];
        if (kk_ == 20) t1 = ts[21]; if (kk_ == 21) { t0_ = ts[21]; t1 = ts[22]; } if (kk_ == 22) t0_ = ts[22]; if (kk_ >= 23 && kk_ <= 27) { t0_ = ts[21]; t1 = ts[kk_]; }
#ifdef MK_TIME_CUM
        t0_ = ts[0];
#endif
        F.out[0] = MK_TIME_SCALE * (float)(t1 - t0_); }
#endif
#ifdef MK_DUMP
    xcd_barrier(bar); dump_phase(ws, F.out);
#endif
#undef IN
#undef SEAM
#undef GEMM_RUN
}


extern "C" void kernel_launch(void* const* d_in, const int* in_sizes, int n_in, void* d_out, int out_size, void* d_ws, size_t ws_size, hipStream_t stream) {
    static int grid = 0;
    if (grid == 0) {
        if (n_in != 28 || in_sizes[0] != MR * DM || out_size != MR * DM || ws_size < WS_END) { fprintf(stderr, "kernel_launch: unexpected shapes / workspace (n_in %d, in0 %d, out %d, ws %zu, need %zu); nothing launched\n", n_in, n_in > 0 ? in_sizes[0] : -1, out_size, ws_size, (size_t)WS_END); grid = -1; return; }
        int dev = 0, cus = 0, per_cu = 0;
        if (hipGetDevice(&dev) != hipSuccess || hipDeviceGetAttribute(&cus, hipDeviceAttributeMultiprocessorCount, dev) != hipSuccess) { grid = -1; return; }
        if (hipFuncSetAttribute((const void*)hybrid_fwd, hipFuncAttributeMaxDynamicSharedMemorySize, LDS_BYTES) != hipSuccess) { fprintf(stderr, "kernel_launch: hipFuncSetAttribute failed\n"); grid = -1; return; }
        if (hipOccupancyMaxActiveBlocksPerMultiprocessor(&per_cu, (const void*)hybrid_fwd, NWAVES * 64, LDS_BYTES) != hipSuccess || per_cu < 1) { fprintf(stderr, "kernel_launch: occupancy query reports %d workgroups per CU\n", per_cu); per_cu = 1; }
        (void)hipGetLastError();
        grid = cus;
        if (grid < 64) { fprintf(stderr, "kernel_launch: %d CUs: too few\n", grid); grid = -1; return; }
    }
    if (grid < 0) return;
    if (hipMemsetAsync((char*)d_ws + WS_CTL, 0, CTL_ZERO_BYTES, stream) != hipSuccess) return;
    Args a{};
    for (int i = 0; i < 28; ++i) a.in[i] = (const float*)d_in[i];
    a.out = (float*)d_out; a.ws = (unsigned char*)d_ws;
#ifndef MK_LAST_PHASE
#define MK_LAST_PHASE (N_PHASES - 1)
#endif
    for (int li = 0; li < N_LAUNCHES && li <= MK_LAST_PHASE; ++li) {
        if (N_LAUNCHES == 1) { a.ph_lo = 0; a.ph_hi = MK_LAST_PHASE + 1; } else { a.ph_lo = li; a.ph_hi = li + 1; }
        a.li = li;
        hipLaunchKernelGGL(hybrid_fwd, dim3(grid), dim3(NWAVES * 64), LDS_BYTES, stream, a);
        const hipError_t le = hipPeekAtLastError();
        if (le != hipSuccess) { fprintf(stderr, "kernel_launch: launch %d failed: %s\n", li, hipGetErrorName(le)); break; }
    }
}
```

```cpp
#include <hip/hip_runtime.h>
#include <cstdio>
#include <cstdint>

namespace pg8 {
#define PG8_LAS __attribute__((address_space(3)))
typedef unsigned short bf16_t;
typedef short bf16x8 __attribute__((ext_vector_type(8)));
typedef float f32x4 __attribute__((ext_vector_type(4)));
typedef unsigned u32x4 __attribute__((ext_vector_type(4)));
constexpr int BM = 256, BK = 64, HALF = 128, HTB = HALF * BK * 2  , STAGE_BYTES = 8 * HTB, NXCD = 8, WGM = 8;

__host__ __device__ __forceinline__ int lds_byte(int r, int c) { const int st = (r >> 4) * 2 + (c >> 5), rr = r & 15, cc = c & 31, ob = rr * 64 + cc * 2; return st * 1024 + (ob ^ (((ob >> 9) & 1) << 5)); }
__host__ __device__ __forceinline__ void stage_rc(int b, int& R, int& C) { const int st = b / 1024, sb = b % 1024, swz = sb ^ (((sb >> 9) & 1) << 5); R = (st >> 1) * 16 + swz / 64; C = (st & 1) * 32 + (swz % 64) / 2; }
__host__ __device__ __forceinline__ int perm32(int rho) { const int n = rho >> 4, i = rho & 15; return 8 * (i >> 2) + 4 * n + (i & 3); }

struct Unit { int pm, pn; };
struct Gemm { const bf16_t* A; const bf16_t* Bt; int M, N, K, lda, ldb; const bf16_t* A2 = nullptr; int nsplit = 1 << 30; };

struct StaticOrder {
    int nM, nN, nwg, G, c;
    __host__ __device__ void init(int M, int N, int G_, int c_) { nM = M / BM; nN = N / BM; nwg = nM * nN; G = G_; c = c_; }
    __host__ __device__ bool next(int i, Unit& u) const {
        const long L = (long)i * G + c; if (L >= nwg) return false;
        int wgid = (int)L; { const int q = nwg / NXCD, r = nwg % NXCD, xcd = wgid % NXCD, off = wgid / NXCD; wgid = (xcd < r ? xcd * (q + 1) : r * (q + 1) + (xcd - r) * q) + off; }
        const int nig = WGM * nN, gid = wgid / nig, fm = gid * WGM, gsz = (nM - fm) < WGM ? (nM - fm) : WGM;
        u.pm = fm + ((wgid % nig) % gsz); u.pn = (wgid % nig) / gsz; return true;
    }
    __device__ __forceinline__ void a_ready(const Unit&) const {}
    __device__ __forceinline__ void done(const Unit&) const {}
};

typedef float f32x2_cv __attribute__((ext_vector_type(2))); typedef __bf16 bf16x2_cv __attribute__((ext_vector_type(2)));
__device__ __forceinline__ unsigned cvt_pk_bf16(float lo, float hi) { const f32x2_cv v = {lo, hi}; const bf16x2_cv b = __builtin_convertvector(v, bf16x2_cv); return __builtin_bit_cast(unsigned, b); }
typedef float f32x2 __attribute__((ext_vector_type(2)));
#define EPI_IDS int t_ = threadIdx.x; asm volatile("" : "+v"(t_)); const int wr = t_ >> 8, wc = (t_ >> 6) & 3, fr = t_ & 15, fq = (t_ >> 4) & 3; (void)wr_; (void)wc_; (void)fr_; (void)fq_
__device__ __forceinline__ u32x4 pack8(const f32x4 a, const f32x4 b) { u32x4 w; w.x = cvt_pk_bf16(a[0], a[1]); w.y = cvt_pk_bf16(a[2], a[3]); w.z = cvt_pk_bf16(b[0], b[1]); w.w = cvt_pk_bf16(b[2], b[3]); return w; }
__device__ __forceinline__ float bf_lo(unsigned w) { return __builtin_bit_cast(float, w << 16); }
__device__ __forceinline__ float bf_hi(unsigned w) { return __builtin_bit_cast(float, w & 0xffff0000u); }
__device__ __forceinline__ float sigmoidf_(float x) { return __builtin_amdgcn_rcpf(1.0f + __expf(-x)); }
__device__ __forceinline__ float siluf_(float x) { return x * sigmoidf_(x); }

struct EpiSwiGLU {
    static constexpr bool PERM = true, AFTER_DRAIN = false, PRE = true;
    bf16_t* H;
    const float* RS;
    __device__ __forceinline__ void pre(const Unit& u, int wr, int fr, float (&rsv)[8]) const {
#pragma unroll
        for (int i = 0; i < 8; ++i) rsv[i] = RS ? RS[u.pm * BM + wr * 64 + fr + (i >> 2) * HALF + (i & 3) * 16] : 1.f;
    }
    __device__ __forceinline__ void operator()(const f32x4 (&acc)[2][2][4][2], const Unit& u, int wr_, int wc_, int fr_, int fq_, const float (&rsv)[8]) const {
        EPI_IDS;
        const int row0 = u.pm * BM + wr * 64 + fr, col = u.pn * HALF + wc * 32 + 8 * fq;
#pragma unroll
        for (int ai = 0; ai < 2; ++ai)
#pragma unroll
            for (int m = 0; m < 4; ++m) { const float rs = rsv[4 * ai + m];
                const f32x4 g0 = acc[ai][0][m][0] * rs, g1 = acc[ai][0][m][1] * rs, u0 = acc[ai][1][m][0] * rs, u1 = acc[ai][1][m][1] * rs;
                f32x4 h0, h1;
#pragma unroll
                for (int j = 0; j < 4; ++j) { h0[j] = siluf_(g0[j]) * u0[j]; h1[j] = siluf_(g1[j]) * u1[j]; }
                *(u32x4*)(H + (size_t)(row0 + ai * HALF + m * 16) * 2816 + col) = pack8(h0, h1);
            }
    }
};
struct EpiFSS {
    static constexpr bool PERM = true, AFTER_DRAIN = false, PRE = false;
    bf16_t* Fo; float* SS;
    __device__ __forceinline__ void operator()(const f32x4 (&acc)[2][2][4][2], const Unit& u, int wr_, int wc_, int fr_, int fq_) const {
        EPI_IDS;
        const int row0 = u.pm * BM + wr * 64 + fr, col = u.pn * BM + wc * 32 + 8 * fq;
#pragma unroll
        for (int ai = 0; ai < 2; ++ai)
#pragma unroll
            for (int m = 0; m < 4; ++m) {
                const int row = row0 + ai * HALF + m * 16; float ss = 0.f;
#pragma unroll
                for (int bj = 0; bj < 2; ++bj) { const f32x4 v0 = acc[ai][bj][m][0], v1 = acc[ai][bj][m][1];
                    ss += (v0[0] * v0[0] + v0[1] * v0[1]) + (v0[2] * v0[2] + v0[3] * v0[3]) + (v1[0] * v1[0] + v1[1] * v1[1]) + (v1[2] * v1[2] + v1[3] * v1[3]);
                    *(u32x4*)(Fo + (size_t)row * 1024 + col + bj * HALF) = pack8(v0, v1); }
                ss += __shfl_xor(ss, 16); ss += __shfl_xor(ss, 32);
                if (fq == 0) SS[((size_t)u.pn * 33024 + row) * 4 + wc] = ss;
            }
    }
};
struct EpiWin {
    static constexpr bool PERM = true, AFTER_DRAIN = false, PRE = true;
    const float* RS;
    __device__ __forceinline__ void pre(const Unit& u, int wr, int fr, float (&rsv)[8]) const {
#pragma unroll
        for (int i = 0; i < 8; ++i) rsv[i] = RS ? RS[u.pm * BM + wr * 64 + fr + (i >> 2) * HALF + (i & 3) * 16] : 1.f;
    }
    bf16_t* Q; bf16_t* KV; bf16_t* ZR; const float* rope; int MR; bf16_t* VT;
    __device__ __forceinline__ void operator()(const f32x4 (&acc)[2][2][4][2], const Unit& u, int wr_, int wc_, int fr_, int fq_, const float (&rsv)[8]) const {
        EPI_IDS;
        const int row0 = u.pm * BM + wr * 64 + fr, pn = u.pn;
        bf16_t* base; int ld, colt;
        if (pn < 2) { base = Q; ld = 512; colt = pn * 256; } else if (pn == 2) { base = KV; ld = 256; colt = 0; } else { base = ZR; ld = 1792; colt = (pn - 3) * 256; }
        const bool rope_lane = (pn <= 2) && ((wc & 1) == 0) && (fq < 2);
        f32x4 css[2][4], sns[2][4];
#pragma unroll
        for (int ai = 0; ai < 2; ++ai)
#pragma unroll
            for (int m = 0; m < 4; ++m) { css[ai][m] = (f32x4){1.f, 1.f, 1.f, 1.f}; sns[ai][m] = (f32x4){0.f, 0.f, 0.f, 0.f};
                if (rope_lane) { const int row = row0 + ai * HALF + m * 16; const int pos = row < MR ? (row & 8191) + 16 : (row < MR + 16 ? row - MR : 0);
                    css[ai][m] = *(const f32x4*)(rope + pos * 16 + 4 * fq); sns[ai][m] = *(const f32x4*)(rope + pos * 16 + 8 + 4 * fq); } }
#pragma unroll
        for (int ai = 0; ai < 2; ++ai)
#pragma unroll
            for (int m = 0; m < 4; ++m) {
                const int row = row0 + ai * HALF + m * 16;
                const f32x4 cs = css[ai][m], sn = sns[ai][m];
#pragma unroll
                for (int bj = 0; bj < 2; ++bj) { f32x4 v0 = acc[ai][bj][m][0] * rsv[4 * ai + m], v1 = acc[ai][bj][m][1] * rsv[4 * ai + m];
                    if (rope_lane && (pn < 2 || bj == 0)) { const f32x4 x1 = v0, x2 = v1; v0 = x1 * cs - x2 * sn; v1 = x2 * cs + x1 * sn; }
                    const u32x4 pk = pack8(v0, v1);
                    if (pn == 2 && bj == 1) {
                        const int dv = wc * 32 + 8 * fq, pos = (row & 8191) + 16; bf16_t* vt = VT + (((size_t)((row >> 13) * 2 + (dv >> 6)) * 513 + (pos >> 4)) * 64 + (dv & 63)) * 16 + (pos & 15);
#pragma unroll
                        for (int j = 0; j < 8; ++j) vt[j * 16] = (bf16_t)((j & 1) ? (pk[j >> 1] >> 16) : (pk[j >> 1] & 0xffffu));
                    } else *(u32x4*)(base + (size_t)row * ld + colt + bj * HALF + wc * 32 + 8 * fq) = pk; }
                asm volatile("" ::: "memory");
            }
    }
};
struct EpiLora {
    static constexpr bool PERM = true, AFTER_DRAIN = false, PRE = false;
    bf16_t* LW; bf16_t* Aa; bf16_t* Gg; const float* w0; const float* a0;
    __device__ __forceinline__ void operator()(const f32x4 (&acc)[2][2][4][2], const Unit& u, int wr_, int wc_, int fr_, int fq_) const {
        EPI_IDS;
        const int row0 = u.pm * BM + wr * 64 + fr, pn = u.pn, kind = pn >> 1, colt = (pn & 1) * 256 + wc * 32 + 8 * fq;
#pragma unroll
        for (int bj = 0; bj < 2; ++bj) {
            const int col = colt + bj * HALF;
            f32x4 b0 = (f32x4){0.f, 0.f, 0.f, 0.f}, b1 = b0;
            if (kind == 0) { b0 = *(const f32x4*)(w0 + col); b1 = *(const f32x4*)(w0 + col + 4); }
            else if (kind == 1) { b0 = *(const f32x4*)(a0 + col); b1 = *(const f32x4*)(a0 + col + 4); }
#pragma unroll
            for (int ai = 0; ai < 2; ++ai)
#pragma unroll
                for (int m = 0; m < 4; ++m) {
                    const int row = row0 + ai * HALF + m * 16;
                    f32x4 v0 = acc[ai][bj][m][0] + b0, v1 = acc[ai][bj][m][1] + b1;
                    if (kind == 0) {
#pragma unroll
                        for (int j = 0; j < 4; ++j) { v0[j] = -0.6065306597126334f * sigmoidf_(v0[j]); v1[j] = -0.6065306597126334f * sigmoidf_(v1[j]); }
                        *(u32x4*)(LW + (size_t)row * 512 + col) = pack8(v0, v1);
                    } else if (kind == 1) {
#pragma unroll
                        for (int j = 0; j < 4; ++j) { v0[j] = sigmoidf_(v0[j]); v1[j] = sigmoidf_(v1[j]); }
                        *(u32x4*)(Aa + (size_t)row * 512 + col) = pack8(v0, v1);
                    } else {
                        *(u32x4*)(Gg + (size_t)row * 512 + col) = pack8(v0, v1);
                    }
                    asm volatile("" ::: "memory");
                }
        }
    }
};
struct EpiGates {
    static constexpr bool PERM = true, AFTER_DRAIN = false, PRE = false;
    bf16_t* Go;
    __device__ __forceinline__ void operator()(const f32x4 (&acc)[2][2][4][2], const Unit& u, int wr_, int wc_, int fr_, int fq_) const {
        EPI_IDS;
        const int row0 = u.pm * BM + wr * 64 + fr, col = u.pn * BM + wc * 32 + 8 * fq;
#pragma unroll
        for (int ai = 0; ai < 2; ++ai)
#pragma unroll
            for (int m = 0; m < 4; ++m)
#pragma unroll
                for (int bj = 0; bj < 2; ++bj) { f32x4 v0 = acc[ai][bj][m][0], v1 = acc[ai][bj][m][1];
#pragma unroll
                    for (int j = 0; j < 4; ++j) { v0[j] = sigmoidf_(v0[j]); v1[j] = sigmoidf_(v1[j]); }
                    *(u32x4*)(Go + (size_t)(row0 + ai * HALF + m * 16) * 2048 + col + bj * HALF) = pack8(v0, v1); }
    }
};
template <bool SECOND> struct EpiBranch {
    static constexpr bool PERM = true, AFTER_DRAIN = false, PRE = false;
    bf16_t* Mg; const bf16_t* Gt;
    __device__ __forceinline__ void operator()(const f32x4 (&acc)[2][2][4][2], const Unit& u, int wr_, int wc_, int fr_, int fq_) const {
        EPI_IDS;
        const int row0 = u.pm * BM + wr * 64 + fr, col = u.pn * BM + wc * 32 + 8 * fq;
#pragma unroll
        for (int ai = 0; ai < 2; ++ai)
#pragma unroll
            for (int m = 0; m < 4; ++m)
#pragma unroll
                for (int bj = 0; bj < 2; ++bj) {
                    const size_t row = (size_t)(row0 + ai * HALF + m * 16);
                    const u32x4 gw = *(const u32x4*)(Gt + row * 2048 + col + bj * HALF);
                    f32x4 v0 = acc[ai][bj][m][0], v1 = acc[ai][bj][m][1];
                    v0[0] *= bf_lo(gw.x); v0[1] *= bf_hi(gw.x); v0[2] *= bf_lo(gw.y); v0[3] *= bf_hi(gw.y);
                    v1[0] *= bf_lo(gw.z); v1[1] *= bf_hi(gw.z); v1[2] *= bf_lo(gw.w); v1[3] *= bf_hi(gw.w);
                    u32x4* dst = (u32x4*)(Mg + row * 1024 + col + bj * HALF);
                    if (SECOND) { const u32x4 pw = *dst;
                        v0[0] += bf_lo(pw.x); v0[1] += bf_hi(pw.x); v0[2] += bf_lo(pw.y); v0[3] += bf_hi(pw.y);
                        v1[0] += bf_lo(pw.z); v1[1] += bf_hi(pw.z); v1[2] += bf_lo(pw.w); v1[3] += bf_hi(pw.w); }
                    *dst = pack8(v0, v1);
                    asm volatile("" ::: "memory");
                }
    }
};
struct EpiMerge {
    static constexpr bool PERM = true, AFTER_DRAIN = false, PRE = false;
    bf16_t* Mg; const bf16_t* Gt; unsigned* cnt;
    __device__ __forceinline__ void operator()(const f32x4 (&acc)[2][2][4][2], const Unit& u, int wr_, int wc_, int fr_, int fq_) const {
        EPI_IDS;
        const int row0 = u.pm * BM + wr * 64 + fr, col = u.pn * HALF + wc * 32 + 8 * fq;
#pragma unroll
        for (int ai = 0; ai < 2; ++ai)
#pragma unroll
            for (int m = 0; m < 4; ++m) {
                const size_t row = (size_t)(row0 + ai * HALF + m * 16);
#ifdef MK_GATE_SC
                u32x4 ga, gr;
                { const unsigned long long* pa = (const unsigned long long*)(Gt + row * 2048 + col); const unsigned long long* pr = (const unsigned long long*)(Gt + row * 2048 + 1024 + col);
                  const unsigned long long a0_ = __hip_atomic_load(pa, __ATOMIC_RELAXED, __HIP_MEMORY_SCOPE_SYSTEM), a1_ = __hip_atomic_load(pa + 1, __ATOMIC_RELAXED, __HIP_MEMORY_SCOPE_SYSTEM);
                  const unsigned long long r0_ = __hip_atomic_load(pr, __ATOMIC_RELAXED, __HIP_MEMORY_SCOPE_SYSTEM), r1_ = __hip_atomic_load(pr + 1, __ATOMIC_RELAXED, __HIP_MEMORY_SCOPE_SYSTEM);
                  ga.x = (unsigned)a0_; ga.y = (unsigned)(a0_ >> 32); ga.z = (unsigned)a1_; ga.w = (unsigned)(a1_ >> 32); gr.x = (unsigned)r0_; gr.y = (unsigned)(r0_ >> 32); gr.z = (unsigned)r1_; gr.w = (unsigned)(r1_ >> 32); }
#else
                const u32x4 ga = *(const u32x4*)(Gt + row * 2048 + col), gr = *(const u32x4*)(Gt + row * 2048 + 1024 + col);
#endif
#ifdef MK_GATE_CHECK
                { const float gmx = fmaxf(fmaxf(fmaxf(bf_lo(ga.x), bf_hi(ga.x)), fmaxf(bf_lo(ga.y), bf_hi(ga.y))), fmaxf(fmaxf(bf_lo(gr.z), bf_hi(gr.z)), fmaxf(bf_lo(gr.w), bf_hi(gr.w))));
                  const float gmn = fminf(fminf(fminf(bf_lo(ga.x), bf_hi(ga.x)), fminf(bf_lo(ga.y), bf_hi(ga.y))), fminf(fminf(bf_lo(gr.z), bf_hi(gr.z)), fminf(bf_lo(gr.w), bf_hi(gr.w))));
                  if (gmx > 1.001f || gmn < 0.f) atomicAdd(cnt, 1u); }
#endif
                const f32x4 a0 = acc[ai][0][m][0], a1 = acc[ai][0][m][1], r0 = acc[ai][1][m][0], r1 = acc[ai][1][m][1];
                f32x4 v0, v1;
                v0[0] = a0[0] * bf_lo(ga.x) + r0[0] * bf_lo(gr.x); v0[1] = a0[1] * bf_hi(ga.x) + r0[1] * bf_hi(gr.x); v0[2] = a0[2] * bf_lo(ga.y) + r0[2] * bf_lo(gr.y); v0[3] = a0[3] * bf_hi(ga.y) + r0[3] * bf_hi(gr.y);
                v1[0] = a1[0] * bf_lo(ga.z) + r1[0] * bf_lo(gr.z); v1[1] = a1[1] * bf_hi(ga.z) + r1[1] * bf_hi(gr.z); v1[2] = a1[2] * bf_lo(ga.w) + r1[2] * bf_lo(gr.w); v1[3] = a1[3] * bf_hi(ga.w) + r1[3] * bf_hi(gr.w);
                *(u32x4*)(Mg + row * 1024 + col) = pack8(v0, v1);
                asm volatile("" ::: "memory");
            }
    }
};
struct EpiPlain {
    static constexpr bool PERM = true, AFTER_DRAIN = false, PRE = false;
    bf16_t* O; int ldc; int npl; size_t plane;
    __device__ __forceinline__ void operator()(const f32x4 (&acc)[2][2][4][2], const Unit& u, int wr_, int wc_, int fr_, int fq_) const {
        EPI_IDS;
        const int row0 = u.pm * BM + wr * 64 + fr, col = (u.pn % npl) * BM + wc * 32 + 8 * fq; bf16_t* O = this->O + (size_t)(u.pn / npl) * plane;
#pragma unroll
        for (int ai = 0; ai < 2; ++ai)
#pragma unroll
            for (int m = 0; m < 4; ++m)
#pragma unroll
                for (int bj = 0; bj < 2; ++bj) *(u32x4*)(O + (size_t)(row0 + ai * HALF + m * 16) * ldc + col + bj * HALF) = pack8(acc[ai][bj][m][0], acc[ai][bj][m][1]);
    }
};
struct EpiGateMerge {
    static constexpr bool PERM = true, AFTER_DRAIN = false, PRE = true;
    const float* RS;
    __device__ __forceinline__ void pre(const Unit& u, int wr, int fr, float (&rsv)[8]) const {
#pragma unroll
        for (int i = 0; i < 8; ++i) rsv[i] = RS ? RS[u.pm * BM + wr * 64 + fr + (i >> 2) * HALF + (i & 3) * 16] : 1.f;
    }
    bf16_t* Mg; const bf16_t* Y1; const bf16_t* Y2;
    __device__ __forceinline__ void operator()(const f32x4 (&acc)[2][2][4][2], const Unit& u, int wr_, int wc_, int fr_, int fq_, const float (&rsv)[8]) const {
        EPI_IDS;
        const int row0 = u.pm * BM + wr * 64 + fr, col = u.pn * HALF + wc * 32 + 8 * fq;
        u32x4 y1s[2][4], y2s[2][4];
#pragma unroll
        for (int ai = 0; ai < 2; ++ai)
#pragma unroll
            for (int m = 0; m < 4; ++m) { const size_t o = (size_t)(row0 + ai * HALF + m * 16) * 1024 + col; y1s[ai][m] = *(const u32x4*)(Y1 + o); y2s[ai][m] = *(const u32x4*)(Y2 + o); }
#pragma unroll
        for (int ai = 0; ai < 2; ++ai)
#pragma unroll
            for (int m = 0; m < 4; ++m) {
                const size_t o = (size_t)(row0 + ai * HALF + m * 16) * 1024 + col;
                const u32x4 y1 = y1s[ai][m], y2 = y2s[ai][m];
                const float rs = rsv[4 * ai + m];
                const f32x4 a0 = acc[ai][0][m][0] * rs, a1 = acc[ai][0][m][1] * rs, r0 = acc[ai][1][m][0] * rs, r1 = acc[ai][1][m][1] * rs;
                f32x4 v0, v1;
                v0[0] = sigmoidf_(a0[0]) * bf_lo(y1.x) + sigmoidf_(r0[0]) * bf_lo(y2.x); v0[1] = sigmoidf_(a0[1]) * bf_hi(y1.x) + sigmoidf_(r0[1]) * bf_hi(y2.x);
                v0[2] = sigmoidf_(a0[2]) * bf_lo(y1.y) + sigmoidf_(r0[2]) * bf_lo(y2.y); v0[3] = sigmoidf_(a0[3]) * bf_hi(y1.y) + sigmoidf_(r0[3]) * bf_hi(y2.y);
                v1[0] = sigmoidf_(a1[0]) * bf_lo(y1.z) + sigmoidf_(r1[0]) * bf_lo(y2.z); v1[1] = sigmoidf_(a1[1]) * bf_hi(y1.z) + sigmoidf_(r1[1]) * bf_hi(y2.z);
                v1[2] = sigmoidf_(a1[2]) * bf_lo(y1.w) + sigmoidf_(r1[2]) * bf_lo(y2.w); v1[3] = sigmoidf_(a1[3]) * bf_hi(y1.w) + sigmoidf_(r1[3]) * bf_hi(y2.w);
                *(u32x4*)(Mg + o) = pack8(v0, v1);
                asm volatile("" ::: "memory");
            }
    }
};
template <class Epi, class Sched, bool ALIGN_EPI = false, bool SP2 = false>
__device__ __forceinline__ void gemm_phase(PG8_LAS unsigned char* lds, const Gemm g, const Sched& S, const Epi& E) {
    int tid_ = threadIdx.x; asm volatile("" : "+v"(tid_));
    const int tid = tid_, wid = __builtin_amdgcn_readfirstlane(tid >> 6), lane = tid & 63, wr = wid >> 2, wc = wid & 3, fr = lane & 15, fq = lane >> 4;
    const int K = g.K, nt = K / BK;
    unsigned voffA[2], voffB[2];
#pragma unroll
    for (int i = 0; i < 2; ++i) { int R, C; stage_rc(tid * 16 + i * 8192, R, C); const int Rb = Epi::PERM ? ((R & ~31) + perm32(R & 31)) : R;
        voffA[i] = (unsigned)(R * g.lda + C) * 2u; voffB[i] = (unsigned)(Rb * g.ldb + C) * 2u; }
    const size_t kstep = (size_t)(BK * 2);
    const size_t hstepA = (size_t)HALF * g.lda * 2, hstepB = (size_t)HALF * g.ldb * 2;
    const size_t tstepA = 2 * hstepA, tstepB = 2 * hstepB;
    const unsigned ldsw = (unsigned)wid * 1024u;
    const int aoff = lds_byte(wr * 64 + fr, fq * 8), boff = lds_byte(wc * 32 + fr, fq * 8);
#define PG8_SA(b, h) (((b) * 2 + (h)) * HTB)
#define PG8_SB(b, h) ((4 + (b) * 2 + (h)) * HTB)
#define PG8_STAGE(bufoff, gbase, voff) do { _Pragma("unroll") for (int _i = 0; _i < 2; ++_i) \
        __builtin_amdgcn_global_load_lds((const unsigned*)((const char*)(gbase) + (voff)[_i]), (PG8_LAS unsigned*)(lds + (bufoff) + ldsw + _i * 8192), 16, 0, 0); } while (0)
#define PG8_LDA(dst, b, h) do { _Pragma("unroll") for (int m = 0; m < 4; ++m) _Pragma("unroll") for (int k = 0; k < 2; ++k) dst[m][k] = *(const PG8_LAS bf16x8*)(lds + PG8_SA(b, h) + aoff + m * 2048 + k * 1024); } while (0)
#define PG8_LDB(dst, b, h) do { _Pragma("unroll") for (int n = 0; n < 2; ++n) _Pragma("unroll") for (int k = 0; k < 2; ++k) dst[n][k] = *(const PG8_LAS bf16x8*)(lds + PG8_SB(b, h) + boff + n * 2048 + k * 1024); } while (0)
#define PG8_MMA(ai, bj, At, Bt) do { __builtin_amdgcn_s_setprio(1); _Pragma("unroll") for (int m = 0; m < 4; ++m) _Pragma("unroll") for (int n = 0; n < 2; ++n) _Pragma("unroll") for (int k = 0; k < 2; ++k) \
        acc[ai][bj][m][n] = __builtin_amdgcn_mfma_f32_16x16x32_bf16(Bt[n][k], At[m][k], acc[ai][bj][m][n], 0, 0, 0); __builtin_amdgcn_s_setprio(0); } while (0)
#define PG8_WAIT_V(n) asm volatile("s_waitcnt vmcnt(" #n ")" ::: "memory")
#define PG8_WAIT_L(n) asm volatile("s_waitcnt lgkmcnt(" #n ")" ::: "memory")
#define PG8_BAR __builtin_amdgcn_s_barrier()
#define PG8_SCHED __builtin_amdgcn_sched_barrier(0)
    Unit cur, nxt; int ui = 0;
    if (!S.next(0, cur)) return;
    f32x4 acc[2][2][4][2];
#pragma unroll
    for (int a = 0; a < 2; ++a)
#pragma unroll
        for (int b = 0; b < 2; ++b)
#pragma unroll
            for (int m = 0; m < 4; ++m)
#pragma unroll
                for (int n = 0; n < 2; ++n) acc[a][b][m][n] = (f32x4){0.f, 0.f, 0.f, 0.f};
    bf16x8 At[4][2], B0[2][2], B1[2][2];
    const char* cA = (const char*)(cur.pn >= g.nsplit ? g.A2 : g.A) + (size_t)cur.pm * tstepA; const char* cB = (const char*)g.Bt + (size_t)cur.pn * tstepB;
    S.a_ready(cur);
    float rsv[8]; if constexpr (Epi::PRE) E.pre(cur, wr, fr, rsv);
    if constexpr (SP2) {
        PG8_STAGE(PG8_SB(0, 0), cB, voffB); PG8_STAGE(PG8_SB(0, 1), cB + hstepB, voffB); PG8_STAGE(PG8_SA(0, 0), cA, voffA); PG8_STAGE(PG8_SA(0, 1), cA + hstepA, voffA);
        if (wr == 1) PG8_BAR;
        PG8_WAIT_V(2); PG8_BAR;
        PG8_STAGE(PG8_SB(1, 0), cB + kstep, voffB); PG8_STAGE(PG8_SA(1, 0), cA + kstep, voffA); PG8_STAGE(PG8_SB(1, 1), cB + hstepB + kstep, voffB);
        PG8_WAIT_V(6); PG8_BAR;
    } else {
        PG8_STAGE(PG8_SB(0, 0), cB, voffB); PG8_STAGE(PG8_SA(0, 0), cA, voffA); PG8_STAGE(PG8_SB(0, 1), cB + hstepB, voffB); PG8_STAGE(PG8_SA(0, 1), cA + hstepA, voffA);
        if (wr == 1) PG8_BAR;
        PG8_WAIT_V(4); PG8_BAR;
        PG8_STAGE(PG8_SB(1, 0), cB + kstep, voffB); PG8_STAGE(PG8_SA(1, 0), cA + kstep, voffA); PG8_STAGE(PG8_SB(1, 1), cB + hstepB + kstep, voffB);
        PG8_WAIT_V(6); PG8_BAR;
    }
    for (;;) {
        const bool has_next = S.next(ui + 1, nxt);
        const char* nA = has_next ? (const char*)(nxt.pn >= g.nsplit ? g.A2 : g.A) + (size_t)nxt.pm * tstepA : cA; const char* nB = has_next ? (const char*)g.Bt + (size_t)nxt.pn * tstepB : cB;
        for (int t = 0; t < nt; t += 2) {
            const bool last = (t == nt - 2);
            const char* a1 = cA + (size_t)(t + 1) * kstep;
            const char* a2 = last ? nA : cA + (size_t)(t + 2) * kstep; const char* b2 = last ? nB : cB + (size_t)(t + 2) * kstep;
            const char* a3 = a2 + kstep; const char* b3 = b2 + kstep;
            if (last && has_next) S.a_ready(nxt);
            if constexpr (SP2) {
            PG8_LDB(B0, 0, 0); PG8_LDB(B1, 0, 1); PG8_SCHED; PG8_LDA(At, 0, 0); PG8_STAGE(PG8_SA(1, 1), a1 + hstepA, voffA);
            PG8_WAIT_V(8); PG8_WAIT_L(0); PG8_BAR; PG8_MMA(0, 0, At, B0); PG8_MMA(0, 1, At, B1); PG8_BAR; PG8_SCHED;
            PG8_LDA(At, 0, 1); PG8_STAGE(PG8_SB(0, 0), b2, voffB); PG8_STAGE(PG8_SB(0, 1), b2 + hstepB, voffB); PG8_STAGE(PG8_SA(0, 0), a2, voffA);
            PG8_WAIT_V(8); PG8_WAIT_L(0); PG8_BAR; PG8_MMA(1, 0, At, B0); PG8_MMA(1, 1, At, B1); PG8_BAR; PG8_SCHED;
            PG8_LDB(B0, 1, 0); PG8_LDB(B1, 1, 1); PG8_SCHED; PG8_LDA(At, 1, 0); PG8_STAGE(PG8_SA(0, 1), a2 + hstepA, voffA);
            PG8_WAIT_V(8); PG8_WAIT_L(0); PG8_BAR; PG8_MMA(0, 0, At, B0); PG8_MMA(0, 1, At, B1); PG8_BAR; PG8_SCHED;
            PG8_LDA(At, 1, 1); PG8_STAGE(PG8_SB(1, 0), b3, voffB); PG8_STAGE(PG8_SB(1, 1), b3 + hstepB, voffB); PG8_STAGE(PG8_SA(1, 0), a3, voffA);
            PG8_WAIT_V(8); PG8_WAIT_L(0); PG8_BAR; PG8_MMA(1, 0, At, B0); PG8_MMA(1, 1, At, B1); PG8_BAR; PG8_SCHED;
            } else {
            PG8_LDB(B0, 0, 0); PG8_SCHED; PG8_LDA(At, 0, 0); PG8_STAGE(PG8_SA(1, 1), a1 + hstepA, voffA);
            PG8_WAIT_L(8); PG8_BAR; PG8_WAIT_L(0); PG8_MMA(0, 0, At, B0); PG8_BAR; PG8_SCHED;
            PG8_LDB(B1, 0, 1); PG8_STAGE(PG8_SB(0, 0), b2, voffB);
            PG8_BAR; PG8_WAIT_L(0); PG8_MMA(0, 1, At, B1); PG8_BAR;
            PG8_LDA(At, 0, 1); PG8_STAGE(PG8_SA(0, 0), a2, voffA);
            PG8_BAR; PG8_WAIT_L(0); PG8_MMA(1, 0, At, B0); PG8_BAR; PG8_SCHED;
            PG8_STAGE(PG8_SB(0, 1), b2 + hstepB, voffB);
            PG8_WAIT_V(6); PG8_BAR; PG8_MMA(1, 1, At, B1); PG8_BAR;
            PG8_LDB(B0, 1, 0); PG8_SCHED; PG8_LDA(At, 1, 0); PG8_STAGE(PG8_SA(0, 1), a2 + hstepA, voffA);
            PG8_WAIT_L(8); PG8_BAR; PG8_WAIT_L(0); PG8_MMA(0, 0, At, B0); PG8_BAR; PG8_SCHED;
            PG8_LDB(B1, 1, 1); PG8_STAGE(PG8_SB(1, 0), b3, voffB);
            PG8_BAR; PG8_WAIT_L(0); PG8_MMA(0, 1, At, B1); PG8_BAR;
            PG8_LDA(At, 1, 1); PG8_STAGE(PG8_SA(1, 0), a3, voffA);
            PG8_BAR; PG8_WAIT_L(0); PG8_MMA(1, 0, At, B0); PG8_BAR; PG8_SCHED;
            PG8_STAGE(PG8_SB(1, 1), b3 + hstepB, voffB);
            PG8_WAIT_V(6); PG8_BAR; PG8_MMA(1, 1, At, B1); PG8_BAR;
            }
        }
        if constexpr (ALIGN_EPI) { if (wr == 0) PG8_BAR; }
        if constexpr (!Epi::AFTER_DRAIN) { if constexpr (Epi::PRE) E(acc, cur, wr, wc, fr, fq, rsv); else E(acc, cur, wr, wc, fr, fq); S.done(cur); }
        if (!has_next) break;
#pragma unroll
        for (int a = 0; a < 2; ++a)
#pragma unroll
            for (int b = 0; b < 2; ++b)
#pragma unroll
                for (int m = 0; m < 4; ++m)
#pragma unroll
                    for (int n = 0; n < 2; ++n) acc[a][b][m][n] = (f32x4){0.f, 0.f, 0.f, 0.f};
        cur = nxt; cA = nA; cB = nB; ++ui;
        if constexpr (Epi::PRE) E.pre(cur, wr, fr, rsv);
        if constexpr (ALIGN_EPI) { if (wr == 1) PG8_BAR; }
    }
    PG8_WAIT_V(0);
    if constexpr (!ALIGN_EPI) { if (wr == 0) PG8_BAR; }
    PG8_BAR;
    if constexpr (Epi::AFTER_DRAIN) { E.fused(acc, cur, wr, wc, fr, fq, lds, wid, lane); S.done(cur); }
#undef PG8_SA
#undef PG8_SB
#undef PG8_STAGE
#undef PG8_LDA
#undef PG8_LDB
#undef PG8_MMA
#undef PG8_WAIT_V
#undef PG8_WAIT_L
#undef PG8_BAR
#undef PG8_SCHED
}
}

constexpr int NWAVES = 8;
constexpr int DM = 1024, NB = 4, SEQL = 8192, NMETA = 16, DFF = 2816;
constexpr int MR = NB * SEQL;
constexpr int MP = MR + 256;
constexpr int NHID2 = 2 * DFF;
constexpr int NIN = 4608, NIN_A = 2560;
#ifndef MK_GN_EPS
#define MK_GN_EPS 64e-5f
#endif
constexpr float NORM_EPS = 1e-6f, GN_EPS = MK_GN_EPS;

constexpr size_t MiB = 1u << 20;
constexpr size_t WS_CTL = 0, CTL_ZERO_BYTES = 64 * 1024;
constexpr size_t WS_WGU1 = 128 * 1024;
constexpr size_t WS_WD1  = WS_WGU1 + (size_t)NHID2 * DM * 2;
constexpr size_t WS_WIN  = WS_WD1 + (size_t)DM * DFF * 2;
constexpr size_t WS_WBR = WS_WIN + (size_t)NIN * DM * 2;
constexpr size_t WS_WATT = WS_WBR, WS_WRWKV = WS_WBR + (size_t)DM * 512 * 2;
constexpr size_t WS_WMIX = WS_WBR + (size_t)2048 * DM * 2;
constexpr size_t WS_WGU2 = WS_WMIX + (size_t)DM * DM * 2;
constexpr size_t WS_WD2  = WS_WGU2 + (size_t)NHID2 * DM * 2;
constexpr size_t WS_WL   = WS_WD2 + (size_t)DM * DFF * 2;
constexpr size_t WS_ROPE = WS_WL + (size_t)1536 * 256 * 2;
constexpr size_t WS_SS   = WS_ROPE + (size_t)8208 * 16 * 4;
constexpr size_t WS_HMETA = WS_SS + (size_t)MP * 16 * 4;
constexpr size_t WS_SMALL_END = WS_HMETA + 16 * 1024 * 4;
constexpr size_t WS_XN = 52 * MiB;
constexpr size_t WS_HM = WS_XN, WS_RS2 = WS_XN + 1 * MiB, WS_RS3 = WS_XN + 2 * MiB;
constexpr size_t WS_F  = WS_XN + (size_t)MP * DM * 2;
constexpr size_t WS_BIG = WS_F + (size_t)MP * DM * 2;
constexpr size_t WS_HID = WS_BIG;
constexpr size_t WS_Q  = WS_BIG;
constexpr size_t WS_KV = WS_Q + (size_t)MP * 512 * 2;
constexpr size_t WS_ZR = WS_KV + (size_t)MP * 256 * 2;
constexpr size_t WS_LW = WS_ZR + (size_t)MP * 1792 * 2;
constexpr size_t WS_AA = WS_LW + (size_t)MP * 512 * 2;
constexpr size_t WS_GG = WS_AA + (size_t)MP * 512 * 2;
constexpr size_t WS_LA = WS_GG + (size_t)MP * 512 * 2;
constexpr size_t WS_MIX_END = WS_LA + (size_t)MP * 256 * 2;
constexpr size_t WS_QY = WS_LA;
constexpr size_t WS_SST = WS_LW;
constexpr size_t WS_DOTS = WS_SS;
static_assert(WS_QY + (size_t)4128 * 16384 <= 512 * MiB && (size_t)4128 * 8192 <= (size_t)MP * 512 * 4, "rwkv images");
constexpr size_t WS_GATES = WS_LW;
constexpr size_t WS_MERGED = WS_ZR;
constexpr size_t WS_VT = 503 * MiB + 512 * 1024;
constexpr int PV = 8208;
constexpr size_t WS_END = 512 * MiB;
static_assert(WS_QY + (size_t)4128 * 16384 <= WS_VT && WS_VT + (size_t)NB * 2 * 64 * PV * 2 <= WS_END, "VT");
static_assert(WS_SMALL_END <= WS_XN && WS_HID + (size_t)MP * DFF * 2 <= WS_END && WS_MIX_END <= WS_END && WS_MERGED + (size_t)MR * DM * 2 <= WS_LW && WS_GATES + (size_t)MR * 2048 * 2 <= WS_END, "d_ws map");
constexpr int CW_LASTCHUNK = 10240;
constexpr int CW_BAR = 1024;

constexpr int RING_OFF = 0, RING_BYTES = 131072;
constexpr int LDSCTL_OFF = RING_BYTES, MISC_OFF = LDSCTL_OFF + 320;
constexpr int LDS_BYTES = 147456;

#define GAS __attribute__((address_space(1)))
#define LAS __attribute__((address_space(3)))
typedef unsigned short bf16;
typedef unsigned v4u __attribute__((ext_vector_type(4)));
typedef unsigned v2u __attribute__((ext_vector_type(2)));
typedef float f32x4 __attribute__((ext_vector_type(4)));
typedef float f32x2v __attribute__((ext_vector_type(2)));
typedef float f32x16 __attribute__((ext_vector_type(16)));
typedef short bf16x8 __attribute__((ext_vector_type(8)));
typedef GAS unsigned gu32;
#define RLX_AGENT __ATOMIC_RELAXED, __HIP_MEMORY_SCOPE_AGENT
#define LDS_WAIT() asm volatile("s_waitcnt lgkmcnt(0)" ::: "memory")
#define VM_WAIT() asm volatile("s_waitcnt vmcnt(0)" ::: "memory")
__device__ __forceinline__ unsigned pk2(float lo, float hi) { return pg8::cvt_pk_bf16(lo, hi); }
__device__ __forceinline__ unsigned f2bf(float f) { return pg8::cvt_pk_bf16(f, 0.f) & 0xffffu; }
__device__ __forceinline__ float bflo(unsigned w) { return __builtin_bit_cast(float, w << 16); }
__device__ __forceinline__ float bfhi(unsigned w) { return __builtin_bit_cast(float, w & 0xffff0000u); }
__device__ __forceinline__ float bf1(bf16 h) { return __builtin_bit_cast(float, (unsigned)h << 16); }
__device__ __forceinline__ float sigm(float x) { return 1.0f / (1.0f + __expf(-x)); }

#define XB_TMO      128
#define XB_XCNT(j)  (256  + 64 * (j))
#define XB_XSUB(j)  (1280 + 64 * (j))
#define XB_XGEN(j)  (2304 + 64 * (j))
#define XB_TOP      3328
#define XB_TOPGEN   3392
#define XCD_BAR_WORDS 3456
#define XB_SPIN_CAP (1u << 24)

__device__ __forceinline__ unsigned xb_ld(unsigned* p)              { return __hip_atomic_load(p, __ATOMIC_RELAXED, __HIP_MEMORY_SCOPE_AGENT); }
__device__ __forceinline__ unsigned xb_add(unsigned* p, unsigned v) { return __hip_atomic_fetch_add(p, v, __ATOMIC_RELAXED, __HIP_MEMORY_SCOPE_AGENT); }
__device__ __forceinline__ unsigned xb_xcc_id() { return (unsigned)__builtin_amdgcn_s_getreg((3 << 11) | 20) & 0xFu; }
#define XB_SPIN(cond, bar) do { unsigned _sp = 0; while (cond) { __builtin_amdgcn_s_sleep(1); \
    if ((++_sp & 255u) == 0u) { if (xb_ld(&(bar)[XB_TMO])) break; if (_sp > XB_SPIN_CAP) { atomicAdd(&(bar)[XB_TMO], 1u); break; } } } } while (0)

struct XcdBarrier {
    unsigned* bar; unsigned x;
    volatile LAS unsigned* st;
};

__device__ __forceinline__ XcdBarrier xcd_barrier_post(unsigned* bar, volatile LAS unsigned* st) {
    XcdBarrier b; b.bar = bar; b.x = xb_xcc_id(); b.st = st;
    if (threadIdx.x == 0) (void)xb_add(&bar[XB_XCNT(b.x)], 1u);
    return b;
}
__device__ __forceinline__ void xcd_barrier_complete(unsigned* bar, unsigned x, unsigned& nloc, unsigned& nx) {
    const unsigned G = gridDim.x * gridDim.y * gridDim.z;
    unsigned sum, cnt, mine, sp = 0u;
    for (;;) {
        sum = 0u; cnt = 0u; mine = 0u;
#pragma unroll
        for (unsigned j = 0; j < 16; ++j) { const unsigned c = xb_ld(&bar[XB_XCNT(j)]); sum += c; cnt += (c > 0u) ? 1u : 0u; mine = (j == x) ? c : mine; }
        if (sum == G) break;
        __builtin_amdgcn_s_sleep(1);
        if ((++sp & 255u) == 0u) { if (xb_ld(&bar[XB_TMO])) break; if (sp > XB_SPIN_CAP) { atomicAdd(&bar[XB_TMO], 1u); break; } }
    }
    nloc = mine > 0u ? mine : 1u; nx = cnt > 0u ? cnt : 1u;
}

__device__ __forceinline__ void xcd_barrier(const XcdBarrier& b) {
    asm volatile("s_waitcnt vmcnt(0)" ::: "memory");
    __syncthreads();
    if (threadIdx.x == 0) {
        unsigned* bar = b.bar;
        __builtin_amdgcn_s_waitcnt(0);
        unsigned nloc = b.st[0], nx = b.st[1];
        if (nloc == 0u) { xcd_barrier_complete(bar, b.x, nloc, nx); b.st[0] = nloc; b.st[1] = nx; }
        const unsigned old = xb_add(&bar[XB_XSUB(b.x)], 1u);
        const unsigned gen = old / nloc;
        if (old + 1u == (gen + 1u) * nloc) {
            __builtin_amdgcn_fence(__ATOMIC_RELEASE, "");
            asm volatile("s_waitcnt vmcnt(0)" ::: "memory");
            const unsigned og = xb_add(&bar[XB_TOP], 1u);
            const unsigned tg = og / nx;
            if (og + 1u == (tg + 1u) * nx) xb_add(&bar[XB_TOPGEN], 1u);
            else XB_SPIN(xb_ld(&bar[XB_TOPGEN]) == tg, bar);
            __builtin_amdgcn_fence(__ATOMIC_ACQUIRE, "");
            xb_add(&bar[XB_XGEN(b.x)], 1u);
            asm volatile("s_waitcnt vmcnt(0)" ::: "memory");
        } else {
            XB_SPIN(xb_ld(&bar[XB_XGEN(b.x)]) == gen, bar);
            __builtin_amdgcn_fence(__ATOMIC_ACQUIRE, "");
            asm volatile("s_waitcnt vmcnt(0)" ::: "memory");
        }
    }
    __syncthreads();
}


struct Frame {
    LAS unsigned char* lds;
    volatile LAS unsigned* MISC;
    gu32* ctl;
    int tid, lane, wave;
    int vcu, G;
    float* out; unsigned char* ws;
};
struct Args { const float* in[28]; float* out; unsigned char* ws; int ph_lo, ph_hi, li, pad; };
__device__ __forceinline__ const float* inp(int k) {
    typedef const float* cfp;
    const __attribute__((address_space(4))) char* kp = (const __attribute__((address_space(4))) char*)__builtin_amdgcn_kernarg_segment_ptr();
    return *(volatile const __attribute__((address_space(4))) cfp*)(kp + 8 * k);
}
__device__ __forceinline__ float wave_sum(float v) {
#pragma unroll
    for (int o = 1; o < 64; o <<= 1) v += __shfl_xor(v, o);
    return v;
}

__device__ __forceinline__ float dpp_f(float v, const int ctrl_sel) {
    const int x = __builtin_bit_cast(int, v); int r;
    if (ctrl_sel == 0) r = __builtin_amdgcn_update_dpp(0, x, 0xB1, 0xF, 0xF, true);
    else if (ctrl_sel == 1) r = __builtin_amdgcn_update_dpp(0, x, 0x4E, 0xF, 0xF, true);
    else r = __builtin_amdgcn_update_dpp(0, x, 0x141, 0xF, 0xF, true);
    return __builtin_bit_cast(float, r);
}
__device__ __forceinline__ float wave_sum_dpp(float v) {
    v += dpp_f(v, 0); v += dpp_f(v, 1); v += dpp_f(v, 2);
    { const int x = __builtin_bit_cast(int, v); v += __builtin_bit_cast(float, __builtin_amdgcn_update_dpp(0, x, 0x140, 0xF, 0xF, true)); }
    const int xi = __builtin_bit_cast(int, v);
    return (__builtin_bit_cast(float, __builtin_amdgcn_readlane(xi, 0)) + __builtin_bit_cast(float, __builtin_amdgcn_readlane(xi, 16))) + (__builtin_bit_cast(float, __builtin_amdgcn_readlane(xi, 32)) + __builtin_bit_cast(float, __builtin_amdgcn_readlane(xi, 48)));
}
struct MapId { __device__ __forceinline__ int operator()(int n) const { return n; } };
struct MapGateUp { __device__ __forceinline__ int operator()(int n) const { return n < DFF ? 256 * (n >> 7) + (n & 127) : 256 * ((n - DFF) >> 7) + 128 + ((n - DFF) & 127); } };
struct MapBrA { __device__ __forceinline__ int operator()(int n) const { return 256 * (n >> 7) + (n & 127); } };
struct MapBrR { __device__ __forceinline__ int operator()(int n) const { return 256 * (n >> 7) + 128 + (n & 127); } };
struct MapWin { __device__ __forceinline__ int operator()(int n) const { if (n >= 2560) { const int j = n - 2560; return j < 1024 ? 2560 + 256 * (j >> 7) + (j & 127) : 2560 + 256 * ((j - 1024) >> 7) + 128 + ((j - 1024) & 127); } if (n >= 640) return n; const int s = n & 63; if (s >= 16) return n; const int d = (s >= 4 && s < 8) ? s + 4 : ((s >= 8 && s < 12) ? s - 4 : s); return n - s + d; } };
template <class Map>
__device__ __forceinline__ void p0_transpose_item(const float* W, int K, int N, bf16* WT, LAS float* scr, int item, int lane, Map map, const float* kgain = nullptr) {
    const int ldk = K, kofs = 0;
    const int nblk = N / 32, kb = item / nblk, nb = item % nblk, k0 = 64 * kb, n0 = 32 * nb;
#pragma unroll 8
    for (int i = 0; i < 32; ++i) { const int kk = 2 * i + (lane >> 5); scr[kk * 33 + (lane & 31)] = W[(size_t)(k0 + kk) * N + n0 + (lane & 31)]; }
    LDS_WAIT(); asm volatile("" ::: "memory");
    const int c = lane & 7;
    f32x4 ga = (f32x4){1.f, 1.f, 1.f, 1.f}, gb = ga; if (kgain) { ga = *(const f32x4*)(kgain + k0 + 8 * c); gb = *(const f32x4*)(kgain + k0 + 8 * c + 4); }
#pragma unroll
    for (int j = 0; j < 4; ++j) { const int n = (lane >> 3) + 8 * j; const LAS float* s = scr + (8 * c) * 33 + n;
        v4u o; o.x = pk2(s[0 * 33] * ga.x, s[1 * 33] * ga.y); o.y = pk2(s[2 * 33] * ga.z, s[3 * 33] * ga.w); o.z = pk2(s[4 * 33] * gb.x, s[5 * 33] * gb.y); o.w = pk2(s[6 * 33] * gb.z, s[7 * 33] * gb.w);
        *(GAS v4u*)(WT + (size_t)map(n0 + n) * ldk + kofs + k0 + 8 * c) = o; }
    LDS_WAIT(); asm volatile("" ::: "memory");
}
__device__ __forceinline__ void rms_row_to_bf16(int lane, const float* xrow, const float* gain, bf16* orow) {
    const f32x4* xr = (const f32x4*)xrow + lane; const f32x4* gr = (const f32x4*)gain + lane;
    f32x4 v[4]; float s = 0.f;
#pragma unroll
    for (int j = 0; j < 4; ++j) { v[j] = xr[64 * j]; s += (v[j].x * v[j].x + v[j].y * v[j].y) + (v[j].z * v[j].z + v[j].w * v[j].w); }
    const float rstd = 1.f / sqrtf(wave_sum(s) * (1.f / DM) + NORM_EPS);
    v2u* o8 = (v2u*)orow + lane;
#pragma unroll
    for (int j = 0; j < 4; ++j) { const f32x4 g = gr[64 * j]; v2u w; w.x = pk2(v[j].x * rstd * g.x, v[j].y * rstd * g.y); w.y = pk2(v[j].z * rstd * g.z, v[j].w * rstd * g.w); o8[64 * j] = w; }
}
#define XN1_BASE (F.out)
__device__ __forceinline__ void p0_prologue(Frame& F, const Args& A) {
    LAS float* scr = (LAS float*)(F.lds + RING_OFF + F.wave * 16384);
    const int gw = F.vcu * NWAVES + F.wave, NGW = F.G * NWAVES;
    unsigned char* ws = F.ws;
    constexpr int I_GU = (DM / 64) * (NHID2 / 32), I_D = (DFF / 64) * (DM / 32), I_IN = (DM / 64) * (NIN / 32);
    constexpr int NITEMS = I_GU + I_D + I_IN;
    for (int it = gw; it < NITEMS; it += NGW) {
        int r = it;
        if (r < I_GU) { p0_transpose_item(inp(3), DM, NHID2, (bf16*)(ws + WS_WGU1), scr, r, F.lane, MapGateUp()); continue; } r -= I_GU;
        if (r < I_D) { p0_transpose_item(inp(4), DFF, DM, (bf16*)(ws + WS_WD1), scr, r, F.lane, MapId()); continue; } r -= I_D;
        p0_transpose_item(inp(7), DM, NIN, (bf16*)(ws + WS_WIN), scr, r, F.lane, MapWin(), inp(6));
    }
    { const int gt = (F.vcu * NWAVES + F.wave) * 64 + F.lane, NGT = NGW * 64; bf16* WL = (bf16*)(ws + WS_WL);
      for (int e = gt; e < 1536 * 256; e += NGT) { const int n = e >> 8, k = e & 255; float v = 0.f;
          if (n < 512) { if (k < 64) v = inp(11)[k * 512 + n]; }
          else if (n < 1024) { if (k >= 64 && k < 128) v = inp(13)[(k - 64) * 512 + (n - 512)]; }
          else { if (k >= 128) v = inp(14)[(k - 128) * 512 + (n - 1024)]; }
          WL[e] = (bf16)f2bf(v); }
      float* rope = (float*)(ws + WS_ROPE);
      for (int e = gt; e < 8208 * 8; e += NGT) { const int pos = e >> 3, i = e & 7;
          const double fr = i == 0 ? 1.0 : i == 1 ? 0.19392274474868576 : i == 2 ? 0.03760603093086393 : i == 3 ? 0.007292664737217109 : i == 4 ? 0.001414213562373095 : i == 5 ? 0.0002742481756762073 : i == 6 ? 5.318295896944988e-05 : 1.031338537721246e-05;
          const double ang = (double)pos * fr; const double kq = __builtin_rint(ang * 0.15915494309189535); const double red = __builtin_fma(-kq, 6.283185307179586, ang) - kq * 2.4492935982947064e-16;
          const float rf = (float)red; rope[pos * 16 + i] = cosf(rf); rope[pos * 16 + 8 + i] = sinf(rf); }
    }
    f32x4 g1[4];
#pragma unroll
    for (int j = 0; j < 4; ++j) g1[j] = ((const f32x4*)inp(2))[F.lane + 64 * j];
    for (int m0 = gw; m0 < MR + NMETA; m0 += 4 * NGW) {
        f32x4 v[4][4];
#pragma unroll
        for (int u = 0; u < 4; ++u) { const int m = m0 + u * NGW < MR + NMETA ? m0 + u * NGW : m0; const f32x4* xr = (const f32x4*)(m < MR ? inp(0) + (size_t)m * DM : inp(1) + (size_t)(m - MR) * DM) + F.lane;
#pragma unroll
            for (int j = 0; j < 4; ++j) v[u][j] = xr[64 * j]; }
#pragma unroll
        for (int u = 0; u < 4; ++u) { const int m = m0 + u * NGW; if (m < MR + NMETA) { float s = 0.f;
#pragma unroll
            for (int j = 0; j < 4; ++j) s += (v[u][j].x * v[u][j].x + v[u][j].y * v[u][j].y) + (v[u][j].z * v[u][j].z + v[u][j].w * v[u][j].w);
            const float rstd = 1.f / sqrtf(wave_sum_dpp(s) * (1.f / DM) + NORM_EPS); v2u* o8 = (v2u*)((bf16*)XN1_BASE + (size_t)m * DM) + F.lane;
#pragma unroll
            for (int j = 0; j < 4; ++j) { const f32x4 g = g1[j]; v2u w; w.x = pk2(v[u][j].x * rstd * g.x, v[u][j].y * rstd * g.y); w.y = pk2(v[u][j].z * rstd * g.z, v[u][j].w * rstd * g.w); o8[64 * j] = w; } } }
    }
}


__device__ __forceinline__ void convert_late_weights(Frame& F, const Args& A, int gw, int NGW, LAS unsigned char* ldsbase) {
    LAS float* scr = (LAS float*)(ldsbase + F.wave * 16384); unsigned char* ws = F.ws;
    constexpr int I_GU = (DM / 64) * (NHID2 / 32), I_D = (DFF / 64) * (DM / 32), I_BR = (512 / 64) * (DM / 32), I_MIX = (DM / 64) * (DM / 32);
    constexpr int NITEMS = I_GU + I_D + 2 * I_BR + I_MIX;
    for (int it = gw; it < NITEMS; it += NGW) {
        int r = it;
        if (r < I_GU) { p0_transpose_item(inp(25), DM, NHID2, (bf16*)(ws + WS_WGU2), scr, r, F.lane, MapGateUp(), inp(24)); continue; } r -= I_GU;
        if (r < I_D) { p0_transpose_item(inp(26), DFF, DM, (bf16*)(ws + WS_WD2), scr, r, F.lane, MapId()); continue; } r -= I_D;
        if (r < I_BR) { p0_transpose_item(inp(20), 512, DM, (bf16*)(ws + WS_WATT), scr, r, F.lane, MapId()); continue; } r -= I_BR;
        if (r < I_BR) { p0_transpose_item(inp(21), 512, DM, (bf16*)(ws + WS_WRWKV), scr, r, F.lane, MapId()); continue; } r -= I_BR;
        p0_transpose_item(inp(22), DM, DM, (bf16*)(ws + WS_WMIX), scr, r, F.lane, MapId());
    }
}

constexpr size_t WS_H2 = WS_BIG + 180 * MiB;
template <int MODE>
__device__ __forceinline__ void row_pass(Frame& F, const Args& A, const float* gpost, const float* gpre, float scale) {
    const int gw = F.vcu * NWAVES + F.wave, NGW = F.G * NWAVES, lane = F.lane;
    const int nrows = MODE == 0 ? MR + NMETA : MR;
    const bf16* Fb = (const bf16*)(F.ws + WS_F); const float* SS = (const float*)(F.ws + WS_SS);
    constexpr int NR = 4;
    f32x4 gpo[4], gpr[4];
#pragma unroll
    for (int j = 0; j < 4; ++j) { gpo[j] = ((const f32x4*)gpost)[lane + 64 * j]; gpr[j] = gpo[j]; }
    for (int m0 = gw; m0 < nrows; m0 += NR * NGW) {
        float ssf[NR]; v2u fw[NR][4]; f32x4 hv[NR][4]; bool on[NR];
#pragma unroll
        for (int u = 0; u < NR; ++u) { const int m = m0 + u * NGW; on[u] = m < nrows; const int mc = on[u] ? m : m0;
            ssf[u] = SS[((size_t)((lane & 15) >> 2) * MP + mc) * 4 + (lane & 3)];
#pragma unroll
            for (int j = 0; j < 4; ++j) { fw[u][j] = ((const v2u*)(Fb + (size_t)mc * DM))[lane + 64 * j];
                if (MODE == 0) hv[u][j] = ((const f32x4*)(mc < MR ? inp(0) + (size_t)mc * DM : inp(1) + (size_t)(mc - MR) * DM))[lane + 64 * j];
                else { const v2u hw = ((const v2u*)((MODE == 1 ? (const bf16*)F.out : (const bf16*)(F.ws + WS_H2)) + (size_t)mc * DM))[lane + 64 * j]; hv[u][j] = (f32x4){bflo(hw.x), bfhi(hw.x), bflo(hw.y), bfhi(hw.y)}; } } }
#pragma unroll
        for (int u = 0; u < NR; ++u) if (on[u]) { const int m = m0 + u * NGW;
            float sf = ssf[u]; sf += dpp_f(sf, 0); sf += dpp_f(sf, 1); sf += dpp_f(sf, 2); { const int x = __builtin_bit_cast(int, sf); sf += __builtin_bit_cast(float, __builtin_amdgcn_update_dpp(0, x, 0x140, 0xF, 0xF, true)); }
            if (MODE == 0 && m >= MR) { float s2 = 0.f;
#pragma unroll
                for (int j = 0; j < 4; ++j) s2 += bflo(fw[u][j].x) * bflo(fw[u][j].x) + bfhi(fw[u][j].x) * bfhi(fw[u][j].x) + bflo(fw[u][j].y) * bflo(fw[u][j].y) + bfhi(fw[u][j].y) * bfhi(fw[u][j].y);
                sf = wave_sum_dpp(s2); }
            const float rf = scale / sqrtf(sf * (1.f / DM) + NORM_EPS);
            f32x4 h[4]; float s = 0.f;
#pragma unroll
            for (int j = 0; j < 4; ++j) {
                const f32x4 g = gpo[j]; const f32x4 hq = hv[u][j];
                f32x4 r; r.x = hq.x + bflo(fw[u][j].x) * rf * g.x; r.y = hq.y + bfhi(fw[u][j].x) * rf * g.y; r.z = hq.z + bflo(fw[u][j].y) * rf * g.z; r.w = hq.w + bfhi(fw[u][j].y) * rf * g.w;
                h[j] = r; s += (r.x * r.x + r.y * r.y) + (r.z * r.z + r.w * r.w);
                if (MODE == 2) ((f32x4*)(F.out + (size_t)m * DM))[lane + 64 * j] = r;
                else { v2u w; w.x = pk2(r.x, r.y); w.y = pk2(r.z, r.w); bf16* hb = MODE == 1 ? (bf16*)(F.ws + WS_H2) + (size_t)m * DM : (m < MR ? (bf16*)F.out + (size_t)m * DM : (bf16*)(F.ws + WS_HM) + (size_t)(m - MR) * DM); ((v2u*)hb)[lane + 64 * j] = w; }
            }
            if (MODE != 2) { const float rstd = 1.f / sqrtf(wave_sum_dpp(s) * (1.f / DM) + NORM_EPS); if (lane == 0) ((float*)(F.ws + (MODE == 0 ? WS_RS2 : WS_RS3)))[m] = rstd; }
        }
    }
}

__device__ __forceinline__ int prev_row(int m) { return m < MR ? ((m & 8191) == 0 ? MR + 15 : m - 1) : (m == MR ? -1 : m - 1); }
__device__ __forceinline__ void lora_a_pass(Frame& F, const Args& A) {
    const int gw = F.vcu * NWAVES + F.wave, NGW = F.G * NWAVES, lane = F.lane;
    const bf16* ZR = (const bf16*)(F.ws + WS_ZR); bf16* LA = (bf16*)(F.ws + WS_LA); const float* mu = inp(9) + 1536;
    const f32x4 muv = ((const f32x4*)mu)[lane];
    for (int g4 = gw; 4 * g4 < MR + NMETA; g4 += NGW) { const int m0 = 4 * g4;
        v2u zc[4], zp0 = (v2u){0u, 0u};
        { const int pm = prev_row(m0); if (pm >= 0) zp0 = ((const v2u*)(ZR + (size_t)pm * 1792 + 1536))[lane]; }
#pragma unroll
        for (int u = 0; u < 4; ++u) zc[u] = ((const v2u*)(ZR + (size_t)(m0 + u) * 1792 + 1536))[lane];
#pragma unroll
        for (int u = 0; u < 4; ++u) { const int m = m0 + u; const v2u zpv = u == 0 ? zp0 : zc[u > 0 ? u - 1 : 0];
            float x[4] = {bflo(zc[u].x), bfhi(zc[u].x), bflo(zc[u].y), bfhi(zc[u].y)}; const float p[4] = {bflo(zpv.x), bfhi(zpv.x), bflo(zpv.y), bfhi(zpv.y)};
            x[0] += (p[0] - x[0]) * muv.x; x[1] += (p[1] - x[1]) * muv.y; x[2] += (p[2] - x[2]) * muv.z; x[3] += (p[3] - x[3]) * muv.w;
            if (lane < 16) {
#pragma unroll
                for (int j = 0; j < 4; ++j) x[j] = tanhf(x[j]);
            } else if (lane >= 32) {
#pragma unroll
                for (int j = 0; j < 4; ++j) x[j] = sigm(x[j]);
            }
            v2u w; w.x = pk2(x[0], x[1]); w.y = pk2(x[2], x[3]);
            ((v2u*)(LA + (size_t)m * 256))[lane] = w; }
    }
}

#ifndef MK_ATT_SCALE
#define MK_ATT_SCALE 1.0f
#endif
__device__ __forceinline__ int crow(int r, int hi) { return (r & 3) + 8 * (r >> 2) + 4 * hi; }
constexpr int AT_KP = 144, AT_VP = 80, AT_KBYTES = 32 * AT_KP;
__device__ __forceinline__ void attn_item(Frame& F, const Args& A, int b, int head, int qb) {
    const int lane = F.lane, r32 = lane & 31, hi = lane >> 5, kvh = head >> 2, t0 = qb * 32, rr = lane >> 3, ck = lane & 7;
    const bf16* Q = (const bf16*)(F.ws + WS_Q); const bf16* KV = (const bf16*)(F.ws + WS_KV); bf16* AC = (bf16*)(F.ws + WS_Q);
    LAS unsigned char* Kl = F.lds + RING_OFF + F.wave * 16384; LAS unsigned char* Vl = Kl + AT_KBYTES;
    const float sink2 = inp(8)[head] * 1.4426950408889634f;
    v4u qg[4], kg[5][4], vg[5][4];
#pragma unroll
    for (int j = 0; j < 4; ++j) qg[j] = *(const v4u*)(Q + (size_t)(b * SEQL + t0 + 8 * j + rr) * 512 + head * 64 + 8 * ck);
#pragma unroll
    for (int i = 0; i < 5; ++i)
#pragma unroll
        for (int j = 0; j < 4; ++j) { const int tk = t0 - 128 + 32 * i + 8 * j + rr;
            const size_t krow = tk >= 0 ? (size_t)(b * SEQL + tk) : (tk >= -16 ? (size_t)(MR + 16 + tk) : (size_t)MR);
            kg[i][j] = *(const v4u*)(KV + krow * 256 + kvh * 64 + 8 * ck); }
    const bf16* vtb = (const bf16*)(F.ws + WS_VT) + (size_t)(b * 2 + kvh) * (PV / 16) * 1024;
#pragma unroll
    for (int i = 0; i < 5; ++i)
#pragma unroll
        for (int j = 0; j < 4; ++j) { const int x = 64 * j + lane; int pb = ((t0 - 112 + 32 * i) >> 4) + (x >> 7); pb = pb < 0 ? 0 : pb;
            vg[i][j] = *(const v4u*)(vtb + (size_t)pb * 1024 + (x & 127) * 8); }
    __builtin_amdgcn_sched_barrier(0);
    bf16x8 qf[4];
#pragma unroll
    for (int j = 0; j < 4; ++j) *(LAS v4u*)(Kl + (8 * j + rr) * AT_KP + 16 * ck) = qg[j];
#pragma unroll
    for (int s = 0; s < 4; ++s) qf[s] = *(const LAS bf16x8*)(Kl + r32 * AT_KP + 32 * s + 16 * hi);
    f32x16 S[5];
#pragma unroll
    for (int i = 0; i < 5; ++i) {
#pragma unroll
        for (int j = 0; j < 4; ++j) *(LAS v4u*)(Kl + (8 * j + rr) * AT_KP + 16 * ck) = kg[i][j];
        bf16x8 kf[4];
#pragma unroll
        for (int s = 0; s < 4; ++s) kf[s] = *(const LAS bf16x8*)(Kl + r32 * AT_KP + 32 * s + 16 * hi);
        f32x16 a = {};
#pragma unroll
        for (int s = 0; s < 4; ++s) a = __builtin_amdgcn_mfma_f32_32x32x16_bf16(kf[s], qf[s], a, 0, 0, 0);
        S[i] = a;
    }
    const float sc = 0.125f * 1.4426950408889634f; const int dq = r32 - 4 * hi;
#pragma unroll
    for (int r = 0; r < 16; ++r) { const int cr = (r & 3) + 8 * (r >> 2);
        S[0][r] = cr > dq ? S[0][r] * sc : -1e30f; S[4][r] = cr <= dq ? S[4][r] * sc : -1e30f;
        S[1][r] *= sc; S[2][r] *= sc; S[3][r] *= sc; }
    if (t0 < 112) {
#pragma unroll
        for (int i = 0; i < 4; ++i)
#pragma unroll
            for (int r = 0; r < 16; ++r) if (t0 - 128 + 32 * i + crow(r, hi) < -16) S[i][r] = -1e30f;
    }
    float mx = sink2;
#pragma unroll
    for (int i = 0; i < 5; ++i)
#pragma unroll
        for (int r = 0; r < 16; ++r) mx = fmaxf(mx, S[i][r]);
    mx = fmaxf(mx, __shfl_xor(mx, 32));
    float sum = 0.f;
#pragma unroll
    for (int i = 0; i < 5; ++i)
#pragma unroll
        for (int r = 0; r < 16; ++r) { const float p = __builtin_amdgcn_exp2f(S[i][r] - mx); S[i][r] = p; sum += p; }
    sum += __shfl_xor(sum, 32);
    const float inv = 1.0f / (sum + __builtin_amdgcn_exp2f(sink2 - mx));
    f32x16 O0 = {}, O1 = {};
#pragma unroll
    for (int i = 0; i < 5; ++i) {
#pragma unroll
        for (int j = 0; j < 4; ++j) { const int x = 64 * j + lane; *(LAS v4u*)(Vl + ((x & 127) >> 1) * AT_VP + (x >> 7) * 32 + (x & 1) * 16) = vg[i][j]; }
#pragma unroll
        for (int s = 0; s < 2; ++s) {
            bf16x8 pa;
#pragma unroll
            for (int j = 0; j < 8; j += 2) { const unsigned w = pg8::cvt_pk_bf16(S[i][8 * s + j], S[i][8 * s + j + 1]); pa[j] = (short)(w & 0xffffu); pa[j + 1] = (short)(w >> 16); }
            const v2u a0 = *(const LAS v2u*)(Vl + r32 * AT_VP + 32 * s + 8 * hi), a1 = *(const LAS v2u*)(Vl + r32 * AT_VP + 32 * s + 16 + 8 * hi);
            const v2u c0 = *(const LAS v2u*)(Vl + (r32 + 32) * AT_VP + 32 * s + 8 * hi), c1 = *(const LAS v2u*)(Vl + (r32 + 32) * AT_VP + 32 * s + 16 + 8 * hi);
            const v4u v0 = {a0.x, a0.y, a1.x, a1.y}, v1 = {c0.x, c0.y, c1.x, c1.y};
            O0 = __builtin_amdgcn_mfma_f32_32x32x16_bf16(__builtin_bit_cast(bf16x8, v0), pa, O0, 0, 0, 0);
            O1 = __builtin_amdgcn_mfma_f32_32x32x16_bf16(__builtin_bit_cast(bf16x8, v1), pa, O1, 0, 0, 0);
        }
    }
    const float iv = inv * MK_ATT_SCALE;
#pragma unroll
    for (int g = 0; g < 4; ++g) {
        *(LAS v2u*)(Kl + r32 * AT_KP + (8 * g + 4 * hi) * 2) = (v2u){pk2(O0[4 * g] * iv, O0[4 * g + 1] * iv), pk2(O0[4 * g + 2] * iv, O0[4 * g + 3] * iv)};
        *(LAS v2u*)(Kl + r32 * AT_KP + (32 + 8 * g + 4 * hi) * 2) = (v2u){pk2(O1[4 * g] * iv, O1[4 * g + 1] * iv), pk2(O1[4 * g + 2] * iv, O1[4 * g + 3] * iv)}; }
#pragma unroll
    for (int j = 0; j < 4; ++j) *(v4u*)(AC + (size_t)(b * SEQL + t0 + 8 * j + rr) * 512 + head * 64 + 8 * ck) = *(const LAS v4u*)(Kl + (8 * j + rr) * AT_KP + 16 * ck);
}


__device__ __forceinline__ bf16x8 lora_afrag(const bf16* ZR, size_t m, long pm, int chan, const float* mu, int kind) {
    const v4u zc = *(const v4u*)(ZR + m * 1792 + chan); v4u zp = (v4u){0u, 0u, 0u, 0u}; if (pm >= 0) zp = *(const v4u*)(ZR + (size_t)pm * 1792 + chan);
    const f32x4 m0 = *(const f32x4*)(mu + chan), m1 = *(const f32x4*)(mu + chan + 4); const float mv[8] = {m0.x, m0.y, m0.z, m0.w, m1.x, m1.y, m1.z, m1.w};
    float x[8];
#pragma unroll
    for (int j = 0; j < 4; ++j) { const float c0 = bflo(zc[j]), c1 = bfhi(zc[j]), p0 = bflo(zp[j]), p1 = bfhi(zp[j]); x[2 * j] = c0 + (p0 - c0) * mv[2 * j]; x[2 * j + 1] = c1 + (p1 - c1) * mv[2 * j + 1]; }
#pragma unroll
    for (int j = 0; j < 8; ++j) x[j] = kind == 0 ? tanhf(x[j]) : (kind == 2 ? sigm(x[j]) : x[j]);
    bf16x8 r;
#pragma unroll
    for (int j = 0; j < 8; j += 2) { const unsigned w = pk2(x[j], x[j + 1]); r[j] = (short)(w & 0xffffu); r[j + 1] = (short)(w >> 16); }
    return r;
}
__device__ __forceinline__ void lora_fused(Frame& F, const Args& A) {
    const int gw = F.vcu * NWAVES + F.wave, NGW = F.G * NWAVES, lane = F.lane, r32 = lane & 31, hi = lane >> 5;
    const bf16* ZR = (const bf16*)(F.ws + WS_ZR); const bf16* WL = (const bf16*)(F.ws + WS_WL); const float* mu = inp(9);
    bf16* LW = (bf16*)(F.ws + WS_LW); bf16* AA = (bf16*)(F.ws + WS_AA); bf16* GG = (bf16*)(F.ws + WS_GG);
    constexpr int NRB = (MR + NMETA + 31) / 32;
    for (int it = gw; it < NRB * 3; it += NGW) {
        const int kind = it % 3, r0 = (it / 3) * 32, k0 = kind == 0 ? 0 : (kind == 1 ? 64 : 128), nk = kind == 2 ? 8 : 4;
        const int mrow = r0 + r32 < MR + NMETA ? r0 + r32 : MR + NMETA - 1; const long pm = prev_row(mrow);
        bf16x8 af[8];
#pragma unroll
        for (int s = 0; s < 8; ++s) af[s] = lora_afrag(ZR, (size_t)mrow, pm, 1536 + k0 + (s < nk ? 16 * s : 0) + 8 * hi, mu, kind);
        const float* bias = kind == 0 ? inp(10) : inp(12);
        const bf16* wbase = WL + (size_t)(kind * 512 + r32) * 256 + k0 + 8 * hi;
        bf16x8 bcur[8], bnxt[8];
#pragma unroll
        for (int s = 0; s < 8; ++s) bcur[s] = *(const bf16x8*)(wbase + (s < nk ? 16 * s : 0));
        for (int nb = 0; nb < 16; ++nb) {
            const bf16* wn = wbase + (size_t)((nb + 1 < 16 ? nb + 1 : nb) * 32) * 256;
#pragma unroll
            for (int s = 0; s < 8; ++s) bnxt[s] = *(const bf16x8*)(wn + (s < nk ? 16 * s : 0));
            f32x16 acc = {};
#pragma unroll
            for (int s = 0; s < 8; ++s) if (s < nk) acc = __builtin_amdgcn_mfma_f32_32x32x16_bf16(af[s], bcur[s], acc, 0, 0, 0);
            const int col = nb * 32 + r32; const float bv = kind == 2 ? 0.f : bias[col];
#pragma unroll
            for (int r = 0; r < 16; ++r) { const int row = r0 + crow(r, hi); if (row < MR + NMETA) { const size_t o = (size_t)row * 512 + col; const float v = acc[r] + bv;
                if (kind == 0) LW[o] = (bf16)f2bf(-0.6065306597126334f * sigm(v)); else if (kind == 1) AA[o] = (bf16)f2bf(sigm(v)); else GG[o] = (bf16)f2bf(v); } }
#pragma unroll
            for (int s = 0; s < 8; ++s) bcur[s] = bnxt[s];
        }
    }
}

#ifndef MK_YN_SCALE
#define MK_YN_SCALE 1.0f
#endif
#ifndef MK_BONUS_SCALE
#define MK_BONUS_SCALE 1.0f
#endif
__device__ __forceinline__ float half_sum(float v) {
    v += dpp_f(v, 0); v += dpp_f(v, 1); v += dpp_f(v, 2);
    { const int x = __builtin_bit_cast(int, v); v += __builtin_bit_cast(float, __builtin_amdgcn_update_dpp(0, x, 0x140, 0xF, 0xF, true)); }
    { const int x = __builtin_bit_cast(int, v); v += __builtin_bit_cast(float, __builtin_amdgcn_ds_swizzle(x, 0x401F)); }
    return v;
}


typedef float f32x4m __attribute__((ext_vector_type(4)));
__device__ __forceinline__ f32x4m mini16(const bf16* A16, int lda, const bf16* Brow0, int ldb, int K, int lane) {
    const int r = lane & 15, q = lane >> 4; f32x4m acc = {0.f, 0.f, 0.f, 0.f};
    const bf16* ap = A16 + (size_t)r * lda + 8 * q; const bf16* bp = Brow0 + (size_t)r * ldb + 8 * q;
#pragma unroll 8
    for (int ks = 0; ks < K / 32; ++ks) { const bf16x8 a = *(const bf16x8*)(ap + 32 * ks), b = *(const bf16x8*)(bp + 32 * ks); acc = __builtin_amdgcn_mfma_f32_16x16x32_bf16(a, b, acc, 0, 0, 0); }
    return acc;
}
template <int K, int NB>
__device__ __forceinline__ void mini16_wg(Frame& F, const bf16* A16, int lda, const bf16* B0, const bf16* B1, int ldb, f32x4m (&out)[NB]) {
    constexpr int NKS = K / 256; static_assert(K % 256 == 0 && NB >= 1 && NB <= 2, "mini16_wg");
    const int lane = F.lane, wave = F.wave, r = lane & 15, q = lane >> 4;
    const bf16* ap = A16 + (size_t)r * lda + 8 * q + 32 * NKS * wave; const bf16* bp0 = B0 + (size_t)r * ldb + 8 * q + 32 * NKS * wave; const bf16* bp1 = B1 + (size_t)r * ldb + 8 * q + 32 * NKS * wave;
    bf16x8 a[NKS], b0[NKS], b1[NKS];
#pragma unroll
    for (int ks = 0; ks < NKS; ++ks) { a[ks] = *(const bf16x8*)(ap + 32 * ks); b0[ks] = *(const bf16x8*)(bp0 + 32 * ks); if (NB == 2) b1[ks] = *(const bf16x8*)(bp1 + 32 * ks); }
    f32x4m acc0 = {0.f, 0.f, 0.f, 0.f}, acc1 = acc0;
#pragma unroll
    for (int ks = 0; ks < NKS; ++ks) { acc0 = __builtin_amdgcn_mfma_f32_16x16x32_bf16(a[ks], b0[ks], acc0, 0, 0, 0); if (NB == 2) acc1 = __builtin_amdgcn_mfma_f32_16x16x32_bf16(a[ks], b1[ks], acc1, 0, 0, 0); }
    LAS f32x4m* red = (LAS f32x4m*)(F.lds + RING_OFF);
    red[wave * 64 + lane] = acc0; if (NB == 2) red[(8 + wave) * 64 + lane] = acc1;
    __syncthreads();
    if (wave == 0) {
#pragma unroll
        for (int nb = 0; nb < NB; ++nb) { f32x4m s = red[(nb * 8) * 64 + lane];
#pragma unroll
            for (int w = 1; w < 8; ++w) s += red[(nb * 8 + w) * 64 + lane];
            out[nb] = s; } }
    __syncthreads();
}
__device__ __forceinline__ float row16_sum(float v) { v += dpp_f(v, 0); v += dpp_f(v, 1); v += dpp_f(v, 2); const int x = __builtin_bit_cast(int, v); return v + __builtin_bit_cast(float, __builtin_amdgcn_update_dpp(0, x, 0x140, 0xF, 0xF, true)); }
__device__ __forceinline__ void meta_gateup(Frame& F, const bf16* Wgu, int i) {
    const int lane = F.lane, r = lane & 15, q = lane >> 4, j0 = 16 * i; const bf16* A16 = (const bf16*)F.out + (size_t)MR * DM;
    const int grow = 256 * (j0 >> 7) + (j0 & 127);
    f32x4m gu[2]; mini16_wg<DM, 2>(F, A16, DM, Wgu + (size_t)grow * DM, Wgu + (size_t)(grow + 128) * DM, DM, gu);
    if (F.wave != 0) return;
    const f32x4m g = gu[0], u = gu[1];
    bf16* H = (bf16*)(F.ws + WS_HID);
#pragma unroll
    for (int x = 0; x < 4; ++x) H[(size_t)(MR + 4 * q + x) * DFF + j0 + r] = (bf16)f2bf(g[x] * sigm(g[x]) * u[x]);
}
__device__ __forceinline__ void meta_down(Frame& F, const bf16* Wd, int i) {
    const int lane = F.lane, r = lane & 15, q = lane >> 4, n0 = 16 * i; const bf16* A16 = (const bf16*)(F.ws + WS_HID) + (size_t)MR * DFF; bf16* Fo = (bf16*)(F.ws + WS_F);
    f32x4m av[1]; mini16_wg<DFF, 1>(F, A16, DFF, Wd + (size_t)n0 * DFF, Wd + (size_t)n0 * DFF, DFF, av);
    if (F.wave != 0) return;
    const f32x4m a = av[0];
#pragma unroll
    for (int x = 0; x < 4; ++x) Fo[(size_t)(MR + 4 * q + x) * DM + n0 + r] = (bf16)f2bf(a[x]);
}
__device__ __forceinline__ void meta_win(Frame& F, int i) {
    const int lane = F.lane, r = lane & 15, q = lane >> 4, c0 = 512 + 16 * i; const bf16* A16 = (const bf16*)(F.ws + WS_HM);
    f32x4m av[1]; mini16_wg<DM, 1>(F, A16, DM, (const bf16*)(F.ws + WS_WIN) + (size_t)c0 * DM, (const bf16*)(F.ws + WS_WIN) + (size_t)c0 * DM, DM, av);
    if (F.wave != 0) return;
    f32x4m a = av[0];
    { const float* RS = (const float*)(F.ws + WS_RS2) + MR;
#pragma unroll
      for (int x = 0; x < 4; ++x) a[x] *= RS[4 * q + x]; }
    if (c0 < 640 && (c0 & 63) == 0) {
        const float* rope = (const float*)(F.ws + WS_ROPE); const bool lo = (r & 4) == 0; const int fi = r < 8 ? (r & 3) : 4 + (r & 3);
#pragma unroll
        for (int x = 0; x < 4; ++x) { const float other = __shfl_xor(a[x], 4); const int pos = 4 * q + x; const float cs = rope[pos * 16 + fi], sn = rope[pos * 16 + 8 + fi];
            a[x] = lo ? a[x] * cs - other * sn : a[x] * cs + other * sn; }
    }
    if (c0 >= 640 && c0 < 768) {
        const int dv = c0 - 640 + r; const v2u w = {pk2(a[0], a[1]), pk2(a[2], a[3])};
#pragma unroll
        for (int b = 0; b < NB; ++b) *(v2u*)((bf16*)(F.ws + WS_VT) + ((size_t)(b * 2 + (dv >> 6)) * (PV / 16) * 64 + (dv & 63)) * 16 + 4 * q) = w;
        return; }
    bf16* dst; int ld, col;
    if (c0 < 768) { dst = (bf16*)(F.ws + WS_KV); ld = 256; col = c0 - 512; } else { dst = (bf16*)(F.ws + WS_ZR); ld = 1792; col = c0 - 768; }
#pragma unroll
    for (int x = 0; x < 4; ++x) dst[(size_t)(MR + 4 * q + x) * ld + col + r] = (bf16)f2bf(a[x]);
}
__device__ __forceinline__ void meta_lora(Frame& F, int i) {
    const int lane = F.lane, r = lane & 15, q = lane >> 4, n0 = 16 * i, kind = n0 >> 9, col = (n0 & 511) + r; const bf16* A16 = (const bf16*)(F.ws + WS_LA) + (size_t)MR * 256;
    const f32x4m a = mini16(A16, 256, (const bf16*)(F.ws + WS_WL) + (size_t)n0 * 256, 256, 256, lane);
    const float bias = kind == 0 ? inp(10)[col] : (kind == 1 ? inp(12)[col] : 0.f);
    bf16* dst = (bf16*)(F.ws + (kind == 0 ? WS_LW : (kind == 1 ? WS_AA : WS_GG)));
#pragma unroll
    for (int x = 0; x < 4; ++x) { const float v = a[x] + bias; const float o = kind == 0 ? -0.6065306597126334f * sigm(v) : (kind == 1 ? sigm(v) : v); dst[(size_t)(MR + 4 * q + x) * 512 + col] = (bf16)f2bf(o); }
}

constexpr int RW_P = 72;
constexpr int RW_NCH = 129;
constexpr int RW_AT = 0, RW_RT = 9216, RW_BT = 18432, RW_KT = 27648;
constexpr int RW_RHS = RW_BT;
constexpr int RW_VT = 36864, RW_BHT = 46080, RW_KHT = 55296, RW_WT = 64512, RW_UT = 73728;
constexpr int RW_AAB = 82944;
constexpr int RW_AAK = 99328, RW_ARB = 108544, RW_ARK = 117760;
constexpr int RW_TINV = 92160;
constexpr int RW_MISC = 126976;
static_assert(RW_MISC + 2048 + 512 <= RING_BYTES, "rwkv LDS map");
typedef short s16x4v __attribute__((ext_vector_type(4)));

__device__ __forceinline__ f32x16 rw_mm(f32x16 acc, const LAS bf16* X, int ti, const LAS bf16* Yt, int tn, int lane) {
    const LAS bf16* xp = X + (32 * ti + (lane & 31)) * RW_P + 8 * (lane >> 5); const LAS bf16* yp = Yt + (32 * tn + (lane & 31)) * RW_P + 8 * (lane >> 5);
#pragma unroll
    for (int ks = 0; ks < 4; ++ks) { const bf16x8 a = *(const LAS bf16x8*)(xp + 16 * ks), b = *(const LAS bf16x8*)(yp + 16 * ks); acc = __builtin_amdgcn_mfma_f32_32x32x16_bf16(a, b, acc, 0, 0, 0); }
    return acc;
}
__device__ __forceinline__ bf16x8 rw_pack8(const f32x16& v, int s) {
    bf16x8 r;
#pragma unroll
    for (int j = 0; j < 8; j += 2) { const unsigned w = pg8::cvt_pk_bf16(v[8 * s + j], v[8 * s + j + 1]); r[j] = (short)(w & 0xffffu); r[j + 1] = (short)(w >> 16); }
    return r;
}
__device__ __forceinline__ size_t rw_item(int bh, int c) { return (size_t)bh * RW_NCH + c; }

struct RwRaw { unsigned zr[9], zk[9], zv[9], al[8], lw[8]; float par[6]; };
__device__ __forceinline__ void rw_load_raw(RwRaw& R, Frame& F, int b, int h, int c) {
    const int ch = F.tid & 63, tg = F.tid >> 6, hc = h * 64 + ch;
    const bf16* ZR = (const bf16*)(F.ws + WS_ZR); const bf16* LW = (const bf16*)(F.ws + WS_LW); const bf16* AA = (const bf16*)(F.ws + WS_AA);
#pragma unroll
    for (int j = 0; j < 9; ++j) { const int p = 64 * c - 48 + 8 * tg + j - 1; const int pc = p < 0 ? 0 : p;
        const size_t m = pc < 16 ? (size_t)(MR + pc) : (size_t)(b * SEQL + pc - 16); const bf16* z = ZR + m * 1792 + hc;
        R.zr[j] = z[0]; R.zk[j] = z[512]; R.zv[j] = z[1024];
        if (j > 0) { R.al[j - 1] = AA[m * 512 + hc]; R.lw[j - 1] = LW[m * 512 + hc]; } }
    R.par[0] = inp(9)[hc]; R.par[1] = inp(9)[512 + hc]; R.par[2] = inp(9)[1024 + hc]; R.par[3] = inp(15)[hc]; R.par[4] = inp(16)[hc]; R.par[5] = inp(17)[hc];
}
__device__ __forceinline__ float bfw(unsigned w) { return __builtin_bit_cast(float, w << 16); }
#ifdef MK_ITEM_PROF
#define RWP(k) do { if (blockIdx.x == 0 && threadIdx.x == 0) { const unsigned long long t_ = __builtin_amdgcn_s_memrealtime(); ((unsigned long long*)(F.ws + 32768))[k] += t_ - tprev_; tprev_ = t_; } } while (0)
#elif defined(MK_ITEM_MARK)
#define RWP(k) asm volatile("; RWP_MARK " #k ::: "memory")
#else
#define RWP(k) do { } while (0)
#endif
__device__ __forceinline__ void rwkv_item(Frame& F, int b, int h, int c, RwRaw& raw, int nb, int nh, int nc) {
    constexpr int MODE = 1;
#ifdef MK_ITEM_PROF
    unsigned long long tprev_ = __builtin_amdgcn_s_memrealtime();
#endif
    const int tid = F.tid, lane = F.lane, wave = F.wave, r32 = lane & 31, hi = lane >> 5;
    LAS unsigned char* L = F.lds;
    LAS bf16* At = (LAS bf16*)(L + RW_AT); LAS bf16* Rt = (LAS bf16*)(L + RW_RT); LAS bf16* Bt = (LAS bf16*)(L + RW_BT); LAS bf16* Kt = (LAS bf16*)(L + RW_KT);
    LAS bf16* Vt = (LAS bf16*)(L + RW_VT); LAS bf16* Bht = (LAS bf16*)(L + RW_BHT); LAS bf16* Kht = (LAS bf16*)(L + RW_KHT); LAS bf16* Wt = (LAS bf16*)(L + RW_WT); LAS bf16* Ut = (LAS bf16*)(L + RW_UT);
    LAS bf16* Aab = (LAS bf16*)(L + RW_AAB); LAS bf16* RhsB = (LAS bf16*)(L + RW_RHS);
    LAS bf16* Aak = (LAS bf16*)(L + RW_AAK); LAS bf16* Arb = (LAS bf16*)(L + RW_ARB); LAS bf16* Ark = (LAS bf16*)(L + RW_ARK); LAS bf16* Qm = Aak;
    LAS float* gtot = (LAS float*)(L + RW_MISC); LAS float* dots = gtot + 512; LAS float* lend = dots + 64;
    const bf16* ZR = (const bf16*)(F.ws + WS_ZR); const bf16* LW = (const bf16*)(F.ws + WS_LW); const bf16* AA = (const bf16*)(F.ws + WS_AA);
    const int bh = b * 8 + h;
    {
        const int ch = tid & 63, tg = tid >> 6, hc = h * 64 + ch;
        const float mur = raw.par[0], muk = raw.par[1], muv = raw.par[2], kkc = raw.par[3], kac = raw.par[4], rkc = raw.par[5];
        float zr_[9], zk_[9], zv_[9], al_[8], lwr_[8];
#pragma unroll
        for (int j = 0; j < 9; ++j) { zr_[j] = bfw(raw.zr[j]); zk_[j] = bfw(raw.zk[j]); zv_[j] = bfw(raw.zv[j]); if (j > 0) { al_[j - 1] = bfw(raw.al[j - 1]); lwr_[j - 1] = bfw(raw.lw[j - 1]); } }
        if (c == 0) {
#pragma unroll
            for (int j = 0; j < 9; ++j) { const float ok = 8 * tg + j - 1 >= 48 ? 1.f : 0.f; zr_[j] *= ok; zk_[j] *= ok; zv_[j] *= ok; if (j > 0) { al_[j - 1] *= ok; lwr_[j - 1] *= ok; } } }
        if (nc >= 0) rw_load_raw(raw, F, nb, nh, nc);
        float rr[8], kq[8], km[8], vv[8], bb[8], lw8[8];
        float run = 0.f;
        float V[16];
#pragma unroll
        for (int j = 0; j < 8; ++j) {
            const float r = zr_[j + 1] + (zr_[j] - zr_[j + 1]) * mur, k = zk_[j + 1] + (zk_[j] - zk_[j + 1]) * muk, v = zv_[j + 1] + (zv_[j] - zv_[j + 1]) * muv;
            const float al = al_[j], lw = lwr_[j];
            const float q = k * kkc, kmod = k * (1.f + (al - 1.f) * kac);
            V[2 * j] = q * q; V[2 * j + 1] = r * kmod * rkc;
            rr[j] = r; kq[j] = q; km[j] = kmod; vv[j] = v; run += lw; lw8[j] = run;
        }
        {
            const int ln = F.lane; const bool b3 = (ln & 8) != 0, b2 = (ln & 4) != 0, b1 = (ln & 2) != 0, b0 = (ln & 1) != 0;
#define RS_STEP(N, BIT, CTRL) _Pragma("unroll") for (int k_ = 0; k_ < (N); ++k_) { const float mine_ = BIT ? V[k_ + (N)] : V[k_], send_ = BIT ? V[k_] : V[k_ + (N)]; \
                V[k_] = mine_ + __builtin_bit_cast(float, __builtin_amdgcn_update_dpp(0, __builtin_bit_cast(int, send_), CTRL, 0xF, 0xF, true)); }
            RS_STEP(8, b3, 0x140)
            RS_STEP(4, b2, 0x141)
            RS_STEP(2, b1, 0x1B)
            RS_STEP(1, b0, 0xB1)
#undef RS_STEP
            float x = V[0];
            x += __builtin_bit_cast(float, __builtin_amdgcn_ds_swizzle(__builtin_bit_cast(int, x), 0x401F));
            x += __shfl_xor(x, 32);
            if (ln < 16 && (ln & 1)) ((float*)(F.ws + WS_DOTS))[rw_item(bh, c) * 64 + 8 * tg + (ln >> 1)] = x;
            const float rn = __builtin_amdgcn_rsqf(fmaxf(x, 1e-24f));
#pragma unroll
            for (int j = 0; j < 8; ++j) { const float rj = __builtin_bit_cast(float, __builtin_amdgcn_readlane(__builtin_bit_cast(int, rn), 2 * j)); kq[j] *= rj; bb[j] = kq[j] * al_[j]; }
        }
        gtot[tg * 64 + ch] = run;
        __syncthreads();
        float off = 0.f, tot = 0.f;
#pragma unroll
        for (int g2 = 0; g2 < 8; ++g2) { const float x = gtot[g2 * 64 + ch]; tot += x; if (g2 < tg) off += x; }
        if (tg == 0) lend[ch] = tot;
        unsigned vt_[4], bh_[4], kh_[4];
        const float eT = __expf(tot); float ePrev = __expf(off);
#pragma unroll
        for (int j = 0; j < 8; ++j) {
            const int t = 8 * tg + j; const float Lt = off + lw8[j];
            const float eL = __expf(Lt), eP = ePrev, eN = __expf(-Lt), eE = eT * eN; ePrev = eL;
            At[t * RW_P + ch] = (bf16)f2bf(-kq[j] * eP); Rt[t * RW_P + ch] = (bf16)f2bf(rr[j] * eL); Bt[t * RW_P + ch] = (bf16)f2bf(bb[j] * eN); Kt[t * RW_P + ch] = (bf16)f2bf(km[j] * eN);
            const unsigned v_ = f2bf(vv[j]), b_ = f2bf(bb[j] * eE), k_ = f2bf(km[j] * eE);
            if (j & 1) { vt_[j >> 1] |= v_ << 16; bh_[j >> 1] |= b_ << 16; kh_[j >> 1] |= k_ << 16; } else { vt_[j >> 1] = v_; bh_[j >> 1] = b_; kh_[j >> 1] = k_; }
        }
        *(LAS v4u*)(Vt + ch * RW_P + 8 * tg) = (v4u){vt_[0], vt_[1], vt_[2], vt_[3]};
        *(LAS v4u*)(Bht + ch * RW_P + 8 * tg) = (v4u){bh_[0], bh_[1], bh_[2], bh_[3]};
        *(LAS v4u*)(Kht + ch * RW_P + 8 * tg) = (v4u){kh_[0], kh_[1], kh_[2], kh_[3]};
    }
    __syncthreads(); RWP(0);
#pragma unroll
    for (int rnd = 0; rnd < 2; ++rnd) {
        const int mat = (wave >> 2) + 2 * rnd, ti = (wave >> 1) & 1, tn = wave & 1;
        f32x16 acc = {};
        acc = rw_mm(acc, (const LAS bf16*)(L + ((mat & 1) ? RW_KT : RW_BT)), tn, (const LAS bf16*)(L + (mat < 2 ? RW_AT : RW_RT)), ti, lane);
        LAS bf16* dstm = (LAS bf16*)(L + (mat == 0 ? RW_AAB : RW_AAK + (mat - 1) * 9216));
        const int t = 32 * ti + r32, lim = t + (mat >> 1);
#pragma unroll
        for (int g = 0; g < 4; ++g) { const int sb = 32 * tn + 8 * g + 4 * hi;
            const float v0 = sb < lim ? acc[4 * g] : 0.f, v1 = sb + 1 < lim ? acc[4 * g + 1] : 0.f, v2 = sb + 2 < lim ? acc[4 * g + 2] : 0.f, v3 = sb + 3 < lim ? acc[4 * g + 3] : 0.f;
            *(LAS v2u*)(dstm + t * RW_P + sb) = (v2u){pk2(v0, v1), pk2(v2, v3)}; }
    }
    __syncthreads(); RWP(1);
    if (wave < 4) { const int ti = wave >> 1, tn = wave & 1; f32x16 acc = {}; acc = rw_mm(acc, Aak, ti, Vt, tn, lane);
#pragma unroll
        for (int g = 0; g < 4; ++g) *(LAS v2u*)(RhsB + (32 * tn + r32) * RW_P + 32 * ti + 8 * g + 4 * hi) = (v2u){pk2(acc[4 * g], acc[4 * g + 1]), pk2(acc[4 * g + 2], acc[4 * g + 3])};
    } else {
        const int d = wave & 3, cl = lane & 15, q = lane >> 4;
        const LAS bf16* Ad = Aab + (16 * d) * RW_P + 16 * d;
        f32x4m aN, aT;
#pragma unroll
        for (int r = 0; r < 4; ++r) aN[r] = bf1(Ad[(4 * q + r) * RW_P + cl]);
        { const v2u w = *(const LAS v2u*)(Ad + cl * RW_P + 4 * q); aT[0] = bflo(w.x); aT[1] = bfhi(w.x); aT[2] = bflo(w.y); aT[3] = bfhi(w.y); }
#define MM4(dst_, a_, b_, init_) { f32x4m z_ = init_; _Pragma("unroll") for (int s_ = 0; s_ < 4; ++s_) z_ = __builtin_amdgcn_mfma_f32_16x16x4f32(a_[s_], b_[s_], z_, 0, 0, 0); dst_ = z_; }
        const f32x4m zero4 = {0.f, 0.f, 0.f, 0.f};
        f32x4m a2N, a2T, a4N, a4T, a8N, b1T, b2T, b3T, iaT;
        MM4(a2N, aT, aN, zero4); MM4(a2T, aN, aT, zero4);
#pragma unroll
        for (int r = 0; r < 4; ++r) iaT[r] = aT[r] + (cl == 4 * q + r ? 1.f : 0.f);
        MM4(a4N, a2T, a2N, zero4); MM4(a4T, a2N, a2T, zero4);
        MM4(b1T, a2N, iaT, iaT);
        MM4(a8N, a4T, a4N, zero4);
        MM4(b2T, a4N, b1T, b1T);
        MM4(b3T, a8N, b2T, b2T);
#undef MM4
        *(LAS f32x4m*)(L + RW_TINV + (d * 64 + lane) * 16) = b3T;
    }
    __syncthreads(); RWP(2);
    {
        const int cl = lane & 15, q = lane >> 4, cc = (wave & 3) * 16 + cl;
        LAS bf16* xrow = (wave < 4 ? Ut : Wt) + cc * RW_P;
        f32x4m Tt[4];
#pragma unroll
        for (int b = 0; b < 4; ++b) Tt[b] = *(const LAS f32x4m*)(L + RW_TINV + (b * 64 + lane) * 16);
        unsigned xp[4][2];
#pragma unroll
        for (int b = 0; b < 4; ++b) {
            f32x4m acc;
            if (wave < 4) { const v2u w = *(const LAS v2u*)(RhsB + cc * RW_P + 16 * b + 4 * q); acc[0] = bflo(w.x); acc[1] = bfhi(w.x); acc[2] = bflo(w.y); acc[3] = bfhi(w.y); }
            else {
#pragma unroll
                for (int r = 0; r < 4; ++r) acc[r] = bf1(At[(16 * b + 4 * q + r) * RW_P + cc]); }
#pragma unroll
            for (int mq = 0; mq < 2; ++mq) if (32 * mq < 16 * b) {
                const v2u a0 = *(const LAS v2u*)(Aab + (16 * b + cl) * RW_P + 32 * mq + 4 * q), a1 = *(const LAS v2u*)(Aab + (16 * b + cl) * RW_P + 32 * mq + 16 + 4 * q);
                const bool second = 2 * mq + 1 < b;
                const v4u au = {a0.x, a0.y, a1.x, a1.y}, xu = {xp[2 * mq][0], xp[2 * mq][1], second ? xp[2 * mq + 1][0] : 0u, second ? xp[2 * mq + 1][1] : 0u};
                acc = __builtin_amdgcn_mfma_f32_16x16x32_bf16(__builtin_bit_cast(bf16x8, au), __builtin_bit_cast(bf16x8, xu), acc, 0, 0, 0);
            }
            f32x4m x = {0.f, 0.f, 0.f, 0.f};
#pragma unroll
            for (int s = 0; s < 4; ++s) x = __builtin_amdgcn_mfma_f32_16x16x4f32(Tt[b][s], acc[s], x, 0, 0, 0);
            xp[b][0] = pk2(x[0], x[1]); xp[b][1] = pk2(x[2], x[3]);
            *(LAS v2u*)(xrow + 16 * b + 4 * q) = (v2u){xp[b][0], xp[b][1]};
        }
    }
    __syncthreads(); RWP(3);
    {
        const int ti = (wave >> 1) & 1, tn = wave & 1; f32x16 acc = {};
        unsigned char* dst = F.ws + WS_F + rw_item(bh, c) * 16384;
        if (wave < 4) { acc = rw_mm(acc, Wt, tn, Bht, ti, lane);
            bf16* MT = (bf16*)dst; const int k2 = 32 * ti + r32; const float ed = __expf(lend[k2]);
#pragma unroll
            for (int g = 0; g < 4; ++g) { const int k1 = 32 * tn + 8 * g + 4 * hi;
                const float v0 = acc[4 * g] + (k1 == k2 ? ed : 0.f), v1 = acc[4 * g + 1] + (k1 + 1 == k2 ? ed : 0.f), v2 = acc[4 * g + 2] + (k1 + 2 == k2 ? ed : 0.f), v3 = acc[4 * g + 3] + (k1 + 3 == k2 ? ed : 0.f);
                *(v2u*)(MT + k2 * 64 + k1) = (v2u){pk2(v0, v1), pk2(v2, v3)}; }
        } else { acc = rw_mm(acc, Bht, ti, Ut, tn, lane); acc = rw_mm(acc, Kht, ti, Vt, tn, lane);
            v4u* GT = (v4u*)(dst + 8192) + ((ti * 2 + tn) * 64 + lane) * 2;
            const bf16x8 g0 = rw_pack8(acc, 0), g1 = rw_pack8(acc, 1); GT[0] = __builtin_bit_cast(v4u, g0); GT[1] = __builtin_bit_cast(v4u, g1); }
    }
    RWP(4);
    if (c > 0) {
        const int ti = (wave >> 1) & 1, tn = wave & 1; f32x16 acc = {};
        unsigned char* dst = F.ws + WS_QY + rw_item(bh, c) * 16384;
        if (wave < 4) { acc = rw_mm(acc, Wt, tn, Arb, ti, lane);
            bf16* Qg = (bf16*)dst; const int t = 32 * ti + r32;
#pragma unroll
            for (int g = 0; g < 4; ++g) { const int k = 32 * tn + 8 * g + 4 * hi; const v2u rw = *(const LAS v2u*)(Rt + t * RW_P + k);
                *(v2u*)(Qg + t * 64 + k) = (v2u){pk2(acc[4 * g] + bflo(rw.x), acc[4 * g + 1] + bfhi(rw.x)), pk2(acc[4 * g + 2] + bflo(rw.y), acc[4 * g + 3] + bfhi(rw.y))}; }
        } else { acc = rw_mm(acc, Ut, tn, Arb, ti, lane); acc = rw_mm(acc, Vt, tn, Ark, ti, lane);
            v4u* YT = (v4u*)(dst + 8192) + ((ti * 2 + tn) * 64 + lane) * 2;
            const bf16x8 g0 = rw_pack8(acc, 0), g1 = rw_pack8(acc, 1); YT[0] = __builtin_bit_cast(v4u, g0); YT[1] = __builtin_bit_cast(v4u, g1); }
    }
    __syncthreads(); RWP(5);
}

struct OutRaw { v4u qg[4], s0[4], s1[4]; };
__device__ __forceinline__ void rwkv_out_load(OutRaw& R, Frame& F, int bh, int c, int ti) {
    const int lane = F.lane, r32 = lane & 31, b = bh >> 3, h = bh & 7, rr = lane >> 3, ck = lane & 7;
    const unsigned char* src = F.ws + WS_QY + rw_item(bh, c) * 16384; const bf16* Qg = (const bf16*)src; const v4u* YT = (const v4u*)(src + 8192);
    const v4u* SI = (const v4u*)(F.ws + WS_SST + rw_item(bh, c) * 8192);
#pragma unroll
    for (int j = 0; j < 4; ++j) R.qg[j] = *(const v4u*)(Qg + (32 * ti + 8 * j + rr) * 64 + 8 * ck);
#pragma unroll
    for (int e = 0; e < 4; ++e) { R.s0[e] = SI[(((e >> 1) * 2 + 0) * 2 + (e & 1)) * 64 + lane]; R.s1[e] = SI[(((e >> 1) * 2 + 1) * 2 + (e & 1)) * 64 + lane]; }
}
__device__ __forceinline__ void rwkv_out(Frame& F, const OutRaw& R, int bh, int c, int ti) {
    constexpr int P_ = 144;
    const int lane = F.lane, r32 = lane & 31, hi = lane >> 5, b = bh >> 3, h = bh & 7, rr = lane >> 3, ck = lane & 7;
    LAS unsigned char* Zl = F.lds + RING_OFF + F.wave * 16384; LAS unsigned char* Gl = Zl + 33 * P_; LAS unsigned char* Ql = Gl + 32 * P_;
    const int tok0 = 64 * (c - 1) + 32 * ti; const size_t m0 = (size_t)(b * SEQL + tok0);
    bf16* RO = (bf16*)(F.ws + WS_F);
    const size_t pm0 = tok0 == 0 ? (size_t)(MR + 15) : m0 - 1;
    const bf16* ZR = (const bf16*)(F.ws + WS_ZR); const bf16* GG = (const bf16*)(F.ws + WS_GG);
    const v4u* YT = (const v4u*)(F.ws + WS_QY + rw_item(bh, c) * 16384 + 8192);
    const float dt = ((const float*)(F.ws + WS_DOTS))[rw_item(bh, c) * 64 + 32 * ti + r32];
    const v4u a0 = YT[((ti * 2 + 0) * 64 + lane) * 2], a1 = YT[((ti * 2 + 0) * 64 + lane) * 2 + 1], b0 = YT[((ti * 2 + 1) * 64 + lane) * 2], b1 = YT[((ti * 2 + 1) * 64 + lane) * 2 + 1];
    v4u qg[4], zg[4], gg4[4], s0[4], s1[4];
#pragma unroll
    for (int j = 0; j < 4; ++j) { qg[j] = R.qg[j]; s0[j] = R.s0[j]; s1[j] = R.s1[j]; }
    const v4u zprev = *(const v4u*)(ZR + pm0 * 1792 + 1024 + h * 64 + 8 * ck);
#pragma unroll
    for (int j = 0; j < 4; ++j) { zg[j] = *(const v4u*)(ZR + (m0 + 8 * j + rr) * 1792 + 1024 + h * 64 + 8 * ck); gg4[j] = *(const v4u*)(GG + (m0 + 8 * j + rr) * 512 + h * 64 + 8 * ck); }
    __builtin_amdgcn_sched_barrier(0);
#pragma unroll
    for (int j = 0; j < 4; ++j) *(LAS v4u*)(Ql + (8 * j + rr) * P_ + 16 * ck) = qg[j];
    f32x16 y0, y1;
#pragma unroll
    for (int j = 0; j < 4; ++j) { y0[2 * j] = bflo(a0[j]); y0[2 * j + 1] = bfhi(a0[j]); y0[8 + 2 * j] = bflo(a1[j]); y0[8 + 2 * j + 1] = bfhi(a1[j]);
                                  y1[2 * j] = bflo(b0[j]); y1[2 * j + 1] = bfhi(b0[j]); y1[8 + 2 * j] = bflo(b1[j]); y1[8 + 2 * j + 1] = bfhi(b1[j]); }
#pragma unroll
    for (int e = 0; e < 4; ++e) {
        const v2u qa = *(const LAS v2u*)(Ql + r32 * P_ + (32 * (e >> 1) + 16 * (e & 1) + 4 * hi) * 2), qb = *(const LAS v2u*)(Ql + r32 * P_ + (32 * (e >> 1) + 16 * (e & 1) + 8 + 4 * hi) * 2);
        const v4u qf = {qa.x, qa.y, qb.x, qb.y};
        y0 = __builtin_amdgcn_mfma_f32_32x32x16_bf16(__builtin_bit_cast(bf16x8, s0[e]), __builtin_bit_cast(bf16x8, qf), y0, 0, 0, 0);
        y1 = __builtin_amdgcn_mfma_f32_32x32x16_bf16(__builtin_bit_cast(bf16x8, s1[e]), __builtin_bit_cast(bf16x8, qf), y1, 0, 0, 0);
    }
    if (lane < 8) *(LAS v4u*)(Zl + 16 * ck) = zprev;
#pragma unroll
    for (int j = 0; j < 4; ++j) { *(LAS v4u*)(Zl + (1 + 8 * j + rr) * P_ + 16 * ck) = zg[j]; *(LAS v4u*)(Gl + (8 * j + rr) * P_ + 16 * ck) = gg4[j]; }
    float sm = 0.f;
#pragma unroll
    for (int r = 0; r < 16; ++r) sm += y0[r] + y1[r];
    sm += __shfl_xor(sm, 32);
    const float mean = sm * (1.f / 64.f);
    float sv = 0.f;
#pragma unroll
    for (int r = 0; r < 16; ++r) { y0[r] -= mean; y1[r] -= mean; sv += y0[r] * y0[r] + y1[r] * y1[r]; }
    sv += __shfl_xor(sv, 32);
    const float rs = 1.f / sqrtf(sv * (1.f / 64.f) + GN_EPS);
    const float* lnw = inp(18) + h * 64 + 4 * hi; const float* lnb = inp(19) + h * 64 + 4 * hi; const float* mvp = inp(9) + 1024 + h * 64 + 4 * hi;
#pragma unroll
    for (int tn = 0; tn < 2; ++tn)
#pragma unroll
        for (int g = 0; g < 4; ++g) { const int co = (32 * tn + 8 * g + 4 * hi) * 2;
            const f32x4 w4 = *(const f32x4*)(lnw + 32 * tn + 8 * g), b4 = *(const f32x4*)(lnb + 32 * tn + 8 * g), m4 = *(const f32x4*)(mvp + 32 * tn + 8 * g);
            const v2u zv = *(const LAS v2u*)(Zl + (1 + r32) * P_ + co), pv = *(const LAS v2u*)(Zl + r32 * P_ + co), gv = *(const LAS v2u*)(Gl + r32 * P_ + co);
            const float z[4] = {bflo(zv.x), bfhi(zv.x), bflo(zv.y), bfhi(zv.y)}, p[4] = {bflo(pv.x), bfhi(pv.x), bflo(pv.y), bfhi(pv.y)}, gt[4] = {bflo(gv.x), bfhi(gv.x), bflo(gv.y), bfhi(gv.y)};
            float o[4];
#pragma unroll
            for (int x = 0; x < 4; ++x) { const float d = tn == 0 ? y0[4 * g + x] : y1[4 * g + x]; const float v = z[x] + (p[x] - z[x]) * m4[x]; o[x] = (d * rs * w4[x] + b4[x] + dt * v) * gt[x]; }
            *(LAS v2u*)(Gl + r32 * P_ + co) = (v2u){pk2(o[0], o[1]), pk2(o[2], o[3])};
        }
#pragma unroll
    for (int j = 0; j < 4; ++j) *(v4u*)(RO + (m0 + 8 * j + rr) * 512 + h * 64 + 8 * ck) = *(const LAS v4u*)(Gl + (8 * j + rr) * P_ + 16 * ck);
}

constexpr int RWC_MP = 68;
constexpr int RWC_SLOT = 64 * RWC_MP * 2 + 4096;
constexpr int RWC_FLAGS = 7 * RWC_SLOT;
__device__ __forceinline__ void rwkv_chain_wg(Frame& F, int bh, int tv) {
    const int lane = F.lane, wave = F.wave, r32 = lane & 31, hi = lane >> 5;
    LAS unsigned char* L = F.lds; volatile LAS unsigned* flag = (volatile LAS unsigned*)(L + RWC_FLAGS);
    if (F.tid < 7) flag[F.tid] = 0u;
    __syncthreads();
    if (wave != 0) {
        const int slot = wave - 1; LAS unsigned char* sb = L + slot * RWC_SLOT;
        v4u mv[8], gv[4];
#define RWC_LOAD(MV, GV, CC) do { const unsigned char* src_ = F.ws + WS_F + rw_item(bh, (CC)) * 16384; const v4u* MT_ = (const v4u*)src_; const v4u* GT_ = (const v4u*)(src_ + 8192); \
            _Pragma("unroll") for (int i = 0; i < 8; ++i) MV[i] = MT_[lane + 64 * i]; \
            _Pragma("unroll") for (int i = 0; i < 4; ++i) { const int idx = lane + 64 * i, t2 = idx >> 7, l = (idx >> 1) & 63, hf = idx & 1; GV[i] = GT_[((t2 * 2 + tv) * 64 + l) * 2 + hf]; } } while (0)
        RWC_LOAD(mv, gv, slot);
        for (int c = slot; c < RW_NCH; c += 7) {
            v4u mn[8], gn[4];
            if (c + 7 == RW_NCH - 1) {
                unsigned* fl_ = (unsigned*)(F.ctl + CW_LASTCHUNK + bh); unsigned* tmo_ = (unsigned*)(F.ctl + CW_BAR);
                XB_SPIN(__hip_atomic_load(fl_, __ATOMIC_RELAXED, __HIP_MEMORY_SCOPE_AGENT) == 0u, tmo_);
                __builtin_amdgcn_fence(__ATOMIC_ACQUIRE, ""); }
            RWC_LOAD(mn, gn, (c + 7 < RW_NCH ? c + 7 : c));
            asm volatile("s_waitcnt vmcnt(12)" ::: "memory");
            while (flag[slot] != 0u) __builtin_amdgcn_s_sleep(2);
#pragma unroll
            for (int i = 0; i < 8; ++i) { const int idx = lane + 64 * i; *(LAS v4u*)(sb + (idx >> 3) * (RWC_MP * 2) + (idx & 7) * 16) = mv[i]; }
#pragma unroll
            for (int i = 0; i < 4; ++i) *(LAS v4u*)(sb + 64 * RWC_MP * 2 + (lane + 64 * i) * 16) = gv[i];
            asm volatile("s_waitcnt lgkmcnt(0)" ::: "memory");
            if (lane == 0) flag[slot] = 1u;
#pragma unroll
            for (int i = 0; i < 8; ++i) mv[i] = mn[i];
#pragma unroll
            for (int i = 0; i < 4; ++i) gv[i] = gn[i];
        }
#undef RWC_LOAD
        return;
    }
    f32x16 s0 = {}, s1 = {};
    __builtin_amdgcn_s_setprio(3);
    for (int c = 0; c < RW_NCH; ++c) {
        const int slot = c % 7; const LAS unsigned char* sb = L + slot * RWC_SLOT;
        v4u* SI = (v4u*)(F.ws + WS_SST + rw_item(bh, c) * 8192);
        const bf16x8 b00 = rw_pack8(s0, 0), b01 = rw_pack8(s0, 1), b10 = rw_pack8(s1, 0), b11 = rw_pack8(s1, 1);
        SI[((0 * 2 + tv) * 2 + 0) * 64 + lane] = __builtin_bit_cast(v4u, b00); SI[((0 * 2 + tv) * 2 + 1) * 64 + lane] = __builtin_bit_cast(v4u, b01);
        SI[((1 * 2 + tv) * 2 + 0) * 64 + lane] = __builtin_bit_cast(v4u, b10); SI[((1 * 2 + tv) * 2 + 1) * 64 + lane] = __builtin_bit_cast(v4u, b11);
        while (flag[slot] == 0u) __builtin_amdgcn_s_sleep(1);
        asm volatile("" ::: "memory");
        s16x4v ma[2][2][2], mb[2][2][2]; v4u g[2][2];
#pragma unroll
        for (int tk = 0; tk < 2; ++tk)
#pragma unroll
            for (int s = 0; s < 2; ++s)
#pragma unroll
                for (int t2 = 0; t2 < 2; ++t2) { const LAS bf16* mp = (const LAS bf16*)sb + (32 * t2 + r32) * RWC_MP + 32 * tk + 16 * s + 4 * hi; ma[tk][s][t2] = *(const LAS s16x4v*)(mp); mb[tk][s][t2] = *(const LAS s16x4v*)(mp + 8); }
#pragma unroll
        for (int t2 = 0; t2 < 2; ++t2) { g[t2][0] = *(const LAS v4u*)(sb + 64 * RWC_MP * 2 + ((t2 * 64 + lane) * 2) * 16); g[t2][1] = *(const LAS v4u*)(sb + 64 * RWC_MP * 2 + ((t2 * 64 + lane) * 2 + 1) * 16); }
        asm volatile("s_waitcnt lgkmcnt(0)" ::: "memory");
        if (lane == 0) flag[slot] = 0u;
        f32x16 n0, n1;
#pragma unroll
        for (int j = 0; j < 4; ++j) { n0[2 * j] = bflo(g[0][0][j]); n0[2 * j + 1] = bfhi(g[0][0][j]); n0[8 + 2 * j] = bflo(g[0][1][j]); n0[8 + 2 * j + 1] = bfhi(g[0][1][j]);
                                      n1[2 * j] = bflo(g[1][0][j]); n1[2 * j + 1] = bfhi(g[1][0][j]); n1[8 + 2 * j] = bflo(g[1][1][j]); n1[8 + 2 * j + 1] = bfhi(g[1][1][j]); }
#pragma unroll
        for (int tk = 0; tk < 2; ++tk)
#pragma unroll
            for (int s = 0; s < 2; ++s) {
                const bf16x8 bfr = tk == 0 ? (s == 0 ? b00 : b01) : (s == 0 ? b10 : b11);
#pragma unroll
                for (int t2 = 0; t2 < 2; ++t2) {
                    const s16x4v xa = ma[tk][s][t2], xb = mb[tk][s][t2];
                    const bf16x8 af = {xa[0], xa[1], xa[2], xa[3], xb[0], xb[1], xb[2], xb[3]};
                    if (t2 == 0) n0 = __builtin_amdgcn_mfma_f32_32x32x16_bf16(af, bfr, n0, 0, 0, 0); else n1 = __builtin_amdgcn_mfma_f32_32x32x16_bf16(af, bfr, n1, 0, 0, 0);
                }
            }
        s0 = n0; s1 = n1;
    }
    __builtin_amdgcn_s_setprio(0);
}

#ifdef MK_DUMP
__device__ __forceinline__ void dump_phase(const unsigned char* ws, float* out) {
    const size_t n = (size_t)MR * DM; const size_t i0 = (size_t)blockIdx.x * blockDim.x + threadIdx.x, st = (size_t)gridDim.x * blockDim.x;
    for (size_t i = i0; i < n; i += st) { const size_t m = i >> 10, c = i & 1023; float v = 0.f;
        if (MK_DUMP == 1) v = bf1(((const bf16*)(ws + WS_F))[m * 1024 + c]);
        else if (MK_DUMP == 2) v = bf1(((const bf16*)(ws + WS_ZR))[m * 1792 + c]);
        else if (MK_DUMP == 3) v = c < 512 ? ((const float*)(ws + WS_LW))[m * 512 + c] : bf1(((const bf16*)(ws + WS_AA))[m * 512 + c - 512]);
        else if (MK_DUMP == 4) v = bf1(((const bf16*)(ws + WS_MERGED))[m * 1024 + c]);
        else if (MK_DUMP == 5) v = c < 512 ? bf1(((const bf16*)(ws + WS_Q))[m * 512 + c]) : (c < 768 ? bf1(((const bf16*)(ws + WS_KV))[m * 256 + c - 512]) : bf1(((const bf16*)(ws + WS_LA))[m * 256 + c - 768]));
        else if (MK_DUMP == 6) v = bf1(((const bf16*)(ws + WS_GATES))[m * 2048 + c]);
        else if (MK_DUMP == 7) v = bf1(((const bf16*)(ws + WS_F))[m * 1024 + c]);
        else if (MK_DUMP == 8) v = c < 512 ? bf1(((const bf16*)(ws + WS_GG))[m * 512 + c]) : bf1(((const bf16*)(ws + WS_ZR))[m * 1792 + 1024 + c - 512]);
        else if (MK_DUMP == 9) v = ((const float*)(ws + WS_SS))[((size_t)((c & 15) >> 2) * MP + m) * 4 + (c & 3)];
        else if (MK_DUMP == 10) v = bf1(((const bf16*)(ws + WS_XN))[m * 1024 + c]);
        out[i] = v; }
}
#endif
#ifndef MK_N_LAUNCHES
#define MK_N_LAUNCHES 1
#endif
constexpr int N_PHASES = 15;
constexpr int N_LAUNCHES = MK_N_LAUNCHES;
__global__ void __launch_bounds__(NWAVES * 64, 2) hybrid_fwd(Args args) {
    extern __shared__ __attribute__((aligned(16))) unsigned char lds[];
    Frame F;
    F.lds = (LAS unsigned char*)lds;
    F.MISC = (volatile LAS unsigned*)(F.lds + MISC_OFF);
#define FRAME_REFRESH() do { int t_ = threadIdx.x; asm volatile("" : "+v"(t_)); F.tid = t_; F.lane = t_ & 63; F.wave = __builtin_amdgcn_readfirstlane(t_ >> 6); } while (0)
    FRAME_REFRESH();
    F.G = gridDim.x; { const int bx = blockIdx.x; F.vcu = (F.G % 8 == 0) ? (bx % 8) * (F.G / 8) + bx / 8 : bx; }
    unsigned char* ws = args.ws; F.ws = ws; F.out = args.out;
    F.ctl = (gu32*)(ws + WS_CTL);
    for (int u = F.tid; u < (LDS_BYTES - LDSCTL_OFF) / 4; u += NWAVES * 64) ((LAS unsigned*)(F.lds + LDSCTL_OFF))[u] = 0u;
    __syncthreads();
    XcdBarrier bar; bar.bar = (unsigned*)(F.ctl + CW_BAR); bar.x = 0; bar.st = nullptr;
    if (N_LAUNCHES == 1) bar = xcd_barrier_post((unsigned*)(F.ctl + CW_BAR), F.MISC + 8);
    const int lo = args.ph_lo, hi = args.ph_hi;
#ifndef PHASE_MASK
#define PHASE_MASK 0x7fff
#endif
#define IN(k) (((PHASE_MASK >> (k)) & 1) && lo <= (k) && (k) < hi)
#ifndef MK_TIME_SCALE
#define MK_TIME_SCALE 0.001f
#endif
#ifdef MK_TIME_PHASE
#define SEAM(k) do { if (IN(k) && IN((k) + 1)) xcd_barrier(bar); if (blockIdx.x == 0 && threadIdx.x == 0) { const unsigned long long t_ = __builtin_amdgcn_s_memrealtime(); ((unsigned long long*)(ws + 16384))[(k) + 1] = t_; } } while (0)
#else
#define SEAM(k) do { if (IN(k) && IN((k) + 1)) xcd_barrier(bar); } while (0)
#endif
#define GEMM_RUN(EpiT, Eobj, Aptr, lda_, Bptr, ldb_, M_, N_, K_) do { pg8::Gemm g_{(const pg8::bf16_t*)(Aptr), (const pg8::bf16_t*)(Bptr), (M_), (N_), (K_), (lda_), (ldb_)}; pg8::StaticOrder S_; S_.init((M_), (N_), F.G, (int)blockIdx.x); \
        pg8::gemm_phase<EpiT, pg8::StaticOrder, true, true>(F.lds + RING_OFF, g_, S_, Eobj); } while (0)

#ifdef MK_COH_TEST
    {
        float* Tb = (float*)(ws + WS_BIG + 300 * MiB); const int g = blockIdx.x, G = gridDim.x, nb = (g + 1) % G; float acc = 0.f; unsigned bad = 0;
        for (int rep = 0; rep < 4; ++rep) {
            for (int i = threadIdx.x; i < 8192; i += 512) Tb[(size_t)g * 8192 + i] = 1.0f + rep;
            xcd_barrier(bar);
            for (int i = threadIdx.x; i < 8192; i += 512) acc += Tb[(size_t)nb * 8192 + i];
            xcd_barrier(bar);
            for (int i = threadIdx.x; i < 8192; i += 512) Tb[(size_t)g * 8192 + i] = 100.0f + rep * 7 + i;
            xcd_barrier(bar);
            for (int i = threadIdx.x; i < 8192; i += 512) { const float v = Tb[(size_t)nb * 8192 + i]; bad += (v != 100.0f + rep * 7 + i) ? 1u : 0u; }
            xcd_barrier(bar);
        }
        if (acc == 12345.f) bad++;
        if (bad) atomicAdd((unsigned*)(F.ctl + 901), bad);
    }
#endif
#ifdef MK_ITEM_PROF
    if (blockIdx.x == 0 && threadIdx.x == 0) { for (int i_ = 0; i_ < 8; ++i_) ((unsigned long long*)(ws + 32768))[i_] = 0ull; }
#endif
#ifdef MK_TIME_PHASE
    if (blockIdx.x == 0 && threadIdx.x == 0) ((unsigned long long*)(ws + 16384))[0] = __builtin_amdgcn_s_memrealtime();
#endif
    if (IN(0)) { FRAME_REFRESH(); p0_prologue(F, args); } SEAM(0);
    if (IN(1)) { FRAME_REFRESH(); { for (int it = F.vcu; it < DFF / 16; it += F.G) meta_gateup(F, (const bf16*)(ws + WS_WGU1), it); }
        pg8::EpiSwiGLU E{(pg8::bf16_t*)(ws + WS_HID), nullptr}; GEMM_RUN(pg8::EpiSwiGLU, E, (unsigned char*)F.out, DM, ws + WS_WGU1, DM, MR, NHID2, DM); } SEAM(1);
    if (IN(2)) { FRAME_REFRESH(); { for (int it = F.vcu; it < 64; it += F.G) meta_down(F, (const bf16*)(ws + WS_WD1), it); }
        pg8::EpiFSS E{(pg8::bf16_t*)(ws + WS_F), (float*)(ws + WS_SS)}; GEMM_RUN(pg8::EpiFSS, E, ws + WS_HID, DFF, ws + WS_WD1, DFF, MR, DM, DFF); } SEAM(2);
    if (IN(3)) { FRAME_REFRESH(); row_pass<0>(F, args, inp(5), inp(6), 0.5f); } SEAM(3);
    if (IN(4)) { pg8::EpiWin E{(const float*)(ws + WS_RS2), (pg8::bf16_t*)(ws + WS_Q), (pg8::bf16_t*)(ws + WS_KV), (pg8::bf16_t*)(ws + WS_ZR), (const float*)(ws + WS_ROPE), MR, (pg8::bf16_t*)(ws + WS_VT)}; FRAME_REFRESH(); { for (int it = F.vcu; it < 128; it += F.G) meta_win(F, it); }
        GEMM_RUN(pg8::EpiWin, E, (unsigned char*)F.out, DM, ws + WS_WIN, DM, MR, NIN_A, DM); } SEAM(4);
#ifdef MK_GEMM_CHECK4
    if (IN(4)) { xcd_barrier(bar);
        { unsigned char* w2 = ws + WS_BIG + 165 * MiB; pg8::EpiWin E{(const float*)(ws + WS_RS2), (pg8::bf16_t*)(w2), (pg8::bf16_t*)(w2 + (WS_KV - WS_Q)), (pg8::bf16_t*)(w2 + (WS_ZR - WS_Q)), (const float*)(ws + WS_ROPE), MR, (pg8::bf16_t*)(ws + WS_VT)};
          pg8::Gemm g_{(const pg8::bf16_t*)(ws + WS_XN), (const pg8::bf16_t*)(ws + WS_WIN), MP, NIN_A, DM, DM, DM}; pg8::StaticOrder S_; S_.init(MP, NIN_A, F.G, (int)((blockIdx.x + 101) % gridDim.x));
          pg8::gemm_phase<pg8::EpiWin, pg8::StaticOrder, true, true>(F.lds + RING_OFF, g_, S_, E); }
        xcd_barrier(bar);
        { FRAME_REFRESH(); const unsigned* a = (const unsigned*)(ws + WS_Q); const unsigned* b = (const unsigned*)(ws + WS_BIG + 165 * MiB); unsigned bad = 0;
          for (size_t i = (size_t)blockIdx.x * 512 + F.tid; i < (size_t)MP * 2560 / 2; i += (size_t)gridDim.x * 512) bad += (a[i] != b[i]) ? 1u : 0u;
          if (bad) atomicAdd((unsigned*)(F.ctl + 900), bad); }
        xcd_barrier(bar);
    }
#endif
    if (IN(5)) { FRAME_REFRESH(); lora_a_pass(F, args);
#ifdef MK_PROBE_BAR
        xcd_barrier(bar); xcd_barrier(bar); xcd_barrier(bar); xcd_barrier(bar);
#endif
    } SEAM(5);
    if (IN(6)) { pg8::EpiLora E{(pg8::bf16_t*)(ws + WS_LW), (pg8::bf16_t*)(ws + WS_AA), (pg8::bf16_t*)(ws + WS_GG), inp(10), inp(12)}; FRAME_REFRESH(); { const int gw = F.vcu * NWAVES + F.wave, NGW = F.G * NWAVES; for (int it = gw; it < 96; it += NGW) meta_lora(F, it); }
        int kl_ = 256; asm volatile("" : "+s"(kl_)); GEMM_RUN(pg8::EpiLora, E, ws + WS_LA, 256, ws + WS_WL, 256, MR, 1536, kl_); } SEAM(6);
    if (IN(7)) { FRAME_REFRESH();
        { RwRaw raw; { const int it0 = (int)blockIdx.x; rw_load_raw(raw, F, it0 >> 10, (it0 >> 7) & 7, it0 & 127); }
          for (int it = (int)blockIdx.x; it < 32 * 128; it += F.G) { const int bh = it >> 7, c = it & 127; const int itn = it + F.G, bhn = itn >> 7, cn = itn < 32 * 128 ? (itn & 127) : -1;
              rwkv_item(F, bh >> 3, bh & 7, c, raw, bhn >> 3, bhn & 7, cn); } }
        xcd_barrier(bar);
#ifdef MK_TIME_PHASE
        if (blockIdx.x == 0 && threadIdx.x == 0) ((unsigned long long*)(ws + 16384))[21] = __builtin_amdgcn_s_memrealtime();
#endif
        FRAME_REFRESH();
#ifdef MK_SKIP_CHAIN
        if ((int)blockIdx.x < 64) { if (F.G == 12345) rwkv_chain_wg(F, (int)blockIdx.x >> 1, (int)blockIdx.x & 1); }
#else
        if ((int)blockIdx.x < 64) { rwkv_chain_wg(F, (int)blockIdx.x >> 1, (int)blockIdx.x & 1);
#ifdef MK_TIME_PHASE
            if (blockIdx.x == 0 && threadIdx.x == 0) ((unsigned long long*)(ws + 16384))[23] = __builtin_amdgcn_s_memrealtime();
#endif
        }
#endif
#ifdef MK_SKIP_ATT
        else if (false) {
#else
        else {
#endif
            if ((int)blockIdx.x >= F.G - 32) {
                const int bhl = (int)blockIdx.x - (F.G - 32); RwRaw rawl; rw_load_raw(rawl, F, bhl >> 3, bhl & 7, 128);
                rwkv_item(F, bhl >> 3, bhl & 7, 128, rawl, 0, 0, -1);
                asm volatile("s_waitcnt vmcnt(0)" ::: "memory"); __syncthreads();
                if (threadIdx.x == 0) { __builtin_amdgcn_fence(__ATOMIC_RELEASE, ""); asm volatile("s_waitcnt vmcnt(0)" ::: "memory");
                    __hip_atomic_store((unsigned*)(F.ctl + CW_LASTCHUNK + bhl), 1u, __ATOMIC_RELAXED, __HIP_MEMORY_SCOPE_AGENT); }
                FRAME_REFRESH();
            }
            const int gw = ((int)blockIdx.x - 64) * NWAVES + F.wave, NGW = (F.G - 64) * NWAVES;
            for (int it = gw; it < NB * 8 * (SEQL / 32); it += NGW) { const int head = it & 7, qb = (it >> 3) & 255, b = it >> 11; attn_item(F, args, b, head, qb); }
#ifdef MK_TIME_PHASE
            if (blockIdx.x == MK_TS_WG && threadIdx.x == 0) ((unsigned long long*)(ws + 16384))[24] = __builtin_amdgcn_s_memrealtime();
            if (F.lane == 0 && F.wave == MK_TS_WAVE) atomicMax((unsigned long long*)(ws + 16384) + 26, (unsigned long long)__builtin_amdgcn_s_memrealtime());
#endif
#ifndef MK_SKIP_CONV
            convert_late_weights(F, args, gw, NGW, F.lds);
#endif
#ifdef MK_TIME_PHASE
            if (blockIdx.x == MK_TS_WG && threadIdx.x == 0) ((unsigned long long*)(ws + 16384))[25] = __builtin_amdgcn_s_memrealtime();
            if (F.lane == 0) atomicMax((unsigned long long*)(ws + 16384) + 27, (unsigned long long)__builtin_amdgcn_s_memrealtime());
#endif
            }
        xcd_barrier(bar);
#ifdef MK_TIME_PHASE
        if (blockIdx.x == 0 && threadIdx.x == 0) ((unsigned long long*)(ws + 16384))[22] = __builtin_amdgcn_s_memrealtime();
#endif
        FRAME_REFRESH();
        { const int gw = (int)blockIdx.x * NWAVES + F.wave, NGW = F.G * NWAVES;
          constexpr int T_ = 32 * 128 * 2; OutRaw R;
          if (gw < T_) rwkv_out_load(R, F, gw >> 8, ((gw >> 1) & 127) + 1, gw & 1);
          for (int it = gw; it < T_; it += NGW) { const int ti = it & 1, c = ((it >> 1) & 127) + 1, bh = it >> 8; const int itn = it + NGW < T_ ? it + NGW : it;
              OutRaw N; rwkv_out_load(N, F, itn >> 8, ((itn >> 1) & 127) + 1, itn & 1);
              rwkv_out(F, R, bh, c, ti); R = N; } }
    }
    SEAM(7);
    if (IN(8)) {
        static_assert(WS_WRWKV == WS_WATT + (size_t)DM * 512 * 2, "branch weights adjacent");
        { pg8::EpiPlain E{(pg8::bf16_t*)(ws + WS_GATES), DM, 4, (size_t)MR * DM};
          pg8::Gemm g_{(const pg8::bf16_t*)(ws + WS_Q), (const pg8::bf16_t*)(ws + WS_WATT), MR, 2 * DM, 512, 512, 512, (const pg8::bf16_t*)(ws + WS_F), 4}; pg8::StaticOrder S_; S_.init(MR, 2 * DM, F.G, (int)blockIdx.x);
          pg8::gemm_phase<pg8::EpiPlain, pg8::StaticOrder, true, true>(F.lds + RING_OFF, g_, S_, E); }
    } SEAM(8);
    if (IN(9)) { pg8::EpiGateMerge E{(const float*)(ws + WS_RS2), (pg8::bf16_t*)(ws + WS_MERGED), (const pg8::bf16_t*)(ws + WS_GATES), (const pg8::bf16_t*)(ws + WS_GATES) + (size_t)MR * DM};
        GEMM_RUN(pg8::EpiGateMerge, E, (unsigned char*)F.out, DM, ws + WS_WIN + (size_t)NIN_A * DM * 2, DM, MR, 2048, DM); } SEAM(9);
    if (IN(10)) { pg8::EpiFSS E{(pg8::bf16_t*)(ws + WS_F), (float*)(ws + WS_SS)}; GEMM_RUN(pg8::EpiFSS, E, ws + WS_MERGED, DM, ws + WS_WMIX, DM, MR, DM, DM); } SEAM(10);
#ifdef MK_GEMM_CHECK
    if (IN(10)) { xcd_barrier(bar);
        { pg8::EpiFSS E{(pg8::bf16_t*)(ws + WS_BIG + 192 * MiB), (float*)(ws + WS_BIG + 256 * MiB)}; pg8::Gemm g_{(const pg8::bf16_t*)(ws + WS_MERGED), (const pg8::bf16_t*)(ws + WS_WMIX), MR, DM, DM, DM, DM}; pg8::StaticOrder S_; S_.init(MR, DM, F.G, (int)((blockIdx.x + 37) % gridDim.x));
          pg8::gemm_phase<pg8::EpiFSS, pg8::StaticOrder, true, true>(F.lds + RING_OFF, g_, S_, E); }
        xcd_barrier(bar);
        { FRAME_REFRESH(); const unsigned* a = (const unsigned*)(ws + WS_F); const unsigned* b = (const unsigned*)(ws + WS_BIG + 192 * MiB); unsigned bad = 0;
          for (size_t i = (size_t)blockIdx.x * 512 + F.tid; i < (size_t)MR * DM / 2; i += (size_t)gridDim.x * 512) bad += (a[i] != b[i]) ? 1u : 0u;
          if (bad) atomicAdd((unsigned*)(F.ctl + 900), bad); }
    }
#endif
    if (IN(11)) { FRAME_REFRESH(); row_pass<1>(F, args, inp(23), inp(24), 1.0f); } SEAM(11);
    if (IN(12)) { pg8::EpiSwiGLU E{(pg8::bf16_t*)(ws + WS_HID), (const float*)(ws + WS_RS3)}; GEMM_RUN(pg8::EpiSwiGLU, E, ws + WS_H2, DM, ws + WS_WGU2, DM, MR, NHID2, DM); } SEAM(12);
    if (IN(13)) { pg8::EpiFSS E{(pg8::bf16_t*)(ws + WS_F), (float*)(ws + WS_SS)}; GEMM_RUN(pg8::EpiFSS, E, ws + WS_HID, DFF, ws + WS_WD2, DFF, MR, DM, DFF); } SEAM(13);
    if (IN(14)) { FRAME_REFRESH(); row_pass<2>(F, args, inp(27), inp(27), 0.5f); }
#if defined(MK_GEMM_CHECK) || defined(MK_COH_TEST) || defined(MK_GEMM_CHECK4) || defined(MK_GATE_CHECK) || defined(MK_GATE_SCAN)
    { xcd_barrier(bar); if (blockIdx.x == 0 && threadIdx.x == 0) { const unsigned nb = __hip_atomic_load((unsigned*)(F.ctl + 900), __ATOMIC_RELAXED, __HIP_MEMORY_SCOPE_AGENT); const unsigned nc = __hip_atomic_load((unsigned*)(F.ctl + 901), __ATOMIC_RELAXED, __HIP_MEMORY_SCOPE_AGENT); if (nb) F.out[0] = 1.0e4f; if (nc) { const unsigned msk = __hip_atomic_load((unsigned*)(F.ctl + 902), __ATOMIC_RELAXED, __HIP_MEMORY_SCOPE_AGENT); F.out[1] = 1.0e6f + 1000.f * (float)nc; F.out[2] = 1.0e10f * (float)msk; } } }
#endif
#ifdef MK_ITEM_PROF
    if (blockIdx.x == 0 && threadIdx.x == 0) F.out[0] = 0.001f * (float)((const unsigned long long*)(ws + 32768))[MK_ITEM_PROF];
#endif
#ifdef MK_TIME_PHASE
    if (blockIdx.x == 0 && threadIdx.x == 0) { const unsigned long long* ts = (const unsigned long long*)(ws + 16384); const unsigned long long te = __builtin_amdgcn_s_memrealtime();
        const int kk_ = MK_TIME_PHASE; unsigned long long t0_ = ts[kk_ < 20 ? kk_ : 7], t1 = kk_ == 14 ? te : ts[(kk_ < 20 ? kk_ : 7) + 1];
        if (kk_ == 20) t1 = ts[21]; if (kk_ == 21) { t0_ = ts[21]; t1 = ts[22]; } if (kk_ == 22) t0_ = ts[22]; if (kk_ >= 23 && kk_ <= 27) { t0_ = ts[21]; t1 = ts[kk_]; }
#ifdef MK_TIME_CUM
        t0_ = ts[0];
#endif
        F.out[0] = MK_TIME_SCALE * (float)(t1 - t0_); }
#endif
#ifdef MK_DUMP
    xcd_barrier(bar); dump_phase(ws, F.out);
#endif
#undef IN
#undef SEAM
#undef GEMM_RUN
}


extern "C" void kernel_launch(void* const* d_in, const int* in_sizes, int n_in, void* d_out, int out_size, void* d_ws, size_t ws_size, hipStream_t stream) {
    static int grid = 0;
    if (grid == 0) {
        if (n_in != 28 || in_sizes[0] != MR * DM || out_size != MR * DM || ws_size < WS_END) { fprintf(stderr, "kernel_launch: unexpected shapes / workspace (n_in %d, in0 %d, out %d, ws %zu, need %zu); nothing launched\n", n_in, n_in > 0 ? in_sizes[0] : -1, out_size, ws_size, (size_t)WS_END); grid = -1; return; }
        int dev = 0, cus = 0, per_cu = 0;
        if (hipGetDevice(&dev) != hipSuccess || hipDeviceGetAttribute(&cus, hipDeviceAttributeMultiprocessorCount, dev) != hipSuccess) { grid = -1; return; }
        if (hipFuncSetAttribute((const void*)hybrid_fwd, hipFuncAttributeMaxDynamicSharedMemorySize, LDS_BYTES) != hipSuccess) { fprintf(stderr, "kernel_launch: hipFuncSetAttribute failed\n"); grid = -1; return; }
        if (hipOccupancyMaxActiveBlocksPerMultiprocessor(&per_cu, (const void*)hybrid_fwd, NWAVES * 64, LDS_BYTES) != hipSuccess || per_cu < 1) { fprintf(stderr, "kernel_launch: occupancy query reports %d workgroups per CU\n", per_cu); per_cu = 1; }
        (void)hipGetLastError();
        grid = cus;
        if (grid < 64) { fprintf(stderr, "kernel_launch: %d CUs: too few\n", grid); grid = -1; return; }
    }
    if (grid < 0) return;
    if (hipMemsetAsync((char*)d_ws + WS_CTL, 0, CTL_ZERO_BYTES, stream) != hipSuccess) return;
    Args a{};
    for (int i = 0; i < 28; ++i) a.in[i] = (const float*)d_in[i];
    a.out = (float*)d_out; a.ws = (unsigned char*)d_ws;
#ifndef MK_LAST_PHASE
#define MK_LAST_PHASE (N_PHASES - 1)
#endif
    for (int li = 0; li < N_LAUNCHES && li <= MK_LAST_PHASE; ++li) {
        if (N_LAUNCHES == 1) { a.ph_lo = 0; a.ph_hi = MK_LAST_PHASE + 1; } else { a.ph_lo = li; a.ph_hi = li + 1; }
        a.li = li;
        hipLaunchKernelGGL(hybrid_fwd, dim3(grid), dim3(NWAVES * 64), LDS_BYTES, stream, a);
        const hipError_t le = hipPeekAtLastError();
        if (le != hipSuccess) { fprintf(stderr, "kernel_launch: launch %d failed: %s\n", li, hipGetErrorName(le)); break; }
    }
}
```

```cpp
#include <hip/hip_runtime.h>
#include <cstdio>
#include <cstdint>

namespace pg8 {
#define PG8_LAS __attribute__((address_space(3)))
typedef unsigned short bf16_t;
typedef short bf16x8 __attribute__((ext_vector_type(8)));
typedef float f32x4 __attribute__((ext_vector_type(4)));
typedef unsigned u32x4 __attribute__((ext_vector_type(4)));
constexpr int BM = 256, BK = 64, HALF = 128, HTB = HALF * BK * 2  , STAGE_BYTES = 8 * HTB, NXCD = 8, WGM = 8;

__host__ __device__ __forceinline__ int lds_byte(int r, int c) { const int st = (r >> 4) * 2 + (c >> 5), rr = r & 15, cc = c & 31, ob = rr * 64 + cc * 2; return st * 1024 + (ob ^ (((ob >> 9) & 1) << 5)); }
__host__ __device__ __forceinline__ void stage_rc(int b, int& R, int& C) { const int st = b / 1024, sb = b % 1024, swz = sb ^ (((sb >> 9) & 1) << 5); R = (st >> 1) * 16 + swz / 64; C = (st & 1) * 32 + (swz % 64) / 2; }
__host__ __device__ __forceinline__ int perm32(int rho) { const int n = rho >> 4, i = rho & 15; return 8 * (i >> 2) + 4 * n + (i & 3); }

struct Unit { int pm, pn; };
struct Gemm { const bf16_t* A; const bf16_t* Bt; int M, N, K, lda, ldb; const bf16_t* A2 = nullptr; int nsplit = 1 << 30; };

struct StaticOrder {
    int nM, nN, nwg, G, c;
    __host__ __device__ void init(int M, int N, int G_, int c_) { nM = M / BM; nN = N / BM; nwg = nM * nN; G = G_; c = c_; }
    __host__ __device__ bool next(int i, Unit& u) const {
        const long L = (long)i * G + c; if (L >= nwg) return false;
        int wgid = (int)L; { const int q = nwg / NXCD, r = nwg % NXCD, xcd = wgid % NXCD, off = wgid / NXCD; wgid = (xcd < r ? xcd * (q + 1) : r * (q + 1) + (xcd - r) * q) + off; }
        const int nig = WGM * nN, gid = wgid / nig, fm = gid * WGM, gsz = (nM - fm) < WGM ? (nM - fm) : WGM;
        u.pm = fm + ((wgid % nig) % gsz); u.pn = (wgid % nig) / gsz; return true;
    }
    __device__ __forceinline__ void a_ready(const Unit&) const {}
    __device__ __forceinline__ void done(const Unit&) const {}
};

typedef float f32x2_cv __attribute__((ext_vector_type(2))); typedef __bf16 bf16x2_cv __attribute__((ext_vector_type(2)));
__device__ __forceinline__ unsigned cvt_pk_bf16(float lo, float hi) { const f32x2_cv v = {lo, hi}; const bf16x2_cv b = __builtin_convertvector(v, bf16x2_cv); return __builtin_bit_cast(unsigned, b); }
typedef float f32x2 __attribute__((ext_vector_type(2)));
#define EPI_IDS int t_ = threadIdx.x; asm volatile("" : "+v"(t_)); const int wr = t_ >> 8, wc = (t_ >> 6) & 3, fr = t_ & 15, fq = (t_ >> 4) & 3; (void)wr_; (void)wc_; (void)fr_; (void)fq_
__device__ __forceinline__ u32x4 pack8(const f32x4 a, const f32x4 b) { u32x4 w; w.x = cvt_pk_bf16(a[0], a[1]); w.y = cvt_pk_bf16(a[2], a[3]); w.z = cvt_pk_bf16(b[0], b[1]); w.w = cvt_pk_bf16(b[2], b[3]); return w; }
__device__ __forceinline__ float bf_lo(unsigned w) { return __builtin_bit_cast(float, w << 16); }
__device__ __forceinline__ float bf_hi(unsigned w) { return __builtin_bit_cast(float, w & 0xffff0000u); }
__device__ __forceinline__ float sigmoidf_(float x) { return __builtin_amdgcn_rcpf(1.0f + __expf(-x)); }
__device__ __forceinline__ float siluf_(float x) { return x * sigmoidf_(x); }

struct EpiSwiGLU {
    static constexpr bool PERM = true, AFTER_DRAIN = false, PRE = true;
    bf16_t* H;
    const float* RS;
    __device__ __forceinline__ void pre(const Unit& u, int wr, int fr, float (&rsv)[8]) const {
#pragma unroll
        for (int i = 0; i < 8; ++i) rsv[i] = RS ? RS[u.pm * BM + wr * 64 + fr + (i >> 2) * HALF + (i & 3) * 16] : 1.f;
    }
    __device__ __forceinline__ void operator()(const f32x4 (&acc)[2][2][4][2], const Unit& u, int wr_, int wc_, int fr_, int fq_, const float (&rsv)[8]) const {
        EPI_IDS;
        const int row0 = u.pm * BM + wr * 64 + fr, col = u.pn * HALF + wc * 32 + 8 * fq;
#pragma unroll
        for (int ai = 0; ai < 2; ++ai)
#pragma unroll
            for (int m = 0; m < 4; ++m) { const float rs = rsv[4 * ai + m];
                const f32x4 g0 = acc[ai][0][m][0] * rs, g1 = acc[ai][0][m][1] * rs, u0 = acc[ai][1][m][0] * rs, u1 = acc[ai][1][m][1] * rs;
                f32x4 h0, h1;
#pragma unroll
                for (int j = 0; j < 4; ++j) { h0[j] = siluf_(g0[j]) * u0[j]; h1[j] = siluf_(g1[j]) * u1[j]; }
                *(u32x4*)(H + (size_t)(row0 + ai * HALF + m * 16) * 2816 + col) = pack8(h0, h1);
            }
    }
};
struct EpiFSS {
    static constexpr bool PERM = true, AFTER_DRAIN = false, PRE = false;
    bf16_t* Fo; float* SS;
    __device__ __forceinline__ void operator()(const f32x4 (&acc)[2][2][4][2], const Unit& u, int wr_, int wc_, int fr_, int fq_) const {
        EPI_IDS;
        const int row0 = u.pm * BM + wr * 64 + fr, col = u.pn * BM + wc * 32 + 8 * fq;
#pragma unroll
        for (int ai = 0; ai < 2; ++ai)
#pragma unroll
            for (int m = 0; m < 4; ++m) {
                const int row = row0 + ai * HALF + m * 16; float ss = 0.f;
#pragma unroll
                for (int bj = 0; bj < 2; ++bj) { const f32x4 v0 = acc[ai][bj][m][0], v1 = acc[ai][bj][m][1];
                    ss += (v0[0] * v0[0] + v0[1] * v0[1]) + (v0[2] * v0[2] + v0[3] * v0[3]) + (v1[0] * v1[0] + v1[1] * v1[1]) + (v1[2] * v1[2] + v1[3] * v1[3]);
                    *(u32x4*)(Fo + (size_t)row * 1024 + col + bj * HALF) = pack8(v0, v1); }
                ss += __shfl_xor(ss, 16); ss += __shfl_xor(ss, 32);
                if (fq == 0) SS[((size_t)u.pn * 33024 + row) * 4 + wc] = ss;
            }
    }
};
struct EpiWin {
    static constexpr bool PERM = true, AFTER_DRAIN = false, PRE = true;
    const float* RS;
    __device__ __forceinline__ void pre(const Unit& u, int wr, int fr, float (&rsv)[8]) const {
#pragma unroll
        for (int i = 0; i < 8; ++i) rsv[i] = RS ? RS[u.pm * BM + wr * 64 + fr + (i >> 2) * HALF + (i & 3) * 16] : 1.f;
    }
    bf16_t* Q; bf16_t* KV; bf16_t* ZR; const float* rope; int MR; bf16_t* VT;
    __device__ __forceinline__ void operator()(const f32x4 (&acc)[2][2][4][2], const Unit& u, int wr_, int wc_, int fr_, int fq_, const float (&rsv)[8]) const {
        EPI_IDS;
        const int row0 = u.pm * BM + wr * 64 + fr, pn = u.pn;
        bf16_t* base; int ld, colt;
        if (pn < 2) { base = Q; ld = 512; colt = pn * 256; } else if (pn == 2) { base = KV; ld = 256; colt = 0; } else { base = ZR; ld = 1792; colt = (pn - 3) * 256; }
        const bool rope_lane = (pn <= 2) && ((wc & 1) == 0) && (fq < 2);
        f32x4 css[2][4], sns[2][4];
#pragma unroll
        for (int ai = 0; ai < 2; ++ai)
#pragma unroll
            for (int m = 0; m < 4; ++m) { css[ai][m] = (f32x4){1.f, 1.f, 1.f, 1.f}; sns[ai][m] = (f32x4){0.f, 0.f, 0.f, 0.f};
                if (rope_lane) { const int row = row0 + ai * HALF + m * 16; const int pos = row < MR ? (row & 8191) + 16 : (row < MR + 16 ? row - MR : 0);
                    css[ai][m] = *(const f32x4*)(rope + pos * 16 + 4 * fq); sns[ai][m] = *(const f32x4*)(rope + pos * 16 + 8 + 4 * fq); } }
#pragma unroll
        for (int ai = 0; ai < 2; ++ai)
#pragma unroll
            for (int m = 0; m < 4; ++m) {
                const int row = row0 + ai * HALF + m * 16;
                const f32x4 cs = css[ai][m], sn = sns[ai][m];
#pragma unroll
                for (int bj = 0; bj < 2; ++bj) { f32x4 v0 = acc[ai][bj][m][0] * rsv[4 * ai + m], v1 = acc[ai][bj][m][1] * rsv[4 * ai + m];
                    if (rope_lane && (pn < 2 || bj == 0)) { const f32x4 x1 = v0, x2 = v1; v0 = x1 * cs - x2 * sn; v1 = x2 * cs + x1 * sn; }
                    const u32x4 pk = pack8(v0, v1);
                    if (pn == 2 && bj == 1) {
                        const int dv = wc * 32 + 8 * fq, pos = (row & 8191) + 16; bf16_t* vt = VT + (((size_t)((row >> 13) * 2 + (dv >> 6)) * 513 + (pos >> 4)) * 64 + (dv & 63)) * 16 + (pos & 15);
#pragma unroll
                        for (int j = 0; j < 8; ++j) vt[j * 16] = (bf16_t)((j & 1) ? (pk[j >> 1] >> 16) : (pk[j >> 1] & 0xffffu));
                    } else *(u32x4*)(base + (size_t)row * ld + colt + bj * HALF + wc * 32 + 8 * fq) = pk; }
                asm volatile("" ::: "memory");
            }
    }
};
struct EpiLora {
    static constexpr bool PERM = true, AFTER_DRAIN = false, PRE = false;
    bf16_t* LW; bf16_t* Aa; bf16_t* Gg; const float* w0; const float* a0;
    __device__ __forceinline__ void operator()(const f32x4 (&acc)[2][2][4][2], const Unit& u, int wr_, int wc_, int fr_, int fq_) const {
        EPI_IDS;
        const int row0 = u.pm * BM + wr * 64 + fr, pn = u.pn, kind = pn >> 1, colt = (pn & 1) * 256 + wc * 32 + 8 * fq;
#pragma unroll
        for (int bj = 0; bj < 2; ++bj) {
            const int col = colt + bj * HALF;
            f32x4 b0 = (f32x4){0.f, 0.f, 0.f, 0.f}, b1 = b0;
            if (kind == 0) { b0 = *(const f32x4*)(w0 + col); b1 = *(const f32x4*)(w0 + col + 4); }
            else if (kind == 1) { b0 = *(const f32x4*)(a0 + col); b1 = *(const f32x4*)(a0 + col + 4); }
#pragma unroll
            for (int ai = 0; ai < 2; ++ai)
#pragma unroll
                for (int m = 0; m < 4; ++m) {
                    const int row = row0 + ai * HALF + m * 16;
                    f32x4 v0 = acc[ai][bj][m][0] + b0, v1 = acc[ai][bj][m][1] + b1;
                    if (kind == 0) {
#pragma unroll
                        for (int j = 0; j < 4; ++j) { v0[j] = -0.6065306597126334f * sigmoidf_(v0[j]); v1[j] = -0.6065306597126334f * sigmoidf_(v1[j]); }
                        *(u32x4*)(LW + (size_t)row * 512 + col) = pack8(v0, v1);
                    } else if (kind == 1) {
#pragma unroll
                        for (int j = 0; j < 4; ++j) { v0[j] = sigmoidf_(v0[j]); v1[j] = sigmoidf_(v1[j]); }
                        *(u32x4*)(Aa + (size_t)row * 512 + col) = pack8(v0, v1);
                    } else {
                        *(u32x4*)(Gg + (size_t)row * 512 + col) = pack8(v0, v1);
                    }
                    asm volatile("" ::: "memory");
                }
        }
    }
};
struct EpiGates {
    static constexpr bool PERM = true, AFTER_DRAIN = false, PRE = false;
    bf16_t* Go;
    __device__ __forceinline__ void operator()(const f32x4 (&acc)[2][2][4][2], const Unit& u, int wr_, int wc_, int fr_, int fq_) const {
        EPI_IDS;
        const int row0 = u.pm * BM + wr * 64 + fr, col = u.pn * BM + wc * 32 + 8 * fq;
#pragma unroll
        for (int ai = 0; ai < 2; ++ai)
#pragma unroll
            for (int m = 0; m < 4; ++m)
#pragma unroll
                for (int bj = 0; bj < 2; ++bj) { f32x4 v0 = acc[ai][bj][m][0], v1 = acc[ai][bj][m][1];
#pragma unroll
                    for (int j = 0; j < 4; ++j) { v0[j] = sigmoidf_(v0[j]); v1[j] = sigmoidf_(v1[j]); }
                    *(u32x4*)(Go + (size_t)(row0 + ai * HALF + m * 16) * 2048 + col + bj * HALF) = pack8(v0, v1); }
    }
};
template <bool SECOND> struct EpiBranch {
    static constexpr bool PERM = true, AFTER_DRAIN = false, PRE = false;
    bf16_t* Mg; const bf16_t* Gt;
    __device__ __forceinline__ void operator()(const f32x4 (&acc)[2][2][4][2], const Unit& u, int wr_, int wc_, int fr_, int fq_) const {
        EPI_IDS;
        const int row0 = u.pm * BM + wr * 64 + fr, col = u.pn * BM + wc * 32 + 8 * fq;
#pragma unroll
        for (int ai = 0; ai < 2; ++ai)
#pragma unroll
            for (int m = 0; m < 4; ++m)
#pragma unroll
                for (int bj = 0; bj < 2; ++bj) {
                    const size_t row = (size_t)(row0 + ai * HALF + m * 16);
                    const u32x4 gw = *(const u32x4*)(Gt + row * 2048 + col + bj * HALF);
                    f32x4 v0 = acc[ai][bj][m][0], v1 = acc[ai][bj][m][1];
                    v0[0] *= bf_lo(gw.x); v0[1] *= bf_hi(gw.x); v0[2] *= bf_lo(gw.y); v0[3] *= bf_hi(gw.y);
                    v1[0] *= bf_lo(gw.z); v1[1] *= bf_hi(gw.z); v1[2] *= bf_lo(gw.w); v1[3] *= bf_hi(gw.w);
                    u32x4* dst = (u32x4*)(Mg + row * 1024 + col + bj * HALF);
                    if (SECOND) { const u32x4 pw = *dst;
                        v0[0] += bf_lo(pw.x); v0[1] += bf_hi(pw.x); v0[2] += bf_lo(pw.y); v0[3] += bf_hi(pw.y);
                        v1[0] += bf_lo(pw.z); v1[1] += bf_hi(pw.z); v1[2] += bf_lo(pw.w); v1[3] += bf_hi(pw.w); }
                    *dst = pack8(v0, v1);
                    asm volatile("" ::: "memory");
                }
    }
};
struct EpiMerge {
    static constexpr bool PERM = true, AFTER_DRAIN = false, PRE = false;
    bf16_t* Mg; const bf16_t* Gt; unsigned* cnt;
    __device__ __forceinline__ void operator()(const f32x4 (&acc)[2][2][4][2], const Unit& u, int wr_, int wc_, int fr_, int fq_) const {
        EPI_IDS;
        const int row0 = u.pm * BM + wr * 64 + fr, col = u.pn * HALF + wc * 32 + 8 * fq;
#pragma unroll
        for (int ai = 0; ai < 2; ++ai)
#pragma unroll
            for (int m = 0; m < 4; ++m) {
                const size_t row = (size_t)(row0 + ai * HALF + m * 16);
#ifdef MK_GATE_SC
                u32x4 ga, gr;
                { const unsigned long long* pa = (const unsigned long long*)(Gt + row * 2048 + col); const unsigned long long* pr = (const unsigned long long*)(Gt + row * 2048 + 1024 + col);
                  const unsigned long long a0_ = __hip_atomic_load(pa, __ATOMIC_RELAXED, __HIP_MEMORY_SCOPE_SYSTEM), a1_ = __hip_atomic_load(pa + 1, __ATOMIC_RELAXED, __HIP_MEMORY_SCOPE_SYSTEM);
                  const unsigned long long r0_ = __hip_atomic_load(pr, __ATOMIC_RELAXED, __HIP_MEMORY_SCOPE_SYSTEM), r1_ = __hip_atomic_load(pr + 1, __ATOMIC_RELAXED, __HIP_MEMORY_SCOPE_SYSTEM);
                  ga.x = (unsigned)a0_; ga.y = (unsigned)(a0_ >> 32); ga.z = (unsigned)a1_; ga.w = (unsigned)(a1_ >> 32); gr.x = (unsigned)r0_; gr.y = (unsigned)(r0_ >> 32); gr.z = (unsigned)r1_; gr.w = (unsigned)(r1_ >> 32); }
#else
                const u32x4 ga = *(const u32x4*)(Gt + row * 2048 + col), gr = *(const u32x4*)(Gt + row * 2048 + 1024 + col);
#endif
#ifdef MK_GATE_CHECK
                { const float gmx = fmaxf(fmaxf(fmaxf(bf_lo(ga.x), bf_hi(ga.x)), fmaxf(bf_lo(ga.y), bf_hi(ga.y))), fmaxf(fmaxf(bf_lo(gr.z), bf_hi(gr.z)), fmaxf(bf_lo(gr.w), bf_hi(gr.w))));
                  const float gmn = fminf(fminf(fminf(bf_lo(ga.x), bf_hi(ga.x)), fminf(bf_lo(ga.y), bf_hi(ga.y))), fminf(fminf(bf_lo(gr.z), bf_hi(gr.z)), fminf(bf_lo(gr.w), bf_hi(gr.w))));
                  if (gmx > 1.001f || gmn < 0.f) atomicAdd(cnt, 1u); }
#endif
                const f32x4 a0 = acc[ai][0][m][0], a1 = acc[ai][0][m][1], r0 = acc[ai][1][m][0], r1 = acc[ai][1][m][1];
                f32x4 v0, v1;
                v0[0] = a0[0] * bf_lo(ga.x) + r0[0] * bf_lo(gr.x); v0[1] = a0[1] * bf_hi(ga.x) + r0[1] * bf_hi(gr.x); v0[2] = a0[2] * bf_lo(ga.y) + r0[2] * bf_lo(gr.y); v0[3] = a0[3] * bf_hi(ga.y) + r0[3] * bf_hi(gr.y);
                v1[0] = a1[0] * bf_lo(ga.z) + r1[0] * bf_lo(gr.z); v1[1] = a1[1] * bf_hi(ga.z) + r1[1] * bf_hi(gr.z); v1[2] = a1[2] * bf_lo(ga.w) + r1[2] * bf_lo(gr.w); v1[3] = a1[3] * bf_hi(ga.w) + r1[3] * bf_hi(gr.w);
                *(u32x4*)(Mg + row * 1024 + col) = pack8(v0, v1);
                asm volatile("" ::: "memory");
            }
    }
};
struct EpiPlain {
    static constexpr bool PERM = true, AFTER_DRAIN = false, PRE = false;
    bf16_t* O; int ldc; int npl; size_t plane;
    __device__ __forceinline__ void operator()(const f32x4 (&acc)[2][2][4][2], const Unit& u, int wr_, int wc_, int fr_, int fq_) const {
        EPI_IDS;
        const int row0 = u.pm * BM + wr * 64 + fr, col = (u.pn % npl) * BM + wc * 32 + 8 * fq; bf16_t* O = this->O + (size_t)(u.pn / npl) * plane;
#pragma unroll
        for (int ai = 0; ai < 2; ++ai)
#pragma unroll
            for (int m = 0; m < 4; ++m)
#pragma unroll
                for (int bj = 0; bj < 2; ++bj) *(u32x4*)(O + (size_t)(row0 + ai * HALF + m * 16) * ldc + col + bj * HALF) = pack8(acc[ai][bj][m][0], acc[ai][bj][m][1]);
    }
};
struct EpiGateMerge {
    static constexpr bool PERM = true, AFTER_DRAIN = false, PRE = true;
    const float* RS;
    __device__ __forceinline__ void pre(const Unit& u, int wr, int fr, float (&rsv)[8]) const {
#pragma unroll
        for (int i = 0; i < 8; ++i) rsv[i] = RS ? RS[u.pm * BM + wr * 64 + fr + (i >> 2) * HALF + (i & 3) * 16] : 1.f;
    }
    bf16_t* Mg; const bf16_t* Y1; const bf16_t* Y2;
    __device__ __forceinline__ void operator()(const f32x4 (&acc)[2][2][4][2], const Unit& u, int wr_, int wc_, int fr_, int fq_, const float (&rsv)[8]) const {
        EPI_IDS;
        const int row0 = u.pm * BM + wr * 64 + fr, col = u.pn * HALF + wc * 32 + 8 * fq;
        u32x4 y1s[2][4], y2s[2][4];
#pragma unroll
        for (int ai = 0; ai < 2; ++ai)
#pragma unroll
            for (int m = 0; m < 4; ++m) { const size_t o = (size_t)(row0 + ai * HALF + m * 16) * 1024 + col; y1s[ai][m] = *(const u32x4*)(Y1 + o); y2s[ai][m] = *(const u32x4*)(Y2 + o); }
#pragma unroll
        for (int ai = 0; ai < 2; ++ai)
#pragma unroll
            for (int m = 0; m < 4; ++m) {
                const size_t o = (size_t)(row0 + ai * HALF + m * 16) * 1024 + col;
                const u32x4 y1 = y1s[ai][m], y2 = y2s[ai][m];
                const float rs = rsv[4 * ai + m];
                const f32x4 a0 = acc[ai][0][m][0] * rs, a1 = acc[ai][0][m][1] * rs, r0 = acc[ai][1][m][0] * rs, r1 = acc[ai][1][m][1] * rs;
                f32x4 v0, v1;
                v0[0] = sigmoidf_(a0[0]) * bf_lo(y1.x) + sigmoidf_(r0[0]) * bf_lo(y2.x); v0[1] = sigmoidf_(a0[1]) * bf_hi(y1.x) + sigmoidf_(r0[1]) * bf_hi(y2.x);
                v0[2] = sigmoidf_(a0[2]) * bf_lo(y1.y) + sigmoidf_(r0[2]) * bf_lo(y2.y); v0[3] = sigmoidf_(a0[3]) * bf_hi(y1.y) + sigmoidf_(r0[3]) * bf_hi(y2.y);
                v1[0] = sigmoidf_(a1[0]) * bf_lo(y1.z) + sigmoidf_(r1[0]) * bf_lo(y2.z); v1[1] = sigmoidf_(a1[1]) * bf_hi(y1.z) + sigmoidf_(r1[1]) * bf_hi(y2.z);
                v1[2] = sigmoidf_(a1[2]) * bf_lo(y1.w) + sigmoidf_(r1[2]) * bf_lo(y2.w); v1[3] = sigmoidf_(a1[3]) * bf_hi(y1.w) + sigmoidf_(r1[3]) * bf_hi(y2.w);
                *(u32x4*)(Mg + o) = pack8(v0, v1);
                asm volatile("" ::: "memory");
            }
    }
};
template <class Epi, class Sched, bool ALIGN_EPI = false, bool SP2 = false>
__device__ __forceinline__ void gemm_phase(PG8_LAS unsigned char* lds, const Gemm g, const Sched& S, const Epi& E) {
    int tid_ = threadIdx.x; asm volatile("" : "+v"(tid_));
    const int tid = tid_, wid = __builtin_amdgcn_readfirstlane(tid >> 6), lane = tid & 63, wr = wid >> 2, wc = wid & 3, fr = lane & 15, fq = lane >> 4;
    const int K = g.K, nt = K / BK;
    unsigned voffA[2], voffB[2];
#pragma unroll
    for (int i = 0; i < 2; ++i) { int R, C; stage_rc(tid * 16 + i * 8192, R, C); const int Rb = Epi::PERM ? ((R & ~31) + perm32(R & 31)) : R;
        voffA[i] = (unsigned)(R * g.lda + C) * 2u; voffB[i] = (unsigned)(Rb * g.ldb + C) * 2u; }
    const size_t kstep = (size_t)(BK * 2);
    const size_t hstepA = (size_t)HALF * g.lda * 2, hstepB = (size_t)HALF * g.ldb * 2;
    const size_t tstepA = 2 * hstepA, tstepB = 2 * hstepB;
    const unsigned ldsw = (unsigned)wid * 1024u;
    const int aoff = lds_byte(wr * 64 + fr, fq * 8), boff = lds_byte(wc * 32 + fr, fq * 8);
#define PG8_SA(b, h) (((b) * 2 + (h)) * HTB)
#define PG8_SB(b, h) ((4 + (b) * 2 + (h)) * HTB)
#define PG8_STAGE(bufoff, gbase, voff) do { _Pragma("unroll") for (int _i = 0; _i < 2; ++_i) \
        __builtin_amdgcn_global_load_lds((const unsigned*)((const char*)(gbase) + (voff)[_i]), (PG8_LAS unsigned*)(lds + (bufoff) + ldsw + _i * 8192), 16, 0, 0); } while (0)
#define PG8_LDA(dst, b, h) do { _Pragma("unroll") for (int m = 0; m < 4; ++m) _Pragma("unroll") for (int k = 0; k < 2; ++k) dst[m][k] = *(const PG8_LAS bf16x8*)(lds + PG8_SA(b, h) + aoff + m * 2048 + k * 1024); } while (0)
#define PG8_LDB(dst, b, h) do { _Pragma("unroll") for (int n = 0; n < 2; ++n) _Pragma("unroll") for (int k = 0; k < 2; ++k) dst[n][k] = *(const PG8_LAS bf16x8*)(lds + PG8_SB(b, h) + boff + n * 2048 + k * 1024); } while (0)
#define PG8_MMA(ai, bj, At, Bt) do { __builtin_amdgcn_s_setprio(1); _Pragma("unroll") for (int m = 0; m < 4; ++m) _Pragma("unroll") for (int n = 0; n < 2; ++n) _Pragma("unroll") for (int k = 0; k < 2; ++k) \
        acc[ai][bj][m][n] = __builtin_amdgcn_mfma_f32_16x16x32_bf16(Bt[n][k], At[m][k], acc[ai][bj][m][n], 0, 0, 0); __builtin_amdgcn_s_setprio(0); } while (0)
#define PG8_WAIT_V(n) asm volatile("s_waitcnt vmcnt(" #n ")" ::: "memory")
#define PG8_WAIT_L(n) asm volatile("s_waitcnt lgkmcnt(" #n ")" ::: "memory")
#define PG8_BAR __builtin_amdgcn_s_barrier()
#define PG8_SCHED __builtin_amdgcn_sched_barrier(0)
    Unit cur, nxt; int ui = 0;
    if (!S.next(0, cur)) return;
    f32x4 acc[2][2][4][2];
#pragma unroll
    for (int a = 0; a < 2; ++a)
#pragma unroll
        for (int b = 0; b < 2; ++b)
#pragma unroll
            for (int m = 0; m < 4; ++m)
#pragma unroll
                for (int n = 0; n < 2; ++n) acc[a][b][m][n] = (f32x4){0.f, 0.f, 0.f, 0.f};
    bf16x8 At[4][2], B0[2][2], B1[2][2];
    const char* cA = (const char*)(cur.pn >= g.nsplit ? g.A2 : g.A) + (size_t)cur.pm * tstepA; const char* cB = (const char*)g.Bt + (size_t)cur.pn * tstepB;
    S.a_ready(cur);
    float rsv[8]; if constexpr (Epi::PRE) E.pre(cur, wr, fr, rsv);
    if constexpr (SP2) {
        PG8_STAGE(PG8_SB(0, 0), cB, voffB); PG8_STAGE(PG8_SB(0, 1), cB + hstepB, voffB); PG8_STAGE(PG8_SA(0, 0), cA, voffA); PG8_STAGE(PG8_SA(0, 1), cA + hstepA, voffA);
        if (wr == 1) PG8_BAR;
        PG8_WAIT_V(2); PG8_BAR;
        PG8_STAGE(PG8_SB(1, 0), cB + kstep, voffB); PG8_STAGE(PG8_SA(1, 0), cA + kstep, voffA); PG8_STAGE(PG8_SB(1, 1), cB + hstepB + kstep, voffB);
        PG8_WAIT_V(6); PG8_BAR;
    } else {
        PG8_STAGE(PG8_SB(0, 0), cB, voffB); PG8_STAGE(PG8_SA(0, 0), cA, voffA); PG8_STAGE(PG8_SB(0, 1), cB + hstepB, voffB); PG8_STAGE(PG8_SA(0, 1), cA + hstepA, voffA);
        if (wr == 1) PG8_BAR;
        PG8_WAIT_V(4); PG8_BAR;
        PG8_STAGE(PG8_SB(1, 0), cB + kstep, voffB); PG8_STAGE(PG8_SA(1, 0), cA + kstep, voffA); PG8_STAGE(PG8_SB(1, 1), cB + hstepB + kstep, voffB);
        PG8_WAIT_V(6); PG8_BAR;
    }
    for (;;) {
        const bool has_next = S.next(ui + 1, nxt);
        const char* nA = has_next ? (const char*)(nxt.pn >= g.nsplit ? g.A2 : g.A) + (size_t)nxt.pm * tstepA : cA; const char* nB = has_next ? (const char*)g.Bt + (size_t)nxt.pn * tstepB : cB;
        for (int t = 0; t < nt; t += 2) {
            const bool last = (t == nt - 2);
            const char* a1 = cA + (size_t)(t + 1) * kstep;
            const char* a2 = last ? nA : cA + (size_t)(t + 2) * kstep; const char* b2 = last ? nB : cB + (size_t)(t + 2) * kstep;
            const char* a3 = a2 + kstep; const char* b3 = b2 + kstep;
            if (last && has_next) S.a_ready(nxt);
            if constexpr (SP2) {
            PG8_LDB(B0, 0, 0); PG8_LDB(B1, 0, 1); PG8_SCHED; PG8_LDA(At, 0, 0); PG8_STAGE(PG8_SA(1, 1), a1 + hstepA, voffA);
            PG8_WAIT_V(8); PG8_WAIT_L(0); PG8_BAR; PG8_MMA(0, 0, At, B0); PG8_MMA(0, 1, At, B1); PG8_BAR; PG8_SCHED;
            PG8_LDA(At, 0, 1); PG8_STAGE(PG8_SB(0, 0), b2, voffB); PG8_STAGE(PG8_SB(0, 1), b2 + hstepB, voffB); PG8_STAGE(PG8_SA(0, 0), a2, voffA);
            PG8_WAIT_V(8); PG8_WAIT_L(0); PG8_BAR; PG8_MMA(1, 0, At, B0); PG8_MMA(1, 1, At, B1); PG8_BAR; PG8_SCHED;
            PG8_LDB(B0, 1, 0); PG8_LDB(B1, 1, 1); PG8_SCHED; PG8_LDA(At, 1, 0); PG8_STAGE(PG8_SA(0, 1), a2 + hstepA, voffA);
            PG8_WAIT_V(8); PG8_WAIT_L(0); PG8_BAR; PG8_MMA(0, 0, At, B0); PG8_MMA(0, 1, At, B1); PG8_BAR; PG8_SCHED;
            PG8_LDA(At, 1, 1); PG8_STAGE(PG8_SB(1, 0), b3, voffB); PG8_STAGE(PG8_SB(1, 1), b3 + hstepB, voffB); PG8_STAGE(PG8_SA(1, 0), a3, voffA);
            PG8_WAIT_V(8); PG8_WAIT_L(0); PG8_BAR; PG8_MMA(1, 0, At, B0); PG8_MMA(1, 1, At, B1); PG8_BAR; PG8_SCHED;
            } else {
            PG8_LDB(B0, 0, 0); PG8_SCHED; PG8_LDA(At, 0, 0); PG8_STAGE(PG8_SA(1, 1), a1 + hstepA, voffA);
            PG8_WAIT_L(8); PG8_BAR; PG8_WAIT_L(0); PG8_MMA(0, 0, At, B0); PG8_BAR; PG8_SCHED;
            PG8_LDB(B1, 0, 1); PG8_STAGE(PG8_SB(0, 0), b2, voffB);
            PG8_BAR; PG8_WAIT_L(0); PG8_MMA(0, 1, At, B1); PG8_BAR;
            PG8_LDA(At, 0, 1); PG8_STAGE(PG8_SA(0, 0), a2, voffA);
            PG8_BAR; PG8_WAIT_L(0); PG8_MMA(1, 0, At, B0); PG8_BAR; PG8_SCHED;
            PG8_STAGE(PG8_SB(0, 1), b2 + hstepB, voffB);
            PG8_WAIT_V(6); PG8_BAR; PG8_MMA(1, 1, At, B1); PG8_BAR;
            PG8_LDB(B0, 1, 0); PG8_SCHED; PG8_LDA(At, 1, 0); PG8_STAGE(PG8_SA(0, 1), a2 + hstepA, voffA);
            PG8_WAIT_L(8); PG8_BAR; PG8_WAIT_L(0); PG8_MMA(0, 0, At, B0); PG8_BAR; PG8_SCHED;
            PG8_LDB(B1, 1, 1); PG8_STAGE(PG8_SB(1, 0), b3, voffB);
            PG8_BAR; PG8_WAIT_L(0); PG8_MMA(0, 1, At, B1); PG8_BAR;
            PG8_LDA(At, 1, 1); PG8_STAGE(PG8_SA(1, 0), a3, voffA);
            PG8_BAR; PG8_WAIT_L(0); PG8_MMA(1, 0, At, B0); PG8_BAR; PG8_SCHED;
            PG8_STAGE(PG8_SB(1, 1), b3 + hstepB, voffB);
            PG8_WAIT_V(6); PG8_BAR; PG8_MMA(1, 1, At, B1); PG8_BAR;
            }
        }
        if constexpr (ALIGN_EPI) { if (wr == 0) PG8_BAR; }
        if constexpr (!Epi::AFTER_DRAIN) { if constexpr (Epi::PRE) E(acc, cur, wr, wc, fr, fq, rsv); else E(acc, cur, wr, wc, fr, fq); S.done(cur); }
        if (!has_next) break;
#pragma unroll
        for (int a = 0; a < 2; ++a)
#pragma unroll
            for (int b = 0; b < 2; ++b)
#pragma unroll
                for (int m = 0; m < 4; ++m)
#pragma unroll
                    for (int n = 0; n < 2; ++n) acc[a][b][m][n] = (f32x4){0.f, 0.f, 0.f, 0.f};
        cur = nxt; cA = nA; cB = nB; ++ui;
        if constexpr (Epi::PRE) E.pre(cur, wr, fr, rsv);
        if constexpr (ALIGN_EPI) { if (wr == 1) PG8_BAR; }
    }
    PG8_WAIT_V(0);
    if constexpr (!ALIGN_EPI) { if (wr == 0) PG8_BAR; }
    PG8_BAR;
    if constexpr (Epi::AFTER_DRAIN) { E.fused(acc, cur, wr, wc, fr, fq, lds, wid, lane); S.done(cur); }
#undef PG8_SA
#undef PG8_SB
#undef PG8_STAGE
#undef PG8_LDA
#undef PG8_LDB
#undef PG8_MMA
#undef PG8_WAIT_V
#undef PG8_WAIT_L
#undef PG8_BAR
#undef PG8_SCHED
}
}

constexpr int NWAVES = 8;
constexpr int DM = 1024, NB = 4, SEQL = 8192, NMETA = 16, DFF = 2816;
constexpr int MR = NB * SEQL;
constexpr int MP = MR + 256;
constexpr int NHID2 = 2 * DFF;
constexpr int NIN = 4608, NIN_A = 2560;
#ifndef MK_GN_EPS
#define MK_GN_EPS 64e-5f
#endif
constexpr float NORM_EPS = 1e-6f, GN_EPS = MK_GN_EPS;

constexpr size_t MiB = 1u << 20;
constexpr size_t WS_CTL = 0, CTL_ZERO_BYTES = 64 * 1024;
constexpr size_t WS_WGU1 = 128 * 1024;
constexpr size_t WS_WD1  = WS_WGU1 + (size_t)NHID2 * DM * 2;
constexpr size_t WS_WIN  = WS_WD1 + (size_t)DM * DFF * 2;
constexpr size_t WS_WBR = WS_WIN + (size_t)NIN * DM * 2;
constexpr size_t WS_WATT = WS_WBR, WS_WRWKV = WS_WBR + (size_t)DM * 512 * 2;
constexpr size_t WS_WMIX = WS_WBR + (size_t)2048 * DM * 2;
constexpr size_t WS_WGU2 = WS_WMIX + (size_t)DM * DM * 2;
constexpr size_t WS_WD2  = WS_WGU2 + (size_t)NHID2 * DM * 2;
constexpr size_t WS_WL   = WS_WD2 + (size_t)DM * DFF * 2;
constexpr size_t WS_ROPE = WS_WL + (size_t)1536 * 256 * 2;
constexpr size_t WS_SS   = WS_ROPE + (size_t)8208 * 16 * 4;
constexpr size_t WS_HMETA = WS_SS + (size_t)MP * 16 * 4;
constexpr size_t WS_SMALL_END = WS_HMETA + 16 * 1024 * 4;
constexpr size_t WS_XN = 52 * MiB;
constexpr size_t WS_HM = WS_XN, WS_RS2 = WS_XN + 1 * MiB, WS_RS3 = WS_XN + 2 * MiB;
constexpr size_t WS_F  = WS_XN + (size_t)MP * DM * 2;
constexpr size_t WS_BIG = WS_F + (size_t)MP * DM * 2;
constexpr size_t WS_HID = WS_BIG;
constexpr size_t WS_Q  = WS_BIG;
constexpr size_t WS_KV = WS_Q + (size_t)MP * 512 * 2;
constexpr size_t WS_ZR = WS_KV + (size_t)MP * 256 * 2;
constexpr size_t WS_LW = WS_ZR + (size_t)MP * 1792 * 2;
constexpr size_t WS_AA = WS_LW + (size_t)MP * 512 * 2;
constexpr size_t WS_GG = WS_AA + (size_t)MP * 512 * 2;
constexpr size_t WS_LA = WS_GG + (size_t)MP * 512 * 2;
constexpr size_t WS_MIX_END = WS_LA + (size_t)MP * 256 * 2;
constexpr size_t WS_QY = WS_LA;
constexpr size_t WS_SST = WS_LW;
constexpr size_t WS_DOTS = WS_SS;
static_assert(WS_QY + (size_t)4128 * 16384 <= 512 * MiB && (size_t)4128 * 8192 <= (size_t)MP * 512 * 4, "rwkv images");
constexpr size_t WS_GATES = WS_LW;
constexpr size_t WS_MERGED = WS_ZR;
constexpr size_t WS_VT = 503 * MiB + 512 * 1024;
constexpr int PV = 8208;
constexpr size_t WS_END = 512 * MiB;
static_assert(WS_QY + (size_t)4128 * 16384 <= WS_VT && WS_VT + (size_t)NB * 2 * 64 * PV * 2 <= WS_END, "VT");
static_assert(WS_SMALL_END <= WS_XN && WS_HID + (size_t)MP * DFF * 2 <= WS_END && WS_MIX_END <= WS_END && WS_MERGED + (size_t)MR * DM * 2 <= WS_LW && WS_GATES + (size_t)MR * 2048 * 2 <= WS_END, "d_ws map");
constexpr int CW_LASTCHUNK = 10240;
constexpr int CW_BAR = 1024;

constexpr int RING_OFF = 0, RING_BYTES = 131072;
constexpr int LDSCTL_OFF = RING_BYTES, MISC_OFF = LDSCTL_OFF + 320;
constexpr int LDS_BYTES = 147456;

#define GAS __attribute__((address_space(1)))
#define LAS __attribute__((address_space(3)))
typedef unsigned short bf16;
typedef unsigned v4u __attribute__((ext_vector_type(4)));
typedef unsigned v2u __attribute__((ext_vector_type(2)));
typedef float f32x4 __attribute__((ext_vector_type(4)));
typedef float f32x2v __attribute__((ext_vector_type(2)));
typedef float f32x16 __attribute__((ext_vector_type(16)));
typedef short bf16x8 __attribute__((ext_vector_type(8)));
typedef GAS unsigned gu32;
#define RLX_AGENT __ATOMIC_RELAXED, __HIP_MEMORY_SCOPE_AGENT
#define LDS_WAIT() asm volatile("s_waitcnt lgkmcnt(0)" ::: "memory")
#define VM_WAIT() asm volatile("s_waitcnt vmcnt(0)" ::: "memory")
__device__ __forceinline__ unsigned pk2(float lo, float hi) { return pg8::cvt_pk_bf16(lo, hi); }
__device__ __forceinline__ unsigned f2bf(float f) { return pg8::cvt_pk_bf16(f, 0.f) & 0xffffu; }
__device__ __forceinline__ float bflo(unsigned w) { return __builtin_bit_cast(float, w << 16); }
__device__ __forceinline__ float bfhi(unsigned w) { return __builtin_bit_cast(float, w & 0xffff0000u); }
__device__ __forceinline__ float bf1(bf16 h) { return __builtin_bit_cast(float, (unsigned)h << 16); }
__device__ __forceinline__ float sigm(float x) { return 1.0f / (1.0f + __expf(-x)); }

#define XB_TMO      128
#define XB_XCNT(j)  (256  + 64 * (j))
#define XB_XSUB(j)  (1280 + 64 * (j))
#define XB_XGEN(j)  (2304 + 64 * (j))
#define XB_TOP      3328
#define XB_TOPGEN   3392
#define XCD_BAR_WORDS 3456
#define XB_SPIN_CAP (1u << 24)

__device__ __forceinline__ unsigned xb_ld(unsigned* p)              { return __hip_atomic_load(p, __ATOMIC_RELAXED, __HIP_MEMORY_SCOPE_AGENT); }
__device__ __forceinline__ unsigned xb_add(unsigned* p, unsigned v) { return __hip_atomic_fetch_add(p, v, __ATOMIC_RELAXED, __HIP_MEMORY_SCOPE_AGENT); }
__device__ __forceinline__ unsigned xb_xcc_id() { return (unsigned)__builtin_amdgcn_s_getreg((3 << 11) | 20) & 0xFu; }
#define XB_SPIN(cond, bar) do { unsigned _sp = 0; while (cond) { __builtin_amdgcn_s_sleep(1); \
    if ((++_sp & 255u) == 0u) { if (xb_ld(&(bar)[XB_TMO])) break; if (_sp > XB_SPIN_CAP) { atomicAdd(&(bar)[XB_TMO], 1u); break; } } } } while (0)

struct XcdBarrier {
    unsigned* bar; unsigned x;
    volatile LAS unsigned* st;
};

__device__ __forceinline__ XcdBarrier xcd_barrier_post(unsigned* bar, volatile LAS unsigned* st) {
    XcdBarrier b; b.bar = bar; b.x = xb_xcc_id(); b.st = st;
    if (threadIdx.x == 0) (void)xb_add(&bar[XB_XCNT(b.x)], 1u);
    return b;
}
__device__ __forceinline__ void xcd_barrier_complete(unsigned* bar, unsigned x, unsigned& nloc, unsigned& nx) {
    const unsigned G = gridDim.x * gridDim.y * gridDim.z;
    unsigned sum, cnt, mine, sp = 0u;
    for (;;) {
        sum = 0u; cnt = 0u; mine = 0u;
#pragma unroll
        for (unsigned j = 0; j < 16; ++j) { const unsigned c = xb_ld(&bar[XB_XCNT(j)]); sum += c; cnt += (c > 0u) ? 1u : 0u; mine = (j == x) ? c : mine; }
        if (sum == G) break;
        __builtin_amdgcn_s_sleep(1);
        if ((++sp & 255u) == 0u) { if (xb_ld(&bar[XB_TMO])) break; if (sp > XB_SPIN_CAP) { atomicAdd(&bar[XB_TMO], 1u); break; } }
    }
    nloc = mine > 0u ? mine : 1u; nx = cnt > 0u ? cnt : 1u;
}

__device__ __forceinline__ void xcd_barrier(const XcdBarrier& b) {
    asm volatile("s_waitcnt vmcnt(0)" ::: "memory");
    __syncthreads();
    if (threadIdx.x == 0) {
        unsigned* bar = b.bar;
        __builtin_amdgcn_s_waitcnt(0);
        unsigned nloc = b.st[0], nx = b.st[1];
        if (nloc == 0u) { xcd_barrier_complete(bar, b.x, nloc, nx); b.st[0] = nloc; b.st[1] = nx; }
        const unsigned old = xb_add(&bar[XB_XSUB(b.x)], 1u);
        const unsigned gen = old / nloc;
        if (old + 1u == (gen + 1u) * nloc) {
            __builtin_amdgcn_fence(__ATOMIC_RELEASE, "");
            asm volatile("s_waitcnt vmcnt(0)" ::: "memory");
            const unsigned og = xb_add(&bar[XB_TOP], 1u);
            const unsigned tg = og / nx;
            if (og + 1u == (tg + 1u) * nx) xb_add(&bar[XB_TOPGEN], 1u);
            else XB_SPIN(xb_ld(&bar[XB_TOPGEN]) == tg, bar);
            __builtin_amdgcn_fence(__ATOMIC_ACQUIRE, "");
            xb_add(&bar[XB_XGEN(b.x)], 1u);
            asm volatile("s_waitcnt vmcnt(0)" ::: "memory");
        } else {
            XB_SPIN(xb_ld(&bar[XB_XGEN(b.x)]) == gen, bar);
            __builtin_amdgcn_fence(__ATOMIC_ACQUIRE, "");
            asm volatile("s_waitcnt vmcnt(0)" ::: "memory");
        }
    }
    __syncthreads();
}


struct Frame {
    LAS unsigned char* lds;
    volatile LAS unsigned* MISC;
    gu32* ctl;
    int tid, lane, wave;
    int vcu, G;
    float* out; unsigned char* ws;
};
struct Args { const float* in[28]; float* out; unsigned char* ws; int ph_lo, ph_hi, li, pad; };
__device__ __forceinline__ const float* inp(int k) {
    typedef const float* cfp;
    const __attribute__((address_space(4))) char* kp = (const __attribute__((address_space(4))) char*)__builtin_amdgcn_kernarg_segment_ptr();
    return *(volatile const __attribute__((address_space(4))) cfp*)(kp + 8 * k);
}
__device__ __forceinline__ float wave_sum(float v) {
#pragma unroll
    for (int o = 1; o < 64; o <<= 1) v += __shfl_xor(v, o);
    return v;
}

__device__ __forceinline__ float dpp_f(float v, const int ctrl_sel) {
    const int x = __builtin_bit_cast(int, v); int r;
    if (ctrl_sel == 0) r = __builtin_amdgcn_update_dpp(0, x, 0xB1, 0xF, 0xF, true);
    else if (ctrl_sel == 1) r = __builtin_amdgcn_update_dpp(0, x, 0x4E, 0xF, 0xF, true);
    else r = __builtin_amdgcn_update_dpp(0, x, 0x141, 0xF, 0xF, true);
    return __builtin_bit_cast(float, r);
}
__device__ __forceinline__ float wave_sum_dpp(float v) {
    v += dpp_f(v, 0); v += dpp_f(v, 1); v += dpp_f(v, 2);
    { const int x = __builtin_bit_cast(int, v); v += __builtin_bit_cast(float, __builtin_amdgcn_update_dpp(0, x, 0x140, 0xF, 0xF, true)); }
    const int xi = __builtin_bit_cast(int, v);
    return (__builtin_bit_cast(float, __builtin_amdgcn_readlane(xi, 0)) + __builtin_bit_cast(float, __builtin_amdgcn_readlane(xi, 16))) + (__builtin_bit_cast(float, __builtin_amdgcn_readlane(xi, 32)) + __builtin_bit_cast(float, __builtin_amdgcn_readlane(xi, 48)));
}
struct MapId { __device__ __forceinline__ int operator()(int n) const { return n; } };
struct MapGateUp { __device__ __forceinline__ int operator()(int n) const { return n < DFF ? 256 * (n >> 7) + (n & 127) : 256 * ((n - DFF) >> 7) + 128 + ((n - DFF) & 127); } };
struct MapBrA { __device__ __forceinline__ int operator()(int n) const { return 256 * (n >> 7) + (n & 127); } };
struct MapBrR { __device__ __forceinline__ int operator()(int n) const { return 256 * (n >> 7) + 128 + (n & 127); } };
struct MapWin { __device__ __forceinline__ int operator()(int n) const { if (n >= 2560) { const int j = n - 2560; return j < 1024 ? 2560 + 256 * (j >> 7) + (j & 127) : 2560 + 256 * ((j - 1024) >> 7) + 128 + ((j - 1024) & 127); } if (n >= 640) return n; const int s = n & 63; if (s >= 16) return n; const int d = (s >= 4 && s < 8) ? s + 4 : ((s >= 8 && s < 12) ? s - 4 : s); return n - s + d; } };
template <class Map>
__device__ __forceinline__ void p0_transpose_item(const float* W, int K, int N, bf16* WT, LAS float* scr, int item, int lane, Map map, const float* kgain = nullptr) {
    const int ldk = K, kofs = 0;
    const int nblk = N / 32, kb = item / nblk, nb = item % nblk, k0 = 64 * kb, n0 = 32 * nb;
#pragma unroll 8
    for (int i = 0; i < 32; ++i) { const int kk = 2 * i + (lane >> 5); scr[kk * 33 + (lane & 31)] = W[(size_t)(k0 + kk) * N + n0 + (lane & 31)]; }
    LDS_WAIT(); asm volatile("" ::: "memory");
    const int c = lane & 7;
    f32x4 ga = (f32x4){1.f, 1.f, 1.f, 1.f}, gb = ga; if (kgain) { ga = *(const f32x4*)(kgain + k0 + 8 * c); gb = *(const f32x4*)(kgain + k0 + 8 * c + 4); }
#pragma unroll
    for (int j = 0; j < 4; ++j) { const int n = (lane >> 3) + 8 * j; const LAS float* s = scr + (8 * c) * 33 + n;
        v4u o; o.x = pk2(s[0 * 33] * ga.x, s[1 * 33] * ga.y); o.y = pk2(s[2 * 33] * ga.z, s[3 * 33] * ga.w); o.z = pk2(s[4 * 33] * gb.x, s[5 * 33] * gb.y); o.w = pk2(s[6 * 33] * gb.z, s[7 * 33] * gb.w);
        *(GAS v4u*)(WT + (size_t)map(n0 + n) * ldk + kofs + k0 + 8 * c) = o; }
    LDS_WAIT(); asm volatile("" ::: "memory");
}
__device__ __forceinline__ void rms_row_to_bf16(int lane, const float* xrow, const float* gain, bf16* orow) {
    const f32x4* xr = (const f32x4*)xrow + lane; const f32x4* gr = (const f32x4*)gain + lane;
    f32x4 v[4]; float s = 0.f;
#pragma unroll
    for (int j = 0; j < 4; ++j) { v[j] = xr[64 * j]; s += (v[j].x * v[j].x + v[j].y * v[j].y) + (v[j].z * v[j].z + v[j].w * v[j].w); }
    const float rstd = 1.f / sqrtf(wave_sum(s) * (1.f / DM) + NORM_EPS);
    v2u* o8 = (v2u*)orow + lane;
#pragma unroll
    for (int j = 0; j < 4; ++j) { const f32x4 g = gr[64 * j]; v2u w; w.x = pk2(v[j].x * rstd * g.x, v[j].y * rstd * g.y); w.y = pk2(v[j].z * rstd * g.z, v[j].w * rstd * g.w); o8[64 * j] = w; }
}
#define XN1_BASE (F.out)
__device__ __forceinline__ void p0_prologue(Frame& F, const Args& A) {
    LAS float* scr = (LAS float*)(F.lds + RING_OFF + F.wave * 16384);
    const int gw = F.vcu * NWAVES + F.wave, NGW = F.G * NWAVES;
    unsigned char* ws = F.ws;
    constexpr int I_GU = (DM / 64) * (NHID2 / 32), I_D = (DFF / 64) * (DM / 32), I_IN = (DM / 64) * (NIN / 32);
    constexpr int NITEMS = I_GU + I_D + I_IN;
    for (int it = gw; it < NITEMS; it += NGW) {
        int r = it;
        if (r < I_GU) { p0_transpose_item(inp(3), DM, NHID2, (bf16*)(ws + WS_WGU1), scr, r, F.lane, MapGateUp()); continue; } r -= I_GU;
        if (r < I_D) { p0_transpose_item(inp(4), DFF, DM, (bf16*)(ws + WS_WD1), scr, r, F.lane, MapId()); continue; } r -= I_D;
        p0_transpose_item(inp(7), DM, NIN, (bf16*)(ws + WS_WIN), scr, r, F.lane, MapWin(), inp(6));
    }
    { const int gt = (F.vcu * NWAVES + F.wave) * 64 + F.lane, NGT = NGW * 64; bf16* WL = (bf16*)(ws + WS_WL);
      for (int e = gt; e < 1536 * 256; e += NGT) { const int n = e >> 8, k = e & 255; float v = 0.f;
          if (n < 512) { if (k < 64) v = inp(11)[k * 512 + n]; }
          else if (n < 1024) { if (k >= 64 && k < 128) v = inp(13)[(k - 64) * 512 + (n - 512)]; }
          else { if (k >= 128) v = inp(14)[(k - 128) * 512 + (n - 1024)]; }
          WL[e] = (bf16)f2bf(v); }
      float* rope = (float*)(ws + WS_ROPE);
      for (int e = gt; e < 8208 * 8; e += NGT) { const int pos = e >> 3, i = e & 7;
          const double fr = i == 0 ? 1.0 : i == 1 ? 0.19392274474868576 : i == 2 ? 0.03760603093086393 : i == 3 ? 0.007292664737217109 : i == 4 ? 0.001414213562373095 : i == 5 ? 0.0002742481756762073 : i == 6 ? 5.318295896944988e-05 : 1.031338537721246e-05;
          const double ang = (double)pos * fr; const double kq = __builtin_rint(ang * 0.15915494309189535); const double red = __builtin_fma(-kq, 6.283185307179586, ang) - kq * 2.4492935982947064e-16;
          const float rf = (float)red; rope[pos * 16 + i] = cosf(rf); rope[pos * 16 + 8 + i] = sinf(rf); }
    }
    f32x4 g1[4];
#pragma unroll
    for (int j = 0; j < 4; ++j) g1[j] = ((const f32x4*)inp(2))[F.lane + 64 * j];
    for (int m0 = gw; m0 < MR + NMETA; m0 += 4 * NGW) {
        f32x4 v[4][4];
#pragma unroll
        for (int u = 0; u < 4; ++u) { const int m = m0 + u * NGW < MR + NMETA ? m0 + u * NGW : m0; const f32x4* xr = (const f32x4*)(m < MR ? inp(0) + (size_t)m * DM : inp(1) + (size_t)(m - MR) * DM) + F.lane;
#pragma unroll
            for (int j = 0; j < 4; ++j) v[u][j] = xr[64 * j]; }
#pragma unroll
        for (int u = 0; u < 4; ++u) { const int m = m0 + u * NGW; if (m < MR + NMETA) { float s = 0.f;
#pragma unroll
            for (int j = 0; j < 4; ++j) s += (v[u][j].x * v[u][j].x + v[u][j].y * v[u][j].y) + (v[u][j].z * v[u][j].z + v[u][j].w * v[u][j].w);
            const float rstd = 1.f / sqrtf(wave_sum_dpp(s) * (1.f / DM) + NORM_EPS); v2u* o8 = (v2u*)((bf16*)XN1_BASE + (size_t)m * DM) + F.lane;
#pragma unroll
            for (int j = 0; j < 4; ++j) { const f32x4 g = g1[j]; v2u w; w.x = pk2(v[u][j].x * rstd * g.x, v[u][j].y * rstd * g.y); w.y = pk2(v[u][j].z * rstd * g.z, v[u][j].w * rstd * g.w); o8[64 * j] = w; } } }
    }
}


__device__ __forceinline__ void convert_late_weights(Frame& F, const Args& A, int gw, int NGW, LAS unsigned char* ldsbase) {
    LAS float* scr = (LAS float*)(ldsbase + F.wave * 16384); unsigned char* ws = F.ws;
    constexpr int I_GU = (DM / 64) * (NHID2 / 32), I_D = (DFF / 64) * (DM / 32), I_BR = (512 / 64) * (DM / 32), I_MIX = (DM / 64) * (DM / 32);
    constexpr int NITEMS = I_GU + I_D + 2 * I_BR + I_MIX;
    for (int it = gw; it < NITEMS; it += NGW) {
        int r = it;
        if (r < I_GU) { p0_transpose_item(inp(25), DM, NHID2, (bf16*)(ws + WS_WGU2), scr, r, F.lane, MapGateUp(), inp(24)); continue; } r -= I_GU;
        if (r < I_D) { p0_transpose_item(inp(26), DFF, DM, (bf16*)(ws + WS_WD2), scr, r, F.lane, MapId()); continue; } r -= I_D;
        if (r < I_BR) { p0_transpose_item(inp(20), 512, DM, (bf16*)(ws + WS_WATT), scr, r, F.lane, MapId()); continue; } r -= I_BR;
        if (r < I_BR) { p0_transpose_item(inp(21), 512, DM, (bf16*)(ws + WS_WRWKV), scr, r, F.lane, MapId()); continue; } r -= I_BR;
        p0_transpose_item(inp(22), DM, DM, (bf16*)(ws + WS_WMIX), scr, r, F.lane, MapId());
    }
}

constexpr size_t WS_H2 = WS_BIG + 180 * MiB;
template <int MODE>
__device__ __forceinline__ void row_pass(Frame& F, const Args& A, const float* gpost, const float* gpre, float scale) {
    const int gw = F.vcu * NWAVES + F.wave, NGW = F.G * NWAVES, lane = F.lane;
    const int nrows = MODE == 0 ? MR + NMETA : MR;
    const bf16* Fb = (const bf16*)(F.ws + WS_F); const float* SS = (const float*)(F.ws + WS_SS);
    constexpr int NR = 4;
    f32x4 gpo[4], gpr[4];
#pragma unroll
    for (int j = 0; j < 4; ++j) { gpo[j] = ((const f32x4*)gpost)[lane + 64 * j]; gpr[j] = gpo[j]; }
    for (int m0 = gw; m0 < nrows; m0 += NR * NGW) {
        float ssf[NR]; v2u fw[NR][4]; f32x4 hv[NR][4]; bool on[NR];
#pragma unroll
        for (int u = 0; u < NR; ++u) { const int m = m0 + u * NGW; on[u] = m < nrows; const int mc = on[u] ? m : m0;
            ssf[u] = SS[((size_t)((lane & 15) >> 2) * MP + mc) * 4 + (lane & 3)];
#pragma unroll
            for (int j = 0; j < 4; ++j) { fw[u][j] = ((const v2u*)(Fb + (size_t)mc * DM))[lane + 64 * j];
                if (MODE == 0) hv[u][j] = ((const f32x4*)(mc < MR ? inp(0) + (size_t)mc * DM : inp(1) + (size_t)(mc - MR) * DM))[lane + 64 * j];
                else { const v2u hw = ((const v2u*)((MODE == 1 ? (const bf16*)F.out : (const bf16*)(F.ws + WS_H2)) + (size_t)mc * DM))[lane + 64 * j]; hv[u][j] = (f32x4){bflo(hw.x), bfhi(hw.x), bflo(hw.y), bfhi(hw.y)}; } } }
#pragma unroll
        for (int u = 0; u < NR; ++u) if (on[u]) { const int m = m0 + u * NGW;
            float sf = ssf[u]; sf += dpp_f(sf, 0); sf += dpp_f(sf, 1); sf += dpp_f(sf, 2); { const int x = __builtin_bit_cast(int, sf); sf += __builtin_bit_cast(float, __builtin_amdgcn_update_dpp(0, x, 0x140, 0xF, 0xF, true)); }
            if (MODE == 0 && m >= MR) { float s2 = 0.f;
#pragma unroll
                for (int j = 0; j < 4; ++j) s2 += bflo(fw[u][j].x) * bflo(fw[u][j].x) + bfhi(fw[u][j].x) * bfhi(fw[u][j].x) + bflo(fw[u][j].y) * bflo(fw[u][j].y) + bfhi(fw[u][j].y) * bfhi(fw[u][j].y);
                sf = wave_sum_dpp(s2); }
            const float rf = scale / sqrtf(sf * (1.f / DM) + NORM_EPS);
            f32x4 h[4]; float s = 0.f;
#pragma unroll
            for (int j = 0; j < 4; ++j) {
                const f32x4 g = gpo[j]; const f32x4 hq = hv[u][j];
                f32x4 r; r.x = hq.x + bflo(fw[u][j].x) * rf * g.x; r.y = hq.y + bfhi(fw[u][j].x) * rf * g.y; r.z = hq.z + bflo(fw[u][j].y) * rf * g.z; r.w = hq.w + bfhi(fw[u][j].y) * rf * g.w;
                h[j] = r; s += (r.x * r.x + r.y * r.y) + (r.z * r.z + r.w * r.w);
                if (MODE == 2) ((f32x4*)(F.out + (size_t)m * DM))[lane + 64 * j] = r;
                else { v2u w; w.x = pk2(r.x, r.y); w.y = pk2(r.z, r.w); bf16* hb = MODE == 1 ? (bf16*)(F.ws + WS_H2) + (size_t)m * DM : (m < MR ? (bf16*)F.out + (size_t)m * DM : (bf16*)(F.ws + WS_HM) + (size_t)(m - MR) * DM); ((v2u*)hb)[lane + 64 * j] = w; }
            }
            if (MODE != 2) { const float rstd = 1.f / sqrtf(wave_sum_dpp(s) * (1.f / DM) + NORM_EPS); if (lane == 0) ((float*)(F.ws + (MODE == 0 ? WS_RS2 : WS_RS3)))[m] = rstd; }
        }
    }
}

__device__ __forceinline__ int prev_row(int m) { return m < MR ? ((m & 8191) == 0 ? MR + 15 : m - 1) : (m == MR ? -1 : m - 1); }
__device__ __forceinline__ void lora_a_pass(Frame& F, const Args& A) {
    const int gw = F.vcu * NWAVES + F.wave, NGW = F.G * NWAVES, lane = F.lane;
    const bf16* ZR = (const bf16*)(F.ws + WS_ZR); bf16* LA = (bf16*)(F.ws + WS_LA); const float* mu = inp(9) + 1536;
    const f32x4 muv = ((const f32x4*)mu)[lane];
    for (int g4 = gw; 4 * g4 < MR + NMETA; g4 += NGW) { const int m0 = 4 * g4;
        v2u zc[4], zp0 = (v2u){0u, 0u};
        { const int pm = prev_row(m0); if (pm >= 0) zp0 = ((const v2u*)(ZR + (size_t)pm * 1792 + 1536))[lane]; }
#pragma unroll
        for (int u = 0; u < 4; ++u) zc[u] = ((const v2u*)(ZR + (size_t)(m0 + u) * 1792 + 1536))[lane];
#pragma unroll
        for (int u = 0; u < 4; ++u) { const int m = m0 + u; const v2u zpv = u == 0 ? zp0 : zc[u > 0 ? u - 1 : 0];
            float x[4] = {bflo(zc[u].x), bfhi(zc[u].x), bflo(zc[u].y), bfhi(zc[u].y)}; const float p[4] = {bflo(zpv.x), bfhi(zpv.x), bflo(zpv.y), bfhi(zpv.y)};
            x[0] += (p[0] - x[0]) * muv.x; x[1] += (p[1] - x[1]) * muv.y; x[2] += (p[2] - x[2]) * muv.z; x[3] += (p[3] - x[3]) * muv.w;
            if (lane < 16) {
#pragma unroll
                for (int j = 0; j < 4; ++j) x[j] = tanhf(x[j]);
            } else if (lane >= 32) {
#pragma unroll
                for (int j = 0; j < 4; ++j) x[j] = sigm(x[j]);
            }
            v2u w; w.x = pk2(x[0], x[1]); w.y = pk2(x[2], x[3]);
            ((v2u*)(LA + (size_t)m * 256))[lane] = w; }
    }
}

#ifndef MK_ATT_SCALE
#define MK_ATT_SCALE 1.0f
#endif
__device__ __forceinline__ int crow(int r, int hi) { return (r & 3) + 8 * (r >> 2) + 4 * hi; }
constexpr int AT_KP = 144, AT_VP = 80, AT_KBYTES = 32 * AT_KP;
__device__ __forceinline__ void attn_item(Frame& F, const Args& A, int b, int head, int qb) {
    const int lane = F.lane, r32 = lane & 31, hi = lane >> 5, kvh = head >> 2, t0 = qb * 32, rr = lane >> 3, ck = lane & 7;
    const bf16* Q = (const bf16*)(F.ws + WS_Q); const bf16* KV = (const bf16*)(F.ws + WS_KV); bf16* AC = (bf16*)(F.ws + WS_Q);
    LAS unsigned char* Kl = F.lds + RING_OFF + F.wave * 16384; LAS unsigned char* Vl = Kl + AT_KBYTES;
    const float sink2 = inp(8)[head] * 1.4426950408889634f;
    v4u qg[4], kg[5][4], vg[5][4];
#pragma unroll
    for (int j = 0; j < 4; ++j) qg[j] = *(const v4u*)(Q + (size_t)(b * SEQL + t0 + 8 * j + rr) * 512 + head * 64 + 8 * ck);
#pragma unroll
    for (int i = 0; i < 5; ++i)
#pragma unroll
        for (int j = 0; j < 4; ++j) { const int tk = t0 - 128 + 32 * i + 8 * j + rr;
            const size_t krow = tk >= 0 ? (size_t)(b * SEQL + tk) : (tk >= -16 ? (size_t)(MR + 16 + tk) : (size_t)MR);
            kg[i][j] = *(const v4u*)(KV + krow * 256 + kvh * 64 + 8 * ck); }
    const bf16* vtb = (const bf16*)(F.ws + WS_VT) + (size_t)(b * 2 + kvh) * (PV / 16) * 1024;
#pragma unroll
    for (int i = 0; i < 5; ++i)
#pragma unroll
        for (int j = 0; j < 4; ++j) { const int x = 64 * j + lane; int pb = ((t0 - 112 + 32 * i) >> 4) + (x >> 7); pb = pb < 0 ? 0 : pb;
            vg[i][j] = *(const v4u*)(vtb + (size_t)pb * 1024 + (x & 127) * 8); }
    __builtin_amdgcn_sched_barrier(0);
    bf16x8 qf[4];
#pragma unroll
    for (int j = 0; j < 4; ++j) *(LAS v4u*)(Kl + (8 * j + rr) * AT_KP + 16 * ck) = qg[j];
#pragma unroll
    for (int s = 0; s < 4; ++s) qf[s] = *(const LAS bf16x8*)(Kl + r32 * AT_KP + 32 * s + 16 * hi);
    f32x16 S[5];
#pragma unroll
    for (int i = 0; i < 5; ++i) {
#pragma unroll
        for (int j = 0; j < 4; ++j) *(LAS v4u*)(Kl + (8 * j + rr) * AT_KP + 16 * ck) = kg[i][j];
        bf16x8 kf[4];
#pragma unroll
        for (int s = 0; s < 4; ++s) kf[s] = *(const LAS bf16x8*)(Kl + r32 * AT_KP + 32 * s + 16 * hi);
        f32x16 a = {};
#pragma unroll
        for (int s = 0; s < 4; ++s) a = __builtin_amdgcn_mfma_f32_32x32x16_bf16(kf[s], qf[s], a, 0, 0, 0);
        S[i] = a;
    }
    const float sc = 0.125f * 1.4426950408889634f; const int dq = r32 - 4 * hi;
#pragma unroll
    for (int r = 0; r < 16; ++r) { const int cr = (r & 3) + 8 * (r >> 2);
        S[0][r] = cr > dq ? S[0][r] * sc : -1e30f; S[4][r] = cr <= dq ? S[4][r] * sc : -1e30f;
        S[1][r] *= sc; S[2][r] *= sc; S[3][r] *= sc; }
    if (t0 < 112) {
#pragma unroll
        for (int i = 0; i < 4; ++i)
#pragma unroll
            for (int r = 0; r < 16; ++r) if (t0 - 128 + 32 * i + crow(r, hi) < -16) S[i][r] = -1e30f;
    }
    float mx = sink2;
#pragma unroll
    for (int i = 0; i < 5; ++i)
#pragma unroll
        for (int r = 0; r < 16; ++r) mx = fmaxf(mx, S[i][r]);
    mx = fmaxf(mx, __shfl_xor(mx, 32));
    float sum = 0.f;
#pragma unroll
    for (int i = 0; i < 5; ++i)
#pragma unroll
        for (int r = 0; r < 16; ++r) { const float p = __builtin_amdgcn_exp2f(S[i][r] - mx); S[i][r] = p; sum += p; }
    sum += __shfl_xor(sum, 32);
    const float inv = 1.0f / (sum + __builtin_amdgcn_exp2f(sink2 - mx));
    f32x16 O0 = {}, O1 = {};
#pragma unroll
    for (int i = 0; i < 5; ++i) {
#pragma unroll
        for (int j = 0; j < 4; ++j) { const int x = 64 * j + lane; *(LAS v4u*)(Vl + ((x & 127) >> 1) * AT_VP + (x >> 7) * 32 + (x & 1) * 16) = vg[i][j]; }
#pragma unroll
        for (int s = 0; s < 2; ++s) {
            bf16x8 pa;
#pragma unroll
            for (int j = 0; j < 8; j += 2) { const unsigned w = pg8::cvt_pk_bf16(S[i][8 * s + j], S[i][8 * s + j + 1]); pa[j] = (short)(w & 0xffffu); pa[j + 1] = (short)(w >> 16); }
            const v2u a0 = *(const LAS v2u*)(Vl + r32 * AT_VP + 32 * s + 8 * hi), a1 = *(const LAS v2u*)(Vl + r32 * AT_VP + 32 * s + 16 + 8 * hi);
            const v2u c0 = *(const LAS v2u*)(Vl + (r32 + 32) * AT_VP + 32 * s + 8 * hi), c1 = *(const LAS v2u*)(Vl + (r32 + 32) * AT_VP + 32 * s + 16 + 8 * hi);
            const v4u v0 = {a0.x, a0.y, a1.x, a1.y}, v1 = {c0.x, c0.y, c1.x, c1.y};
            O0 = __builtin_amdgcn_mfma_f32_32x32x16_bf16(__builtin_bit_cast(bf16x8, v0), pa, O0, 0, 0, 0);
            O1 = __builtin_amdgcn_mfma_f32_32x32x16_bf16(__builtin_bit_cast(bf16x8, v1), pa, O1, 0, 0, 0);
        }
    }
    const float iv = inv * MK_ATT_SCALE;
#pragma unroll
    for (int g = 0; g < 4; ++g) {
        *(LAS v2u*)(Kl + r32 * AT_KP + (8 * g + 4 * hi) * 2) = (v2u){pk2(O0[4 * g] * iv, O0[4 * g + 1] * iv), pk2(O0[4 * g + 2] * iv, O0[4 * g + 3] * iv)};
        *(LAS v2u*)(Kl + r32 * AT_KP + (32 + 8 * g + 4 * hi) * 2) = (v2u){pk2(O1[4 * g] * iv, O1[4 * g + 1] * iv), pk2(O1[4 * g + 2] * iv, O1[4 * g + 3] * iv)}; }
#pragma unroll
    for (int j = 0; j < 4; ++j) *(v4u*)(AC + (size_t)(b * SEQL + t0 + 8 * j + rr) * 512 + head * 64 + 8 * ck) = *(const LAS v4u*)(Kl + (8 * j + rr) * AT_KP + 16 * ck);
}


__device__ __forceinline__ bf16x8 lora_afrag(const bf16* ZR, size_t m, long pm, int chan, const float* mu, int kind) {
    const v4u zc = *(const v4u*)(ZR + m * 1792 + chan); v4u zp = (v4u){0u, 0u, 0u, 0u}; if (pm >= 0) zp = *(const v4u*)(ZR + (size_t)pm * 1792 + chan);
    const f32x4 m0 = *(const f32x4*)(mu + chan), m1 = *(const f32x4*)(mu + chan + 4); const float mv[8] = {m0.x, m0.y, m0.z, m0.w, m1.x, m1.y, m1.z, m1.w};
    float x[8];
#pragma unroll
    for (int j = 0; j < 4; ++j) { const float c0 = bflo(zc[j]), c1 = bfhi(zc[j]), p0 = bflo(zp[j]), p1 = bfhi(zp[j]); x[2 * j] = c0 + (p0 - c0) * mv[2 * j]; x[2 * j + 1] = c1 + (p1 - c1) * mv[2 * j + 1]; }
#pragma unroll
    for (int j = 0; j < 8; ++j) x[j] = kind == 0 ? tanhf(x[j]) : (kind == 2 ? sigm(x[j]) : x[j]);
    bf16x8 r;
#pragma unroll
    for (int j = 0; j < 8; j += 2) { const unsigned w = pk2(x[j], x[j + 1]); r[j] = (short)(w & 0xffffu); r[j + 1] = (short)(w >> 16); }
    return r;
}
__device__ __forceinline__ void lora_fused(Frame& F, const Args& A) {
    const int gw = F.vcu * NWAVES + F.wave, NGW = F.G * NWAVES, lane = F.lane, r32 = lane & 31, hi = lane >> 5;
    const bf16* ZR = (const bf16*)(F.ws + WS_ZR); const bf16* WL = (const bf16*)(F.ws + WS_WL); const float* mu = inp(9);
    bf16* LW = (bf16*)(F.ws + WS_LW); bf16* AA = (bf16*)(F.ws + WS_AA); bf16* GG = (bf16*)(F.ws + WS_GG);
    constexpr int NRB = (MR + NMETA + 31) / 32;
    for (int it = gw; it < NRB * 3; it += NGW) {
        const int kind = it % 3, r0 = (it / 3) * 32, k0 = kind == 0 ? 0 : (kind == 1 ? 64 : 128), nk = kind == 2 ? 8 : 4;
        const int mrow = r0 + r32 < MR + NMETA ? r0 + r32 : MR + NMETA - 1; const long pm = prev_row(mrow);
        bf16x8 af[8];
#pragma unroll
        for (int s = 0; s < 8; ++s) af[s] = lora_afrag(ZR, (size_t)mrow, pm, 1536 + k0 + (s < nk ? 16 * s : 0) + 8 * hi, mu, kind);
        const float* bias = kind == 0 ? inp(10) : inp(12);
        const bf16* wbase = WL + (size_t)(kind * 512 + r32) * 256 + k0 + 8 * hi;
        bf16x8 bcur[8], bnxt[8];
#pragma unroll
        for (int s = 0; s < 8; ++s) bcur[s] = *(const bf16x8*)(wbase + (s < nk ? 16 * s : 0));
        for (int nb = 0; nb < 16; ++nb) {
            const bf16* wn = wbase + (size_t)((nb + 1 < 16 ? nb + 1 : nb) * 32) * 256;
#pragma unroll
            for (int s = 0; s < 8; ++s) bnxt[s] = *(const bf16x8*)(wn + (s < nk ? 16 * s : 0));
            f32x16 acc = {};
#pragma unroll
            for (int s = 0; s < 8; ++s) if (s < nk) acc = __builtin_amdgcn_mfma_f32_32x32x16_bf16(af[s], bcur[s], acc, 0, 0, 0);
            const int col = nb * 32 + r32; const float bv = kind == 2 ? 0.f : bias[col];
#pragma unroll
            for (int r = 0; r < 16; ++r) { const int row = r0 + crow(r, hi); if (row < MR + NMETA) { const size_t o = (size_t)row * 512 + col; const float v = acc[r] + bv;
                if (kind == 0) LW[o] = (bf16)f2bf(-0.6065306597126334f * sigm(v)); else if (kind == 1) AA[o] = (bf16)f2bf(sigm(v)); else GG[o] = (bf16)f2bf(v); } }
#pragma unroll
            for (int s = 0; s < 8; ++s) bcur[s] = bnxt[s];
        }
    }
}

#ifndef MK_YN_SCALE
#define MK_YN_SCALE 1.0f
#endif
#ifndef MK_BONUS_SCALE
#define MK_BONUS_SCALE 1.0f
#endif
__device__ __forceinline__ float half_sum(float v) {
    v += dpp_f(v, 0); v += dpp_f(v, 1); v += dpp_f(v, 2);
    { const int x = __builtin_bit_cast(int, v); v += __builtin_bit_cast(float, __builtin_amdgcn_update_dpp(0, x, 0x140, 0xF, 0xF, true)); }
    { const int x = __builtin_bit_cast(int, v); v += __builtin_bit_cast(float, __builtin_amdgcn_ds_swizzle(x, 0x401F)); }
    return v;
}


typedef float f32x4m __attribute__((ext_vector_type(4)));
__device__ __forceinline__ f32x4m mini16(const bf16* A16, int lda, const bf16* Brow0, int ldb, int K, int lane) {
    const int r = lane & 15, q = lane >> 4; f32x4m acc = {0.f, 0.f, 0.f, 0.f};
    const bf16* ap = A16 + (size_t)r * lda + 8 * q; const bf16* bp = Brow0 + (size_t)r * ldb + 8 * q;
#pragma unroll 8
    for (int ks = 0; ks < K / 32; ++ks) { const bf16x8 a = *(const bf16x8*)(ap + 32 * ks), b = *(const bf16x8*)(bp + 32 * ks); acc = __builtin_amdgcn_mfma_f32_16x16x32_bf16(a, b, acc, 0, 0, 0); }
    return acc;
}
template <int K, int NB>
__device__ __forceinline__ void mini16_wg(Frame& F, const bf16* A16, int lda, const bf16* B0, const bf16* B1, int ldb, f32x4m (&out)[NB]) {
    constexpr int NKS = K / 256; static_assert(K % 256 == 0 && NB >= 1 && NB <= 2, "mini16_wg");
    const int lane = F.lane, wave = F.wave, r = lane & 15, q = lane >> 4;
    const bf16* ap = A16 + (size_t)r * lda + 8 * q + 32 * NKS * wave; const bf16* bp0 = B0 + (size_t)r * ldb + 8 * q + 32 * NKS * wave; const bf16* bp1 = B1 + (size_t)r * ldb + 8 * q + 32 * NKS * wave;
    bf16x8 a[NKS], b0[NKS], b1[NKS];
#pragma unroll
    for (int ks = 0; ks < NKS; ++ks) { a[ks] = *(const bf16x8*)(ap + 32 * ks); b0[ks] = *(const bf16x8*)(bp0 + 32 * ks); if (NB == 2) b1[ks] = *(const bf16x8*)(bp1 + 32 * ks); }
    f32x4m acc0 = {0.f, 0.f, 0.f, 0.f}, acc1 = acc0;
#pragma unroll
    for (int ks = 0; ks < NKS; ++ks) { acc0 = __builtin_amdgcn_mfma_f32_16x16x32_bf16(a[ks], b0[ks], acc0, 0, 0, 0); if (NB == 2) acc1 = __builtin_amdgcn_mfma_f32_16x16x32_bf16(a[ks], b1[ks], acc1, 0, 0, 0); }
    LAS f32x4m* red = (LAS f32x4m*)(F.lds + RING_OFF);
    red[wave * 64 + lane] = acc0; if (NB == 2) red[(8 + wave) * 64 + lane] = acc1;
    __syncthreads();
    if (wave == 0) {
#pragma unroll
        for (int nb = 0; nb < NB; ++nb) { f32x4m s = red[(nb * 8) * 64 + lane];
#pragma unroll
            for (int w = 1; w < 8; ++w) s += red[(nb * 8 + w) * 64 + lane];
            out[nb] = s; } }
    __syncthreads();
}
__device__ __forceinline__ float row16_sum(float v) { v += dpp_f(v, 0); v += dpp_f(v, 1); v += dpp_f(v, 2); const int x = __builtin_bit_cast(int, v); return v + __builtin_bit_cast(float, __builtin_amdgcn_update_dpp(0, x, 0x140, 0xF, 0xF, true)); }
__device__ __forceinline__ void meta_gateup(Frame& F, const bf16* Wgu, int i) {
    const int lane = F.lane, r = lane & 15, q = lane >> 4, j0 = 16 * i; const bf16* A16 = (const bf16*)F.out + (size_t)MR * DM;
    const int grow = 256 * (j0 >> 7) + (j0 & 127);
    f32x4m gu[2]; mini16_wg<DM, 2>(F, A16, DM, Wgu + (size_t)grow * DM, Wgu + (size_t)(grow + 128) * DM, DM, gu);
    if (F.wave != 0) return;
    const f32x4m g = gu[0], u = gu[1];
    bf16* H = (bf16*)(F.ws + WS_HID);
#pragma unroll
    for (int x = 0; x < 4; ++x) H[(size_t)(MR + 4 * q + x) * DFF + j0 + r] = (bf16)f2bf(g[x] * sigm(g[x]) * u[x]);
}
__device__ __forceinline__ void meta_down(Frame& F, const bf16* Wd, int i) {
    const int lane = F.lane, r = lane & 15, q = lane >> 4, n0 = 16 * i; const bf16* A16 = (const bf16*)(F.ws + WS_HID) + (size_t)MR * DFF; bf16* Fo = (bf16*)(F.ws + WS_F);
    f32x4m av[1]; mini16_wg<DFF, 1>(F, A16, DFF, Wd + (size_t)n0 * DFF, Wd + (size_t)n0 * DFF, DFF, av);
    if (F.wave != 0) return;
    const f32x4m a = av[0];
#pragma unroll
    for (int x = 0; x < 4; ++x) Fo[(size_t)(MR + 4 * q + x) * DM + n0 + r] = (bf16)f2bf(a[x]);
}
__device__ __forceinline__ void meta_win(Frame& F, int i) {
    const int lane = F.lane, r = lane & 15, q = lane >> 4, c0 = 512 + 16 * i; const bf16* A16 = (const bf16*)(F.ws + WS_HM);
    f32x4m av[1]; mini16_wg<DM, 1>(F, A16, DM, (const bf16*)(F.ws + WS_WIN) + (size_t)c0 * DM, (const bf16*)(F.ws + WS_WIN) + (size_t)c0 * DM, DM, av);
    if (F.wave != 0) return;
    f32x4m a = av[0];
    { const float* RS = (const float*)(F.ws + WS_RS2) + MR;
#pragma unroll
      for (int x = 0; x < 4; ++x) a[x] *= RS[4 * q + x]; }
    if (c0 < 640 && (c0 & 63) == 0) {
        const float* rope = (const float*)(F.ws + WS_ROPE); const bool lo = (r & 4) == 0; const int fi = r < 8 ? (r & 3) : 4 + (r & 3);
#pragma unroll
        for (int x = 0; x < 4; ++x) { const float other = __shfl_xor(a[x], 4); const int pos = 4 * q + x; const float cs = rope[pos * 16 + fi], sn = rope[pos * 16 + 8 + fi];
            a[x] = lo ? a[x] * cs - other * sn : a[x] * cs + other * sn; }
    }
    if (c0 >= 640 && c0 < 768) {
        const int dv = c0 - 640 + r; const v2u w = {pk2(a[0], a[1]), pk2(a[2], a[3])};
#pragma unroll
        for (int b = 0; b < NB; ++b) *(v2u*)((bf16*)(F.ws + WS_VT) + ((size_t)(b * 2 + (dv >> 6)) * (PV / 16) * 64 + (dv & 63)) * 16 + 4 * q) = w;
        return; }
    bf16* dst; int ld, col;
    if (c0 < 768) { dst = (bf16*)(F.ws + WS_KV); ld = 256; col = c0 - 512; } else { dst = (bf16*)(F.ws + WS_ZR); ld = 1792; col = c0 - 768; }
#pragma unroll
    for (int x = 0; x < 4; ++x) dst[(size_t)(MR + 4 * q + x) * ld + col + r] = (bf16)f2bf(a[x]);
}
__device__ __forceinline__ void meta_lora(Frame& F, int i) {
    const int lane = F.lane, r = lane & 15, q = lane >> 4, n0 = 16 * i, kind = n0 >> 9, col = (n0 & 511) + r; const bf16* A16 = (const bf16*)(F.ws + WS_LA) + (size_t)MR * 256;
    const f32x4m a = mini16(A16, 256, (const bf16*)(F.ws + WS_WL) + (size_t)n0 * 256, 256, 256, lane);
    const float bias = kind == 0 ? inp(10)[col] : (kind == 1 ? inp(12)[col] : 0.f);
    bf16* dst = (bf16*)(F.ws + (kind == 0 ? WS_LW : (kind == 1 ? WS_AA : WS_GG)));
#pragma unroll
    for (int x = 0; x < 4; ++x) { const float v = a[x] + bias; const float o = kind == 0 ? -0.6065306597126334f * sigm(v) : (kind == 1 ? sigm(v) : v); dst[(size_t)(MR + 4 * q + x) * 512 + col] = (bf16)f2bf(o); }
}

constexpr int RW_P = 72;
constexpr int RW_NCH = 129;
constexpr int RW_AT = 0, RW_RT = 9216, RW_BT = 18432, RW_KT = 27648;
constexpr int RW_RHS = RW_BT;
constexpr int RW_VT = 36864, RW_BHT = 46080, RW_KHT = 55296, RW_WT = 64512, RW_UT = 73728;
constexpr int RW_AAB = 82944;
constexpr int RW_AAK = 99328, RW_ARB = 108544, RW_ARK = 117760;
constexpr int RW_TINV = 92160;
constexpr int RW_MISC = 126976;
static_assert(RW_MISC + 2048 + 512 <= RING_BYTES, "rwkv LDS map");
typedef short s16x4v __attribute__((ext_vector_type(4)));

__device__ __forceinline__ f32x16 rw_mm(f32x16 acc, const LAS bf16* X, int ti, const LAS bf16* Yt, int tn, int lane) {
    const LAS bf16* xp = X + (32 * ti + (lane & 31)) * RW_P + 8 * (lane >> 5); const LAS bf16* yp = Yt + (32 * tn + (lane & 31)) * RW_P + 8 * (lane >> 5);
#pragma unroll
    for (int ks = 0; ks < 4; ++ks) { const bf16x8 a = *(const LAS bf16x8*)(xp + 16 * ks), b = *(const LAS bf16x8*)(yp + 16 * ks); acc = __builtin_amdgcn_mfma_f32_32x32x16_bf16(a, b, acc, 0, 0, 0); }
    return acc;
}
__device__ __forceinline__ bf16x8 rw_pack8(const f32x16& v, int s) {
    bf16x8 r;
#pragma unroll
    for (int j = 0; j < 8; j += 2) { const unsigned w = pg8::cvt_pk_bf16(v[8 * s + j], v[8 * s + j + 1]); r[j] = (short)(w & 0xffffu); r[j + 1] = (short)(w >> 16); }
    return r;
}
__device__ __forceinline__ size_t rw_item(int bh, int c) { return (size_t)bh * RW_NCH + c; }

struct RwRaw { unsigned zr[9], zk[9], zv[9], al[8], lw[8]; float par[6]; };
__device__ __forceinline__ void rw_load_raw(RwRaw& R, Frame& F, int b, int h, int c) {
    const int ch = F.tid & 63, tg = F.tid >> 6, hc = h * 64 + ch;
    const bf16* ZR = (const bf16*)(F.ws + WS_ZR); const bf16* LW = (const bf16*)(F.ws + WS_LW); const bf16* AA = (const bf16*)(F.ws + WS_AA);
#pragma unroll
    for (int j = 0; j < 9; ++j) { const int p = 64 * c - 48 + 8 * tg + j - 1; const int pc = p < 0 ? 0 : p;
        const size_t m = pc < 16 ? (size_t)(MR + pc) : (size_t)(b * SEQL + pc - 16); const bf16* z = ZR + m * 1792 + hc;
        R.zr[j] = z[0]; R.zk[j] = z[512]; R.zv[j] = z[1024];
        if (j > 0) { R.al[j - 1] = AA[m * 512 + hc]; R.lw[j - 1] = LW[m * 512 + hc]; } }
    R.par[0] = inp(9)[hc]; R.par[1] = inp(9)[512 + hc]; R.par[2] = inp(9)[1024 + hc]; R.par[3] = inp(15)[hc]; R.par[4] = inp(16)[hc]; R.par[5] = inp(17)[hc];
}
__device__ __forceinline__ float bfw(unsigned w) { return __builtin_bit_cast(float, w << 16); }
#ifdef MK_ITEM_PROF
#define RWP(k) do { if (blockIdx.x == 0 && threadIdx.x == 0) { const unsigned long long t_ = __builtin_amdgcn_s_memrealtime(); ((unsigned long long*)(F.ws + 32768))[k] += t_ - tprev_; tprev_ = t_; } } while (0)
#elif defined(MK_ITEM_MARK)
#define RWP(k) asm volatile("; RWP_MARK " #k ::: "memory")
#else
#define RWP(k) do { } while (0)
#endif
__device__ __forceinline__ void rwkv_item(Frame& F, int b, int h, int c, RwRaw& raw, int nb, int nh, int nc) {
    constexpr int MODE = 1;
#ifdef MK_ITEM_PROF
    unsigned long long tprev_ = __builtin_amdgcn_s_memrealtime();
#endif
    const int tid = F.tid, lane = F.lane, wave = F.wave, r32 = lane & 31, hi = lane >> 5;
    LAS unsigned char* L = F.lds;
    LAS bf16* At = (LAS bf16*)(L + RW_AT); LAS bf16* Rt = (LAS bf16*)(L + RW_RT); LAS bf16* Bt = (LAS bf16*)(L + RW_BT); LAS bf16* Kt = (LAS bf16*)(L + RW_KT);
    LAS bf16* Vt = (LAS bf16*)(L + RW_VT); LAS bf16* Bht = (LAS bf16*)(L + RW_BHT); LAS bf16* Kht = (LAS bf16*)(L + RW_KHT); LAS bf16* Wt = (LAS bf16*)(L + RW_WT); LAS bf16* Ut = (LAS bf16*)(L + RW_UT);
    LAS bf16* Aab = (LAS bf16*)(L + RW_AAB); LAS bf16* RhsB = (LAS bf16*)(L + RW_RHS);
    LAS bf16* Aak = (LAS bf16*)(L + RW_AAK); LAS bf16* Arb = (LAS bf16*)(L + RW_ARB); LAS bf16* Ark = (LAS bf16*)(L + RW_ARK); LAS bf16* Qm = Aak;
    LAS float* gtot = (LAS float*)(L + RW_MISC); LAS float* dots = gtot + 512; LAS float* lend = dots + 64;
    const bf16* ZR = (const bf16*)(F.ws + WS_ZR); const bf16* LW = (const bf16*)(F.ws + WS_LW); const bf16* AA = (const bf16*)(F.ws + WS_AA);
    const int bh = b * 8 + h;
    {
        const int ch = tid & 63, tg = tid >> 6, hc = h * 64 + ch;
        const float mur = raw.par[0], muk = raw.par[1], muv = raw.par[2], kkc = raw.par[3], kac = raw.par[4], rkc = raw.par[5];
        float zr_[9], zk_[9], zv_[9], al_[8], lwr_[8];
#pragma unroll
        for (int j = 0; j < 9; ++j) { zr_[j] = bfw(raw.zr[j]); zk_[j] = bfw(raw.zk[j]); zv_[j] = bfw(raw.zv[j]); if (j > 0) { al_[j - 1] = bfw(raw.al[j - 1]); lwr_[j - 1] = bfw(raw.lw[j - 1]); } }
        if (c == 0) {
#pragma unroll
            for (int j = 0; j < 9; ++j) { const float ok = 8 * tg + j - 1 >= 48 ? 1.f : 0.f; zr_[j] *= ok; zk_[j] *= ok; zv_[j] *= ok; if (j > 0) { al_[j - 1] *= ok; lwr_[j - 1] *= ok; } } }
        if (nc >= 0) rw_load_raw(raw, F, nb, nh, nc);
        float rr[8], kq[8], km[8], vv[8], bb[8], lw8[8];
        float run = 0.f;
        float V[16];
#pragma unroll
        for (int j = 0; j < 8; ++j) {
            const float r = zr_[j + 1] + (zr_[j] - zr_[j + 1]) * mur, k = zk_[j + 1] + (zk_[j] - zk_[j + 1]) * muk, v = zv_[j + 1] + (zv_[j] - zv_[j + 1]) * muv;
            const float al = al_[j], lw = lwr_[j];
            const float q = k * kkc, kmod = k * (1.f + (al - 1.f) * kac);
            V[2 * j] = q * q; V[2 * j + 1] = r * kmod * rkc;
            rr[j] = r; kq[j] = q; km[j] = kmod; vv[j] = v; run += lw; lw8[j] = run;
        }
        {
            const int ln = F.lane; const bool b3 = (ln & 8) != 0, b2 = (ln & 4) != 0, b1 = (ln & 2) != 0, b0 = (ln & 1) != 0;
#define RS_STEP(N, BIT, CTRL) _Pragma("unroll") for (int k_ = 0; k_ < (N); ++k_) { const float mine_ = BIT ? V[k_ + (N)] : V[k_], send_ = BIT ? V[k_] : V[k_ + (N)]; \
                V[k_] = mine_ + __builtin_bit_cast(float, __builtin_amdgcn_update_dpp(0, __builtin_bit_cast(int, send_), CTRL, 0xF, 0xF, true)); }
            RS_STEP(8, b3, 0x140)
            RS_STEP(4, b2, 0x141)
            RS_STEP(2, b1, 0x1B)
            RS_STEP(1, b0, 0xB1)
#undef RS_STEP
            float x = V[0];
            x += __builtin_bit_cast(float, __builtin_amdgcn_ds_swizzle(__builtin_bit_cast(int, x), 0x401F));
            x += __shfl_xor(x, 32);
            if (ln < 16 && (ln & 1)) ((float*)(F.ws + WS_DOTS))[rw_item(bh, c) * 64 + 8 * tg + (ln >> 1)] = x;
            const float rn = __builtin_amdgcn_rsqf(fmaxf(x, 1e-24f));
#pragma unroll
            for (int j = 0; j < 8; ++j) { const float rj = __builtin_bit_cast(float, __builtin_amdgcn_readlane(__builtin_bit_cast(int, rn), 2 * j)); kq[j] *= rj; bb[j] = kq[j] * al_[j]; }
        }
        gtot[tg * 64 + ch] = run;
        __syncthreads();
        float off = 0.f, tot = 0.f;
#pragma unroll
        for (int g2 = 0; g2 < 8; ++g2) { const float x = gtot[g2 * 64 + ch]; tot += x; if (g2 < tg) off += x; }
        if (tg == 0) lend[ch] = tot;
        unsigned vt_[4], bh_[4], kh_[4];
        const float eT = __expf(tot); float ePrev = __expf(off);
#pragma unroll
        for (int j = 0; j < 8; ++j) {
            const int t = 8 * tg + j; const float Lt = off + lw8[j];
            const float eL = __expf(Lt), eP = ePrev, eN = __expf(-Lt), eE = eT * eN; ePrev = eL;
            At[t * RW_P + ch] = (bf16)f2bf(-kq[j] * eP); Rt[t * RW_P + ch] = (bf16)f2bf(rr[j] * eL); Bt[t * RW_P + ch] = (bf16)f2bf(bb[j] * eN); Kt[t * RW_P + ch] = (bf16)f2bf(km[j] * eN);
            const unsigned v_ = f2bf(vv[j]), b_ = f2bf(bb[j] * eE), k_ = f2bf(km[j] * eE);
            if (j & 1) { vt_[j >> 1] |= v_ << 16; bh_[j >> 1] |= b_ << 16; kh_[j >> 1] |= k_ << 16; } else { vt_[j >> 1] = v_; bh_[j >> 1] = b_; kh_[j >> 1] = k_; }
        }
        *(LAS v4u*)(Vt + ch * RW_P + 8 * tg) = (v4u){vt_[0], vt_[1], vt_[2], vt_[3]};
        *(LAS v4u*)(Bht + ch * RW_P + 8 * tg) = (v4u){bh_[0], bh_[1], bh_[2], bh_[3]};
        *(LAS v4u*)(Kht + ch * RW_P + 8 * tg) = (v4u){kh_[0], kh_[1], kh_[2], kh_[3]};
    }
    __syncthreads(); RWP(0);
#pragma unroll
    for (int rnd = 0; rnd < 2; ++rnd) {
        const int mat = (wave >> 2) + 2 * rnd, ti = (wave >> 1) & 1, tn = wave & 1;
        f32x16 acc = {};
        acc = rw_mm(acc, (const LAS bf16*)(L + ((mat & 1) ? RW_KT : RW_BT)), tn, (const LAS bf16*)(L + (mat < 2 ? RW_AT : RW_RT)), ti, lane);
        LAS bf16* dstm = (LAS bf16*)(L + (mat == 0 ? RW_AAB : RW_AAK + (mat - 1) * 9216));
        const int t = 32 * ti + r32, lim = t + (mat >> 1);
#pragma unroll
        for (int g = 0; g < 4; ++g) { const int sb = 32 * tn + 8 * g + 4 * hi;
            const float v0 = sb < lim ? acc[4 * g] : 0.f, v1 = sb + 1 < lim ? acc[4 * g + 1] : 0.f, v2 = sb + 2 < lim ? acc[4 * g + 2] : 0.f, v3 = sb + 3 < lim ? acc[4 * g + 3] : 0.f;
            *(LAS v2u*)(dstm + t * RW_P + sb) = (v2u){pk2(v0, v1), pk2(v2, v3)}; }
    }
    __syncthreads(); RWP(1);
    if (wave < 4) { const int ti = wave >> 1, tn = wave & 1; f32x16 acc = {}; acc = rw_mm(acc, Aak, ti, Vt, tn, lane);
#pragma unroll
        for (int g = 0; g < 4; ++g) *(LAS v2u*)(RhsB + (32 * tn + r32) * RW_P + 32 * ti + 8 * g + 4 * hi) = (v2u){pk2(acc[4 * g], acc[4 * g + 1]), pk2(acc[4 * g + 2], acc[4 * g + 3])};
    } else {
        const int d = wave & 3, cl = lane & 15, q = lane >> 4;
        const LAS bf16* Ad = Aab + (16 * d) * RW_P + 16 * d;
        f32x4m aN, aT;
#pragma unroll
        for (int r = 0; r < 4; ++r) aN[r] = bf1(Ad[(4 * q + r) * RW_P + cl]);
        { const v2u w = *(const LAS v2u*)(Ad + cl * RW_P + 4 * q); aT[0] = bflo(w.x); aT[1] = bfhi(w.x); aT[2] = bflo(w.y); aT[3] = bfhi(w.y); }
#define MM4(dst_, a_, b_, init_) { f32x4m z_ = init_; _Pragma("unroll") for (int s_ = 0; s_ < 4; ++s_) z_ = __builtin_amdgcn_mfma_f32_16x16x4f32(a_[s_], b_[s_], z_, 0, 0, 0); dst_ = z_; }
        const f32x4m zero4 = {0.f, 0.f, 0.f, 0.f};
        f32x4m a2N, a2T, a4N, a4T, a8N, b1T, b2T, b3T, iaT;
        MM4(a2N, aT, aN, zero4); MM4(a2T, aN, aT, zero4);
#pragma unroll
        for (int r = 0; r < 4; ++r) iaT[r] = aT[r] + (cl == 4 * q + r ? 1.f : 0.f);
        MM4(a4N, a2T, a2N, zero4); MM4(a4T, a2N, a2T, zero4);
        MM4(b1T, a2N, iaT, iaT);
        MM4(a8N, a4T, a4N, zero4);
        MM4(b2T, a4N, b1T, b1T);
        MM4(b3T, a8N, b2T, b2T);
#undef MM4
        *(LAS f32x4m*)(L + RW_TINV + (d * 64 + lane) * 16) = b3T;
    }
    __syncthreads(); RWP(2);
    {
        const int cl = lane & 15, q = lane >> 4, cc = (wave & 3) * 16 + cl;
        LAS bf16* xrow = (wave < 4 ? Ut : Wt) + cc * RW_P;
        f32x4m Tt[4];
#pragma unroll
        for (int b = 0; b < 4; ++b) Tt[b] = *(const LAS f32x4m*)(L + RW_TINV + (b * 64 + lane) * 16);
        unsigned xp[4][2];
#pragma unroll
        for (int b = 0; b < 4; ++b) {
            f32x4m acc;
            if (wave < 4) { const v2u w = *(const LAS v2u*)(RhsB + cc * RW_P + 16 * b + 4 * q); acc[0] = bflo(w.x); acc[1] = bfhi(w.x); acc[2] = bflo(w.y); acc[3] = bfhi(w.y); }
            else {
#pragma unroll
                for (int r = 0; r < 4; ++r) acc[r] = bf1(At[(16 * b + 4 * q + r) * RW_P + cc]); }
#pragma unroll
            for (int mq = 0; mq < 2; ++mq) if (32 * mq < 16 * b) {
                const v2u a0 = *(const LAS v2u*)(Aab + (16 * b + cl) * RW_P + 32 * mq + 4 * q), a1 = *(const LAS v2u*)(Aab + (16 * b + cl) * RW_P + 32 * mq + 16 + 4 * q);
                const bool second = 2 * mq + 1 < b;
                const v4u au = {a0.x, a0.y, a1.x, a1.y}, xu = {xp[2 * mq][0], xp[2 * mq][1], second ? xp[2 * mq + 1][0] : 0u, second ? xp[2 * mq + 1][1] : 0u};
                acc = __builtin_amdgcn_mfma_f32_16x16x32_bf16(__builtin_bit_cast(bf16x8, au), __builtin_bit_cast(bf16x8, xu), acc, 0, 0, 0);
            }
            f32x4m x = {0.f, 0.f, 0.f, 0.f};
#pragma unroll
            for (int s = 0; s < 4; ++s) x = __builtin_amdgcn_mfma_f32_16x16x4f32(Tt[b][s], acc[s], x, 0, 0, 0);
            xp[b][0] = pk2(x[0], x[1]); xp[b][1] = pk2(x[2], x[3]);
            *(LAS v2u*)(xrow + 16 * b + 4 * q) = (v2u){xp[b][0], xp[b][1]};
        }
    }
    __syncthreads(); RWP(3);
    {
        const int ti = (wave >> 1) & 1, tn = wave & 1; f32x16 acc = {};
        unsigned char* dst = F.ws + WS_F + rw_item(bh, c) * 16384;
        if (wave < 4) { acc = rw_mm(acc, Wt, tn, Bht, ti, lane);
            bf16* MT = (bf16*)dst; const int k2 = 32 * ti + r32; const float ed = __expf(lend[k2]);
#pragma unroll
            for (int g = 0; g < 4; ++g) { const int k1 = 32 * tn + 8 * g + 4 * hi;
                const float v0 = acc[4 * g] + (k1 == k2 ? ed : 0.f), v1 = acc[4 * g + 1] + (k1 + 1 == k2 ? ed : 0.f), v2 = acc[4 * g + 2] + (k1 + 2 == k2 ? ed : 0.f), v3 = acc[4 * g + 3] + (k1 + 3 == k2 ? ed : 0.f);
                *(v2u*)(MT + k2 * 64 + k1) = (v2u){pk2(v0, v1), pk2(v2, v3)}; }
        } else { acc = rw_mm(acc, Bht, ti, Ut, tn, lane); acc = rw_mm(acc, Kht, ti, Vt, tn, lane);
            v4u* GT = (v4u*)(dst + 8192) + ((ti * 2 + tn) * 64 + lane) * 2;
            const bf16x8 g0 = rw_pack8(acc, 0), g1 = rw_pack8(acc, 1); GT[0] = __builtin_bit_cast(v4u, g0); GT[1] = __builtin_bit_cast(v4u, g1); }
    }
    RWP(4);
    if (c > 0) {
        const int ti = (wave >> 1) & 1, tn = wave & 1; f32x16 acc = {};
        unsigned char* dst = F.ws + WS_QY + rw_item(bh, c) * 16384;
        if (wave < 4) { acc = rw_mm(acc, Wt, tn, Arb, ti, lane);
            bf16* Qg = (bf16*)dst; const int t = 32 * ti + r32;
#pragma unroll
            for (int g = 0; g < 4; ++g) { const int k = 32 * tn + 8 * g + 4 * hi; const v2u rw = *(const LAS v2u*)(Rt + t * RW_P + k);
                *(v2u*)(Qg + t * 64 + k) = (v2u){pk2(acc[4 * g] + bflo(rw.x), acc[4 * g + 1] + bfhi(rw.x)), pk2(acc[4 * g + 2] + bflo(rw.y), acc[4 * g + 3] + bfhi(rw.y))}; }
        } else { acc = rw_mm(acc, Ut, tn, Arb, ti, lane); acc = rw_mm(acc, Vt, tn, Ark, ti, lane);
            v4u* YT = (v4u*)(dst + 8192) + ((ti * 2 + tn) * 64 + lane) * 2;
            const bf16x8 g0 = rw_pack8(acc, 0), g1 = rw_pack8(acc, 1); YT[0] = __builtin_bit_cast(v4u, g0); YT[1] = __builtin_bit_cast(v4u, g1); }
    }
    __syncthreads(); RWP(5);
}

struct OutRaw { v4u qg[4], s0[4], s1[4]; };
__device__ __forceinline__ void rwkv_out_load(OutRaw& R, Frame& F, int bh, int c, int ti) {
    const int lane = F.lane, r32 = lane & 31, b = bh >> 3, h = bh & 7, rr = lane >> 3, ck = lane & 7;
    const unsigned char* src = F.ws + WS_QY + rw_item(bh, c) * 16384; const bf16* Qg = (const bf16*)src; const v4u* YT = (const v4u*)(src + 8192);
    const v4u* SI = (const v4u*)(F.ws + WS_SST + rw_item(bh, c) * 8192);
#pragma unroll
    for (int j = 0; j < 4; ++j) R.qg[j] = *(const v4u*)(Qg + (32 * ti + 8 * j + rr) * 64 + 8 * ck);
#pragma unroll
    for (int e = 0; e < 4; ++e) { R.s0[e] = SI[(((e >> 1) * 2 + 0) * 2 + (e & 1)) * 64 + lane]; R.s1[e] = SI[(((e >> 1) * 2 + 1) * 2 + (e & 1)) * 64 + lane]; }
}
__device__ __forceinline__ void rwkv_out(Frame& F, const OutRaw& R, int bh, int c, int ti) {
    constexpr int P_ = 144;
    const int lane = F.lane, r32 = lane & 31, hi = lane >> 5, b = bh >> 3, h = bh & 7, rr = lane >> 3, ck = lane & 7;
    LAS unsigned char* Zl = F.lds + RING_OFF + F.wave * 16384; LAS unsigned char* Gl = Zl + 33 * P_; LAS unsigned char* Ql = Gl + 32 * P_;
    const int tok0 = 64 * (c - 1) + 32 * ti; const size_t m0 = (size_t)(b * SEQL + tok0);
    bf16* RO = (bf16*)(F.ws + WS_F);
    const size_t pm0 = tok0 == 0 ? (size_t)(MR + 15) : m0 - 1;
    const bf16* ZR = (const bf16*)(F.ws + WS_ZR); const bf16* GG = (const bf16*)(F.ws + WS_GG);
    const v4u* YT = (const v4u*)(F.ws + WS_QY + rw_item(bh, c) * 16384 + 8192);
    const float dt = ((const float*)(F.ws + WS_DOTS))[rw_item(bh, c) * 64 + 32 * ti + r32];
    const v4u a0 = YT[((ti * 2 + 0) * 64 + lane) * 2], a1 = YT[((ti * 2 + 0) * 64 + lane) * 2 + 1], b0 = YT[((ti * 2 + 1) * 64 + lane) * 2], b1 = YT[((ti * 2 + 1) * 64 + lane) * 2 + 1];
    v4u qg[4], zg[4], gg4[4], s0[4], s1[4];
#pragma unroll
    for (int j = 0; j < 4; ++j) { qg[j] = R.qg[j]; s0[j] = R.s0[j]; s1[j] = R.s1[j]; }
    const v4u zprev = *(const v4u*)(ZR + pm0 * 1792 + 1024 + h * 64 + 8 * ck);
#pragma unroll
    for (int j = 0; j < 4; ++j) { zg[j] = *(const v4u*)(ZR + (m0 + 8 * j + rr) * 1792 + 1024 + h * 64 + 8 * ck); gg4[j] = *(const v4u*)(GG + (m0 + 8 * j + rr) * 512 + h * 64 + 8 * ck); }
    __builtin_amdgcn_sched_barrier(0);
#pragma unroll
    for (int j = 0; j < 4; ++j) *(LAS v4u*)(Ql + (8 * j + rr) * P_ + 16 * ck) = qg[j];
    f32x16 y0, y1;
#pragma unroll
    for (int j = 0; j < 4; ++j) { y0[2 * j] = bflo(a0[j]); y0[2 * j + 1] = bfhi(a0[j]); y0[8 + 2 * j] = bflo(a1[j]); y0[8 + 2 * j + 1] = bfhi(a1[j]);
                                  y1[2 * j] = bflo(b0[j]); y1[2 * j + 1] = bfhi(b0[j]); y1[8 + 2 * j] = bflo(b1[j]); y1[8 + 2 * j + 1] = bfhi(b1[j]); }
#pragma unroll
    for (int e = 0; e < 4; ++e) {
        const v2u qa = *(const LAS v2u*)(Ql + r32 * P_ + (32 * (e >> 1) + 16 * (e & 1) + 4 * hi) * 2), qb = *(const LAS v2u*)(Ql + r32 * P_ + (32 * (e >> 1) + 16 * (e & 1) + 8 + 4 * hi) * 2);
        const v4u qf = {qa.x, qa.y, qb.x, qb.y};
        y0 = __builtin_amdgcn_mfma_f32_32x32x16_bf16(__builtin_bit_cast(bf16x8, s0[e]), __builtin_bit_cast(bf16x8, qf), y0, 0, 0, 0);
        y1 = __builtin_amdgcn_mfma_f32_32x32x16_bf16(__builtin_bit_cast(bf16x8, s1[e]), __builtin_bit_cast(bf16x8, qf), y1, 0, 0, 0);
    }
    if (lane < 8) *(LAS v4u*)(Zl + 16 * ck) = zprev;
#pragma unroll
    for (int j = 0; j < 4; ++j) { *(LAS v4u*)(Zl + (1 + 8 * j + rr) * P_ + 16 * ck) = zg[j]; *(LAS v4u*)(Gl + (8 * j + rr) * P_ + 16 * ck) = gg4[j]; }
    float sm = 0.f;
#pragma unroll
    for (int r = 0; r < 16; ++r) sm += y0[r] + y1[r];
    sm += __shfl_xor(sm, 32);
    const float mean = sm * (1.f / 64.f);
    float sv = 0.f;
#pragma unroll
    for (int r = 0; r < 16; ++r) { y0[r] -= mean; y1[r] -= mean; sv += y0[r] * y0[r] + y1[r] * y1[r]; }
    sv += __shfl_xor(sv, 32);
    const float rs = 1.f / sqrtf(sv * (1.f / 64.f) + GN_EPS);
    const float* lnw = inp(18) + h * 64 + 4 * hi; const float* lnb = inp(19) + h * 64 + 4 * hi; const float* mvp = inp(9) + 1024 + h * 64 + 4 * hi;
#pragma unroll
    for (int tn = 0; tn < 2; ++tn)
#pragma unroll
        for (int g = 0; g < 4; ++g) { const int co = (32 * tn + 8 * g + 4 * hi) * 2;
            const f32x4 w4 = *(const f32x4*)(lnw + 32 * tn + 8 * g), b4 = *(const f32x4*)(lnb + 32 * tn + 8 * g), m4 = *(const f32x4*)(mvp + 32 * tn + 8 * g);
            const v2u zv = *(const LAS v2u*)(Zl + (1 + r32) * P_ + co), pv = *(const LAS v2u*)(Zl + r32 * P_ + co), gv = *(const LAS v2u*)(Gl + r32 * P_ + co);
            const float z[4] = {bflo(zv.x), bfhi(zv.x), bflo(zv.y), bfhi(zv.y)}, p[4] = {bflo(pv.x), bfhi(pv.x), bflo(pv.y), bfhi(pv.y)}, gt[4] = {bflo(gv.x), bfhi(gv.x), bflo(gv.y), bfhi(gv.y)};
            float o[4];
#pragma unroll
            for (int x = 0; x < 4; ++x) { const float d = tn == 0 ? y0[4 * g + x] : y1[4 * g + x]; const float v = z[x] + (p[x] - z[x]) * m4[x]; o[x] = (d * rs * w4[x] + b4[x] + dt * v) * gt[x]; }
            *(LAS v2u*)(Gl + r32 * P_ + co) = (v2u){pk2(o[0], o[1]), pk2(o[2], o[3])};
        }
#pragma unroll
    for (int j = 0; j < 4; ++j) *(v4u*)(RO + (m0 + 8 * j + rr) * 512 + h * 64 + 8 * ck) = *(const LAS v4u*)(Gl + (8 * j + rr) * P_ + 16 * ck);
}

constexpr int RWC_MP = 68;
constexpr int RWC_SLOT = 64 * RWC_MP * 2 + 4096;
constexpr int RWC_FLAGS = 7 * RWC_SLOT;
__device__ __forceinline__ void rwkv_chain_wg(Frame& F, int bh, int tv) {
    const int lane = F.lane, wave = F.wave, r32 = lane & 31, hi = lane >> 5;
    LAS unsigned char* L = F.lds; volatile LAS unsigned* flag = (volatile LAS unsigned*)(L + RWC_FLAGS);
    if (F.tid < 7) flag[F.tid] = 0u;
    __syncthreads();
    if (wave != 0) {
        const int slot = wave - 1; LAS unsigned char* sb = L + slot * RWC_SLOT;
        v4u mv[8], gv[4];
#define RWC_LOAD(MV, GV, CC) do { const unsigned char* src_ = F.ws + WS_F + rw_item(bh, (CC)) * 16384; const v4u* MT_ = (const v4u*)src_; const v4u* GT_ = (const v4u*)(src_ + 8192); \
            _Pragma("unroll") for (int i = 0; i < 8; ++i) MV[i] = MT_[lane + 64 * i]; \
            _Pragma("unroll") for (int i = 0; i < 4; ++i) { const int idx = lane + 64 * i, t2 = idx >> 7, l = (idx >> 1) & 63, hf = idx & 1; GV[i] = GT_[((t2 * 2 + tv) * 64 + l) * 2 + hf]; } } while (0)
        v4u mw[8], gw_[4];
#define RWC_STEP(MV, GV, NM, NG) do { \
            if (c + 7 == RW_NCH - 1) {        \
                unsigned* fl_ = (unsigned*)(F.ctl + CW_LASTCHUNK + bh); unsigned* tmo_ = (unsigned*)(F.ctl + CW_BAR); \
                XB_SPIN(__hip_atomic_load(fl_, __ATOMIC_RELAXED, __HIP_MEMORY_SCOPE_AGENT) == 0u, tmo_); \
                __builtin_amdgcn_fence(__ATOMIC_ACQUIRE, ""); } \
            RWC_LOAD(NM, NG, (c + 7 < RW_NCH ? c + 7 : c));                                            \
            asm volatile("s_waitcnt vmcnt(12)" ::: "memory");                                         \
            while (flag[slot] != 0u) __builtin_amdgcn_s_sleep(2);                                     \
            _Pragma("unroll") for (int i = 0; i < 8; ++i) { const int idx = lane + 64 * i; *(LAS v4u*)(sb + (idx >> 3) * (RWC_MP * 2) + (idx & 7) * 16) = MV[i]; } \
            _Pragma("unroll") for (int i = 0; i < 4; ++i) *(LAS v4u*)(sb + 64 * RWC_MP * 2 + (lane + 64 * i) * 16) = GV[i]; \
            asm volatile("s_waitcnt lgkmcnt(0)" ::: "memory"); \
            if (lane == 0) flag[slot] = 1u; } while (0)
        RWC_LOAD(mv, gv, slot);
        for (int c = slot;;) {
            RWC_STEP(mv, gv, mw, gw_); c += 7; if (c >= RW_NCH) break;
            RWC_STEP(mw, gw_, mv, gv); c += 7; if (c >= RW_NCH) break;
        }
#undef RWC_STEP
#undef RWC_LOAD
        return;
    }
    f32x16 s0 = {}, s1 = {};
    __builtin_amdgcn_s_setprio(3);
    for (int c = 0; c < RW_NCH; ++c) {
        const int slot = c % 7; const LAS unsigned char* sb = L + slot * RWC_SLOT;
        v4u* SI = (v4u*)(F.ws + WS_SST + rw_item(bh, c) * 8192);
        const bf16x8 b00 = rw_pack8(s0, 0), b01 = rw_pack8(s0, 1), b10 = rw_pack8(s1, 0), b11 = rw_pack8(s1, 1);
        SI[((0 * 2 + tv) * 2 + 0) * 64 + lane] = __builtin_bit_cast(v4u, b00); SI[((0 * 2 + tv) * 2 + 1) * 64 + lane] = __builtin_bit_cast(v4u, b01);
        SI[((1 * 2 + tv) * 2 + 0) * 64 + lane] = __builtin_bit_cast(v4u, b10); SI[((1 * 2 + tv) * 2 + 1) * 64 + lane] = __builtin_bit_cast(v4u, b11);
        while (flag[slot] == 0u) __builtin_amdgcn_s_sleep(1);
        asm volatile("" ::: "memory");
        s16x4v ma[2][2][2], mb[2][2][2]; v4u g[2][2];
#pragma unroll
        for (int tk = 0; tk < 2; ++tk)
#pragma unroll
            for (int s = 0; s < 2; ++s)
#pragma unroll
                for (int t2 = 0; t2 < 2; ++t2) { const LAS bf16* mp = (const LAS bf16*)sb + (32 * t2 + r32) * RWC_MP + 32 * tk + 16 * s + 4 * hi; ma[tk][s][t2] = *(const LAS s16x4v*)(mp); mb[tk][s][t2] = *(const LAS s16x4v*)(mp + 8); }
#pragma unroll
        for (int t2 = 0; t2 < 2; ++t2) { g[t2][0] = *(const LAS v4u*)(sb + 64 * RWC_MP * 2 + ((t2 * 64 + lane) * 2) * 16); g[t2][1] = *(const LAS v4u*)(sb + 64 * RWC_MP * 2 + ((t2 * 64 + lane) * 2 + 1) * 16); }
        asm volatile("s_waitcnt lgkmcnt(0)" ::: "memory");
        if (lane == 0) flag[slot] = 0u;
        f32x16 n0, n1;
#pragma unroll
        for (int j = 0; j < 4; ++j) { n0[2 * j] = bflo(g[0][0][j]); n0[2 * j + 1] = bfhi(g[0][0][j]); n0[8 + 2 * j] = bflo(g[0][1][j]); n0[8 + 2 * j + 1] = bfhi(g[0][1][j]);
                                      n1[2 * j] = bflo(g[1][0][j]); n1[2 * j + 1] = bfhi(g[1][0][j]); n1[8 + 2 * j] = bflo(g[1][1][j]); n1[8 + 2 * j + 1] = bfhi(g[1][1][j]); }
#pragma unroll
        for (int tk = 0; tk < 2; ++tk)
#pragma unroll
            for (int s = 0; s < 2; ++s) {
                const bf16x8 bfr = tk == 0 ? (s == 0 ? b00 : b01) : (s == 0 ? b10 : b11);
#pragma unroll
                for (int t2 = 0; t2 < 2; ++t2) {
                    const s16x4v xa = ma[tk][s][t2], xb = mb[tk][s][t2];
                    const bf16x8 af = {xa[0], xa[1], xa[2], xa[3], xb[0], xb[1], xb[2], xb[3]};
                    if (t2 == 0) n0 = __builtin_amdgcn_mfma_f32_32x32x16_bf16(af, bfr, n0, 0, 0, 0); else n1 = __builtin_amdgcn_mfma_f32_32x32x16_bf16(af, bfr, n1, 0, 0, 0);
                }
            }
        s0 = n0; s1 = n1;
    }
    __builtin_amdgcn_s_setprio(0);
}

#ifdef MK_DUMP
__device__ __forceinline__ void dump_phase(const unsigned char* ws, float* out) {
    const size_t n = (size_t)MR * DM; const size_t i0 = (size_t)blockIdx.x * blockDim.x + threadIdx.x, st = (size_t)gridDim.x * blockDim.x;
    for (size_t i = i0; i < n; i += st) { const size_t m = i >> 10, c = i & 1023; float v = 0.f;
        if (MK_DUMP == 1) v = bf1(((const bf16*)(ws + WS_F))[m * 1024 + c]);
        else if (MK_DUMP == 2) v = bf1(((const bf16*)(ws + WS_ZR))[m * 1792 + c]);
        else if (MK_DUMP == 3) v = c < 512 ? ((const float*)(ws + WS_LW))[m * 512 + c] : bf1(((const bf16*)(ws + WS_AA))[m * 512 + c - 512]);
        else if (MK_DUMP == 4) v = bf1(((const bf16*)(ws + WS_MERGED))[m * 1024 + c]);
        else if (MK_DUMP == 5) v = c < 512 ? bf1(((const bf16*)(ws + WS_Q))[m * 512 + c]) : (c < 768 ? bf1(((const bf16*)(ws + WS_KV))[m * 256 + c - 512]) : bf1(((const bf16*)(ws + WS_LA))[m * 256 + c - 768]));
        else if (MK_DUMP == 6) v = bf1(((const bf16*)(ws + WS_GATES))[m * 2048 + c]);
        else if (MK_DUMP == 7) v = bf1(((const bf16*)(ws + WS_F))[m * 1024 + c]);
        else if (MK_DUMP == 8) v = c < 512 ? bf1(((const bf16*)(ws + WS_GG))[m * 512 + c]) : bf1(((const bf16*)(ws + WS_ZR))[m * 1792 + 1024 + c - 512]);
        else if (MK_DUMP == 9) v = ((const float*)(ws + WS_SS))[((size_t)((c & 15) >> 2) * MP + m) * 4 + (c & 3)];
        else if (MK_DUMP == 10) v = bf1(((const bf16*)(ws + WS_XN))[m * 1024 + c]);
        out[i] = v; }
}
#endif
#ifndef MK_N_LAUNCHES
#define MK_N_LAUNCHES 1
#endif
constexpr int N_PHASES = 15;
constexpr int N_LAUNCHES = MK_N_LAUNCHES;
__global__ void __launch_bounds__(NWAVES * 64, 2) hybrid_fwd(Args args) {
    extern __shared__ __attribute__((aligned(16))) unsigned char lds[];
    Frame F;
    F.lds = (LAS unsigned char*)lds;
    F.MISC = (volatile LAS unsigned*)(F.lds + MISC_OFF);
#define FRAME_REFRESH() do { int t_ = threadIdx.x; asm volatile("" : "+v"(t_)); F.tid = t_; F.lane = t_ & 63; F.wave = __builtin_amdgcn_readfirstlane(t_ >> 6); } while (0)
    FRAME_REFRESH();
    F.G = gridDim.x; { const int bx = blockIdx.x; F.vcu = (F.G % 8 == 0) ? (bx % 8) * (F.G / 8) + bx / 8 : bx; }
    unsigned char* ws = args.ws; F.ws = ws; F.out = args.out;
    F.ctl = (gu32*)(ws + WS_CTL);
    for (int u = F.tid; u < (LDS_BYTES - LDSCTL_OFF) / 4; u += NWAVES * 64) ((LAS unsigned*)(F.lds + LDSCTL_OFF))[u] = 0u;
    __syncthreads();
    XcdBarrier bar; bar.bar = (unsigned*)(F.ctl + CW_BAR); bar.x = 0; bar.st = nullptr;
    if (N_LAUNCHES == 1) bar = xcd_barrier_post((unsigned*)(F.ctl + CW_BAR), F.MISC + 8);
    const int lo = args.ph_lo, hi = args.ph_hi;
#ifndef PHASE_MASK
#define PHASE_MASK 0x7fff
#endif
#define IN(k) (((PHASE_MASK >> (k)) & 1) && lo <= (k) && (k) < hi)
#ifndef MK_TIME_SCALE
#define MK_TIME_SCALE 0.001f
#endif
#ifdef MK_TIME_PHASE
#define SEAM(k) do { if (IN(k) && IN((k) + 1)) xcd_barrier(bar); if (blockIdx.x == 0 && threadIdx.x == 0) { const unsigned long long t_ = __builtin_amdgcn_s_memrealtime(); ((unsigned long long*)(ws + 16384))[(k) + 1] = t_; } } while (0)
#else
#define SEAM(k) do { if (IN(k) && IN((k) + 1)) xcd_barrier(bar); } while (0)
#endif
#define GEMM_RUN(EpiT, Eobj, Aptr, lda_, Bptr, ldb_, M_, N_, K_) do { pg8::Gemm g_{(const pg8::bf16_t*)(Aptr), (const pg8::bf16_t*)(Bptr), (M_), (N_), (K_), (lda_), (ldb_)}; pg8::StaticOrder S_; S_.init((M_), (N_), F.G, (int)blockIdx.x); \
        pg8::gemm_phase<EpiT, pg8::StaticOrder, true, true>(F.lds + RING_OFF, g_, S_, Eobj); } while (0)

#ifdef MK_COH_TEST
    {
        float* Tb = (float*)(ws + WS_BIG + 300 * MiB); const int g = blockIdx.x, G = gridDim.x, nb = (g + 1) % G; float acc = 0.f; unsigned bad = 0;
        for (int rep = 0; rep < 4; ++rep) {
            for (int i = threadIdx.x; i < 8192; i += 512) Tb[(size_t)g * 8192 + i] = 1.0f + rep;
            xcd_barrier(bar);
            for (int i = threadIdx.x; i < 8192; i += 512) acc += Tb[(size_t)nb * 8192 + i];
            xcd_barrier(bar);
            for (int i = threadIdx.x; i < 8192; i += 512) Tb[(size_t)g * 8192 + i] = 100.0f + rep * 7 + i;
            xcd_barrier(bar);
            for (int i = threadIdx.x; i < 8192; i += 512) { const float v = Tb[(size_t)nb * 8192 + i]; bad += (v != 100.0f + rep * 7 + i) ? 1u : 0u; }
            xcd_barrier(bar);
        }
        if (acc == 12345.f) bad++;
        if (bad) atomicAdd((unsigned*)(F.ctl + 901), bad);
    }
#endif
#ifdef MK_ITEM_PROF
    if (blockIdx.x == 0 && threadIdx.x == 0) { for (int i_ = 0; i_ < 8; ++i_) ((unsigned long long*)(ws + 32768))[i_] = 0ull; }
#endif
#ifdef MK_TIME_PHASE
    if (blockIdx.x == 0 && threadIdx.x == 0) ((unsigned long long*)(ws + 16384))[0] = __builtin_amdgcn_s_memrealtime();
#endif
    if (IN(0)) { FRAME_REFRESH(); p0_prologue(F, args); } SEAM(0);
    if (IN(1)) { FRAME_REFRESH(); { for (int it = F.vcu; it < DFF / 16; it += F.G) meta_gateup(F, (const bf16*)(ws + WS_WGU1), it); }
        pg8::EpiSwiGLU E{(pg8::bf16_t*)(ws + WS_HID), nullptr}; GEMM_RUN(pg8::EpiSwiGLU, E, (unsigned char*)F.out, DM, ws + WS_WGU1, DM, MR, NHID2, DM); } SEAM(1);
    if (IN(2)) { FRAME_REFRESH(); { for (int it = F.vcu; it < 64; it += F.G) meta_down(F, (const bf16*)(ws + WS_WD1), it); }
        pg8::EpiFSS E{(pg8::bf16_t*)(ws + WS_F), (float*)(ws + WS_SS)}; GEMM_RUN(pg8::EpiFSS, E, ws + WS_HID, DFF, ws + WS_WD1, DFF, MR, DM, DFF); } SEAM(2);
    if (IN(3)) { FRAME_REFRESH(); row_pass<0>(F, args, inp(5), inp(6), 0.5f); } SEAM(3);
    if (IN(4)) { pg8::EpiWin E{(const float*)(ws + WS_RS2), (pg8::bf16_t*)(ws + WS_Q), (pg8::bf16_t*)(ws + WS_KV), (pg8::bf16_t*)(ws + WS_ZR), (const float*)(ws + WS_ROPE), MR, (pg8::bf16_t*)(ws + WS_VT)}; FRAME_REFRESH(); { for (int it = F.vcu; it < 128; it += F.G) meta_win(F, it); }
        GEMM_RUN(pg8::EpiWin, E, (unsigned char*)F.out, DM, ws + WS_WIN, DM, MR, NIN_A, DM); } SEAM(4);
#ifdef MK_GEMM_CHECK4
    if (IN(4)) { xcd_barrier(bar);
        { unsigned char* w2 = ws + WS_BIG + 165 * MiB; pg8::EpiWin E{(const float*)(ws + WS_RS2), (pg8::bf16_t*)(w2), (pg8::bf16_t*)(w2 + (WS_KV - WS_Q)), (pg8::bf16_t*)(w2 + (WS_ZR - WS_Q)), (const float*)(ws + WS_ROPE), MR, (pg8::bf16_t*)(ws + WS_VT)};
          pg8::Gemm g_{(const pg8::bf16_t*)(ws + WS_XN), (const pg8::bf16_t*)(ws + WS_WIN), MP, NIN_A, DM, DM, DM}; pg8::StaticOrder S_; S_.init(MP, NIN_A, F.G, (int)((blockIdx.x + 101) % gridDim.x));
          pg8::gemm_phase<pg8::EpiWin, pg8::StaticOrder, true, true>(F.lds + RING_OFF, g_, S_, E); }
        xcd_barrier(bar);
        { FRAME_REFRESH(); const unsigned* a = (const unsigned*)(ws + WS_Q); const unsigned* b = (const unsigned*)(ws + WS_BIG + 165 * MiB); unsigned bad = 0;
          for (size_t i = (size_t)blockIdx.x * 512 + F.tid; i < (size_t)MP * 2560 / 2; i += (size_t)gridDim.x * 512) bad += (a[i] != b[i]) ? 1u : 0u;
          if (bad) atomicAdd((unsigned*)(F.ctl + 900), bad); }
        xcd_barrier(bar);
    }
#endif
    if (IN(5)) { FRAME_REFRESH(); lora_a_pass(F, args);
#ifdef MK_PROBE_BAR
        xcd_barrier(bar); xcd_barrier(bar); xcd_barrier(bar); xcd_barrier(bar);
#endif
    } SEAM(5);
    if (IN(6)) { pg8::EpiLora E{(pg8::bf16_t*)(ws + WS_LW), (pg8::bf16_t*)(ws + WS_AA), (pg8::bf16_t*)(ws + WS_GG), inp(10), inp(12)}; FRAME_REFRESH(); { const int gw = F.vcu * NWAVES + F.wave, NGW = F.G * NWAVES; for (int it = gw; it < 96; it += NGW) meta_lora(F, it); }
        int kl_ = 256; asm volatile("" : "+s"(kl_)); GEMM_RUN(pg8::EpiLora, E, ws + WS_LA, 256, ws + WS_WL, 256, MR, 1536, kl_); } SEAM(6);
    if (IN(7)) { FRAME_REFRESH();
        { RwRaw raw; { const int it0 = (int)blockIdx.x; rw_load_raw(raw, F, it0 >> 10, (it0 >> 7) & 7, it0 & 127); }
          for (int it = (int)blockIdx.x; it < 32 * 128; it += F.G) { const int bh = it >> 7, c = it & 127; const int itn = it + F.G, bhn = itn >> 7, cn = itn < 32 * 128 ? (itn & 127) : -1;
              rwkv_item(F, bh >> 3, bh & 7, c, raw, bhn >> 3, bhn & 7, cn); } }
        xcd_barrier(bar);
#ifdef MK_TIME_PHASE
        if (blockIdx.x == 0 && threadIdx.x == 0) ((unsigned long long*)(ws + 16384))[21] = __builtin_amdgcn_s_memrealtime();
#endif
        FRAME_REFRESH();
#ifdef MK_SKIP_CHAIN
        if ((int)blockIdx.x < 64) { if (F.G == 12345) rwkv_chain_wg(F, (int)blockIdx.x >> 1, (int)blockIdx.x & 1); }
#else
        if ((int)blockIdx.x < 64) { rwkv_chain_wg(F, (int)blockIdx.x >> 1, (int)blockIdx.x & 1);
#ifdef MK_TIME_PHASE
            if (blockIdx.x == 0 && threadIdx.x == 0) ((unsigned long long*)(ws + 16384))[23] = __builtin_amdgcn_s_memrealtime();
#endif
        }
#endif
#ifdef MK_SKIP_ATT
        else if (false) {
#else
        else {
#endif
            if ((int)blockIdx.x >= F.G - 32) {
                const int bhl = (int)blockIdx.x - (F.G - 32); RwRaw rawl; rw_load_raw(rawl, F, bhl >> 3, bhl & 7, 128);
                rwkv_item(F, bhl >> 3, bhl & 7, 128, rawl, 0, 0, -1);
                asm volatile("s_waitcnt vmcnt(0)" ::: "memory"); __syncthreads();
                if (threadIdx.x == 0) { __builtin_amdgcn_fence(__ATOMIC_RELEASE, ""); asm volatile("s_waitcnt vmcnt(0)" ::: "memory");
                    __hip_atomic_store((unsigned*)(F.ctl + CW_LASTCHUNK + bhl), 1u, __ATOMIC_RELAXED, __HIP_MEMORY_SCOPE_AGENT); }
                FRAME_REFRESH();
            }
            const int gw = ((int)blockIdx.x - 64) * NWAVES + F.wave, NGW = (F.G - 64) * NWAVES;
            for (int it = gw; it < NB * 8 * (SEQL / 32); it += NGW) { const int head = it & 7, qb = (it >> 3) & 255, b = it >> 11; attn_item(F, args, b, head, qb); }
#ifdef MK_TIME_PHASE
            if (blockIdx.x == MK_TS_WG && threadIdx.x == 0) ((unsigned long long*)(ws + 16384))[24] = __builtin_amdgcn_s_memrealtime();
            if (F.lane == 0 && F.wave == MK_TS_WAVE) atomicMax((unsigned long long*)(ws + 16384) + 26, (unsigned long long)__builtin_amdgcn_s_memrealtime());
#endif
#ifndef MK_SKIP_CONV
            convert_late_weights(F, args, gw, NGW, F.lds);
#endif
#ifdef MK_TIME_PHASE
            if (blockIdx.x == MK_TS_WG && threadIdx.x == 0) ((unsigned long long*)(ws + 16384))[25] = __builtin_amdgcn_s_memrealtime();
            if (F.lane == 0) atomicMax((unsigned long long*)(ws + 16384) + 27, (unsigned long long)__builtin_amdgcn_s_memrealtime());
#endif
            }
        xcd_barrier(bar);
#ifdef MK_TIME_PHASE
        if (blockIdx.x == 0 && threadIdx.x == 0) ((unsigned long long*)(ws + 16384))[22] = __builtin_amdgcn_s_memrealtime();
#endif
        FRAME_REFRESH();
        { const int gw = (int)blockIdx.x * NWAVES + F.wave, NGW = F.G * NWAVES;
          constexpr int T_ = 32 * 128 * 2; OutRaw R;
          if (gw < T_) rwkv_out_load(R, F, gw >> 8, ((gw >> 1) & 127) + 1, gw & 1);
          for (int it = gw; it < T_; it += NGW) { const int ti = it & 1, c = ((it >> 1) & 127) + 1, bh = it >> 8; const int itn = it + NGW < T_ ? it + NGW : it;
              OutRaw N; rwkv_out_load(N, F, itn >> 8, ((itn >> 1) & 127) + 1, itn & 1);
              rwkv_out(F, R, bh, c, ti); R = N; } }
    }
    SEAM(7);
    if (IN(8)) {
        static_assert(WS_WRWKV == WS_WATT + (size_t)DM * 512 * 2, "branch weights adjacent");
        { pg8::EpiPlain E{(pg8::bf16_t*)(ws + WS_GATES), DM, 4, (size_t)MR * DM};
          pg8::Gemm g_{(const pg8::bf16_t*)(ws + WS_Q), (const pg8::bf16_t*)(ws + WS_WATT), MR, 2 * DM, 512, 512, 512, (const pg8::bf16_t*)(ws + WS_F), 4}; pg8::StaticOrder S_; S_.init(MR, 2 * DM, F.G, (int)blockIdx.x);
          pg8::gemm_phase<pg8::EpiPlain, pg8::StaticOrder, true, true>(F.lds + RING_OFF, g_, S_, E); }
    } SEAM(8);
    if (IN(9)) { pg8::EpiGateMerge E{(const float*)(ws + WS_RS2), (pg8::bf16_t*)(ws + WS_MERGED), (const pg8::bf16_t*)(ws + WS_GATES), (const pg8::bf16_t*)(ws + WS_GATES) + (size_t)MR * DM};
        GEMM_RUN(pg8::EpiGateMerge, E, (unsigned char*)F.out, DM, ws + WS_WIN + (size_t)NIN_A * DM * 2, DM, MR, 2048, DM); } SEAM(9);
    if (IN(10)) { pg8::EpiFSS E{(pg8::bf16_t*)(ws + WS_F), (float*)(ws + WS_SS)}; GEMM_RUN(pg8::EpiFSS, E, ws + WS_MERGED, DM, ws + WS_WMIX, DM, MR, DM, DM); } SEAM(10);
#ifdef MK_GEMM_CHECK
    if (IN(10)) { xcd_barrier(bar);
        { pg8::EpiFSS E{(pg8::bf16_t*)(ws + WS_BIG + 192 * MiB), (float*)(ws + WS_BIG + 256 * MiB)}; pg8::Gemm g_{(const pg8::bf16_t*)(ws + WS_MERGED), (const pg8::bf16_t*)(ws + WS_WMIX), MR, DM, DM, DM, DM}; pg8::StaticOrder S_; S_.init(MR, DM, F.G, (int)((blockIdx.x + 37) % gridDim.x));
          pg8::gemm_phase<pg8::EpiFSS, pg8::StaticOrder, true, true>(F.lds + RING_OFF, g_, S_, E); }
        xcd_barrier(bar);
        { FRAME_REFRESH(); const unsigned* a = (const unsigned*)(ws + WS_F); const unsigned* b = (const unsigned*)(ws + WS_BIG + 192 * MiB); unsigned bad = 0;
          for (size_t i = (size_t)blockIdx.x * 512 + F.tid; i < (size_t)MR * DM / 2; i += (size_t)gridDim.x * 512) bad += (a[i] != b[i]) ? 1u : 0u;
          if (bad) atomicAdd((unsigned*)(F.ctl + 900), bad); }
    }
#endif
    if (IN(11)) { FRAME_REFRESH(); row_pass<1>(F, args, inp(23), inp(24), 1.0f); } SEAM(11);
    if (IN(12)) { pg8::EpiSwiGLU E{(pg8::bf16_t*)(ws + WS_HID), (const float*)(ws + WS_RS3)}; GEMM_RUN(pg8::EpiSwiGLU, E, ws + WS_H2, DM, ws + WS_WGU2, DM, MR, NHID2, DM); } SEAM(12);
    if (IN(13)) { pg8::EpiFSS E{(pg8::bf16_t*)(ws + WS_F), (float*)(ws + WS_SS)}; GEMM_RUN(pg8::EpiFSS, E, ws + WS_HID, DFF, ws + WS_WD2, DFF, MR, DM, DFF); } SEAM(13);
    if (IN(14)) { FRAME_REFRESH(); row_pass<2>(F, args, inp(27), inp(27), 0.5f); }
#if defined(MK_GEMM_CHECK) || defined(MK_COH_TEST) || defined(MK_GEMM_CHECK4) || defined(MK_GATE_CHECK) || defined(MK_GATE_SCAN)
    { xcd_barrier(bar); if (blockIdx.x == 0 && threadIdx.x == 0) { const unsigned nb = __hip_atomic_load((unsigned*)(F.ctl + 900), __ATOMIC_RELAXED, __HIP_MEMORY_SCOPE_AGENT); const unsigned nc = __hip_atomic_load((unsigned*)(F.ctl + 901), __ATOMIC_RELAXED, __HIP_MEMORY_SCOPE_AGENT); if (nb) F.out[0] = 1.0e4f; if (nc) { const unsigned msk = __hip_atomic_load((unsigned*)(F.ctl + 902), __ATOMIC_RELAXED, __HIP_MEMORY_SCOPE_AGENT); F.out[1] = 1.0e6f + 1000.f * (float)nc; F.out[2] = 1.0e10f * (float)msk; } } }
#endif
#ifdef MK_ITEM_PROF
    if (blockIdx.x == 0 && threadIdx.x == 0) F.out[0] = 0.001f * (float)((const unsigned long long*)(ws + 32768))[MK_ITEM_PROF];
#endif
#ifdef MK_TIME_PHASE
    if (blockIdx.x == 0 && threadIdx.x == 0) { const unsigned long long* ts = (const unsigned long long*)(ws + 16384); const unsigned long long te = __builtin_amdgcn_s_memrealtime();
        const int kk_ = MK_TIME_PHASE; unsigned long long t0_ = ts[kk_ < 20 ? kk_ : 7], t1 = kk_ == 14 ? te : ts[(kk_ < 20 ? kk_ : 7) + 1];
        if (kk_ == 20) t1 = ts[21]; if (kk_ == 21) { t0_ = ts[21]; t1 = ts[22]; } if (kk_ == 22) t0_ = ts[22]; if (kk_ >= 23 && kk_ <= 27) { t0_ = ts[21]; t1 = ts[kk_]; }
#ifdef MK_TIME_CUM
        t0_ = ts[0];
#endif
        F.out[0] = MK_TIME_SCALE * (float)(t1 - t0_); }
#endif
#ifdef MK_DUMP
    xcd_barrier(bar); dump_phase(ws, F.out);
#endif
#undef IN
#undef SEAM
#undef GEMM_RUN
}


extern "C" void kernel_launch(void* const* d_in, const int* in_sizes, int n_in, void* d_out, int out_size, void* d_ws, size_t ws_size, hipStream_t stream) {
    static int grid = 0;
    if (grid == 0) {
        if (n_in != 28 || in_sizes[0] != MR * DM || out_size != MR * DM || ws_size < WS_END) { fprintf(stderr, "kernel_launch: unexpected shapes / workspace (n_in %d, in0 %d, out %d, ws %zu, need %zu); nothing launched\n", n_in, n_in > 0 ? in_sizes[0] : -1, out_size, ws_size, (size_t)WS_END); grid = -1; return; }
        int dev = 0, cus = 0, per_cu = 0;
        if (hipGetDevice(&dev) != hipSuccess || hipDeviceGetAttribute(&cus, hipDeviceAttributeMultiprocessorCount, dev) != hipSuccess) { grid = -1; return; }
        if (hipFuncSetAttribute((const void*)hybrid_fwd, hipFuncAttributeMaxDynamicSharedMemorySize, LDS_BYTES) != hipSuccess) { fprintf(stderr, "kernel_launch: hipFuncSetAttribute failed\n"); grid = -1; return; }
        if (hipOccupancyMaxActiveBlocksPerMultiprocessor(&per_cu, (const void*)hybrid_fwd, NWAVES * 64, LDS_BYTES) != hipSuccess || per_cu < 1) { fprintf(stderr, "kernel_launch: occupancy query reports %d workgroups per CU\n", per_cu); per_cu = 1; }
        (void)hipGetLastError();
        grid = cus;
        if (grid < 64) { fprintf(stderr, "kernel_launch: %d CUs: too few\n", grid); grid = -1; return; }
    }
    if (grid < 0) return;
    if (hipMemsetAsync((char*)d_ws + WS_CTL, 0, CTL_ZERO_BYTES, stream) != hipSuccess) return;
    Args a{};
    for (int i = 0; i < 28; ++i) a.in[i] = (const float*)d_in[i];
    a.out = (float*)d_out; a.ws = (unsigned char*)d_ws;
#ifndef MK_LAST_PHASE
#define MK_LAST_PHASE (N_PHASES - 1)
#endif
    for (int li = 0; li < N_LAUNCHES && li <= MK_LAST_PHASE; ++li) {
        if (N_LAUNCHES == 1) { a.ph_lo = 0; a.ph_hi = MK_LAST_PHASE + 1; } else { a.ph_lo = li; a.ph_hi = li + 1; }
        a.li = li;
        hipLaunchKernelGGL(hybrid_fwd, dim3(grid), dim3(NWAVES * 64), LDS_BYTES, stream, a);
        const hipError_t le = hipPeekAtLastError();
        if (le != hipSuccess) { fprintf(stderr, "kernel_launch: launch %d failed: %s\n", li, hipGetErrorName(le)); break; }
    }
}
```

```cpp
#include <hip/hip_runtime.h>
#include <cstdio>
#include <cstdint>

namespace pg8 {
#define PG8_LAS __attribute__((address_space(3)))
typedef unsigned short bf16_t;
typedef short bf16x8 __attribute__((ext_vector_type(8)));
typedef float f32x4 __attribute__((ext_vector_type(4)));
typedef unsigned u32x4 __attribute__((ext_vector_type(4)));
constexpr int BM = 256, BK = 64, HALF = 128, HTB = HALF * BK * 2  , STAGE_BYTES = 8 * HTB, NXCD = 8, WGM = 8;

__host__ __device__ __forceinline__ int lds_byte(int r, int c) { const int st = (r >> 4) * 2 + (c >> 5), rr = r & 15, cc = c & 31, ob = rr * 64 + cc * 2; return st * 1024 + (ob ^ (((ob >> 9) & 1) << 5)); }
__host__ __device__ __forceinline__ void stage_rc(int b, int& R, int& C) { const int st = b / 1024, sb = b % 1024, swz = sb ^ (((sb >> 9) & 1) << 5); R = (st >> 1) * 16 + swz / 64; C = (st & 1) * 32 + (swz % 64) / 2; }
__host__ __device__ __forceinline__ int perm32(int rho) { const int n = rho >> 4, i = rho & 15; return 8 * (i >> 2) + 4 * n + (i & 3); }

struct Unit { int pm, pn; };
struct Gemm { const bf16_t* A; const bf16_t* Bt; int M, N, K, lda, ldb; const bf16_t* A2 = nullptr; int nsplit = 1 << 30; };

struct StaticOrder {
    int nM, nN, nwg, G, c;
    __host__ __device__ void init(int M, int N, int G_, int c_) { nM = M / BM; nN = N / BM; nwg = nM * nN; G = G_; c = c_; }
    __host__ __device__ bool next(int i, Unit& u) const {
        const long L = (long)i * G + c; if (L >= nwg) return false;
        int wgid = (int)L; { const int q = nwg / NXCD, r = nwg % NXCD, xcd = wgid % NXCD, off = wgid / NXCD; wgid = (xcd < r ? xcd * (q + 1) : r * (q + 1) + (xcd - r) * q) + off; }
        const int nig = WGM * nN, gid = wgid / nig, fm = gid * WGM, gsz = (nM - fm) < WGM ? (nM - fm) : WGM;
        u.pm = fm + ((wgid % nig) % gsz); u.pn = (wgid % nig) / gsz; return true;
    }
    __device__ __forceinline__ void a_ready(const Unit&) const {}
    __device__ __forceinline__ void done(const Unit&) const {}
};

typedef float f32x2_cv __attribute__((ext_vector_type(2))); typedef __bf16 bf16x2_cv __attribute__((ext_vector_type(2)));
__device__ __forceinline__ unsigned cvt_pk_bf16(float lo, float hi) { const f32x2_cv v = {lo, hi}; const bf16x2_cv b = __builtin_convertvector(v, bf16x2_cv); return __builtin_bit_cast(unsigned, b); }
typedef float f32x2 __attribute__((ext_vector_type(2)));
#define EPI_IDS int t_ = threadIdx.x; asm volatile("" : "+v"(t_)); const int wr = t_ >> 8, wc = (t_ >> 6) & 3, fr = t_ & 15, fq = (t_ >> 4) & 3; (void)wr_; (void)wc_; (void)fr_; (void)fq_
__device__ __forceinline__ u32x4 pack8(const f32x4 a, const f32x4 b) { u32x4 w; w.x = cvt_pk_bf16(a[0], a[1]); w.y = cvt_pk_bf16(a[2], a[3]); w.z = cvt_pk_bf16(b[0], b[1]); w.w = cvt_pk_bf16(b[2], b[3]); return w; }
__device__ __forceinline__ float bf_lo(unsigned w) { return __builtin_bit_cast(float, w << 16); }
__device__ __forceinline__ float bf_hi(unsigned w) { return __builtin_bit_cast(float, w & 0xffff0000u); }
__device__ __forceinline__ float sigmoidf_(float x) { return __builtin_amdgcn_rcpf(1.0f + __expf(-x)); }
__device__ __forceinline__ float siluf_(float x) { return x * sigmoidf_(x); }

struct EpiSwiGLU {
    static constexpr bool PERM = true, AFTER_DRAIN = false, PRE = true;
    bf16_t* H;
    const float* RS;
    __device__ __forceinline__ void pre(const Unit& u, int wr, int fr, float (&rsv)[8]) const {
#pragma unroll
        for (int i = 0; i < 8; ++i) rsv[i] = RS ? RS[u.pm * BM + wr * 64 + fr + (i >> 2) * HALF + (i & 3) * 16] : 1.f;
    }
    __device__ __forceinline__ void operator()(const f32x4 (&acc)[2][2][4][2], const Unit& u, int wr_, int wc_, int fr_, int fq_, const float (&rsv)[8]) const {
        EPI_IDS;
        const int row0 = u.pm * BM + wr * 64 + fr, col = u.pn * HALF + wc * 32 + 8 * fq;
#pragma unroll
        for (int ai = 0; ai < 2; ++ai)
#pragma unroll
            for (int m = 0; m < 4; ++m) { const float rs = rsv[4 * ai + m];
                const f32x4 g0 = acc[ai][0][m][0] * rs, g1 = acc[ai][0][m][1] * rs, u0 = acc[ai][1][m][0] * rs, u1 = acc[ai][1][m][1] * rs;
                f32x4 h0, h1;
#pragma unroll
                for (int j = 0; j < 4; ++j) { h0[j] = siluf_(g0[j]) * u0[j]; h1[j] = siluf_(g1[j]) * u1[j]; }
                *(u32x4*)(H + (size_t)(row0 + ai * HALF + m * 16) * 2816 + col) = pack8(h0, h1);
            }
    }
};
struct EpiFSS {
    static constexpr bool PERM = true, AFTER_DRAIN = false, PRE = false;
    bf16_t* Fo; float* SS;
    __device__ __forceinline__ void operator()(const f32x4 (&acc)[2][2][4][2], const Unit& u, int wr_, int wc_, int fr_, int fq_) const {
        EPI_IDS;
        const int row0 = u.pm * BM + wr * 64 + fr, col = u.pn * BM + wc * 32 + 8 * fq;
#pragma unroll
        for (int ai = 0; ai < 2; ++ai)
#pragma unroll
            for (int m = 0; m < 4; ++m) {
                const int row = row0 + ai * HALF + m * 16; float ss = 0.f;
#pragma unroll
                for (int bj = 0; bj < 2; ++bj) { const f32x4 v0 = acc[ai][bj][m][0], v1 = acc[ai][bj][m][1];
                    ss += (v0[0] * v0[0] + v0[1] * v0[1]) + (v0[2] * v0[2] + v0[3] * v0[3]) + (v1[0] * v1[0] + v1[1] * v1[1]) + (v1[2] * v1[2] + v1[3] * v1[3]);
                    *(u32x4*)(Fo + (size_t)row * 1024 + col + bj * HALF) = pack8(v0, v1); }
                ss += __shfl_xor(ss, 16); ss += __shfl_xor(ss, 32);
                if (fq == 0) SS[((size_t)u.pn * 33024 + row) * 4 + wc] = ss;
            }
    }
};
struct EpiWin {
    static constexpr bool PERM = true, AFTER_DRAIN = false, PRE = true;
    const float* RS;
    __device__ __forceinline__ void pre(const Unit& u, int wr, int fr, float (&rsv)[8]) const {
#pragma unroll
        for (int i = 0; i < 8; ++i) rsv[i] = RS ? RS[u.pm * BM + wr * 64 + fr + (i >> 2) * HALF + (i & 3) * 16] : 1.f;
    }
    bf16_t* Q; bf16_t* KV; bf16_t* ZR; const float* rope; int MR; bf16_t* VT;
    __device__ __forceinline__ void operator()(const f32x4 (&acc)[2][2][4][2], const Unit& u, int wr_, int wc_, int fr_, int fq_, const float (&rsv)[8]) const {
        EPI_IDS;
        const int row0 = u.pm * BM + wr * 64 + fr, pn = u.pn;
        bf16_t* base; int ld, colt;
        if (pn < 2) { base = Q; ld = 512; colt = pn * 256; } else if (pn == 2) { base = KV; ld = 256; colt = 0; } else { base = ZR; ld = 1792; colt = (pn - 3) * 256; }
        const bool rope_lane = (pn <= 2) && ((wc & 1) == 0) && (fq < 2);
        f32x4 css[2][4], sns[2][4];
#pragma unroll
        for (int ai = 0; ai < 2; ++ai)
#pragma unroll
            for (int m = 0; m < 4; ++m) { css[ai][m] = (f32x4){1.f, 1.f, 1.f, 1.f}; sns[ai][m] = (f32x4){0.f, 0.f, 0.f, 0.f};
                if (rope_lane) { const int row = row0 + ai * HALF + m * 16; const int pos = row < MR ? (row & 8191) + 16 : (row < MR + 16 ? row - MR : 0);
                    css[ai][m] = *(const f32x4*)(rope + pos * 16 + 4 * fq); sns[ai][m] = *(const f32x4*)(rope + pos * 16 + 8 + 4 * fq); } }
#pragma unroll
        for (int ai = 0; ai < 2; ++ai)
#pragma unroll
            for (int m = 0; m < 4; ++m) {
                const int row = row0 + ai * HALF + m * 16;
                const f32x4 cs = css[ai][m], sn = sns[ai][m];
#pragma unroll
                for (int bj = 0; bj < 2; ++bj) { f32x4 v0 = acc[ai][bj][m][0] * rsv[4 * ai + m], v1 = acc[ai][bj][m][1] * rsv[4 * ai + m];
                    if (rope_lane && (pn < 2 || bj == 0)) { const f32x4 x1 = v0, x2 = v1; v0 = x1 * cs - x2 * sn; v1 = x2 * cs + x1 * sn; }
                    const u32x4 pk = pack8(v0, v1);
                    if (pn == 2 && bj == 1) {
                        const int dv = wc * 32 + 8 * fq, pos = (row & 8191) + 16; bf16_t* vt = VT + (((size_t)((row >> 13) * 2 + (dv >> 6)) * 513 + (pos >> 4)) * 64 + (dv & 63)) * 16 + (pos & 15);
#pragma unroll
                        for (int j = 0; j < 8; ++j) vt[j * 16] = (bf16_t)((j & 1) ? (pk[j >> 1] >> 16) : (pk[j >> 1] & 0xffffu));
                    } else *(u32x4*)(base + (size_t)row * ld + colt + bj * HALF + wc * 32 + 8 * fq) = pk; }
                asm volatile("" ::: "memory");
            }
    }
};
struct EpiLora {
    static constexpr bool PERM = true, AFTER_DRAIN = false, PRE = false;
    bf16_t* LW; bf16_t* Aa; bf16_t* Gg; const float* w0; const float* a0;
    __device__ __forceinline__ void operator()(const f32x4 (&acc)[2][2][4][2], const Unit& u, int wr_, int wc_, int fr_, int fq_) const {
        EPI_IDS;
        const int row0 = u.pm * BM + wr * 64 + fr, pn = u.pn, kind = pn >> 1, colt = (pn & 1) * 256 + wc * 32 + 8 * fq;
#pragma unroll
        for (int bj = 0; bj < 2; ++bj) {
            const int col = colt + bj * HALF;
            f32x4 b0 = (f32x4){0.f, 0.f, 0.f, 0.f}, b1 = b0;
            if (kind == 0) { b0 = *(const f32x4*)(w0 + col); b1 = *(const f32x4*)(w0 + col + 4); }
            else if (kind == 1) { b0 = *(const f32x4*)(a0 + col); b1 = *(const f32x4*)(a0 + col + 4); }
#pragma unroll
            for (int ai = 0; ai < 2; ++ai)
#pragma unroll
                for (int m = 0; m < 4; ++m) {
                    const int row = row0 + ai * HALF + m * 16;
                    f32x4 v0 = acc[ai][bj][m][0] + b0, v1 = acc[ai][bj][m][1] + b1;
                    if (kind == 0) {
#pragma unroll
                        for (int j = 0; j < 4; ++j) { v0[j] = -0.6065306597126334f * sigmoidf_(v0[j]); v1[j] = -0.6065306597126334f * sigmoidf_(v1[j]); }
                        *(u32x4*)(LW + (size_t)row * 512 + col) = pack8(v0, v1);
                    } else if (kind == 1) {
#pragma unroll
                        for (int j = 0; j < 4; ++j) { v0[j] = sigmoidf_(v0[j]); v1[j] = sigmoidf_(v1[j]); }
                        *(u32x4*)(Aa + (size_t)row * 512 + col) = pack8(v0, v1);
                    } else {
                        *(u32x4*)(Gg + (size_t)row * 512 + col) = pack8(v0, v1);
                    }
                    asm volatile("" ::: "memory");
                }
        }
    }
};
struct EpiGates {
    static constexpr bool PERM = true, AFTER_DRAIN = false, PRE = false;
    bf16_t* Go;
    __device__ __forceinline__ void operator()(const f32x4 (&acc)[2][2][4][2], const Unit& u, int wr_, int wc_, int fr_, int fq_) const {
        EPI_IDS;
        const int row0 = u.pm * BM + wr * 64 + fr, col = u.pn * BM + wc * 32 + 8 * fq;
#pragma unroll
        for (int ai = 0; ai < 2; ++ai)
#pragma unroll
            for (int m = 0; m < 4; ++m)
#pragma unroll
                for (int bj = 0; bj < 2; ++bj) { f32x4 v0 = acc[ai][bj][m][0], v1 = acc[ai][bj][m][1];
#pragma unroll
                    for (int j = 0; j < 4; ++j) { v0[j] = sigmoidf_(v0[j]); v1[j] = sigmoidf_(v1[j]); }
                    *(u32x4*)(Go + (size_t)(row0 + ai * HALF + m * 16) * 2048 + col + bj * HALF) = pack8(v0, v1); }
    }
};
template <bool SECOND> struct EpiBranch {
    static constexpr bool PERM = true, AFTER_DRAIN = false, PRE = false;
    bf16_t* Mg; const bf16_t* Gt;
    __device__ __forceinline__ void operator()(const f32x4 (&acc)[2][2][4][2], const Unit& u, int wr_, int wc_, int fr_, int fq_) const {
        EPI_IDS;
        const int row0 = u.pm * BM + wr * 64 + fr, col = u.pn * BM + wc * 32 + 8 * fq;
#pragma unroll
        for (int ai = 0; ai < 2; ++ai)
#pragma unroll
            for (int m = 0; m < 4; ++m)
#pragma unroll
                for (int bj = 0; bj < 2; ++bj) {
                    const size_t row = (size_t)(row0 + ai * HALF + m * 16);
                    const u32x4 gw = *(const u32x4*)(Gt + row * 2048 + col + bj * HALF);
                    f32x4 v0 = acc[ai][bj][m][0], v1 = acc[ai][bj][m][1];
                    v0[0] *= bf_lo(gw.x); v0[1] *= bf_hi(gw.x); v0[2] *= bf_lo(gw.y); v0[3] *= bf_hi(gw.y);
                    v1[0] *= bf_lo(gw.z); v1[1] *= bf_hi(gw.z); v1[2] *= bf_lo(gw.w); v1[3] *= bf_hi(gw.w);
                    u32x4* dst = (u32x4*)(Mg + row * 1024 + col + bj * HALF);
                    if (SECOND) { const u32x4 pw = *dst;
                        v0[0] += bf_lo(pw.x); v0[1] += bf_hi(pw.x); v0[2] += bf_lo(pw.y); v0[3] += bf_hi(pw.y);
                        v1[0] += bf_lo(pw.z); v1[1] += bf_hi(pw.z); v1[2] += bf_lo(pw.w); v1[3] += bf_hi(pw.w); }
                    *dst = pack8(v0, v1);
                    asm volatile("" ::: "memory");
                }
    }
};
struct EpiMerge {
    static constexpr bool PERM = true, AFTER_DRAIN = false, PRE = false;
    bf16_t* Mg; const bf16_t* Gt; unsigned* cnt;
    __device__ __forceinline__ void operator()(const f32x4 (&acc)[2][2][4][2], const Unit& u, int wr_, int wc_, int fr_, int fq_) const {
        EPI_IDS;
        const int row0 = u.pm * BM + wr * 64 + fr, col = u.pn * HALF + wc * 32 + 8 * fq;
#pragma unroll
        for (int ai = 0; ai < 2; ++ai)
#pragma unroll
            for (int m = 0; m < 4; ++m) {
                const size_t row = (size_t)(row0 + ai * HALF + m * 16);
#ifdef MK_GATE_SC
                u32x4 ga, gr;
                { const unsigned long long* pa = (const unsigned long long*)(Gt + row * 2048 + col); const unsigned long long* pr = (const unsigned long long*)(Gt + row * 2048 + 1024 + col);
                  const unsigned long long a0_ = __hip_atomic_load(pa, __ATOMIC_RELAXED, __HIP_MEMORY_SCOPE_SYSTEM), a1_ = __hip_atomic_load(pa + 1, __ATOMIC_RELAXED, __HIP_MEMORY_SCOPE_SYSTEM);
                  const unsigned long long r0_ = __hip_atomic_load(pr, __ATOMIC_RELAXED, __HIP_MEMORY_SCOPE_SYSTEM), r1_ = __hip_atomic_load(pr + 1, __ATOMIC_RELAXED, __HIP_MEMORY_SCOPE_SYSTEM);
                  ga.x = (unsigned)a0_; ga.y = (unsigned)(a0_ >> 32); ga.z = (unsigned)a1_; ga.w = (unsigned)(a1_ >> 32); gr.x = (unsigned)r0_; gr.y = (unsigned)(r0_ >> 32); gr.z = (unsigned)r1_; gr.w = (unsigned)(r1_ >> 32); }
#else
                const u32x4 ga = *(const u32x4*)(Gt + row * 2048 + col), gr = *(const u32x4*)(Gt + row * 2048 + 1024 + col);
#endif
#ifdef MK_GATE_CHECK
                { const float gmx = fmaxf(fmaxf(fmaxf(bf_lo(ga.x), bf_hi(ga.x)), fmaxf(bf_lo(ga.y), bf_hi(ga.y))), fmaxf(fmaxf(bf_lo(gr.z), bf_hi(gr.z)), fmaxf(bf_lo(gr.w), bf_hi(gr.w))));
                  const float gmn = fminf(fminf(fminf(bf_lo(ga.x), bf_hi(ga.x)), fminf(bf_lo(ga.y), bf_hi(ga.y))), fminf(fminf(bf_lo(gr.z), bf_hi(gr.z)), fminf(bf_lo(gr.w), bf_hi(gr.w))));
                  if (gmx > 1.001f || gmn < 0.f) atomicAdd(cnt, 1u); }
#endif
                const f32x4 a0 = acc[ai][0][m][0], a1 = acc[ai][0][m][1], r0 = acc[ai][1][m][0], r1 = acc[ai][1][m][1];
                f32x4 v0, v1;
                v0[0] = a0[0] * bf_lo(ga.x) + r0[0] * bf_lo(gr.x); v0[1] = a0[1] * bf_hi(ga.x) + r0[1] * bf_hi(gr.x); v0[2] = a0[2] * bf_lo(ga.y) + r0[2] * bf_lo(gr.y); v0[3] = a0[3] * bf_hi(ga.y) + r0[3] * bf_hi(gr.y);
                v1[0] = a1[0] * bf_lo(ga.z) + r1[0] * bf_lo(gr.z); v1[1] = a1[1] * bf_hi(ga.z) + r1[1] * bf_hi(gr.z); v1[2] = a1[2] * bf_lo(ga.w) + r1[2] * bf_lo(gr.w); v1[3] = a1[3] * bf_hi(ga.w) + r1[3] * bf_hi(gr.w);
                *(u32x4*)(Mg + row * 1024 + col) = pack8(v0, v1);
                asm volatile("" ::: "memory");
            }
    }
};
struct EpiPlain {
    static constexpr bool PERM = true, AFTER_DRAIN = false, PRE = false;
    bf16_t* O; int ldc; int npl; size_t plane;
    __device__ __forceinline__ void operator()(const f32x4 (&acc)[2][2][4][2], const Unit& u, int wr_, int wc_, int fr_, int fq_) const {
        EPI_IDS;
        const int row0 = u.pm * BM + wr * 64 + fr, col = (u.pn % npl) * BM + wc * 32 + 8 * fq; bf16_t* O = this->O + (size_t)(u.pn / npl) * plane;
#pragma unroll
        for (int ai = 0; ai < 2; ++ai)
#pragma unroll
            for (int m = 0; m < 4; ++m)
#pragma unroll
                for (int bj = 0; bj < 2; ++bj) *(u32x4*)(O + (size_t)(row0 + ai * HALF + m * 16) * ldc + col + bj * HALF) = pack8(acc[ai][bj][m][0], acc[ai][bj][m][1]);
    }
};
struct EpiGateMerge {
    static constexpr bool PERM = true, AFTER_DRAIN = false, PRE = true;
    const float* RS;
    __device__ __forceinline__ void pre(const Unit& u, int wr, int fr, float (&rsv)[8]) const {
#pragma unroll
        for (int i = 0; i < 8; ++i) rsv[i] = RS ? RS[u.pm * BM + wr * 64 + fr + (i >> 2) * HALF + (i & 3) * 16] : 1.f;
    }
    bf16_t* Mg; const bf16_t* Y1; const bf16_t* Y2;
    __device__ __forceinline__ void operator()(const f32x4 (&acc)[2][2][4][2], const Unit& u, int wr_, int wc_, int fr_, int fq_, const float (&rsv)[8]) const {
        EPI_IDS;
        const int row0 = u.pm * BM + wr * 64 + fr, col = u.pn * HALF + wc * 32 + 8 * fq;
        u32x4 y1s[2][4], y2s[2][4];
#pragma unroll
        for (int ai = 0; ai < 2; ++ai)
#pragma unroll
            for (int m = 0; m < 4; ++m) { const size_t o = (size_t)(row0 + ai * HALF + m * 16) * 1024 + col; y1s[ai][m] = *(const u32x4*)(Y1 + o); y2s[ai][m] = *(const u32x4*)(Y2 + o); }
#pragma unroll
        for (int ai = 0; ai < 2; ++ai)
#pragma unroll
            for (int m = 0; m < 4; ++m) {
                const size_t o = (size_t)(row0 + ai * HALF + m * 16) * 1024 + col;
                const u32x4 y1 = y1s[ai][m], y2 = y2s[ai][m];
                const float rs = rsv[4 * ai + m];
                const f32x4 a0 = acc[ai][0][m][0] * rs, a1 = acc[ai][0][m][1] * rs, r0 = acc[ai][1][m][0] * rs, r1 = acc[ai][1][m][1] * rs;
                f32x4 v0, v1;
                v0[0] = sigmoidf_(a0[0]) * bf_lo(y1.x) + sigmoidf_(r0[0]) * bf_lo(y2.x); v0[1] = sigmoidf_(a0[1]) * bf_hi(y1.x) + sigmoidf_(r0[1]) * bf_hi(y2.x);
                v0[2] = sigmoidf_(a0[2]) * bf_lo(y1.y) + sigmoidf_(r0[2]) * bf_lo(y2.y); v0[3] = sigmoidf_(a0[3]) * bf_hi(y1.y) + sigmoidf_(r0[3]) * bf_hi(y2.y);
                v1[0] = sigmoidf_(a1[0]) * bf_lo(y1.z) + sigmoidf_(r1[0]) * bf_lo(y2.z); v1[1] = sigmoidf_(a1[1]) * bf_hi(y1.z) + sigmoidf_(r1[1]) * bf_hi(y2.z);
                v1[2] = sigmoidf_(a1[2]) * bf_lo(y1.w) + sigmoidf_(r1[2]) * bf_lo(y2.w); v1[3] = sigmoidf_(a1[3]) * bf_hi(y1.w) + sigmoidf_(r1[3]) * bf_hi(y2.w);
                *(u32x4*)(Mg + o) = pack8(v0, v1);
                asm volatile("" ::: "memory");
            }
    }
};
template <class Epi, class Sched, bool ALIGN_EPI = false, bool SP2 = false>
__device__ __forceinline__ void gemm_phase(PG8_LAS unsigned char* lds, const Gemm g, const Sched& S, const Epi& E) {
    int tid_ = threadIdx.x; asm volatile("" : "+v"(tid_));
    const int tid = tid_, wid = __builtin_amdgcn_readfirstlane(tid >> 6), lane = tid & 63, wr = wid >> 2, wc = wid & 3, fr = lane & 15, fq = lane >> 4;
    const int K = g.K, nt = K / BK;
    unsigned voffA[2], voffB[2];
#pragma unroll
    for (int i = 0; i < 2; ++i) { int R, C; stage_rc(tid * 16 + i * 8192, R, C); const int Rb = Epi::PERM ? ((R & ~31) + perm32(R & 31)) : R;
        voffA[i] = (unsigned)(R * g.lda + C) * 2u; voffB[i] = (unsigned)(Rb * g.ldb + C) * 2u; }
    const size_t kstep = (size_t)(BK * 2);
    const size_t hstepA = (size_t)HALF * g.lda * 2, hstepB = (size_t)HALF * g.ldb * 2;
    const size_t tstepA = 2 * hstepA, tstepB = 2 * hstepB;
    const unsigned ldsw = (unsigned)wid * 1024u;
    const int aoff = lds_byte(wr * 64 + fr, fq * 8), boff = lds_byte(wc * 32 + fr, fq * 8);
#define PG8_SA(b, h) (((b) * 2 + (h)) * HTB)
#define PG8_SB(b, h) ((4 + (b) * 2 + (h)) * HTB)
#define PG8_STAGE(bufoff, gbase, voff) do { _Pragma("unroll") for (int _i = 0; _i < 2; ++_i) \
        __builtin_amdgcn_global_load_lds((const unsigned*)((const char*)(gbase) + (voff)[_i]), (PG8_LAS unsigned*)(lds + (bufoff) + ldsw + _i * 8192), 16, 0, 0); } while (0)
#define PG8_LDA(dst, b, h) do { _Pragma("unroll") for (int m = 0; m < 4; ++m) _Pragma("unroll") for (int k = 0; k < 2; ++k) dst[m][k] = *(const PG8_LAS bf16x8*)(lds + PG8_SA(b, h) + aoff + m * 2048 + k * 1024); } while (0)
#define PG8_LDB(dst, b, h) do { _Pragma("unroll") for (int n = 0; n < 2; ++n) _Pragma("unroll") for (int k = 0; k < 2; ++k) dst[n][k] = *(const PG8_LAS bf16x8*)(lds + PG8_SB(b, h) + boff + n * 2048 + k * 1024); } while (0)
#define PG8_MMA(ai, bj, At, Bt) do { __builtin_amdgcn_s_setprio(1); _Pragma("unroll") for (int m = 0; m < 4; ++m) _Pragma("unroll") for (int n = 0; n < 2; ++n) _Pragma("unroll") for (int k = 0; k < 2; ++k) \
        acc[ai][bj][m][n] = __builtin_amdgcn_mfma_f32_16x16x32_bf16(Bt[n][k], At[m][k], acc[ai][bj][m][n], 0, 0, 0); __builtin_amdgcn_s_setprio(0); } while (0)
#define PG8_WAIT_V(n) asm volatile("s_waitcnt vmcnt(" #n ")" ::: "memory")
#define PG8_WAIT_L(n) asm volatile("s_waitcnt lgkmcnt(" #n ")" ::: "memory")
#define PG8_BAR __builtin_amdgcn_s_barrier()
#define PG8_SCHED __builtin_amdgcn_sched_barrier(0)
    Unit cur, nxt; int ui = 0;
    if (!S.next(0, cur)) return;
    f32x4 acc[2][2][4][2];
#pragma unroll
    for (int a = 0; a < 2; ++a)
#pragma unroll
        for (int b = 0; b < 2; ++b)
#pragma unroll
            for (int m = 0; m < 4; ++m)
#pragma unroll
                for (int n = 0; n < 2; ++n) acc[a][b][m][n] = (f32x4){0.f, 0.f, 0.f, 0.f};
    bf16x8 At[4][2], B0[2][2], B1[2][2];
    const char* cA = (const char*)(cur.pn >= g.nsplit ? g.A2 : g.A) + (size_t)cur.pm * tstepA; const char* cB = (const char*)g.Bt + (size_t)cur.pn * tstepB;
    S.a_ready(cur);
    float rsv[8]; if constexpr (Epi::PRE) E.pre(cur, wr, fr, rsv);
    if constexpr (SP2) {
        PG8_STAGE(PG8_SB(0, 0), cB, voffB); PG8_STAGE(PG8_SB(0, 1), cB + hstepB, voffB); PG8_STAGE(PG8_SA(0, 0), cA, voffA); PG8_STAGE(PG8_SA(0, 1), cA + hstepA, voffA);
        if (wr == 1) PG8_BAR;
        PG8_WAIT_V(2); PG8_BAR;
        PG8_STAGE(PG8_SB(1, 0), cB + kstep, voffB); PG8_STAGE(PG8_SA(1, 0), cA + kstep, voffA); PG8_STAGE(PG8_SB(1, 1), cB + hstepB + kstep, voffB);
        PG8_WAIT_V(6); PG8_BAR;
    } else {
        PG8_STAGE(PG8_SB(0, 0), cB, voffB); PG8_STAGE(PG8_SA(0, 0), cA, voffA); PG8_STAGE(PG8_SB(0, 1), cB + hstepB, voffB); PG8_STAGE(PG8_SA(0, 1), cA + hstepA, voffA);
        if (wr == 1) PG8_BAR;
        PG8_WAIT_V(4); PG8_BAR;
        PG8_STAGE(PG8_SB(1, 0), cB + kstep, voffB); PG8_STAGE(PG8_SA(1, 0), cA + kstep, voffA); PG8_STAGE(PG8_SB(1, 1), cB + hstepB + kstep, voffB);
        PG8_WAIT_V(6); PG8_BAR;
    }
    for (;;) {
        const bool has_next = S.next(ui + 1, nxt);
        const char* nA = has_next ? (const char*)(nxt.pn >= g.nsplit ? g.A2 : g.A) + (size_t)nxt.pm * tstepA : cA; const char* nB = has_next ? (const char*)g.Bt + (size_t)nxt.pn * tstepB : cB;
        for (int t = 0; t < nt; t += 2) {
            const bool last = (t == nt - 2);
            const char* a1 = cA + (size_t)(t + 1) * kstep;
            const char* a2 = last ? nA : cA + (size_t)(t + 2) * kstep; const char* b2 = last ? nB : cB + (size_t)(t + 2) * kstep;
            const char* a3 = a2 + kstep; const char* b3 = b2 + kstep;
            if (last && has_next) S.a_ready(nxt);
            if constexpr (SP2) {
            PG8_LDB(B0, 0, 0); PG8_LDB(B1, 0, 1); PG8_SCHED; PG8_LDA(At, 0, 0); PG8_STAGE(PG8_SA(1, 1), a1 + hstepA, voffA);
            PG8_WAIT_V(8); PG8_WAIT_L(0); PG8_BAR; PG8_MMA(0, 0, At, B0); PG8_MMA(0, 1, At, B1); PG8_BAR; PG8_SCHED;
            PG8_LDA(At, 0, 1); PG8_STAGE(PG8_SB(0, 0), b2, voffB); PG8_STAGE(PG8_SB(0, 1), b2 + hstepB, voffB); PG8_STAGE(PG8_SA(0, 0), a2, voffA);
            PG8_WAIT_V(8); PG8_WAIT_L(0); PG8_BAR; PG8_MMA(1, 0, At, B0); PG8_MMA(1, 1, At, B1); PG8_BAR; PG8_SCHED;
            PG8_LDB(B0, 1, 0); PG8_LDB(B1, 1, 1); PG8_SCHED; PG8_LDA(At, 1, 0); PG8_STAGE(PG8_SA(0, 1), a2 + hstepA, voffA);
            PG8_WAIT_V(8); PG8_WAIT_L(0); PG8_BAR; PG8_MMA(0, 0, At, B0); PG8_MMA(0, 1, At, B1); PG8_BAR; PG8_SCHED;
            PG8_LDA(At, 1, 1); PG8_STAGE(PG8_SB(1, 0), b3, voffB); PG8_STAGE(PG8_SB(1, 1), b3 + hstepB, voffB); PG8_STAGE(PG8_SA(1, 0), a3, voffA);
            PG8_WAIT_V(8); PG8_WAIT_L(0); PG8_BAR; PG8_MMA(1, 0, At, B0); PG8_MMA(1, 1, At, B1); PG8_BAR; PG8_SCHED;
            } else {
            PG8_LDB(B0, 0, 0); PG8_SCHED; PG8_LDA(At, 0, 0); PG8_STAGE(PG8_SA(1, 1), a1 + hstepA, voffA);
            PG8_WAIT_L(8); PG8_BAR; PG8_WAIT_L(0); PG8_MMA(0, 0, At, B0); PG8_BAR; PG8_SCHED;
            PG8_LDB(B1, 0, 1); PG8_STAGE(PG8_SB(0, 0), b2, voffB);
            PG8_BAR; PG8_WAIT_L(0); PG8_MMA(0, 1, At, B1); PG8_BAR;
            PG8_LDA(At, 0, 1); PG8_STAGE(PG8_SA(0, 0), a2, voffA);
            PG8_BAR; PG8_WAIT_L(0); PG8_MMA(1, 0, At, B0); PG8_BAR; PG8_SCHED;
            PG8_STAGE(PG8_SB(0, 1), b2 + hstepB, voffB);
            PG8_WAIT_V(6); PG8_BAR; PG8_MMA(1, 1, At, B1); PG8_BAR;
            PG8_LDB(B0, 1, 0); PG8_SCHED; PG8_LDA(At, 1, 0); PG8_STAGE(PG8_SA(0, 1), a2 + hstepA, voffA);
            PG8_WAIT_L(8); PG8_BAR; PG8_WAIT_L(0); PG8_MMA(0, 0, At, B0); PG8_BAR; PG8_SCHED;
            PG8_LDB(B1, 1, 1); PG8_STAGE(PG8_SB(1, 0), b3, voffB);
            PG8_BAR; PG8_WAIT_L(0); PG8_MMA(0, 1, At, B1); PG8_BAR;
            PG8_LDA(At, 1, 1); PG8_STAGE(PG8_SA(1, 0), a3, voffA);
            PG8_BAR; PG8_WAIT_L(0); PG8_MMA(1, 0, At, B0); PG8_BAR; PG8_SCHED;
            PG8_STAGE(PG8_SB(1, 1), b3 + hstepB, voffB);
            PG8_WAIT_V(6); PG8_BAR; PG8_MMA(1, 1, At, B1); PG8_BAR;
            }
        }
        if constexpr (ALIGN_EPI) { if (wr == 0) PG8_BAR; }
        if constexpr (!Epi::AFTER_DRAIN) { if constexpr (Epi::PRE) E(acc, cur, wr, wc, fr, fq, rsv); else E(acc, cur, wr, wc, fr, fq); S.done(cur); }
        if (!has_next) break;
#pragma unroll
        for (int a = 0; a < 2; ++a)
#pragma unroll
            for (int b = 0; b < 2; ++b)
#pragma unroll
                for (int m = 0; m < 4; ++m)
#pragma unroll
                    for (int n = 0; n < 2; ++n) acc[a][b][m][n] = (f32x4){0.f, 0.f, 0.f, 0.f};
        cur = nxt; cA = nA; cB = nB; ++ui;
        if constexpr (Epi::PRE) E.pre(cur, wr, fr, rsv);
        if constexpr (ALIGN_EPI) { if (wr == 1) PG8_BAR; }
    }
    PG8_WAIT_V(0);
    if constexpr (!ALIGN_EPI) { if (wr == 0) PG8_BAR; }
    PG8_BAR;
    if constexpr (Epi::AFTER_DRAIN) { E.fused(acc, cur, wr, wc, fr, fq, lds, wid, lane); S.done(cur); }
#undef PG8_SA
#undef PG8_SB
#undef PG8_STAGE
#undef PG8_LDA
#undef PG8_LDB
#undef PG8_MMA
#undef PG8_WAIT_V
#undef PG8_WAIT_L
#undef PG8_BAR
#undef PG8_SCHED
}
}

constexpr int NWAVES = 8;
constexpr int DM = 1024, NB = 4, SEQL = 8192, NMETA = 16, DFF = 2816;
constexpr int MR = NB * SEQL;
constexpr int MP = MR + 256;
constexpr int NHID2 = 2 * DFF;
constexpr int NIN = 4608, NIN_A = 2560;
#ifndef MK_GN_EPS
#define MK_GN_EPS 64e-5f
#endif
constexpr float NORM_EPS = 1e-6f, GN_EPS = MK_GN_EPS;

constexpr size_t MiB = 1u << 20;
constexpr size_t WS_CTL = 0, CTL_ZERO_BYTES = 64 * 1024;
constexpr size_t WS_WGU1 = 128 * 1024;
constexpr size_t WS_WD1  = WS_WGU1 + (size_t)NHID2 * DM * 2;
constexpr size_t WS_WIN  = WS_WD1 + (size_t)DM * DFF * 2;
constexpr size_t WS_WBR = WS_WIN + (size_t)NIN * DM * 2;
constexpr size_t WS_WATT = WS_WBR, WS_WRWKV = WS_WBR + (size_t)DM * 512 * 2;
constexpr size_t WS_WMIX = WS_WBR + (size_t)2048 * DM * 2;
constexpr size_t WS_WGU2 = WS_WMIX + (size_t)DM * DM * 2;
constexpr size_t WS_WD2  = WS_WGU2 + (size_t)NHID2 * DM * 2;
constexpr size_t WS_WL   = WS_WD2 + (size_t)DM * DFF * 2;
constexpr size_t WS_ROPE = WS_WL + (size_t)1536 * 256 * 2;
constexpr size_t WS_SS   = WS_ROPE + (size_t)8208 * 16 * 4;
constexpr size_t WS_HMETA = WS_SS + (size_t)MP * 16 * 4;
constexpr size_t WS_SMALL_END = WS_HMETA + 16 * 1024 * 4;
constexpr size_t WS_XN = 52 * MiB;
constexpr size_t WS_HM = WS_XN, WS_RS2 = WS_XN + 1 * MiB, WS_RS3 = WS_XN + 2 * MiB;
constexpr size_t WS_F  = WS_XN + (size_t)MP * DM * 2;
constexpr size_t WS_BIG = WS_F + (size_t)MP * DM * 2;
constexpr size_t WS_HID = WS_BIG;
constexpr size_t WS_Q  = WS_BIG;
constexpr size_t WS_KV = WS_Q + (size_t)MP * 512 * 2;
constexpr size_t WS_ZR = WS_KV + (size_t)MP * 256 * 2;
constexpr size_t WS_LW = WS_ZR + (size_t)MP * 1792 * 2;
constexpr size_t WS_AA = WS_LW + (size_t)MP * 512 * 2;
constexpr size_t WS_GG = WS_AA + (size_t)MP * 512 * 2;
constexpr size_t WS_LA = WS_GG + (size_t)MP * 512 * 2;
constexpr size_t WS_MIX_END = WS_LA + (size_t)MP * 256 * 2;
constexpr size_t WS_QY = WS_LA;
constexpr size_t WS_SST = WS_LW;
constexpr size_t WS_DOTS = WS_SS;
static_assert(WS_QY + (size_t)4128 * 16384 <= 512 * MiB && (size_t)4128 * 8192 <= (size_t)MP * 512 * 4, "rwkv images");
constexpr size_t WS_GATES = WS_LW;
constexpr size_t WS_MERGED = WS_ZR;
constexpr size_t WS_VT = 503 * MiB + 512 * 1024;
constexpr int PV = 8208;
constexpr size_t WS_END = 512 * MiB;
static_assert(WS_QY + (size_t)4128 * 16384 <= WS_VT && WS_VT + (size_t)NB * 2 * 64 * PV * 2 <= WS_END, "VT");
static_assert(WS_SMALL_END <= WS_XN && WS_HID + (size_t)MP * DFF * 2 <= WS_END && WS_MIX_END <= WS_END && WS_MERGED + (size_t)MR * DM * 2 <= WS_LW && WS_GATES + (size_t)MR * 2048 * 2 <= WS_END, "d_ws map");
constexpr int CW_LASTCHUNK = 10240;
constexpr int CW_BAR = 1024;

constexpr int RING_OFF = 0, RING_BYTES = 131072;
constexpr int LDSCTL_OFF = RING_BYTES, MISC_OFF = LDSCTL_OFF + 320;
constexpr int LDS_BYTES = 147456;

#define GAS __attribute__((address_space(1)))
#define LAS __attribute__((address_space(3)))
typedef unsigned short bf16;
typedef unsigned v4u __attribute__((ext_vector_type(4)));
typedef unsigned v2u __attribute__((ext_vector_type(2)));
typedef float f32x4 __attribute__((ext_vector_type(4)));
typedef float f32x2v __attribute__((ext_vector_type(2)));
typedef float f32x16 __attribute__((ext_vector_type(16)));
typedef short bf16x8 __attribute__((ext_vector_type(8)));
typedef GAS unsigned gu32;
#define RLX_AGENT __ATOMIC_RELAXED, __HIP_MEMORY_SCOPE_AGENT
#define LDS_WAIT() asm volatile("s_waitcnt lgkmcnt(0)" ::: "memory")
#define VM_WAIT() asm volatile("s_waitcnt vmcnt(0)" ::: "memory")
__device__ __forceinline__ unsigned pk2(float lo, float hi) { return pg8::cvt_pk_bf16(lo, hi); }
__device__ __forceinline__ unsigned f2bf(float f) { return pg8::cvt_pk_bf16(f, 0.f) & 0xffffu; }
__device__ __forceinline__ float bflo(unsigned w) { return __builtin_bit_cast(float, w << 16); }
__device__ __forceinline__ float bfhi(unsigned w) { return __builtin_bit_cast(float, w & 0xffff0000u); }
__device__ __forceinline__ float bf1(bf16 h) { return __builtin_bit_cast(float, (unsigned)h << 16); }
__device__ __forceinline__ float sigm(float x) { return 1.0f / (1.0f + __expf(-x)); }

#define XB_TMO      128
#define XB_XCNT(j)  (256  + 64 * (j))
#define XB_XSUB(j)  (1280 + 64 * (j))
#define XB_XGEN(j)  (2304 + 64 * (j))
#define XB_TOP      3328
#define XB_TOPGEN   3392
#define XCD_BAR_WORDS 3456
#define XB_SPIN_CAP (1u << 24)

__device__ __forceinline__ unsigned xb_ld(unsigned* p)              { return __hip_atomic_load(p, __ATOMIC_RELAXED, __HIP_MEMORY_SCOPE_AGENT); }
__device__ __forceinline__ unsigned xb_add(unsigned* p, unsigned v) { return __hip_atomic_fetch_add(p, v, __ATOMIC_RELAXED, __HIP_MEMORY_SCOPE_AGENT); }
__device__ __forceinline__ unsigned xb_xcc_id() { return (unsigned)__builtin_amdgcn_s_getreg((3 << 11) | 20) & 0xFu; }
#define XB_SPIN(cond, bar) do { unsigned _sp = 0; while (cond) { __builtin_amdgcn_s_sleep(1); \
    if ((++_sp & 255u) == 0u) { if (xb_ld(&(bar)[XB_TMO])) break; if (_sp > XB_SPIN_CAP) { atomicAdd(&(bar)[XB_TMO], 1u); break; } } } } while (0)

struct XcdBarrier {
    unsigned* bar; unsigned x;
    volatile LAS unsigned* st;
};

__device__ __forceinline__ XcdBarrier xcd_barrier_post(unsigned* bar, volatile LAS unsigned* st) {
    XcdBarrier b; b.bar = bar; b.x = xb_xcc_id(); b.st = st;
    if (threadIdx.x == 0) (void)xb_add(&bar[XB_XCNT(b.x)], 1u);
    return b;
}
__device__ __forceinline__ void xcd_barrier_complete(unsigned* bar, unsigned x, unsigned& nloc, unsigned& nx) {
    const unsigned G = gridDim.x * gridDim.y * gridDim.z;
    unsigned sum, cnt, mine, sp = 0u;
    for (;;) {
        sum = 0u; cnt = 0u; mine = 0u;
#pragma unroll
        for (unsigned j = 0; j < 16; ++j) { const unsigned c = xb_ld(&bar[XB_XCNT(j)]); sum += c; cnt += (c > 0u) ? 1u : 0u; mine = (j == x) ? c : mine; }
        if (sum == G) break;
        __builtin_amdgcn_s_sleep(1);
        if ((++sp & 255u) == 0u) { if (xb_ld(&bar[XB_TMO])) break; if (sp > XB_SPIN_CAP) { atomicAdd(&bar[XB_TMO], 1u); break; } }
    }
    nloc = mine > 0u ? mine : 1u; nx = cnt > 0u ? cnt : 1u;
}

__device__ __forceinline__ void xcd_barrier(const XcdBarrier& b) {
    asm volatile("s_waitcnt vmcnt(0)" ::: "memory");
    __syncthreads();
    if (threadIdx.x == 0) {
        unsigned* bar = b.bar;
        __builtin_amdgcn_s_waitcnt(0);
        unsigned nloc = b.st[0], nx = b.st[1];
        if (nloc == 0u) { xcd_barrier_complete(bar, b.x, nloc, nx); b.st[0] = nloc; b.st[1] = nx; }
        const unsigned old = xb_add(&bar[XB_XSUB(b.x)], 1u);
        const unsigned gen = old / nloc;
        if (old + 1u == (gen + 1u) * nloc) {
            __builtin_amdgcn_fence(__ATOMIC_RELEASE, "");
            asm volatile("s_waitcnt vmcnt(0)" ::: "memory");
            const unsigned og = xb_add(&bar[XB_TOP], 1u);
            const unsigned tg = og / nx;
            if (og + 1u == (tg + 1u) * nx) xb_add(&bar[XB_TOPGEN], 1u);
            else XB_SPIN(xb_ld(&bar[XB_TOPGEN]) == tg, bar);
            __builtin_amdgcn_fence(__ATOMIC_ACQUIRE, "");
            xb_add(&bar[XB_XGEN(b.x)], 1u);
            asm volatile("s_waitcnt vmcnt(0)" ::: "memory");
        } else {
            XB_SPIN(xb_ld(&bar[XB_XGEN(b.x)]) == gen, bar);
            __builtin_amdgcn_fence(__ATOMIC_ACQUIRE, "");
            asm volatile("s_waitcnt vmcnt(0)" ::: "memory");
        }
    }
    __syncthreads();
}


struct Frame {
    LAS unsigned char* lds;
    volatile LAS unsigned* MISC;
    gu32* ctl;
    int tid, lane, wave;
    int vcu, G;
    float* out; unsigned char* ws;
};
struct Args { const float* in[28]; float* out; unsigned char* ws; int ph_lo, ph_hi, li, pad; };
__device__ __forceinline__ const float* inp(int k) {
    typedef const float* cfp;
    const __attribute__((address_space(4))) char* kp = (const __attribute__((address_space(4))) char*)__builtin_amdgcn_kernarg_segment_ptr();
    return *(volatile const __attribute__((address_space(4))) cfp*)(kp + 8 * k);
}
__device__ __forceinline__ float wave_sum(float v) {
#pragma unroll
    for (int o = 1; o < 64; o <<= 1) v += __shfl_xor(v, o);
    return v;
}

__device__ __forceinline__ float dpp_f(float v, const int ctrl_sel) {
    const int x = __builtin_bit_cast(int, v); int r;
    if (ctrl_sel == 0) r = __builtin_amdgcn_update_dpp(0, x, 0xB1, 0xF, 0xF, true);
    else if (ctrl_sel == 1) r = __builtin_amdgcn_update_dpp(0, x, 0x4E, 0xF, 0xF, true);
    else r = __builtin_amdgcn_update_dpp(0, x, 0x141, 0xF, 0xF, true);
    return __builtin_bit_cast(float, r);
}
__device__ __forceinline__ float wave_sum_dpp(float v) {
    v += dpp_f(v, 0); v += dpp_f(v, 1); v += dpp_f(v, 2);
    { const int x = __builtin_bit_cast(int, v); v += __builtin_bit_cast(float, __builtin_amdgcn_update_dpp(0, x, 0x140, 0xF, 0xF, true)); }
    const int xi = __builtin_bit_cast(int, v);
    return (__builtin_bit_cast(float, __builtin_amdgcn_readlane(xi, 0)) + __builtin_bit_cast(float, __builtin_amdgcn_readlane(xi, 16))) + (__builtin_bit_cast(float, __builtin_amdgcn_readlane(xi, 32)) + __builtin_bit_cast(float, __builtin_amdgcn_readlane(xi, 48)));
}
struct MapId { __device__ __forceinline__ int operator()(int n) const { return n; } };
struct MapGateUp { __device__ __forceinline__ int operator()(int n) const { return n < DFF ? 256 * (n >> 7) + (n & 127) : 256 * ((n - DFF) >> 7) + 128 + ((n - DFF) & 127); } };
struct MapBrA { __device__ __forceinline__ int operator()(int n) const { return 256 * (n >> 7) + (n & 127); } };
struct MapBrR { __device__ __forceinline__ int operator()(int n) const { return 256 * (n >> 7) + 128 + (n & 127); } };
struct MapWin { __device__ __forceinline__ int operator()(int n) const { if (n >= 2560) { const int j = n - 2560; return j < 1024 ? 2560 + 256 * (j >> 7) + (j & 127) : 2560 + 256 * ((j - 1024) >> 7) + 128 + ((j - 1024) & 127); } if (n >= 640) return n; const int s = n & 63; if (s >= 16) return n; const int d = (s >= 4 && s < 8) ? s + 4 : ((s >= 8 && s < 12) ? s - 4 : s); return n - s + d; } };
template <class Map>
__device__ __forceinline__ void p0_transpose_item(const float* W, int K, int N, bf16* WT, LAS float* scr, int item, int lane, Map map, const float* kgain = nullptr) {
    const int ldk = K, kofs = 0;
    const int nblk = N / 32, kb = item / nblk, nb = item % nblk, k0 = 64 * kb, n0 = 32 * nb;
#pragma unroll 8
    for (int i = 0; i < 32; ++i) { const int kk = 2 * i + (lane >> 5); scr[kk * 33 + (lane & 31)] = W[(size_t)(k0 + kk) * N + n0 + (lane & 31)]; }
    LDS_WAIT(); asm volatile("" ::: "memory");
    const int c = lane & 7;
    f32x4 ga = (f32x4){1.f, 1.f, 1.f, 1.f}, gb = ga; if (kgain) { ga = *(const f32x4*)(kgain + k0 + 8 * c); gb = *(const f32x4*)(kgain + k0 + 8 * c + 4); }
#pragma unroll
    for (int j = 0; j < 4; ++j) { const int n = (lane >> 3) + 8 * j; const LAS float* s = scr + (8 * c) * 33 + n;
        v4u o; o.x = pk2(s[0 * 33] * ga.x, s[1 * 33] * ga.y); o.y = pk2(s[2 * 33] * ga.z, s[3 * 33] * ga.w); o.z = pk2(s[4 * 33] * gb.x, s[5 * 33] * gb.y); o.w = pk2(s[6 * 33] * gb.z, s[7 * 33] * gb.w);
        *(GAS v4u*)(WT + (size_t)map(n0 + n) * ldk + kofs + k0 + 8 * c) = o; }
    LDS_WAIT(); asm volatile("" ::: "memory");
}
__device__ __forceinline__ void rms_row_to_bf16(int lane, const float* xrow, const float* gain, bf16* orow) {
    const f32x4* xr = (const f32x4*)xrow + lane; const f32x4* gr = (const f32x4*)gain + lane;
    f32x4 v[4]; float s = 0.f;
#pragma unroll
    for (int j = 0; j < 4; ++j) { v[j] = xr[64 * j]; s += (v[j].x * v[j].x + v[j].y * v[j].y) + (v[j].z * v[j].z + v[j].w * v[j].w); }
    const float rstd = 1.f / sqrtf(wave_sum(s) * (1.f / DM) + NORM_EPS);
    v2u* o8 = (v2u*)orow + lane;
#pragma unroll
    for (int j = 0; j < 4; ++j) { const f32x4 g = gr[64 * j]; v2u w; w.x = pk2(v[j].x * rstd * g.x, v[j].y * rstd * g.y); w.y = pk2(v[j].z * rstd * g.z, v[j].w * rstd * g.w); o8[64 * j] = w; }
}
#define XN1_BASE (F.out)
__device__ __forceinline__ void p0_prologue(Frame& F, const Args& A) {
    LAS float* scr = (LAS float*)(F.lds + RING_OFF + F.wave * 16384);
    const int gw = F.vcu * NWAVES + F.wave, NGW = F.G * NWAVES;
    unsigned char* ws = F.ws;
    constexpr int I_GU = (DM / 64) * (NHID2 / 32), I_D = (DFF / 64) * (DM / 32), I_IN = (DM / 64) * (NIN / 32);
    constexpr int NITEMS = I_GU + I_D + I_IN;
    for (int it = gw; it < NITEMS; it += NGW) {
        int r = it;
        if (r < I_GU) { p0_transpose_item(inp(3), DM, NHID2, (bf16*)(ws + WS_WGU1), scr, r, F.lane, MapGateUp()); continue; } r -= I_GU;
        if (r < I_D) { p0_transpose_item(inp(4), DFF, DM, (bf16*)(ws + WS_WD1), scr, r, F.lane, MapId()); continue; } r -= I_D;
        p0_transpose_item(inp(7), DM, NIN, (bf16*)(ws + WS_WIN), scr, r, F.lane, MapWin(), inp(6));
    }
    { const int gt = (F.vcu * NWAVES + F.wave) * 64 + F.lane, NGT = NGW * 64; bf16* WL = (bf16*)(ws + WS_WL);
      for (int e = gt; e < 1536 * 256; e += NGT) { const int n = e >> 8, k = e & 255; float v = 0.f;
          if (n < 512) { if (k < 64) v = inp(11)[k * 512 + n]; }
          else if (n < 1024) { if (k >= 64 && k < 128) v = inp(13)[(k - 64) * 512 + (n - 512)]; }
          else { if (k >= 128) v = inp(14)[(k - 128) * 512 + (n - 1024)]; }
          WL[e] = (bf16)f2bf(v); }
      float* rope = (float*)(ws + WS_ROPE);
      for (int e = gt; e < 8208 * 8; e += NGT) { const int pos = e >> 3, i = e & 7;
          const double fr = i == 0 ? 1.0 : i == 1 ? 0.19392274474868576 : i == 2 ? 0.03760603093086393 : i == 3 ? 0.007292664737217109 : i == 4 ? 0.001414213562373095 : i == 5 ? 0.0002742481756762073 : i == 6 ? 5.318295896944988e-05 : 1.031338537721246e-05;
          const double ang = (double)pos * fr; const double kq = __builtin_rint(ang * 0.15915494309189535); const double red = __builtin_fma(-kq, 6.283185307179586, ang) - kq * 2.4492935982947064e-16;
          const float rf = (float)red; rope[pos * 16 + i] = cosf(rf); rope[pos * 16 + 8 + i] = sinf(rf); }
    }
    f32x4 g1[4];
#pragma unroll
    for (int j = 0; j < 4; ++j) g1[j] = ((const f32x4*)inp(2))[F.lane + 64 * j];
    for (int m0 = gw; m0 < MR + NMETA; m0 += 5 * NGW) {
        f32x4 v[5][4];
#pragma unroll
        for (int u = 0; u < 5; ++u) { const int m = m0 + u * NGW < MR + NMETA ? m0 + u * NGW : m0; const f32x4* xr = (const f32x4*)(m < MR ? inp(0) + (size_t)m * DM : inp(1) + (size_t)(m - MR) * DM) + F.lane;
#pragma unroll
            for (int j = 0; j < 4; ++j) v[u][j] = xr[64 * j]; }
#pragma unroll
        for (int u = 0; u < 5; ++u) { const int m = m0 + u * NGW; if (m < MR + NMETA) { float s = 0.f;
#pragma unroll
            for (int j = 0; j < 4; ++j) s += (v[u][j].x * v[u][j].x + v[u][j].y * v[u][j].y) + (v[u][j].z * v[u][j].z + v[u][j].w * v[u][j].w);
            const float rstd = 1.f / sqrtf(wave_sum_dpp(s) * (1.f / DM) + NORM_EPS); v2u* o8 = (v2u*)((bf16*)XN1_BASE + (size_t)m * DM) + F.lane;
#pragma unroll
            for (int j = 0; j < 4; ++j) { const f32x4 g = g1[j]; v2u w; w.x = pk2(v[u][j].x * rstd * g.x, v[u][j].y * rstd * g.y); w.y = pk2(v[u][j].z * rstd * g.z, v[u][j].w * rstd * g.w); o8[64 * j] = w; } } }
    }
}


__device__ __forceinline__ void convert_late_weights(Frame& F, const Args& A, int gw, int NGW, LAS unsigned char* ldsbase) {
    LAS float* scr = (LAS float*)(ldsbase + F.wave * 16384); unsigned char* ws = F.ws;
    constexpr int I_GU = (DM / 64) * (NHID2 / 32), I_D = (DFF / 64) * (DM / 32), I_BR = (512 / 64) * (DM / 32), I_MIX = (DM / 64) * (DM / 32);
    constexpr int NITEMS = I_GU + I_D + 2 * I_BR + I_MIX;
    for (int it = gw; it < NITEMS; it += NGW) {
        int r = it;
        if (r < I_GU) { p0_transpose_item(inp(25), DM, NHID2, (bf16*)(ws + WS_WGU2), scr, r, F.lane, MapGateUp(), inp(24)); continue; } r -= I_GU;
        if (r < I_D) { p0_transpose_item(inp(26), DFF, DM, (bf16*)(ws + WS_WD2), scr, r, F.lane, MapId()); continue; } r -= I_D;
        if (r < I_BR) { p0_transpose_item(inp(20), 512, DM, (bf16*)(ws + WS_WATT), scr, r, F.lane, MapId()); continue; } r -= I_BR;
        if (r < I_BR) { p0_transpose_item(inp(21), 512, DM, (bf16*)(ws + WS_WRWKV), scr, r, F.lane, MapId()); continue; } r -= I_BR;
        p0_transpose_item(inp(22), DM, DM, (bf16*)(ws + WS_WMIX), scr, r, F.lane, MapId());
    }
}

constexpr size_t WS_H2 = WS_BIG + 180 * MiB;
template <int MODE>
__device__ __forceinline__ void row_pass(Frame& F, const Args& A, const float* gpost, const float* gpre, float scale) {
    const int gw = F.vcu * NWAVES + F.wave, NGW = F.G * NWAVES, lane = F.lane;
    const int nrows = MODE == 0 ? MR + NMETA : MR;
    const bf16* Fb = (const bf16*)(F.ws + WS_F); const float* SS = (const float*)(F.ws + WS_SS);
    constexpr int NR = MODE == 0 ? 5 : 4;
    f32x4 gpo[4], gpr[4];
#pragma unroll
    for (int j = 0; j < 4; ++j) { gpo[j] = ((const f32x4*)gpost)[lane + 64 * j]; gpr[j] = gpo[j]; }
    for (int m0 = gw; m0 < nrows; m0 += NR * NGW) {
        float ssf[NR]; v2u fw[NR][4]; f32x4 hv[NR][4]; bool on[NR];
#pragma unroll
        for (int u = 0; u < NR; ++u) { const int m = m0 + u * NGW; on[u] = m < nrows; const int mc = on[u] ? m : m0;
            ssf[u] = SS[((size_t)((lane & 15) >> 2) * MP + mc) * 4 + (lane & 3)];
#pragma unroll
            for (int j = 0; j < 4; ++j) { fw[u][j] = ((const v2u*)(Fb + (size_t)mc * DM))[lane + 64 * j];
                if (MODE == 0) hv[u][j] = ((const f32x4*)(mc < MR ? inp(0) + (size_t)mc * DM : inp(1) + (size_t)(mc - MR) * DM))[lane + 64 * j];
                else { const v2u hw = ((const v2u*)((MODE == 1 ? (const bf16*)F.out : (const bf16*)(F.ws + WS_H2)) + (size_t)mc * DM))[lane + 64 * j]; hv[u][j] = (f32x4){bflo(hw.x), bfhi(hw.x), bflo(hw.y), bfhi(hw.y)}; } } }
#pragma unroll
        for (int u = 0; u < NR; ++u) if (on[u]) { const int m = m0 + u * NGW;
            float sf = ssf[u]; sf += dpp_f(sf, 0); sf += dpp_f(sf, 1); sf += dpp_f(sf, 2); { const int x = __builtin_bit_cast(int, sf); sf += __builtin_bit_cast(float, __builtin_amdgcn_update_dpp(0, x, 0x140, 0xF, 0xF, true)); }
            if (MODE == 0 && m >= MR) { float s2 = 0.f;
#pragma unroll
                for (int j = 0; j < 4; ++j) s2 += bflo(fw[u][j].x) * bflo(fw[u][j].x) + bfhi(fw[u][j].x) * bfhi(fw[u][j].x) + bflo(fw[u][j].y) * bflo(fw[u][j].y) + bfhi(fw[u][j].y) * bfhi(fw[u][j].y);
                sf = wave_sum_dpp(s2); }
            const float rf = scale / sqrtf(sf * (1.f / DM) + NORM_EPS);
            f32x4 h[4]; float s = 0.f;
#pragma unroll
            for (int j = 0; j < 4; ++j) {
                const f32x4 g = gpo[j]; const f32x4 hq = hv[u][j];
                f32x4 r; r.x = hq.x + bflo(fw[u][j].x) * rf * g.x; r.y = hq.y + bfhi(fw[u][j].x) * rf * g.y; r.z = hq.z + bflo(fw[u][j].y) * rf * g.z; r.w = hq.w + bfhi(fw[u][j].y) * rf * g.w;
                h[j] = r; s += (r.x * r.x + r.y * r.y) + (r.z * r.z + r.w * r.w);
                if (MODE == 2) ((f32x4*)(F.out + (size_t)m * DM))[lane + 64 * j] = r;
                else { v2u w; w.x = pk2(r.x, r.y); w.y = pk2(r.z, r.w); bf16* hb = MODE == 1 ? (bf16*)(F.ws + WS_H2) + (size_t)m * DM : (m < MR ? (bf16*)F.out + (size_t)m * DM : (bf16*)(F.ws + WS_HM) + (size_t)(m - MR) * DM); ((v2u*)hb)[lane + 64 * j] = w; }
            }
            if (MODE != 2) { const float rstd = 1.f / sqrtf(wave_sum_dpp(s) * (1.f / DM) + NORM_EPS); if (lane == 0) ((float*)(F.ws + (MODE == 0 ? WS_RS2 : WS_RS3)))[m] = rstd; }
        }
    }
}

__device__ __forceinline__ int prev_row(int m) { return m < MR ? ((m & 8191) == 0 ? MR + 15 : m - 1) : (m == MR ? -1 : m - 1); }
__device__ __forceinline__ void lora_a_pass(Frame& F, const Args& A) {
    const int gw = F.vcu * NWAVES + F.wave, NGW = F.G * NWAVES, lane = F.lane;
    const bf16* ZR = (const bf16*)(F.ws + WS_ZR); bf16* LA = (bf16*)(F.ws + WS_LA); const float* mu = inp(9) + 1536;
    const f32x4 muv = ((const f32x4*)mu)[lane];
    for (int g4 = gw; 4 * g4 < MR + NMETA; g4 += NGW) { const int m0 = 4 * g4;
        v2u zc[4], zp0 = (v2u){0u, 0u};
        { const int pm = prev_row(m0); if (pm >= 0) zp0 = ((const v2u*)(ZR + (size_t)pm * 1792 + 1536))[lane]; }
#pragma unroll
        for (int u = 0; u < 4; ++u) zc[u] = ((const v2u*)(ZR + (size_t)(m0 + u) * 1792 + 1536))[lane];
#pragma unroll
        for (int u = 0; u < 4; ++u) { const int m = m0 + u; const v2u zpv = u == 0 ? zp0 : zc[u > 0 ? u - 1 : 0];
            float x[4] = {bflo(zc[u].x), bfhi(zc[u].x), bflo(zc[u].y), bfhi(zc[u].y)}; const float p[4] = {bflo(zpv.x), bfhi(zpv.x), bflo(zpv.y), bfhi(zpv.y)};
            x[0] += (p[0] - x[0]) * muv.x; x[1] += (p[1] - x[1]) * muv.y; x[2] += (p[2] - x[2]) * muv.z; x[3] += (p[3] - x[3]) * muv.w;
            if (lane < 16) {
#pragma unroll
                for (int j = 0; j < 4; ++j) x[j] = tanhf(x[j]);
            } else if (lane >= 32) {
#pragma unroll
                for (int j = 0; j < 4; ++j) x[j] = sigm(x[j]);
            }
            v2u w; w.x = pk2(x[0], x[1]); w.y = pk2(x[2], x[3]);
            ((v2u*)(LA + (size_t)m * 256))[lane] = w; }
    }
}

#ifndef MK_ATT_SCALE
#define MK_ATT_SCALE 1.0f
#endif
__device__ __forceinline__ int crow(int r, int hi) { return (r & 3) + 8 * (r >> 2) + 4 * hi; }
constexpr int AT_KP = 144, AT_VP = 80, AT_KBYTES = 32 * AT_KP;
__device__ __forceinline__ void attn_item(Frame& F, const Args& A, int b, int head, int qb) {
    const int lane = F.lane, r32 = lane & 31, hi = lane >> 5, kvh = head >> 2, t0 = qb * 32, rr = lane >> 3, ck = lane & 7;
    const bf16* Q = (const bf16*)(F.ws + WS_Q); const bf16* KV = (const bf16*)(F.ws + WS_KV); bf16* AC = (bf16*)(F.ws + WS_Q);
    LAS unsigned char* Kl = F.lds + RING_OFF + F.wave * 16384; LAS unsigned char* Vl = Kl + AT_KBYTES;
    const float sink2 = inp(8)[head] * 1.4426950408889634f;
    v4u qg[4], kg[5][4], vg[5][4];
#pragma unroll
    for (int j = 0; j < 4; ++j) qg[j] = *(const v4u*)(Q + (size_t)(b * SEQL + t0 + 8 * j + rr) * 512 + head * 64 + 8 * ck);
#pragma unroll
    for (int i = 0; i < 5; ++i)
#pragma unroll
        for (int j = 0; j < 4; ++j) { const int tk = t0 - 128 + 32 * i + 8 * j + rr;
            const size_t krow = tk >= 0 ? (size_t)(b * SEQL + tk) : (tk >= -16 ? (size_t)(MR + 16 + tk) : (size_t)MR);
            kg[i][j] = *(const v4u*)(KV + krow * 256 + kvh * 64 + 8 * ck); }
    const bf16* vtb = (const bf16*)(F.ws + WS_VT) + (size_t)(b * 2 + kvh) * (PV / 16) * 1024;
#pragma unroll
    for (int i = 0; i < 5; ++i)
#pragma unroll
        for (int j = 0; j < 4; ++j) { const int x = 64 * j + lane; int pb = ((t0 - 112 + 32 * i) >> 4) + (x >> 7); pb = pb < 0 ? 0 : pb;
            vg[i][j] = *(const v4u*)(vtb + (size_t)pb * 1024 + (x & 127) * 8); }
    __builtin_amdgcn_sched_barrier(0);
    bf16x8 qf[4];
#pragma unroll
    for (int j = 0; j < 4; ++j) *(LAS v4u*)(Kl + (8 * j + rr) * AT_KP + 16 * ck) = qg[j];
#pragma unroll
    for (int s = 0; s < 4; ++s) qf[s] = *(const LAS bf16x8*)(Kl + r32 * AT_KP + 32 * s + 16 * hi);
    f32x16 S[5];
#pragma unroll
    for (int i = 0; i < 5; ++i) {
#pragma unroll
        for (int j = 0; j < 4; ++j) *(LAS v4u*)(Kl + (8 * j + rr) * AT_KP + 16 * ck) = kg[i][j];
        bf16x8 kf[4];
#pragma unroll
        for (int s = 0; s < 4; ++s) kf[s] = *(const LAS bf16x8*)(Kl + r32 * AT_KP + 32 * s + 16 * hi);
        f32x16 a = {};
#pragma unroll
        for (int s = 0; s < 4; ++s) a = __builtin_amdgcn_mfma_f32_32x32x16_bf16(kf[s], qf[s], a, 0, 0, 0);
        S[i] = a;
    }
    const float sc = 0.125f * 1.4426950408889634f; const int dq = r32 - 4 * hi;
#pragma unroll
    for (int r = 0; r < 16; ++r) { const int cr = (r & 3) + 8 * (r >> 2);
        S[0][r] = cr > dq ? S[0][r] * sc : -1e30f; S[4][r] = cr <= dq ? S[4][r] * sc : -1e30f;
        S[1][r] *= sc; S[2][r] *= sc; S[3][r] *= sc; }
    if (t0 < 112) {
#pragma unroll
        for (int i = 0; i < 4; ++i)
#pragma unroll
            for (int r = 0; r < 16; ++r) if (t0 - 128 + 32 * i + crow(r, hi) < -16) S[i][r] = -1e30f;
    }
    float mx = sink2;
#pragma unroll
    for (int i = 0; i < 5; ++i)
#pragma unroll
        for (int r = 0; r < 16; ++r) mx = fmaxf(mx, S[i][r]);
    mx = fmaxf(mx, __shfl_xor(mx, 32));
    float sum = 0.f;
#pragma unroll
    for (int i = 0; i < 5; ++i)
#pragma unroll
        for (int r = 0; r < 16; ++r) { const float p = __builtin_amdgcn_exp2f(S[i][r] - mx); S[i][r] = p; sum += p; }
    sum += __shfl_xor(sum, 32);
    const float inv = 1.0f / (sum + __builtin_amdgcn_exp2f(sink2 - mx));
    f32x16 O0 = {}, O1 = {};
#pragma unroll
    for (int i = 0; i < 5; ++i) {
#pragma unroll
        for (int j = 0; j < 4; ++j) { const int x = 64 * j + lane; *(LAS v4u*)(Vl + ((x & 127) >> 1) * AT_VP + (x >> 7) * 32 + (x & 1) * 16) = vg[i][j]; }
#pragma unroll
        for (int s = 0; s < 2; ++s) {
            bf16x8 pa;
#pragma unroll
            for (int j = 0; j < 8; j += 2) { const unsigned w = pg8::cvt_pk_bf16(S[i][8 * s + j], S[i][8 * s + j + 1]); pa[j] = (short)(w & 0xffffu); pa[j + 1] = (short)(w >> 16); }
            const v2u a0 = *(const LAS v2u*)(Vl + r32 * AT_VP + 32 * s + 8 * hi), a1 = *(const LAS v2u*)(Vl + r32 * AT_VP + 32 * s + 16 + 8 * hi);
            const v2u c0 = *(const LAS v2u*)(Vl + (r32 + 32) * AT_VP + 32 * s + 8 * hi), c1 = *(const LAS v2u*)(Vl + (r32 + 32) * AT_VP + 32 * s + 16 + 8 * hi);
            const v4u v0 = {a0.x, a0.y, a1.x, a1.y}, v1 = {c0.x, c0.y, c1.x, c1.y};
            O0 = __builtin_amdgcn_mfma_f32_32x32x16_bf16(__builtin_bit_cast(bf16x8, v0), pa, O0, 0, 0, 0);
            O1 = __builtin_amdgcn_mfma_f32_32x32x16_bf16(__builtin_bit_cast(bf16x8, v1), pa, O1, 0, 0, 0);
        }
    }
    const float iv = inv * MK_ATT_SCALE;
#pragma unroll
    for (int g = 0; g < 4; ++g) {
        *(LAS v2u*)(Kl + r32 * AT_KP + (8 * g + 4 * hi) * 2) = (v2u){pk2(O0[4 * g] * iv, O0[4 * g + 1] * iv), pk2(O0[4 * g + 2] * iv, O0[4 * g + 3] * iv)};
        *(LAS v2u*)(Kl + r32 * AT_KP + (32 + 8 * g + 4 * hi) * 2) = (v2u){pk2(O1[4 * g] * iv, O1[4 * g + 1] * iv), pk2(O1[4 * g + 2] * iv, O1[4 * g + 3] * iv)}; }
#pragma unroll
    for (int j = 0; j < 4; ++j) *(v4u*)(AC + (size_t)(b * SEQL + t0 + 8 * j + rr) * 512 + head * 64 + 8 * ck) = *(const LAS v4u*)(Kl + (8 * j + rr) * AT_KP + 16 * ck);
}


__device__ __forceinline__ bf16x8 lora_afrag(const bf16* ZR, size_t m, long pm, int chan, const float* mu, int kind) {
    const v4u zc = *(const v4u*)(ZR + m * 1792 + chan); v4u zp = (v4u){0u, 0u, 0u, 0u}; if (pm >= 0) zp = *(const v4u*)(ZR + (size_t)pm * 1792 + chan);
    const f32x4 m0 = *(const f32x4*)(mu + chan), m1 = *(const f32x4*)(mu + chan + 4); const float mv[8] = {m0.x, m0.y, m0.z, m0.w, m1.x, m1.y, m1.z, m1.w};
    float x[8];
#pragma unroll
    for (int j = 0; j < 4; ++j) { const float c0 = bflo(zc[j]), c1 = bfhi(zc[j]), p0 = bflo(zp[j]), p1 = bfhi(zp[j]); x[2 * j] = c0 + (p0 - c0) * mv[2 * j]; x[2 * j + 1] = c1 + (p1 - c1) * mv[2 * j + 1]; }
#pragma unroll
    for (int j = 0; j < 8; ++j) x[j] = kind == 0 ? tanhf(x[j]) : (kind == 2 ? sigm(x[j]) : x[j]);
    bf16x8 r;
#pragma unroll
    for (int j = 0; j < 8; j += 2) { const unsigned w = pk2(x[j], x[j + 1]); r[j] = (short)(w & 0xffffu); r[j + 1] = (short)(w >> 16); }
    return r;
}
__device__ __forceinline__ void lora_fused(Frame& F, const Args& A) {
    const int gw = F.vcu * NWAVES + F.wave, NGW = F.G * NWAVES, lane = F.lane, r32 = lane & 31, hi = lane >> 5;
    const bf16* ZR = (const bf16*)(F.ws + WS_ZR); const bf16* WL = (const bf16*)(F.ws + WS_WL); const float* mu = inp(9);
    bf16* LW = (bf16*)(F.ws + WS_LW); bf16* AA = (bf16*)(F.ws + WS_AA); bf16* GG = (bf16*)(F.ws + WS_GG);
    constexpr int NRB = (MR + NMETA + 31) / 32;
    for (int it = gw; it < NRB * 3; it += NGW) {
        const int kind = it % 3, r0 = (it / 3) * 32, k0 = kind == 0 ? 0 : (kind == 1 ? 64 : 128), nk = kind == 2 ? 8 : 4;
        const int mrow = r0 + r32 < MR + NMETA ? r0 + r32 : MR + NMETA - 1; const long pm = prev_row(mrow);
        bf16x8 af[8];
#pragma unroll
        for (int s = 0; s < 8; ++s) af[s] = lora_afrag(ZR, (size_t)mrow, pm, 1536 + k0 + (s < nk ? 16 * s : 0) + 8 * hi, mu, kind);
        const float* bias = kind == 0 ? inp(10) : inp(12);
        const bf16* wbase = WL + (size_t)(kind * 512 + r32) * 256 + k0 + 8 * hi;
        bf16x8 bcur[8], bnxt[8];
#pragma unroll
        for (int s = 0; s < 8; ++s) bcur[s] = *(const bf16x8*)(wbase + (s < nk ? 16 * s : 0));
        for (int nb = 0; nb < 16; ++nb) {
            const bf16* wn = wbase + (size_t)((nb + 1 < 16 ? nb + 1 : nb) * 32) * 256;
#pragma unroll
            for (int s = 0; s < 8; ++s) bnxt[s] = *(const bf16x8*)(wn + (s < nk ? 16 * s : 0));
            f32x16 acc = {};
#pragma unroll
            for (int s = 0; s < 8; ++s) if (s < nk) acc = __builtin_amdgcn_mfma_f32_32x32x16_bf16(af[s], bcur[s], acc, 0, 0, 0);
            const int col = nb * 32 + r32; const float bv = kind == 2 ? 0.f : bias[col];
#pragma unroll
            for (int r = 0; r < 16; ++r) { const int row = r0 + crow(r, hi); if (row < MR + NMETA) { const size_t o = (size_t)row * 512 + col; const float v = acc[r] + bv;
                if (kind == 0) LW[o] = (bf16)f2bf(-0.6065306597126334f * sigm(v)); else if (kind == 1) AA[o] = (bf16)f2bf(sigm(v)); else GG[o] = (bf16)f2bf(v); } }
#pragma unroll
            for (int s = 0; s < 8; ++s) bcur[s] = bnxt[s];
        }
    }
}

#ifndef MK_YN_SCALE
#define MK_YN_SCALE 1.0f
#endif
#ifndef MK_BONUS_SCALE
#define MK_BONUS_SCALE 1.0f
#endif
__device__ __forceinline__ float half_sum(float v) {
    v += dpp_f(v, 0); v += dpp_f(v, 1); v += dpp_f(v, 2);
    { const int x = __builtin_bit_cast(int, v); v += __builtin_bit_cast(float, __builtin_amdgcn_update_dpp(0, x, 0x140, 0xF, 0xF, true)); }
    { const int x = __builtin_bit_cast(int, v); v += __builtin_bit_cast(float, __builtin_amdgcn_ds_swizzle(x, 0x401F)); }
    return v;
}


typedef float f32x4m __attribute__((ext_vector_type(4)));
__device__ __forceinline__ f32x4m mini16(const bf16* A16, int lda, const bf16* Brow0, int ldb, int K, int lane) {
    const int r = lane & 15, q = lane >> 4; f32x4m acc = {0.f, 0.f, 0.f, 0.f};
    const bf16* ap = A16 + (size_t)r * lda + 8 * q; const bf16* bp = Brow0 + (size_t)r * ldb + 8 * q;
#pragma unroll 8
    for (int ks = 0; ks < K / 32; ++ks) { const bf16x8 a = *(const bf16x8*)(ap + 32 * ks), b = *(const bf16x8*)(bp + 32 * ks); acc = __builtin_amdgcn_mfma_f32_16x16x32_bf16(a, b, acc, 0, 0, 0); }
    return acc;
}
template <int K, int NB>
__device__ __forceinline__ void mini16_wg(Frame& F, const bf16* A16, int lda, const bf16* B0, const bf16* B1, int ldb, f32x4m (&out)[NB]) {
    constexpr int NKS = K / 256; static_assert(K % 256 == 0 && NB >= 1 && NB <= 2, "mini16_wg");
    const int lane = F.lane, wave = F.wave, r = lane & 15, q = lane >> 4;
    const bf16* ap = A16 + (size_t)r * lda + 8 * q + 32 * NKS * wave; const bf16* bp0 = B0 + (size_t)r * ldb + 8 * q + 32 * NKS * wave; const bf16* bp1 = B1 + (size_t)r * ldb + 8 * q + 32 * NKS * wave;
    bf16x8 a[NKS], b0[NKS], b1[NKS];
#pragma unroll
    for (int ks = 0; ks < NKS; ++ks) { a[ks] = *(const bf16x8*)(ap + 32 * ks); b0[ks] = *(const bf16x8*)(bp0 + 32 * ks); if (NB == 2) b1[ks] = *(const bf16x8*)(bp1 + 32 * ks); }
    f32x4m acc0 = {0.f, 0.f, 0.f, 0.f}, acc1 = acc0;
#pragma unroll
    for (int ks = 0; ks < NKS; ++ks) { acc0 = __builtin_amdgcn_mfma_f32_16x16x32_bf16(a[ks], b0[ks], acc0, 0, 0, 0); if (NB == 2) acc1 = __builtin_amdgcn_mfma_f32_16x16x32_bf16(a[ks], b1[ks], acc1, 0, 0, 0); }
    LAS f32x4m* red = (LAS f32x4m*)(F.lds + RING_OFF);
    red[wave * 64 + lane] = acc0; if (NB == 2) red[(8 + wave) * 64 + lane] = acc1;
    __syncthreads();
    if (wave == 0) {
#pragma unroll
        for (int nb = 0; nb < NB; ++nb) { f32x4m s = red[(nb * 8) * 64 + lane];
#pragma unroll
            for (int w = 1; w < 8; ++w) s += red[(nb * 8 + w) * 64 + lane];
            out[nb] = s; } }
    __syncthreads();
}
__device__ __forceinline__ float row16_sum(float v) { v += dpp_f(v, 0); v += dpp_f(v, 1); v += dpp_f(v, 2); const int x = __builtin_bit_cast(int, v); return v + __builtin_bit_cast(float, __builtin_amdgcn_update_dpp(0, x, 0x140, 0xF, 0xF, true)); }
__device__ __forceinline__ void meta_gateup(Frame& F, const bf16* Wgu, int i) {
    const int lane = F.lane, r = lane & 15, q = lane >> 4, j0 = 16 * i; const bf16* A16 = (const bf16*)F.out + (size_t)MR * DM;
    const int grow = 256 * (j0 >> 7) + (j0 & 127);
    f32x4m gu[2]; mini16_wg<DM, 2>(F, A16, DM, Wgu + (size_t)grow * DM, Wgu + (size_t)(grow + 128) * DM, DM, gu);
    if (F.wave != 0) return;
    const f32x4m g = gu[0], u = gu[1];
    bf16* H = (bf16*)(F.ws + WS_HID);
#pragma unroll
    for (int x = 0; x < 4; ++x) H[(size_t)(MR + 4 * q + x) * DFF + j0 + r] = (bf16)f2bf(g[x] * sigm(g[x]) * u[x]);
}
__device__ __forceinline__ void meta_down(Frame& F, const bf16* Wd, int i) {
    const int lane = F.lane, r = lane & 15, q = lane >> 4, n0 = 16 * i; const bf16* A16 = (const bf16*)(F.ws + WS_HID) + (size_t)MR * DFF; bf16* Fo = (bf16*)(F.ws + WS_F);
    f32x4m av[1]; mini16_wg<DFF, 1>(F, A16, DFF, Wd + (size_t)n0 * DFF, Wd + (size_t)n0 * DFF, DFF, av);
    if (F.wave != 0) return;
    const f32x4m a = av[0];
#pragma unroll
    for (int x = 0; x < 4; ++x) Fo[(size_t)(MR + 4 * q + x) * DM + n0 + r] = (bf16)f2bf(a[x]);
}
__device__ __forceinline__ void meta_win(Frame& F, int i) {
    const int lane = F.lane, r = lane & 15, q = lane >> 4, c0 = 512 + 16 * i; const bf16* A16 = (const bf16*)(F.ws + WS_HM);
    f32x4m av[1]; mini16_wg<DM, 1>(F, A16, DM, (const bf16*)(F.ws + WS_WIN) + (size_t)c0 * DM, (const bf16*)(F.ws + WS_WIN) + (size_t)c0 * DM, DM, av);
    if (F.wave != 0) return;
    f32x4m a = av[0];
    { const float* RS = (const float*)(F.ws + WS_RS2) + MR;
#pragma unroll
      for (int x = 0; x < 4; ++x) a[x] *= RS[4 * q + x]; }
    if (c0 < 640 && (c0 & 63) == 0) {
        const float* rope = (const float*)(F.ws + WS_ROPE); const bool lo = (r & 4) == 0; const int fi = r < 8 ? (r & 3) : 4 + (r & 3);
#pragma unroll
        for (int x = 0; x < 4; ++x) { const float other = __shfl_xor(a[x], 4); const int pos = 4 * q + x; const float cs = rope[pos * 16 + fi], sn = rope[pos * 16 + 8 + fi];
            a[x] = lo ? a[x] * cs - other * sn : a[x] * cs + other * sn; }
    }
    if (c0 >= 640 && c0 < 768) {
        const int dv = c0 - 640 + r; const v2u w = {pk2(a[0], a[1]), pk2(a[2], a[3])};
#pragma unroll
        for (int b = 0; b < NB; ++b) *(v2u*)((bf16*)(F.ws + WS_VT) + ((size_t)(b * 2 + (dv >> 6)) * (PV / 16) * 64 + (dv & 63)) * 16 + 4 * q) = w;
        return; }
    bf16* dst; int ld, col;
    if (c0 < 768) { dst = (bf16*)(F.ws + WS_KV); ld = 256; col = c0 - 512; } else { dst = (bf16*)(F.ws + WS_ZR); ld = 1792; col = c0 - 768; }
#pragma unroll
    for (int x = 0; x < 4; ++x) dst[(size_t)(MR + 4 * q + x) * ld + col + r] = (bf16)f2bf(a[x]);
}
__device__ __forceinline__ void meta_lora(Frame& F, int i) {
    const int lane = F.lane, r = lane & 15, q = lane >> 4, n0 = 16 * i, kind = n0 >> 9, col = (n0 & 511) + r; const bf16* A16 = (const bf16*)(F.ws + WS_LA) + (size_t)MR * 256;
    const f32x4m a = mini16(A16, 256, (const bf16*)(F.ws + WS_WL) + (size_t)n0 * 256, 256, 256, lane);
    const float bias = kind == 0 ? inp(10)[col] : (kind == 1 ? inp(12)[col] : 0.f);
    bf16* dst = (bf16*)(F.ws + (kind == 0 ? WS_LW : (kind == 1 ? WS_AA : WS_GG)));
#pragma unroll
    for (int x = 0; x < 4; ++x) { const float v = a[x] + bias; const float o = kind == 0 ? -0.6065306597126334f * sigm(v) : (kind == 1 ? sigm(v) : v); dst[(size_t)(MR + 4 * q + x) * 512 + col] = (bf16)f2bf(o); }
}

constexpr int RW_P = 72;
constexpr int RW_NCH = 129;
constexpr int RW_AT = 0, RW_RT = 9216, RW_BT = 18432, RW_KT = 27648;
constexpr int RW_RHS = RW_BT;
constexpr int RW_VT = 36864, RW_BHT = 46080, RW_KHT = 55296, RW_WT = 64512, RW_UT = 73728;
constexpr int RW_AAB = 82944;
constexpr int RW_AAK = 99328, RW_ARB = 108544, RW_ARK = 117760;
constexpr int RW_TINV = 92160;
constexpr int RW_MISC = 126976;
static_assert(RW_MISC + 2048 + 512 <= RING_BYTES, "rwkv LDS map");
typedef short s16x4v __attribute__((ext_vector_type(4)));

__device__ __forceinline__ f32x16 rw_mm(f32x16 acc, const LAS bf16* X, int ti, const LAS bf16* Yt, int tn, int lane) {
    const LAS bf16* xp = X + (32 * ti + (lane & 31)) * RW_P + 8 * (lane >> 5); const LAS bf16* yp = Yt + (32 * tn + (lane & 31)) * RW_P + 8 * (lane >> 5);
#pragma unroll
    for (int ks = 0; ks < 4; ++ks) { const bf16x8 a = *(const LAS bf16x8*)(xp + 16 * ks), b = *(const LAS bf16x8*)(yp + 16 * ks); acc = __builtin_amdgcn_mfma_f32_32x32x16_bf16(a, b, acc, 0, 0, 0); }
    return acc;
}
__device__ __forceinline__ bf16x8 rw_pack8(const f32x16& v, int s) {
    bf16x8 r;
#pragma unroll
    for (int j = 0; j < 8; j += 2) { const unsigned w = pg8::cvt_pk_bf16(v[8 * s + j], v[8 * s + j + 1]); r[j] = (short)(w & 0xffffu); r[j + 1] = (short)(w >> 16); }
    return r;
}
__device__ __forceinline__ size_t rw_item(int bh, int c) { return (size_t)bh * RW_NCH + c; }

struct RwRaw { unsigned zr[9], zk[9], zv[9], al[8], lw[8]; float par[6]; };
__device__ __forceinline__ void rw_load_raw(RwRaw& R, Frame& F, int b, int h, int c) {
    const int ch = F.tid & 63, tg = F.tid >> 6, hc = h * 64 + ch;
    const bf16* ZR = (const bf16*)(F.ws + WS_ZR); const bf16* LW = (const bf16*)(F.ws + WS_LW); const bf16* AA = (const bf16*)(F.ws + WS_AA);
#pragma unroll
    for (int j = 0; j < 9; ++j) { const int p = 64 * c - 48 + 8 * tg + j - 1; const int pc = p < 0 ? 0 : p;
        const size_t m = pc < 16 ? (size_t)(MR + pc) : (size_t)(b * SEQL + pc - 16); const bf16* z = ZR + m * 1792 + hc;
        R.zr[j] = z[0]; R.zk[j] = z[512]; R.zv[j] = z[1024];
        if (j > 0) { R.al[j - 1] = AA[m * 512 + hc]; R.lw[j - 1] = LW[m * 512 + hc]; } }
    R.par[0] = inp(9)[hc]; R.par[1] = inp(9)[512 + hc]; R.par[2] = inp(9)[1024 + hc]; R.par[3] = inp(15)[hc]; R.par[4] = inp(16)[hc]; R.par[5] = inp(17)[hc];
}
__device__ __forceinline__ float bfw(unsigned w) { return __builtin_bit_cast(float, w << 16); }
#ifdef MK_ITEM_PROF
#define RWP(k) do { if (blockIdx.x == 0 && threadIdx.x == 0) { const unsigned long long t_ = __builtin_amdgcn_s_memrealtime(); ((unsigned long long*)(F.ws + 32768))[k] += t_ - tprev_; tprev_ = t_; } } while (0)
#elif defined(MK_ITEM_MARK)
#define RWP(k) asm volatile("; RWP_MARK " #k ::: "memory")
#else
#define RWP(k) do { } while (0)
#endif
__device__ __forceinline__ void rwkv_item(Frame& F, int b, int h, int c, RwRaw& raw, int nb, int nh, int nc) {
    constexpr int MODE = 1;
#ifdef MK_ITEM_PROF
    unsigned long long tprev_ = __builtin_amdgcn_s_memrealtime();
#endif
    const int tid = F.tid, lane = F.lane, wave = F.wave, r32 = lane & 31, hi = lane >> 5;
    LAS unsigned char* L = F.lds;
    LAS bf16* At = (LAS bf16*)(L + RW_AT); LAS bf16* Rt = (LAS bf16*)(L + RW_RT); LAS bf16* Bt = (LAS bf16*)(L + RW_BT); LAS bf16* Kt = (LAS bf16*)(L + RW_KT);
    LAS bf16* Vt = (LAS bf16*)(L + RW_VT); LAS bf16* Bht = (LAS bf16*)(L + RW_BHT); LAS bf16* Kht = (LAS bf16*)(L + RW_KHT); LAS bf16* Wt = (LAS bf16*)(L + RW_WT); LAS bf16* Ut = (LAS bf16*)(L + RW_UT);
    LAS bf16* Aab = (LAS bf16*)(L + RW_AAB); LAS bf16* RhsB = (LAS bf16*)(L + RW_RHS);
    LAS bf16* Aak = (LAS bf16*)(L + RW_AAK); LAS bf16* Arb = (LAS bf16*)(L + RW_ARB); LAS bf16* Ark = (LAS bf16*)(L + RW_ARK); LAS bf16* Qm = Aak;
    LAS float* gtot = (LAS float*)(L + RW_MISC); LAS float* dots = gtot + 512; LAS float* lend = dots + 64;
    const bf16* ZR = (const bf16*)(F.ws + WS_ZR); const bf16* LW = (const bf16*)(F.ws + WS_LW); const bf16* AA = (const bf16*)(F.ws + WS_AA);
    const int bh = b * 8 + h;
    {
        const int ch = tid & 63, tg = tid >> 6, hc = h * 64 + ch;
        const float mur = raw.par[0], muk = raw.par[1], muv = raw.par[2], kkc = raw.par[3], kac = raw.par[4], rkc = raw.par[5];
        float zr_[9], zk_[9], zv_[9], al_[8], lwr_[8];
#pragma unroll
        for (int j = 0; j < 9; ++j) { zr_[j] = bfw(raw.zr[j]); zk_[j] = bfw(raw.zk[j]); zv_[j] = bfw(raw.zv[j]); if (j > 0) { al_[j - 1] = bfw(raw.al[j - 1]); lwr_[j - 1] = bfw(raw.lw[j - 1]); } }
        if (c == 0) {
#pragma unroll
            for (int j = 0; j < 9; ++j) { const float ok = 8 * tg + j - 1 >= 48 ? 1.f : 0.f; zr_[j] *= ok; zk_[j] *= ok; zv_[j] *= ok; if (j > 0) { al_[j - 1] *= ok; lwr_[j - 1] *= ok; } } }
        if (nc >= 0) rw_load_raw(raw, F, nb, nh, nc);
        float rr[8], kq[8], km[8], vv[8], bb[8], lw8[8];
        float run = 0.f;
        float V[16];
#pragma unroll
        for (int j = 0; j < 8; ++j) {
            const float r = zr_[j + 1] + (zr_[j] - zr_[j + 1]) * mur, k = zk_[j + 1] + (zk_[j] - zk_[j + 1]) * muk, v = zv_[j + 1] + (zv_[j] - zv_[j + 1]) * muv;
            const float al = al_[j], lw = lwr_[j];
            const float q = k * kkc, kmod = k * (1.f + (al - 1.f) * kac);
            V[2 * j] = q * q; V[2 * j + 1] = r * kmod * rkc;
            rr[j] = r; kq[j] = q; km[j] = kmod; vv[j] = v; run += lw; lw8[j] = run;
        }
        {
            const int ln = F.lane; const bool b3 = (ln & 8) != 0, b2 = (ln & 4) != 0, b1 = (ln & 2) != 0, b0 = (ln & 1) != 0;
#define RS_STEP(N, BIT, CTRL) _Pragma("unroll") for (int k_ = 0; k_ < (N); ++k_) { const float mine_ = BIT ? V[k_ + (N)] : V[k_], send_ = BIT ? V[k_] : V[k_ + (N)]; \
                V[k_] = mine_ + __builtin_bit_cast(float, __builtin_amdgcn_update_dpp(0, __builtin_bit_cast(int, send_), CTRL, 0xF, 0xF, true)); }
            RS_STEP(8, b3, 0x140)
            RS_STEP(4, b2, 0x141)
            RS_STEP(2, b1, 0x1B)
            RS_STEP(1, b0, 0xB1)
#undef RS_STEP
            float x = V[0];
            x += __builtin_bit_cast(float, __builtin_amdgcn_ds_swizzle(__builtin_bit_cast(int, x), 0x401F));
            x += __shfl_xor(x, 32);
            if (ln < 16 && (ln & 1)) ((float*)(F.ws + WS_DOTS))[rw_item(bh, c) * 64 + 8 * tg + (ln >> 1)] = x;
            const float rn = __builtin_amdgcn_rsqf(fmaxf(x, 1e-24f));
#pragma unroll
            for (int j = 0; j < 8; ++j) { const float rj = __builtin_bit_cast(float, __builtin_amdgcn_readlane(__builtin_bit_cast(int, rn), 2 * j)); kq[j] *= rj; bb[j] = kq[j] * al_[j]; }
        }
        gtot[tg * 64 + ch] = run;
        __syncthreads();
        float off = 0.f, tot = 0.f;
#pragma unroll
        for (int g2 = 0; g2 < 8; ++g2) { const float x = gtot[g2 * 64 + ch]; tot += x; if (g2 < tg) off += x; }
        if (tg == 0) lend[ch] = tot;
        unsigned vt_[4], bh_[4], kh_[4];
        const float eT = __expf(tot); float ePrev = __expf(off);
#pragma unroll
        for (int j = 0; j < 8; ++j) {
            const int t = 8 * tg + j; const float Lt = off + lw8[j];
            const float eL = __expf(Lt), eP = ePrev, eN = __expf(-Lt), eE = eT * eN; ePrev = eL;
            At[t * RW_P + ch] = (bf16)f2bf(-kq[j] * eP); Rt[t * RW_P + ch] = (bf16)f2bf(rr[j] * eL); Bt[t * RW_P + ch] = (bf16)f2bf(bb[j] * eN); Kt[t * RW_P + ch] = (bf16)f2bf(km[j] * eN);
            const unsigned v_ = f2bf(vv[j]), b_ = f2bf(bb[j] * eE), k_ = f2bf(km[j] * eE);
            if (j & 1) { vt_[j >> 1] |= v_ << 16; bh_[j >> 1] |= b_ << 16; kh_[j >> 1] |= k_ << 16; } else { vt_[j >> 1] = v_; bh_[j >> 1] = b_; kh_[j >> 1] = k_; }
        }
        *(LAS v4u*)(Vt + ch * RW_P + 8 * tg) = (v4u){vt_[0], vt_[1], vt_[2], vt_[3]};
        *(LAS v4u*)(Bht + ch * RW_P + 8 * tg) = (v4u){bh_[0], bh_[1], bh_[2], bh_[3]};
        *(LAS v4u*)(Kht + ch * RW_P + 8 * tg) = (v4u){kh_[0], kh_[1], kh_[2], kh_[3]};
    }
    __syncthreads(); RWP(0);
#pragma unroll
    for (int rnd = 0; rnd < 2; ++rnd) {
        const int mat = (wave >> 2) + 2 * rnd, ti = (wave >> 1) & 1, tn = wave & 1;
        f32x16 acc = {};
        acc = rw_mm(acc, (const LAS bf16*)(L + ((mat & 1) ? RW_KT : RW_BT)), tn, (const LAS bf16*)(L + (mat < 2 ? RW_AT : RW_RT)), ti, lane);
        LAS bf16* dstm = (LAS bf16*)(L + (mat == 0 ? RW_AAB : RW_AAK + (mat - 1) * 9216));
        const int t = 32 * ti + r32, lim = t + (mat >> 1);
#pragma unroll
        for (int g = 0; g < 4; ++g) { const int sb = 32 * tn + 8 * g + 4 * hi;
            const float v0 = sb < lim ? acc[4 * g] : 0.f, v1 = sb + 1 < lim ? acc[4 * g + 1] : 0.f, v2 = sb + 2 < lim ? acc[4 * g + 2] : 0.f, v3 = sb + 3 < lim ? acc[4 * g + 3] : 0.f;
            *(LAS v2u*)(dstm + t * RW_P + sb) = (v2u){pk2(v0, v1), pk2(v2, v3)}; }
    }
    __syncthreads(); RWP(1);
    if (wave < 4) { const int ti = wave >> 1, tn = wave & 1; f32x16 acc = {}; acc = rw_mm(acc, Aak, ti, Vt, tn, lane);
#pragma unroll
        for (int g = 0; g < 4; ++g) *(LAS v2u*)(RhsB + (32 * tn + r32) * RW_P + 32 * ti + 8 * g + 4 * hi) = (v2u){pk2(acc[4 * g], acc[4 * g + 1]), pk2(acc[4 * g + 2], acc[4 * g + 3])};
    } else {
        const int d = wave & 3, cl = lane & 15, q = lane >> 4;
        const LAS bf16* Ad = Aab + (16 * d) * RW_P + 16 * d;
        f32x4m aN, aT;
#pragma unroll
        for (int r = 0; r < 4; ++r) aN[r] = bf1(Ad[(4 * q + r) * RW_P + cl]);
        { const v2u w = *(const LAS v2u*)(Ad + cl * RW_P + 4 * q); aT[0] = bflo(w.x); aT[1] = bfhi(w.x); aT[2] = bflo(w.y); aT[3] = bfhi(w.y); }
#define MM4(dst_, a_, b_, init_) { f32x4m z_ = init_; _Pragma("unroll") for (int s_ = 0; s_ < 4; ++s_) z_ = __builtin_amdgcn_mfma_f32_16x16x4f32(a_[s_], b_[s_], z_, 0, 0, 0); dst_ = z_; }
        const f32x4m zero4 = {0.f, 0.f, 0.f, 0.f};
        f32x4m a2N, a2T, a4N, a4T, a8N, b1T, b2T, b3T, iaT;
        MM4(a2N, aT, aN, zero4); MM4(a2T, aN, aT, zero4);
#pragma unroll
        for (int r = 0; r < 4; ++r) iaT[r] = aT[r] + (cl == 4 * q + r ? 1.f : 0.f);
        MM4(a4N, a2T, a2N, zero4); MM4(a4T, a2N, a2T, zero4);
        MM4(b1T, a2N, iaT, iaT);
        MM4(a8N, a4T, a4N, zero4);
        MM4(b2T, a4N, b1T, b1T);
        MM4(b3T, a8N, b2T, b2T);
#undef MM4
        *(LAS f32x4m*)(L + RW_TINV + (d * 64 + lane) * 16) = b3T;
    }
    __syncthreads(); RWP(2);
    {
        const int cl = lane & 15, q = lane >> 4, cc = (wave & 3) * 16 + cl;
        LAS bf16* xrow = (wave < 4 ? Ut : Wt) + cc * RW_P;
        f32x4m Tt[4];
#pragma unroll
        for (int b = 0; b < 4; ++b) Tt[b] = *(const LAS f32x4m*)(L + RW_TINV + (b * 64 + lane) * 16);
        unsigned xp[4][2];
#pragma unroll
        for (int b = 0; b < 4; ++b) {
            f32x4m acc;
            if (wave < 4) { const v2u w = *(const LAS v2u*)(RhsB + cc * RW_P + 16 * b + 4 * q); acc[0] = bflo(w.x); acc[1] = bfhi(w.x); acc[2] = bflo(w.y); acc[3] = bfhi(w.y); }
            else {
#pragma unroll
                for (int r = 0; r < 4; ++r) acc[r] = bf1(At[(16 * b + 4 * q + r) * RW_P + cc]); }
#pragma unroll
            for (int mq = 0; mq < 2; ++mq) if (32 * mq < 16 * b) {
                const v2u a0 = *(const LAS v2u*)(Aab + (16 * b + cl) * RW_P + 32 * mq + 4 * q), a1 = *(const LAS v2u*)(Aab + (16 * b + cl) * RW_P + 32 * mq + 16 + 4 * q);
                const bool second = 2 * mq + 1 < b;
                const v4u au = {a0.x, a0.y, a1.x, a1.y}, xu = {xp[2 * mq][0], xp[2 * mq][1], second ? xp[2 * mq + 1][0] : 0u, second ? xp[2 * mq + 1][1] : 0u};
                acc = __builtin_amdgcn_mfma_f32_16x16x32_bf16(__builtin_bit_cast(bf16x8, au), __builtin_bit_cast(bf16x8, xu), acc, 0, 0, 0);
            }
            f32x4m x = {0.f, 0.f, 0.f, 0.f};
#pragma unroll
            for (int s = 0; s < 4; ++s) x = __builtin_amdgcn_mfma_f32_16x16x4f32(Tt[b][s], acc[s], x, 0, 0, 0);
            xp[b][0] = pk2(x[0], x[1]); xp[b][1] = pk2(x[2], x[3]);
            *(LAS v2u*)(xrow + 16 * b + 4 * q) = (v2u){xp[b][0], xp[b][1]};
        }
    }
    __syncthreads(); RWP(3);
    {
        const int ti = (wave >> 1) & 1, tn = wave & 1; f32x16 acc = {};
        unsigned char* dst = F.ws + WS_F + rw_item(bh, c) * 16384;
        if (wave < 4) { acc = rw_mm(acc, Wt, tn, Bht, ti, lane);
            bf16* MT = (bf16*)dst; const int k2 = 32 * ti + r32; const float ed = __expf(lend[k2]);
#pragma unroll
            for (int g = 0; g < 4; ++g) { const int k1 = 32 * tn + 8 * g + 4 * hi;
                const float v0 = acc[4 * g] + (k1 == k2 ? ed : 0.f), v1 = acc[4 * g + 1] + (k1 + 1 == k2 ? ed : 0.f), v2 = acc[4 * g + 2] + (k1 + 2 == k2 ? ed : 0.f), v3 = acc[4 * g + 3] + (k1 + 3 == k2 ? ed : 0.f);
                *(v2u*)(MT + k2 * 64 + k1) = (v2u){pk2(v0, v1), pk2(v2, v3)}; }
        } else { acc = rw_mm(acc, Bht, ti, Ut, tn, lane); acc = rw_mm(acc, Kht, ti, Vt, tn, lane);
            v4u* GT = (v4u*)(dst + 8192) + ((ti * 2 + tn) * 64 + lane) * 2;
            const bf16x8 g0 = rw_pack8(acc, 0), g1 = rw_pack8(acc, 1); GT[0] = __builtin_bit_cast(v4u, g0); GT[1] = __builtin_bit_cast(v4u, g1); }
    }
    RWP(4);
    if (c > 0) {
        const int ti = (wave >> 1) & 1, tn = wave & 1; f32x16 acc = {};
        unsigned char* dst = F.ws + WS_QY + rw_item(bh, c) * 16384;
        if (wave < 4) { acc = rw_mm(acc, Wt, tn, Arb, ti, lane);
            bf16* Qg = (bf16*)dst; const int t = 32 * ti + r32;
#pragma unroll
            for (int g = 0; g < 4; ++g) { const int k = 32 * tn + 8 * g + 4 * hi; const v2u rw = *(const LAS v2u*)(Rt + t * RW_P + k);
                *(v2u*)(Qg + t * 64 + k) = (v2u){pk2(acc[4 * g] + bflo(rw.x), acc[4 * g + 1] + bfhi(rw.x)), pk2(acc[4 * g + 2] + bflo(rw.y), acc[4 * g + 3] + bfhi(rw.y))}; }
        } else { acc = rw_mm(acc, Ut, tn, Arb, ti, lane); acc = rw_mm(acc, Vt, tn, Ark, ti, lane);
            v4u* YT = (v4u*)(dst + 8192) + ((ti * 2 + tn) * 64 + lane) * 2;
            const bf16x8 g0 = rw_pack8(acc, 0), g1 = rw_pack8(acc, 1); YT[0] = __builtin_bit_cast(v4u, g0); YT[1] = __builtin_bit_cast(v4u, g1); }
    }
    __syncthreads(); RWP(5);
}

struct OutRaw { v4u qg[4], s0[4], s1[4]; };
__device__ __forceinline__ void rwkv_out_load(OutRaw& R, Frame& F, int bh, int c, int ti) {
    const int lane = F.lane, r32 = lane & 31, b = bh >> 3, h = bh & 7, rr = lane >> 3, ck = lane & 7;
    const unsigned char* src = F.ws + WS_QY + rw_item(bh, c) * 16384; const bf16* Qg = (const bf16*)src; const v4u* YT = (const v4u*)(src + 8192);
    const v4u* SI = (const v4u*)(F.ws + WS_SST + rw_item(bh, c) * 8192);
#pragma unroll
    for (int j = 0; j < 4; ++j) R.qg[j] = *(const v4u*)(Qg + (32 * ti + 8 * j + rr) * 64 + 8 * ck);
#pragma unroll
    for (int e = 0; e < 4; ++e) { R.s0[e] = SI[(((e >> 1) * 2 + 0) * 2 + (e & 1)) * 64 + lane]; R.s1[e] = SI[(((e >> 1) * 2 + 1) * 2 + (e & 1)) * 64 + lane]; }
}
__device__ __forceinline__ void rwkv_out(Frame& F, const OutRaw& R, int bh, int c, int ti) {
    constexpr int P_ = 144;
    const int lane = F.lane, r32 = lane & 31, hi = lane >> 5, b = bh >> 3, h = bh & 7, rr = lane >> 3, ck = lane & 7;
    LAS unsigned char* Zl = F.lds + RING_OFF + F.wave * 16384; LAS unsigned char* Gl = Zl + 33 * P_; LAS unsigned char* Ql = Gl + 32 * P_;
    const int tok0 = 64 * (c - 1) + 32 * ti; const size_t m0 = (size_t)(b * SEQL + tok0);
    bf16* RO = (bf16*)(F.ws + WS_F);
    const size_t pm0 = tok0 == 0 ? (size_t)(MR + 15) : m0 - 1;
    const bf16* ZR = (const bf16*)(F.ws + WS_ZR); const bf16* GG = (const bf16*)(F.ws + WS_GG);
    const v4u* YT = (const v4u*)(F.ws + WS_QY + rw_item(bh, c) * 16384 + 8192);
    const float dt = ((const float*)(F.ws + WS_DOTS))[rw_item(bh, c) * 64 + 32 * ti + r32];
    const v4u a0 = YT[((ti * 2 + 0) * 64 + lane) * 2], a1 = YT[((ti * 2 + 0) * 64 + lane) * 2 + 1], b0 = YT[((ti * 2 + 1) * 64 + lane) * 2], b1 = YT[((ti * 2 + 1) * 64 + lane) * 2 + 1];
    v4u qg[4], zg[4], gg4[4], s0[4], s1[4];
#pragma unroll
    for (int j = 0; j < 4; ++j) { qg[j] = R.qg[j]; s0[j] = R.s0[j]; s1[j] = R.s1[j]; }
    const v4u zprev = *(const v4u*)(ZR + pm0 * 1792 + 1024 + h * 64 + 8 * ck);
#pragma unroll
    for (int j = 0; j < 4; ++j) { zg[j] = *(const v4u*)(ZR + (m0 + 8 * j + rr) * 1792 + 1024 + h * 64 + 8 * ck); gg4[j] = *(const v4u*)(GG + (m0 + 8 * j + rr) * 512 + h * 64 + 8 * ck); }
    __builtin_amdgcn_sched_barrier(0);
#pragma unroll
    for (int j = 0; j < 4; ++j) *(LAS v4u*)(Ql + (8 * j + rr) * P_ + 16 * ck) = qg[j];
    f32x16 y0, y1;
#pragma unroll
    for (int j = 0; j < 4; ++j) { y0[2 * j] = bflo(a0[j]); y0[2 * j + 1] = bfhi(a0[j]); y0[8 + 2 * j] = bflo(a1[j]); y0[8 + 2 * j + 1] = bfhi(a1[j]);
                                  y1[2 * j] = bflo(b0[j]); y1[2 * j + 1] = bfhi(b0[j]); y1[8 + 2 * j] = bflo(b1[j]); y1[8 + 2 * j + 1] = bfhi(b1[j]); }
#pragma unroll
    for (int e = 0; e < 4; ++e) {
        const v2u qa = *(const LAS v2u*)(Ql + r32 * P_ + (32 * (e >> 1) + 16 * (e & 1) + 4 * hi) * 2), qb = *(const LAS v2u*)(Ql + r32 * P_ + (32 * (e >> 1) + 16 * (e & 1) + 8 + 4 * hi) * 2);
        const v4u qf = {qa.x, qa.y, qb.x, qb.y};
        y0 = __builtin_amdgcn_mfma_f32_32x32x16_bf16(__builtin_bit_cast(bf16x8, s0[e]), __builtin_bit_cast(bf16x8, qf), y0, 0, 0, 0);
        y1 = __builtin_amdgcn_mfma_f32_32x32x16_bf16(__builtin_bit_cast(bf16x8, s1[e]), __builtin_bit_cast(bf16x8, qf), y1, 0, 0, 0);
    }
    if (lane < 8) *(LAS v4u*)(Zl + 16 * ck) = zprev;
#pragma unroll
    for (int j = 0; j < 4; ++j) { *(LAS v4u*)(Zl + (1 + 8 * j + rr) * P_ + 16 * ck) = zg[j]; *(LAS v4u*)(Gl + (8 * j + rr) * P_ + 16 * ck) = gg4[j]; }
    float sm = 0.f;
#pragma unroll
    for (int r = 0; r < 16; ++r) sm += y0[r] + y1[r];
    sm += __shfl_xor(sm, 32);
    const float mean = sm * (1.f / 64.f);
    float sv = 0.f;
#pragma unroll
    for (int r = 0; r < 16; ++r) { y0[r] -= mean; y1[r] -= mean; sv += y0[r] * y0[r] + y1[r] * y1[r]; }
    sv += __shfl_xor(sv, 32);
    const float rs = 1.f / sqrtf(sv * (1.f / 64.f) + GN_EPS);
    const float* lnw = inp(18) + h * 64 + 4 * hi; const float* lnb = inp(19) + h * 64 + 4 * hi; const float* mvp = inp(9) + 1024 + h * 64 + 4 * hi;
#pragma unroll
    for (int tn = 0; tn < 2; ++tn)
#pragma unroll
        for (int g = 0; g < 4; ++g) { const int co = (32 * tn + 8 * g + 4 * hi) * 2;
            const f32x4 w4 = *(const f32x4*)(lnw + 32 * tn + 8 * g), b4 = *(const f32x4*)(lnb + 32 * tn + 8 * g), m4 = *(const f32x4*)(mvp + 32 * tn + 8 * g);
            const v2u zv = *(const LAS v2u*)(Zl + (1 + r32) * P_ + co), pv = *(const LAS v2u*)(Zl + r32 * P_ + co), gv = *(const LAS v2u*)(Gl + r32 * P_ + co);
            const float z[4] = {bflo(zv.x), bfhi(zv.x), bflo(zv.y), bfhi(zv.y)}, p[4] = {bflo(pv.x), bfhi(pv.x), bflo(pv.y), bfhi(pv.y)}, gt[4] = {bflo(gv.x), bfhi(gv.x), bflo(gv.y), bfhi(gv.y)};
            float o[4];
#pragma unroll
            for (int x = 0; x < 4; ++x) { const float d = tn == 0 ? y0[4 * g + x] : y1[4 * g + x]; const float v = z[x] + (p[x] - z[x]) * m4[x]; o[x] = (d * rs * w4[x] + b4[x] + dt * v) * gt[x]; }
            *(LAS v2u*)(Gl + r32 * P_ + co) = (v2u){pk2(o[0], o[1]), pk2(o[2], o[3])};
        }
#pragma unroll
    for (int j = 0; j < 4; ++j) *(v4u*)(RO + (m0 + 8 * j + rr) * 512 + h * 64 + 8 * ck) = *(const LAS v4u*)(Gl + (8 * j + rr) * P_ + 16 * ck);
}

constexpr int RWC_MP = 68;
constexpr int RWC_SLOT = 64 * RWC_MP * 2 + 4096;
constexpr int RWC_FLAGS = 7 * RWC_SLOT;
__device__ __forceinline__ void rwkv_chain_wg(Frame& F, int bh, int tv) {
    const int lane = F.lane, wave = F.wave, r32 = lane & 31, hi = lane >> 5;
    LAS unsigned char* L = F.lds; volatile LAS unsigned* flag = (volatile LAS unsigned*)(L + RWC_FLAGS);
    if (F.tid < 7) flag[F.tid] = 0u;
    __syncthreads();
    if (wave != 0) {
        const int slot = wave - 1; LAS unsigned char* sb = L + slot * RWC_SLOT;
        v4u mv[8], gv[4];
#define RWC_LOAD(MV, GV, CC) do { const unsigned char* src_ = F.ws + WS_F + rw_item(bh, (CC)) * 16384; const v4u* MT_ = (const v4u*)src_; const v4u* GT_ = (const v4u*)(src_ + 8192); \
            _Pragma("unroll") for (int i = 0; i < 8; ++i) MV[i] = MT_[lane + 64 * i]; \
            _Pragma("unroll") for (int i = 0; i < 4; ++i) { const int idx = lane + 64 * i, t2 = idx >> 7, l = (idx >> 1) & 63, hf = idx & 1; GV[i] = GT_[((t2 * 2 + tv) * 64 + l) * 2 + hf]; } } while (0)
        v4u mw[8], gw_[4];
#define RWC_STEP(MV, GV, NM, NG) do { \
            if (c + 7 == RW_NCH - 1) {        \
                unsigned* fl_ = (unsigned*)(F.ctl + CW_LASTCHUNK + bh); unsigned* tmo_ = (unsigned*)(F.ctl + CW_BAR); \
                XB_SPIN(__hip_atomic_load(fl_, __ATOMIC_RELAXED, __HIP_MEMORY_SCOPE_AGENT) == 0u, tmo_); \
                __builtin_amdgcn_fence(__ATOMIC_ACQUIRE, ""); } \
            RWC_LOAD(NM, NG, (c + 7 < RW_NCH ? c + 7 : c));                                            \
            asm volatile("s_waitcnt vmcnt(12)" ::: "memory");                                         \
            while (flag[slot] != 0u) __builtin_amdgcn_s_sleep(2);                                     \
            _Pragma("unroll") for (int i = 0; i < 8; ++i) { const int idx = lane + 64 * i; *(LAS v4u*)(sb + (idx >> 3) * (RWC_MP * 2) + (idx & 7) * 16) = MV[i]; } \
            _Pragma("unroll") for (int i = 0; i < 4; ++i) *(LAS v4u*)(sb + 64 * RWC_MP * 2 + (lane + 64 * i) * 16) = GV[i]; \
            asm volatile("s_waitcnt lgkmcnt(0)" ::: "memory"); \
            if (lane == 0) flag[slot] = 1u; } while (0)
        RWC_LOAD(mv, gv, slot);
        for (int c = slot;;) {
            RWC_STEP(mv, gv, mw, gw_); c += 7; if (c >= RW_NCH) break;
            RWC_STEP(mw, gw_, mv, gv); c += 7; if (c >= RW_NCH) break;
        }
#undef RWC_STEP
#undef RWC_LOAD
        return;
    }
    f32x16 s0 = {}, s1 = {};
    __builtin_amdgcn_s_setprio(3);
    for (int c = 0; c < RW_NCH; ++c) {
        const int slot = c % 7; const LAS unsigned char* sb = L + slot * RWC_SLOT;
        v4u* SI = (v4u*)(F.ws + WS_SST + rw_item(bh, c) * 8192);
        const bf16x8 b00 = rw_pack8(s0, 0), b01 = rw_pack8(s0, 1), b10 = rw_pack8(s1, 0), b11 = rw_pack8(s1, 1);
        SI[((0 * 2 + tv) * 2 + 0) * 64 + lane] = __builtin_bit_cast(v4u, b00); SI[((0 * 2 + tv) * 2 + 1) * 64 + lane] = __builtin_bit_cast(v4u, b01);
        SI[((1 * 2 + tv) * 2 + 0) * 64 + lane] = __builtin_bit_cast(v4u, b10); SI[((1 * 2 + tv) * 2 + 1) * 64 + lane] = __builtin_bit_cast(v4u, b11);
        while (flag[slot] == 0u) __builtin_amdgcn_s_sleep(1);
        asm volatile("" ::: "memory");
        s16x4v ma[2][2][2], mb[2][2][2]; v4u g[2][2];
#pragma unroll
        for (int tk = 0; tk < 2; ++tk)
#pragma unroll
            for (int s = 0; s < 2; ++s)
#pragma unroll
                for (int t2 = 0; t2 < 2; ++t2) { const LAS bf16* mp = (const LAS bf16*)sb + (32 * t2 + r32) * RWC_MP + 32 * tk + 16 * s + 4 * hi; ma[tk][s][t2] = *(const LAS s16x4v*)(mp); mb[tk][s][t2] = *(const LAS s16x4v*)(mp + 8); }
#pragma unroll
        for (int t2 = 0; t2 < 2; ++t2) { g[t2][0] = *(const LAS v4u*)(sb + 64 * RWC_MP * 2 + ((t2 * 64 + lane) * 2) * 16); g[t2][1] = *(const LAS v4u*)(sb + 64 * RWC_MP * 2 + ((t2 * 64 + lane) * 2 + 1) * 16); }
        asm volatile("s_waitcnt lgkmcnt(0)" ::: "memory");
        if (lane == 0) flag[slot] = 0u;
        f32x16 n0, n1;
#pragma unroll
        for (int j = 0; j < 4; ++j) { n0[2 * j] = bflo(g[0][0][j]); n0[2 * j + 1] = bfhi(g[0][0][j]); n0[8 + 2 * j] = bflo(g[0][1][j]); n0[8 + 2 * j + 1] = bfhi(g[0][1][j]);
                                      n1[2 * j] = bflo(g[1][0][j]); n1[2 * j + 1] = bfhi(g[1][0][j]); n1[8 + 2 * j] = bflo(g[1][1][j]); n1[8 + 2 * j + 1] = bfhi(g[1][1][j]); }
#pragma unroll
        for (int tk = 0; tk < 2; ++tk)
#pragma unroll
            for (int s = 0; s < 2; ++s) {
                const bf16x8 bfr = tk == 0 ? (s == 0 ? b00 : b01) : (s == 0 ? b10 : b11);
#pragma unroll
                for (int t2 = 0; t2 < 2; ++t2) {
                    const s16x4v xa = ma[tk][s][t2], xb = mb[tk][s][t2];
                    const bf16x8 af = {xa[0], xa[1], xa[2], xa[3], xb[0], xb[1], xb[2], xb[3]};
                    if (t2 == 0) n0 = __builtin_amdgcn_mfma_f32_32x32x16_bf16(af, bfr, n0, 0, 0, 0); else n1 = __builtin_amdgcn_mfma_f32_32x32x16_bf16(af, bfr, n1, 0, 0, 0);
                }
            }
        s0 = n0; s1 = n1;
    }
    __builtin_amdgcn_s_setprio(0);
}

#ifdef MK_DUMP
__device__ __forceinline__ void dump_phase(const unsigned char* ws, float* out) {
    const size_t n = (size_t)MR * DM; const size_t i0 = (size_t)blockIdx.x * blockDim.x + threadIdx.x, st = (size_t)gridDim.x * blockDim.x;
    for (size_t i = i0; i < n; i += st) { const size_t m = i >> 10, c = i & 1023; float v = 0.f;
        if (MK_DUMP == 1) v = bf1(((const bf16*)(ws + WS_F))[m * 1024 + c]);
        else if (MK_DUMP == 2) v = bf1(((const bf16*)(ws + WS_ZR))[m * 1792 + c]);
        else if (MK_DUMP == 3) v = c < 512 ? ((const float*)(ws + WS_LW))[m * 512 + c] : bf1(((const bf16*)(ws + WS_AA))[m * 512 + c - 512]);
        else if (MK_DUMP == 4) v = bf1(((const bf16*)(ws + WS_MERGED))[m * 1024 + c]);
        else if (MK_DUMP == 5) v = c < 512 ? bf1(((const bf16*)(ws + WS_Q))[m * 512 + c]) : (c < 768 ? bf1(((const bf16*)(ws + WS_KV))[m * 256 + c - 512]) : bf1(((const bf16*)(ws + WS_LA))[m * 256 + c - 768]));
        else if (MK_DUMP == 6) v = bf1(((const bf16*)(ws + WS_GATES))[m * 2048 + c]);
        else if (MK_DUMP == 7) v = bf1(((const bf16*)(ws + WS_F))[m * 1024 + c]);
        else if (MK_DUMP == 8) v = c < 512 ? bf1(((const bf16*)(ws + WS_GG))[m * 512 + c]) : bf1(((const bf16*)(ws + WS_ZR))[m * 1792 + 1024 + c - 512]);
        else if (MK_DUMP == 9) v = ((const float*)(ws + WS_SS))[((size_t)((c & 15) >> 2) * MP + m) * 4 + (c & 3)];
        else if (MK_DUMP == 10) v = bf1(((const bf16*)(ws + WS_XN))[m * 1024 + c]);
        out[i] = v; }
}
#endif
#ifndef MK_N_LAUNCHES
#define MK_N_LAUNCHES 1
#endif
constexpr int N_PHASES = 15;
constexpr int N_LAUNCHES = MK_N_LAUNCHES;
__global__ void __launch_bounds__(NWAVES * 64, 2) hybrid_fwd(Args args) {
    extern __shared__ __attribute__((aligned(16))) unsigned char lds[];
    Frame F;
    F.lds = (LAS unsigned char*)lds;
    F.MISC = (volatile LAS unsigned*)(F.lds + MISC_OFF);
#define FRAME_REFRESH() do { int t_ = threadIdx.x; asm volatile("" : "+v"(t_)); F.tid = t_; F.lane = t_ & 63; F.wave = __builtin_amdgcn_readfirstlane(t_ >> 6); } while (0)
    FRAME_REFRESH();
    F.G = gridDim.x; { const int bx = blockIdx.x; F.vcu = (F.G % 8 == 0) ? (bx % 8) * (F.G / 8) + bx / 8 : bx; }
    unsigned char* ws = args.ws; F.ws = ws; F.out = args.out;
    F.ctl = (gu32*)(ws + WS_CTL);
    for (int u = F.tid; u < (LDS_BYTES - LDSCTL_OFF) / 4; u += NWAVES * 64) ((LAS unsigned*)(F.lds + LDSCTL_OFF))[u] = 0u;
    __syncthreads();
    XcdBarrier bar; bar.bar = (unsigned*)(F.ctl + CW_BAR); bar.x = 0; bar.st = nullptr;
    if (N_LAUNCHES == 1) bar = xcd_barrier_post((unsigned*)(F.ctl + CW_BAR), F.MISC + 8);
    const int lo = args.ph_lo, hi = args.ph_hi;
#ifndef PHASE_MASK
#define PHASE_MASK 0x7fff
#endif
#define IN(k) (((PHASE_MASK >> (k)) & 1) && lo <= (k) && (k) < hi)
#ifndef MK_TIME_SCALE
#define MK_TIME_SCALE 0.001f
#endif
#ifdef MK_TIME_PHASE
#define SEAM(k) do { if (IN(k) && IN((k) + 1)) xcd_barrier(bar); if (blockIdx.x == 0 && threadIdx.x == 0) { const unsigned long long t_ = __builtin_amdgcn_s_memrealtime(); ((unsigned long long*)(ws + 16384))[(k) + 1] = t_; } } while (0)
#else
#define SEAM(k) do { if (IN(k) && IN((k) + 1)) xcd_barrier(bar); } while (0)
#endif
#define GEMM_RUN(EpiT, Eobj, Aptr, lda_, Bptr, ldb_, M_, N_, K_) do { pg8::Gemm g_{(const pg8::bf16_t*)(Aptr), (const pg8::bf16_t*)(Bptr), (M_), (N_), (K_), (lda_), (ldb_)}; pg8::StaticOrder S_; S_.init((M_), (N_), F.G, (int)blockIdx.x); \
        pg8::gemm_phase<EpiT, pg8::StaticOrder, true, true>(F.lds + RING_OFF, g_, S_, Eobj); } while (0)

#ifdef MK_COH_TEST
    {
        float* Tb = (float*)(ws + WS_BIG + 300 * MiB); const int g = blockIdx.x, G = gridDim.x, nb = (g + 1) % G; float acc = 0.f; unsigned bad = 0;
        for (int rep = 0; rep < 4; ++rep) {
            for (int i = threadIdx.x; i < 8192; i += 512) Tb[(size_t)g * 8192 + i] = 1.0f + rep;
            xcd_barrier(bar);
            for (int i = threadIdx.x; i < 8192; i += 512) acc += Tb[(size_t)nb * 8192 + i];
            xcd_barrier(bar);
            for (int i = threadIdx.x; i < 8192; i += 512) Tb[(size_t)g * 8192 + i] = 100.0f + rep * 7 + i;
            xcd_barrier(bar);
            for (int i = threadIdx.x; i < 8192; i += 512) { const float v = Tb[(size_t)nb * 8192 + i]; bad += (v != 100.0f + rep * 7 + i) ? 1u : 0u; }
            xcd_barrier(bar);
        }
        if (acc == 12345.f) bad++;
        if (bad) atomicAdd((unsigned*)(F.ctl + 901), bad);
    }
#endif
#ifdef MK_ITEM_PROF
    if (blockIdx.x == 0 && threadIdx.x == 0) { for (int i_ = 0; i_ < 8; ++i_) ((unsigned long long*)(ws + 32768))[i_] = 0ull; }
#endif
#ifdef MK_TIME_PHASE
    if (blockIdx.x == 0 && threadIdx.x == 0) ((unsigned long long*)(ws + 16384))[0] = __builtin_amdgcn_s_memrealtime();
#endif
    if (IN(0)) { FRAME_REFRESH(); p0_prologue(F, args); } SEAM(0);
    if (IN(1)) { FRAME_REFRESH(); { for (int it = F.vcu; it < DFF / 16; it += F.G) meta_gateup(F, (const bf16*)(ws + WS_WGU1), it); }
        pg8::EpiSwiGLU E{(pg8::bf16_t*)(ws + WS_HID), nullptr}; GEMM_RUN(pg8::EpiSwiGLU, E, (unsigned char*)F.out, DM, ws + WS_WGU1, DM, MR, NHID2, DM); } SEAM(1);
    if (IN(2)) { FRAME_REFRESH(); { for (int it = F.vcu; it < 64; it += F.G) meta_down(F, (const bf16*)(ws + WS_WD1), it); }
        pg8::EpiFSS E{(pg8::bf16_t*)(ws + WS_F), (float*)(ws + WS_SS)}; GEMM_RUN(pg8::EpiFSS, E, ws + WS_HID, DFF, ws + WS_WD1, DFF, MR, DM, DFF); } SEAM(2);
    if (IN(3)) { FRAME_REFRESH(); row_pass<0>(F, args, inp(5), inp(6), 0.5f); } SEAM(3);
    if (IN(4)) { pg8::EpiWin E{(const float*)(ws + WS_RS2), (pg8::bf16_t*)(ws + WS_Q), (pg8::bf16_t*)(ws + WS_KV), (pg8::bf16_t*)(ws + WS_ZR), (const float*)(ws + WS_ROPE), MR, (pg8::bf16_t*)(ws + WS_VT)}; FRAME_REFRESH(); { for (int it = F.vcu; it < 128; it += F.G) meta_win(F, it); }
        GEMM_RUN(pg8::EpiWin, E, (unsigned char*)F.out, DM, ws + WS_WIN, DM, MR, NIN_A, DM); } SEAM(4);
#ifdef MK_GEMM_CHECK4
    if (IN(4)) { xcd_barrier(bar);
        { unsigned char* w2 = ws + WS_BIG + 165 * MiB; pg8::EpiWin E{(const float*)(ws + WS_RS2), (pg8::bf16_t*)(w2), (pg8::bf16_t*)(w2 + (WS_KV - WS_Q)), (pg8::bf16_t*)(w2 + (WS_ZR - WS_Q)), (const float*)(ws + WS_ROPE), MR, (pg8::bf16_t*)(ws + WS_VT)};
          pg8::Gemm g_{(const pg8::bf16_t*)(ws + WS_XN), (const pg8::bf16_t*)(ws + WS_WIN), MP, NIN_A, DM, DM, DM}; pg8::StaticOrder S_; S_.init(MP, NIN_A, F.G, (int)((blockIdx.x + 101) % gridDim.x));
          pg8::gemm_phase<pg8::EpiWin, pg8::StaticOrder, true, true>(F.lds + RING_OFF, g_, S_, E); }
        xcd_barrier(bar);
        { FRAME_REFRESH(); const unsigned* a = (const unsigned*)(ws + WS_Q); const unsigned* b = (const unsigned*)(ws + WS_BIG + 165 * MiB); unsigned bad = 0;
          for (size_t i = (size_t)blockIdx.x * 512 + F.tid; i < (size_t)MP * 2560 / 2; i += (size_t)gridDim.x * 512) bad += (a[i] != b[i]) ? 1u : 0u;
          if (bad) atomicAdd((unsigned*)(F.ctl + 900), bad); }
        xcd_barrier(bar);
    }
#endif
    if (IN(5)) { FRAME_REFRESH(); lora_a_pass(F, args);
#ifdef MK_PROBE_BAR
        xcd_barrier(bar); xcd_barrier(bar); xcd_barrier(bar); xcd_barrier(bar);
#endif
    } SEAM(5);
    if (IN(6)) { pg8::EpiLora E{(pg8::bf16_t*)(ws + WS_LW), (pg8::bf16_t*)(ws + WS_AA), (pg8::bf16_t*)(ws + WS_GG), inp(10), inp(12)}; FRAME_REFRESH(); { const int gw = F.vcu * NWAVES + F.wave, NGW = F.G * NWAVES; for (int it = gw; it < 96; it += NGW) meta_lora(F, it); }
        int kl_ = 256; asm volatile("" : "+s"(kl_)); GEMM_RUN(pg8::EpiLora, E, ws + WS_LA, 256, ws + WS_WL, 256, MR, 1536, kl_); } SEAM(6);
    if (IN(7)) { FRAME_REFRESH();
        { RwRaw raw; { const int it0 = (int)blockIdx.x; rw_load_raw(raw, F, it0 >> 10, (it0 >> 7) & 7, it0 & 127); }
          for (int it = (int)blockIdx.x; it < 32 * 128; it += F.G) { const int bh = it >> 7, c = it & 127; const int itn = it + F.G, bhn = itn >> 7, cn = itn < 32 * 128 ? (itn & 127) : -1;
              rwkv_item(F, bh >> 3, bh & 7, c, raw, bhn >> 3, bhn & 7, cn); } }
        xcd_barrier(bar);
#ifdef MK_TIME_PHASE
        if (blockIdx.x == 0 && threadIdx.x == 0) ((unsigned long long*)(ws + 16384))[21] = __builtin_amdgcn_s_memrealtime();
#endif
        FRAME_REFRESH();
#ifdef MK_SKIP_CHAIN
        if ((int)blockIdx.x < 64) { if (F.G == 12345) rwkv_chain_wg(F, (int)blockIdx.x >> 1, (int)blockIdx.x & 1); }
#else
        if ((int)blockIdx.x < 64) { rwkv_chain_wg(F, (int)blockIdx.x >> 1, (int)blockIdx.x & 1);
#ifdef MK_TIME_PHASE
            if (blockIdx.x == 0 && threadIdx.x == 0) ((unsigned long long*)(ws + 16384))[23] = __builtin_amdgcn_s_memrealtime();
#endif
        }
#endif
#ifdef MK_SKIP_ATT
        else if (false) {
#else
        else {
#endif
            if ((int)blockIdx.x >= F.G - 32) {
                const int bhl = (int)blockIdx.x - (F.G - 32); RwRaw rawl; rw_load_raw(rawl, F, bhl >> 3, bhl & 7, 128);
                rwkv_item(F, bhl >> 3, bhl & 7, 128, rawl, 0, 0, -1);
                asm volatile("s_waitcnt vmcnt(0)" ::: "memory"); __syncthreads();
                if (threadIdx.x == 0) { __builtin_amdgcn_fence(__ATOMIC_RELEASE, ""); asm volatile("s_waitcnt vmcnt(0)" ::: "memory");
                    __hip_atomic_store((unsigned*)(F.ctl + CW_LASTCHUNK + bhl), 1u, __ATOMIC_RELAXED, __HIP_MEMORY_SCOPE_AGENT); }
                FRAME_REFRESH();
            }
            const int gw = ((int)blockIdx.x - 64) * NWAVES + F.wave, NGW = (F.G - 64) * NWAVES;
            for (int it = gw; it < NB * 8 * (SEQL / 32); it += NGW) { const int head = it & 7, qb = (it >> 3) & 255, b = it >> 11; attn_item(F, args, b, head, qb); }
#ifdef MK_TIME_PHASE
            if (blockIdx.x == MK_TS_WG && threadIdx.x == 0) ((unsigned long long*)(ws + 16384))[24] = __builtin_amdgcn_s_memrealtime();
            if (F.lane == 0 && F.wave == MK_TS_WAVE) atomicMax((unsigned long long*)(ws + 16384) + 26, (unsigned long long)__builtin_amdgcn_s_memrealtime());
#endif
#ifndef MK_SKIP_CONV
            convert_late_weights(F, args, gw, NGW, F.lds);
#endif
#ifdef MK_TIME_PHASE
            if (blockIdx.x == MK_TS_WG && threadIdx.x == 0) ((unsigned long long*)(ws + 16384))[25] = __builtin_amdgcn_s_memrealtime();
            if (F.lane == 0) atomicMax((unsigned long long*)(ws + 16384) + 27, (unsigned long long)__builtin_amdgcn_s_memrealtime());
#endif
            }
        xcd_barrier(bar);
#ifdef MK_TIME_PHASE
        if (blockIdx.x == 0 && threadIdx.x == 0) ((unsigned long long*)(ws + 16384))[22] = __builtin_amdgcn_s_memrealtime();
#endif
        FRAME_REFRESH();
        { const int gw = (int)blockIdx.x * NWAVES + F.wave, NGW = F.G * NWAVES;
          constexpr int T_ = 32 * 128 * 2; OutRaw R;
          if (gw < T_) rwkv_out_load(R, F, gw >> 8, ((gw >> 1) & 127) + 1, gw & 1);
          for (int it = gw; it < T_; it += NGW) { const int ti = it & 1, c = ((it >> 1) & 127) + 1, bh = it >> 8; const int itn = it + NGW < T_ ? it + NGW : it;
              OutRaw N; rwkv_out_load(N, F, itn >> 8, ((itn >> 1) & 127) + 1, itn & 1);
              rwkv_out(F, R, bh, c, ti); R = N; } }
    }
    SEAM(7);
    if (IN(8)) {
        static_assert(WS_WRWKV == WS_WATT + (size_t)DM * 512 * 2, "branch weights adjacent");
        { pg8::EpiPlain E{(pg8::bf16_t*)(ws + WS_GATES), DM, 4, (size_t)MR * DM};
          pg8::Gemm g_{(const pg8::bf16_t*)(ws + WS_Q), (const pg8::bf16_t*)(ws + WS_WATT), MR, 2 * DM, 512, 512, 512, (const pg8::bf16_t*)(ws + WS_F), 4}; pg8::StaticOrder S_; S_.init(MR, 2 * DM, F.G, (int)blockIdx.x);
          pg8::gemm_phase<pg8::EpiPlain, pg8::StaticOrder, true, true>(F.lds + RING_OFF, g_, S_, E); }
    } SEAM(8);
    if (IN(9)) { pg8::EpiGateMerge E{(const float*)(ws + WS_RS2), (pg8::bf16_t*)(ws + WS_MERGED), (const pg8::bf16_t*)(ws + WS_GATES), (const pg8::bf16_t*)(ws + WS_GATES) + (size_t)MR * DM};
        GEMM_RUN(pg8::EpiGateMerge, E, (unsigned char*)F.out, DM, ws + WS_WIN + (size_t)NIN_A * DM * 2, DM, MR, 2048, DM); } SEAM(9);
    if (IN(10)) { pg8::EpiFSS E{(pg8::bf16_t*)(ws + WS_F), (float*)(ws + WS_SS)}; GEMM_RUN(pg8::EpiFSS, E, ws + WS_MERGED, DM, ws + WS_WMIX, DM, MR, DM, DM); } SEAM(10);
#ifdef MK_GEMM_CHECK
    if (IN(10)) { xcd_barrier(bar);
        { pg8::EpiFSS E{(pg8::bf16_t*)(ws + WS_BIG + 192 * MiB), (float*)(ws + WS_BIG + 256 * MiB)}; pg8::Gemm g_{(const pg8::bf16_t*)(ws + WS_MERGED), (const pg8::bf16_t*)(ws + WS_WMIX), MR, DM, DM, DM, DM}; pg8::StaticOrder S_; S_.init(MR, DM, F.G, (int)((blockIdx.x + 37) % gridDim.x));
          pg8::gemm_phase<pg8::EpiFSS, pg8::StaticOrder, true, true>(F.lds + RING_OFF, g_, S_, E); }
        xcd_barrier(bar);
        { FRAME_REFRESH(); const unsigned* a = (const unsigned*)(ws + WS_F); const unsigned* b = (const unsigned*)(ws + WS_BIG + 192 * MiB); unsigned bad = 0;
          for (size_t i = (size_t)blockIdx.x * 512 + F.tid; i < (size_t)MR * DM / 2; i += (size_t)gridDim.x * 512) bad += (a[i] != b[i]) ? 1u : 0u;
          if (bad) atomicAdd((unsigned*)(F.ctl + 900), bad); }
    }
#endif
    if (IN(11)) { FRAME_REFRESH(); row_pass<1>(F, args, inp(23), inp(24), 1.0f); } SEAM(11);
    if (IN(12)) { pg8::EpiSwiGLU E{(pg8::bf16_t*)(ws + WS_HID), (const float*)(ws + WS_RS3)}; GEMM_RUN(pg8::EpiSwiGLU, E, ws + WS_H2, DM, ws + WS_WGU2, DM, MR, NHID2, DM); } SEAM(12);
    if (IN(13)) { pg8::EpiFSS E{(pg8::bf16_t*)(ws + WS_F), (float*)(ws + WS_SS)}; GEMM_RUN(pg8::EpiFSS, E, ws + WS_HID, DFF, ws + WS_WD2, DFF, MR, DM, DFF); } SEAM(13);
    if (IN(14)) { FRAME_REFRESH(); row_pass<2>(F, args, inp(27), inp(27), 0.5f); }
#if defined(MK_GEMM_CHECK) || defined(MK_COH_TEST) || defined(MK_GEMM_CHECK4) || defined(MK_GATE_CHECK) || defined(MK_GATE_SCAN)
    { xcd_barrier(bar); if (blockIdx.x == 0 && threadIdx.x == 0) { const unsigned nb = __hip_atomic_load((unsigned*)(F.ctl + 900), __ATOMIC_RELAXED, __HIP_MEMORY_SCOPE_AGENT); const unsigned nc = __hip_atomic_load((unsigned*)(F.ctl + 901), __ATOMIC_RELAXED, __HIP_MEMORY_SCOPE_AGENT); if (nb) F.out[0] = 1.0e4f; if (nc) { const unsigned msk = __hip_atomic_load((unsigned*)(F.ctl + 902), __ATOMIC_RELAXED, __HIP_MEMORY_SCOPE_AGENT); F.out[1] = 1.0e6f + 1000.f * (float)nc; F.out[2] = 1.0e10f * (float)msk; } } }
#endif
#ifdef MK_ITEM_PROF
    if (blockIdx.x == 0 && threadIdx.x == 0) F.out[0] = 0.001f * (float)((const unsigned long long*)(ws + 32768))[MK_ITEM_PROF];
#endif
#ifdef MK_TIME_PHASE
    if (blockIdx.x == 0 && threadIdx.x == 0) { const unsigned long long* ts = (const unsigned long long*)(ws + 16384); const unsigned long long te = __builtin_amdgcn_s_memrealtime();
        const int kk_ = MK_TIME_PHASE; unsigned long long t0_ = ts[kk_ < 20 ? kk_ : 7], t1 = kk_ == 14 ? te : ts[(kk_ < 20 ? kk_ : 7) + 1];
        if (kk_ == 20) t1 = ts[21]; if (kk_ == 21) { t0_ = ts[21]; t1 = ts[22]; } if (kk_ == 22) t0_ = ts[22]; if (kk_ >= 23 && kk_ <= 27) { t0_ = ts[21]; t1 = ts[kk_]; }
#ifdef MK_TIME_CUM
        t0_ = ts[0];
#endif
        F.out[0] = MK_TIME_SCALE * (float)(t1 - t0_); }
#endif
#ifdef MK_DUMP
    xcd_barrier(bar); dump_phase(ws, F.out);
#endif
#undef IN
#undef SEAM
#undef GEMM_RUN
}


extern "C" void kernel_launch(void* const* d_in, const int* in_sizes, int n_in, void* d_out, int out_size, void* d_ws, size_t ws_size, hipStream_t stream) {
    static int grid = 0;
    if (grid == 0) {
        if (n_in != 28 || in_sizes[0] != MR * DM || out_size != MR * DM || ws_size < WS_END) { fprintf(stderr, "kernel_launch: unexpected shapes / workspace (n_in %d, in0 %d, out %d, ws %zu, need %zu); nothing launched\n", n_in, n_in > 0 ? in_sizes[0] : -1, out_size, ws_size, (size_t)WS_END); grid = -1; return; }
        int dev = 0, cus = 0, per_cu = 0;
        if (hipGetDevice(&dev) != hipSuccess || hipDeviceGetAttribute(&cus, hipDeviceAttributeMultiprocessorCount, dev) != hipSuccess) { grid = -1; return; }
        if (hipFuncSetAttribute((const void*)hybrid_fwd, hipFuncAttributeMaxDynamicSharedMemorySize, LDS_BYTES) != hipSuccess) { fprintf(stderr, "kernel_launch: hipFuncSetAttribute failed\n"); grid = -1; return; }
        if (hipOccupancyMaxActiveBlocksPerMultiprocessor(&per_cu, (const void*)hybrid_fwd, NWAVES * 64, LDS_BYTES) != hipSuccess || per_cu < 1) { fprintf(stderr, "kernel_launch: occupancy query reports %d workgroups per CU\n", per_cu); per_cu = 1; }
        (void)hipGetLastError();
        grid = cus;
        if (grid < 64) { fprintf(stderr, "kernel_launch: %d CUs: too few\n", grid); grid = -1; return; }
    }
    if (grid < 0) return;
    if (hipMemsetAsync((char*)d_ws + WS_CTL, 0, CTL_ZERO_BYTES, stream) != hipSuccess) return;
    Args a{};
    for (int i = 0; i < 28; ++i) a.in[i] = (const float*)d_in[i];
    a.out = (float*)d_out; a.ws = (unsigned char*)d_ws;
#ifndef MK_LAST_PHASE
#define MK_LAST_PHASE (N_PHASES - 1)
#endif
    for (int li = 0; li < N_LAUNCHES && li <= MK_LAST_PHASE; ++li) {
        if (N_LAUNCHES == 1) { a.ph_lo = 0; a.ph_hi = MK_LAST_PHASE + 1; } else { a.ph_lo = li; a.ph_hi = li + 1; }
        a.li = li;
        hipLaunchKernelGGL(hybrid_fwd, dim3(grid), dim3(NWAVES * 64), LDS_BYTES, stream, a);
        const hipError_t le = hipPeekAtLastError();
        if (le != hipSuccess) { fprintf(stderr, "kernel_launch: launch %d failed: %s\n", li, hipGetErrorName(le)); break; }
    }
}
```
